# Optimizing an MI355X kernel written in HIP

```python
import jax, jax.numpy as jnp
from jax import lax
import numpy as np

D_MODEL = 1024
BATCH = 4
SEQ = 4096
DEPTH = 2
DEC_BATCH = 128
DEC_SEQ = 4
PAST_LEN = 16384
PAGE_SIZE = 128

HEAD_DIM = 64
SWA_Q_HEADS = 8
SWA_KV_HEADS = 2
SWA_GROUP = SWA_Q_HEADS // SWA_KV_HEADS
WINDOW = 128
ROPE_THETA = 10000.0
GLA_HEADS = 4
GLA_DK = 64
GLA_DV = 128
GLA_LOWRANK = 16
GLA_GATE_TEMP = 16.0
GLA_CHUNK = 64
MEM_LEN = 256
XA_HEADS = 4
XA_HEAD_DIM = 128
XA_W = XA_HEADS * XA_HEAD_DIM
D_FF = 2816
EPS = 1e-6

SWA_Q_W = SWA_Q_HEADS * HEAD_DIM
SWA_KV_W = SWA_KV_HEADS * HEAD_DIM
GLA_K_W = GLA_HEADS * GLA_DK
GLA_V_W = GLA_HEADS * GLA_DV
MIX_W = SWA_Q_W + GLA_V_W
_IN_WIDTHS = (SWA_Q_W, SWA_KV_W, SWA_KV_W, GLA_K_W, GLA_K_W, GLA_V_W, GLA_V_W, GLA_LOWRANK)
IN_W = sum(_IN_WIDTHS)
IN_SPLITS = tuple(int(s) for s in np.cumsum(_IN_WIDTHS)[:-1])

kernel_name = "hymba_swa_gla_macaron_memxattn_step"


def rms_norm(x, g):
    xf = x.astype(jnp.float32)
    y = xf * lax.rsqrt(jnp.mean(xf * xf, axis=-1, keepdims=True) + EPS)
    return (y * g.astype(jnp.float32)).astype(x.dtype)


def rope(x, pos):
    half = x.shape[-1] // 2
    inv = ROPE_THETA ** (-jnp.arange(half, dtype=jnp.float32) / half)
    ang = pos.astype(jnp.float32)[:, None] * inv[None, :]
    cos = jnp.cos(ang)[None, :, None, :]
    sin = jnp.sin(ang)[None, :, None, :]
    xf = x.astype(jnp.float32)
    x1, x2 = xf[..., :half], xf[..., half:]
    return jnp.concatenate([x1 * cos - x2 * sin, x2 * cos + x1 * sin], axis=-1).astype(x.dtype)


def swiglu(x, wg, wu, wd):
    return (jax.nn.silu(x @ wg) * (x @ wu)) @ wd


def _swa_core(q, kc, vc, sinks, valid):
    s = jnp.einsum('bnqhgd,bnkhd->bnhgqk', q, kc, preferred_element_type=jnp.float32) * HEAD_DIM ** -0.5
    s = jnp.where(valid[None, :, None, None], s, -jnp.inf)
    sink = sinks.astype(jnp.float32).reshape(1, 1, SWA_KV_HEADS, SWA_GROUP, 1, 1)
    m = jnp.maximum(jnp.max(s, axis=-1, keepdims=True), sink)
    e = jnp.exp(s - m)
    pr = e / (jnp.sum(e, axis=-1, keepdims=True) + jnp.exp(sink - m))
    return jnp.einsum('bnhgqk,bnkhd->bnqhgd', pr.astype(vc.dtype), vc)


def swa_prompt(q, k, v, sinks):
    B, T, Hq, D = q.shape
    nb = T // WINDOW
    qb = q.reshape(B, nb, WINDOW, SWA_KV_HEADS, SWA_GROUP, D)

    def band(z):
        zb = z.reshape(B, nb, WINDOW, SWA_KV_HEADS, D)
        prev = jnp.concatenate([jnp.zeros_like(zb[:, :1]), zb[:, :-1]], axis=1)
        return jnp.concatenate([prev, zb], axis=2)

    i = jnp.arange(WINDOW)[:, None]
    j = jnp.arange(2 * WINDOW)[None, :]
    rel = WINDOW + i - j
    n = jnp.arange(nb)[:, None, None]
    valid = ((rel >= 0) & (rel < WINDOW))[None] & ((n > 0) | (j[None] >= WINDOW))
    o = _swa_core(qb, band(k), band(v), sinks, valid)
    return o.reshape(B, T, Hq * D)


def swa_decode(q, kcat, vcat, sinks):
    B, T, Hq, D = q.shape
    Tk = kcat.shape[1]
    i = jnp.arange(T)[:, None]
    j = jnp.arange(Tk)[None, :]
    rel = WINDOW + i - j
    valid = ((rel >= 0) & (rel < WINDOW))[None]
    o = _swa_core(q.reshape(B, 1, T, SWA_KV_HEADS, SWA_GROUP, D), kcat[:, None], vcat[:, None], sinks, valid)
    return o.reshape(B, T, Hq * D)


def gla_chunked(q, k, v, log_a, s0):
    B, T, H, DK = q.shape
    C = min(GLA_CHUNK, T)
    n = T // C

    def to_chunks(z):
        return z.reshape(B, n, C, H, z.shape[-1]).transpose(1, 0, 3, 2, 4)

    causal = jnp.tril(jnp.ones((C, C), dtype=bool))

    def step(S, inp):
        qc, kc, vc, gc = inp
        b = jnp.cumsum(gc, axis=-2)
        b_last = b[..., -1:, :]
        q_t = qc * jnp.exp(b)
        k_t = kc * jnp.exp(-b)
        A = jnp.where(causal, jnp.einsum('bhqd,bhkd->bhqk', q_t, k_t), 0.0)
        o = jnp.einsum('bhqd,bhdv->bhqv', q_t, S) + jnp.einsum('bhqk,bhkv->bhqv', A, vc)
        k_dec = kc * jnp.exp(b_last - b)
        S_new = jnp.exp(b_last)[..., 0, :, None] * S + jnp.einsum('bhkd,bhkv->bhdv', k_dec, vc)
        return S_new, o

    S, o = lax.scan(step, s0, (to_chunks(q), to_chunks(k), to_chunks(v), to_chunks(log_a)))
    o = o.transpose(1, 0, 3, 2, 4).reshape(B, T, H, v.shape[-1])
    return o, S


def hybrid_mix(h, pos, p, swa_cache, gla_state):
    B, T, _ = h.shape
    z = h @ p['w_in']
    q_s, k_s, v_s, q_g, k_g, v_g, g_g, lr = jnp.split(z, IN_SPLITS, axis=-1)
    q_s = rope(rms_norm(q_s.reshape(B, T, SWA_Q_HEADS, HEAD_DIM), p['swa_q_norm']), pos)
    k_s = rope(rms_norm(k_s.reshape(B, T, SWA_KV_HEADS, HEAD_DIM), p['swa_k_norm']), pos)
    v_s = v_s.reshape(B, T, SWA_KV_HEADS, HEAD_DIM)
    if swa_cache is None:
        a_out = swa_prompt(q_s, k_s, v_s, p['swa_sinks'])
        new_k, new_v = k_s[:, -WINDOW:], v_s[:, -WINDOW:]
    else:
        kcat = jnp.concatenate([swa_cache[0].astype(k_s.dtype), k_s], axis=1)
        vcat = jnp.concatenate([swa_cache[1].astype(v_s.dtype), v_s], axis=1)
        a_out = swa_decode(q_s, kcat, vcat, p['swa_sinks'])
        new_k, new_v = kcat[:, -WINDOW:], vcat[:, -WINDOW:]
    qf = q_g.reshape(B, T, GLA_HEADS, GLA_DK).astype(jnp.float32) * GLA_DK ** -0.5
    kf = k_g.reshape(B, T, GLA_HEADS, GLA_DK).astype(jnp.float32)
    vf = v_g.reshape(B, T, GLA_HEADS, GLA_DV).astype(jnp.float32)
    log_a = jax.nn.log_sigmoid((lr @ p['gla_w_gate'] + p['gla_b_gate']).astype(jnp.float32)) / GLA_GATE_TEMP
    log_a = log_a.reshape(B, T, GLA_HEADS, GLA_DK)
    if gla_state is None:
        s0 = jnp.zeros((B, GLA_HEADS, GLA_DK, GLA_DV), jnp.float32)
    else:
        s0 = gla_state.astype(jnp.float32)
    o, S = gla_chunked(qf, kf, vf, log_a, s0)
    o = rms_norm(o, p['gla_out_norm']).astype(h.dtype) * jax.nn.silu(g_g.reshape(B, T, GLA_HEADS, GLA_DV))
    mix = jnp.concatenate([a_out, o.reshape(B, T, GLA_V_W)], axis=-1) @ p['w_out']
    return mix, new_k, new_v, S.astype(h.dtype)


def mem_kv(mem, p):
    Bm, M, _ = mem.shape
    m = rms_norm(mem, p['mem_norm'])
    k = rms_norm((m @ p['xa_wk']).reshape(Bm, M, XA_HEADS, XA_HEAD_DIM), p['xa_k_norm'])
    v = (m @ p['xa_wv']).reshape(Bm, M, XA_HEADS, XA_HEAD_DIM)
    return k, v


def cross_attn(h, mk, mv, p):
    B, T, _ = h.shape
    q = rms_norm((h @ p['xa_wq']).reshape(B, T, XA_HEADS, XA_HEAD_DIM), p['xa_q_norm'])
    s = jnp.einsum('bqhd,bkhd->bhqk', q, mk.astype(q.dtype), preferred_element_type=jnp.float32) * XA_HEAD_DIM ** -0.5
    a = jax.nn.softmax(s, axis=-1).astype(h.dtype)
    o = jnp.einsum('bhqk,bkhd->bqhd', a, mv.astype(h.dtype)).reshape(B, T, XA_W)
    return o @ p['xa_wo']


def decoder_layer(x, pos, p, swa_cache, gla_state, mk, mv):
    x = x + 0.5 * swiglu(rms_norm(x, p['ffn1_norm']), p['ffn1_wg'], p['ffn1_wu'], p['ffn1_wd'])
    mix, nk, nv, S = hybrid_mix(rms_norm(x, p['mix_norm']), pos, p, swa_cache, gla_state)
    x = x + mix
    x = x + cross_attn(rms_norm(x, p['xa_norm']), mk, mv, p)
    x = x + 0.5 * swiglu(rms_norm(x, p['ffn2_norm']), p['ffn2_wg'], p['ffn2_wu'], p['ffn2_wd'])
    return x, nk, nv, S


def setup_inputs(seed: int = 0) -> dict:
    key = jax.random.key(seed)
    ks = iter(jax.random.split(key, 64))
    L = DEPTH

    def nrm(shape, scale=1.0):
        return jax.random.normal(next(ks), shape, jnp.float32) * scale

    def w(shape, fan_in):
        return nrm(shape, fan_in ** -0.5)

    def gain(shape):
        return 1.0 + nrm(shape, 0.02)

    return {
        'x_prompt': nrm((BATCH, SEQ, D_MODEL)),
        'x_sample': nrm((DEC_BATCH, DEC_SEQ, D_MODEL)),
        'cache_swa_k': nrm((L, DEC_BATCH, WINDOW, SWA_KV_HEADS, HEAD_DIM)),
        'cache_swa_v': nrm((L, DEC_BATCH, WINDOW, SWA_KV_HEADS, HEAD_DIM)),
        'state_gla': nrm((L, DEC_BATCH, GLA_HEADS, GLA_DK, GLA_DV)),
        'cache_mem_k': nrm((L, DEC_BATCH, MEM_LEN, XA_HEADS, XA_HEAD_DIM)),
        'cache_mem_v': nrm((L, DEC_BATCH, MEM_LEN, XA_HEADS, XA_HEAD_DIM)),
        'mem_prompt': nrm((BATCH, MEM_LEN, D_MODEL)),
        'ffn1_norm': gain((L, D_MODEL)),
        'ffn1_wg': w((L, D_MODEL, D_FF), D_MODEL),
        'ffn1_wu': w((L, D_MODEL, D_FF), D_MODEL),
        'ffn1_wd': w((L, D_FF, D_MODEL), D_FF),
        'mix_norm': gain((L, D_MODEL)),
        'w_in': w((L, D_MODEL, IN_W), D_MODEL),
        'swa_q_norm': gain((L, HEAD_DIM)),
        'swa_k_norm': gain((L, HEAD_DIM)),
        'swa_sinks': nrm((L, SWA_Q_HEADS), 0.5),
        'gla_w_gate': w((L, GLA_LOWRANK, GLA_K_W), GLA_LOWRANK),
        'gla_b_gate': nrm((L, GLA_K_W), 0.1),
        'gla_out_norm': gain((L, GLA_DV)),
        'w_out': w((L, MIX_W, D_MODEL), MIX_W),
        'xa_norm': gain((L, D_MODEL)),
        'mem_norm': gain((L, D_MODEL)),
        'xa_wq': w((L, D_MODEL, XA_W), D_MODEL),
        'xa_wk': w((L, D_MODEL, XA_W), D_MODEL),
        'xa_wv': w((L, D_MODEL, XA_W), D_MODEL),
        'xa_q_norm': gain((L, XA_HEAD_DIM)),
        'xa_k_norm': gain((L, XA_HEAD_DIM)),
        'xa_wo': w((L, XA_W, D_MODEL), XA_W),
        'ffn2_norm': gain((L, D_MODEL)),
        'ffn2_wg': w((L, D_MODEL, D_FF), D_MODEL),
        'ffn2_wu': w((L, D_MODEL, D_FF), D_MODEL),
        'ffn2_wd': w((L, D_FF, D_MODEL), D_FF),
    }


def reference(x_prompt, x_sample, cache_swa_k, cache_swa_v, state_gla, cache_mem_k, cache_mem_v,
              mem_prompt, ffn1_norm, ffn1_wg, ffn1_wu, ffn1_wd, mix_norm, w_in, swa_q_norm,
              swa_k_norm, swa_sinks, gla_w_gate, gla_b_gate, gla_out_norm, w_out, xa_norm, mem_norm,
              xa_wq, xa_wk, xa_wv, xa_q_norm, xa_k_norm, xa_wo, ffn2_norm, ffn2_wg, ffn2_wu, ffn2_wd):
    pos_p = jnp.arange(x_prompt.shape[1])
    pos_s = PAST_LEN + jnp.arange(x_sample.shape[1])
    yp, ys = x_prompt, x_sample
    kp_l, vp_l, sp_l, mkp_l, mvp_l, ks_l, vs_l, ss_l = [], [], [], [], [], [], [], []
    for l in range(DEPTH):
        p = {name: arr[l] for name, arr in (
            ('ffn1_norm', ffn1_norm), ('ffn1_wg', ffn1_wg), ('ffn1_wu', ffn1_wu), ('ffn1_wd', ffn1_wd),
            ('mix_norm', mix_norm), ('w_in', w_in), ('swa_q_norm', swa_q_norm), ('swa_k_norm', swa_k_norm),
            ('swa_sinks', swa_sinks), ('gla_w_gate', gla_w_gate), ('gla_b_gate', gla_b_gate),
            ('gla_out_norm', gla_out_norm), ('w_out', w_out), ('xa_norm', xa_norm), ('mem_norm', mem_norm),
            ('xa_wq', xa_wq), ('xa_wk', xa_wk), ('xa_wv', xa_wv), ('xa_q_norm', xa_q_norm),
            ('xa_k_norm', xa_k_norm), ('xa_wo', xa_wo), ('ffn2_norm', ffn2_norm), ('ffn2_wg', ffn2_wg),
            ('ffn2_wu', ffn2_wu), ('ffn2_wd', ffn2_wd))}
        mk_p, mv_p = mem_kv(mem_prompt, p)
        yp, kp, vp, sp = decoder_layer(yp, pos_p, p, None, None, mk_p, mv_p)
        ys, kss, vss, sss = decoder_layer(ys, pos_s, p, (cache_swa_k[l], cache_swa_v[l]), state_gla[l],
                                         cache_mem_k[l], cache_mem_v[l])
        kp_l.append(kp); vp_l.append(vp); sp_l.append(sp); mkp_l.append(mk_p); mvp_l.append(mv_p)
        ks_l.append(kss); vs_l.append(vss); ss_l.append(sss)
    return (yp, ys, jnp.stack(kp_l), jnp.stack(vp_l), jnp.stack(sp_l), jnp.stack(mkp_l), jnp.stack(mvp_l),
            jnp.stack(ks_l), jnp.stack(vs_l), jnp.stack(ss_l))
```

```cpp
#include <hip/hip_runtime.h>
#include <hip/hip_cooperative_groups.h>
#include <cstdio>
#include <cstdint>
namespace cg = cooperative_groups;

#define LAS __attribute__((address_space(3)))
#define DI __device__ __forceinline__
typedef unsigned short bf16_t;
typedef short bf16x8 __attribute__((ext_vector_type(8)));
typedef float f32x4 __attribute__((ext_vector_type(4)));
typedef unsigned u32x4 __attribute__((ext_vector_type(4)));
typedef unsigned u32x2 __attribute__((ext_vector_type(2)));
typedef short v4i16_t __attribute__((ext_vector_type(4)));
#define MFMA16(a, b, c) __builtin_amdgcn_mfma_f32_16x16x32_bf16((a), (b), (c), 0, 0, 0)

constexpr int TP = 16384, TS = 512, T = TP + TS, DM = 1024, FF = 2816, SEQ = 4096;
constexpr int INWP = 2560;
constexpr float EPS = 1e-6f;
constexpr size_t O_Y = 0, O_KP = 17301504, O_VP = 17432576, O_GP = 17563648, O_MKP = 17825792, O_MVP = 18874368, O_KS = 19922944, O_VS = 24117248, O_GS = 28311552;
constexpr size_t al(size_t x) { return (x + 4095) & ~(size_t)4095; }
constexpr size_t WS_RSS = 0;
constexpr size_t WS_RSSM = al(WS_RSS + (size_t)9 * T * 4);
constexpr size_t WS_ROPE = al(WS_RSSM + 1024 * 4);
constexpr size_t WS_XB = al(WS_ROPE + (size_t)4100 * 32 * 8);
constexpr size_t WS_H = al(WS_XB + (size_t)T * 1024 * 2);
constexpr size_t WS_QS = al(WS_H + (size_t)T * FF * 2);
constexpr size_t WS_KS = al(WS_QS + (size_t)T * 512 * 2);
constexpr size_t WS_VS = al(WS_KS + (size_t)T * 128 * 2);
constexpr size_t WS_ZG = al(WS_VS + (size_t)T * 128 * 2);
constexpr size_t WS_LR = al(WS_ZG + (size_t)T * 1536 * 2);
constexpr size_t WS_MIX = al(WS_LR + (size_t)T * 16 * 4);
constexpr size_t WS_QX = al(WS_MIX + (size_t)T * 1024 * 2);
constexpr size_t WS_OX = al(WS_QX + (size_t)T * 512 * 2);
constexpr size_t WS_MEMB = al(WS_OX + (size_t)T * 512 * 2);
constexpr size_t WS_MKV = al(WS_MEMB + (size_t)1024 * 1024 * 2);
constexpr size_t WS_BCUM = al(WS_MKV + (size_t)1024 * 2048 * 4);
constexpr size_t WS_ST = al(WS_BCUM + (size_t)TP * 256 * 4);
constexpr size_t WS_VT = al(WS_ST + (size_t)1024 * 8192 * 4);
constexpr size_t WS_DEC = al(WS_VT + (size_t)1024 * 8192 * 2);
constexpr size_t WS_WKV = al(WS_DEC + (size_t)1024 * 64 * 4);
constexpr size_t WS_WL = al(WS_WKV + (size_t)2048 * 1024 * 2);
constexpr size_t WL_W1 = 0;
constexpr size_t WL_WD1 = WL_W1 + (size_t)5632 * 1024 * 2;
constexpr size_t WL_WIN = WL_WD1 + (size_t)1024 * FF * 2;
constexpr size_t WL_WOUT = WL_WIN + (size_t)INWP * 1024 * 2;
constexpr size_t WL_WQ = WL_WOUT + (size_t)1024 * 1024 * 2;
constexpr size_t WL_WO = WL_WQ + (size_t)512 * 1024 * 2;
constexpr size_t WL_W2 = WL_WO + (size_t)1024 * 512 * 2;
constexpr size_t WL_WD2 = WL_W2 + (size_t)5632 * 1024 * 2;
constexpr size_t WL_SIZE = al(WL_WD2 + (size_t)1024 * FF * 2);
constexpr size_t WS_STB = WS_WL + 2 * WL_SIZE;
constexpr size_t WS_BAR = al(WS_STB + (size_t)1024 * 8192 * 2);
constexpr size_t WS_TOTAL = WS_BAR + 16384;
constexpr int LDS_BYTES = 147456;
constexpr int REP_GEMM = 1, REP_ATT = 1, REP_P0 = 1, REP_SYNC = 1, REP3 = 1, REP4 = 1, REP5 = 1, REP8 = 1;

DI float bf2f(unsigned h) { return __builtin_bit_cast(float, h << 16); }
typedef float f32x2_t __attribute__((ext_vector_type(2)));
typedef __bf16 bf16x2_t __attribute__((ext_vector_type(2)));
DI unsigned pk2(float lo, float hi) { const f32x2_t v = {lo, hi}; const bf16x2_t b = __builtin_convertvector(v, bf16x2_t); return __builtin_bit_cast(unsigned, b); }
DI float blo(unsigned w) { return __builtin_bit_cast(float, w << 16); }
DI float bhi(unsigned w) { return __builtin_bit_cast(float, w & 0xffff0000u); }
DI float silu(float x) { return x * __builtin_amdgcn_rcpf(1.f + __builtin_amdgcn_exp2f(x * -1.4426950408889634f)); }
DI float logsig(float x) { return fminf(x, 0.f) - log1pf(__expf(-fabsf(x))); }

#define XB_TMO      128
#define XB_XCNT(j)  (256  + 64 * (j))
#define XB_XSUB(j)  (1280 + 64 * (j))
#define XB_XGEN(j)  (2304 + 64 * (j))
#define XB_TOP      3328
#define XB_TOPGEN   3392
#define XCD_BAR_WORDS 3456
#define XB_SPIN_CAP (1u << 18)
DI unsigned xb_ld(unsigned* p)              { return __hip_atomic_load(p, __ATOMIC_RELAXED, __HIP_MEMORY_SCOPE_AGENT); }
DI unsigned xb_add(unsigned* p, unsigned v) { return __hip_atomic_fetch_add(p, v, __ATOMIC_RELAXED, __HIP_MEMORY_SCOPE_AGENT); }
DI unsigned xb_xcc_id() { return (unsigned)__builtin_amdgcn_s_getreg((3 << 11) | 20) & 0xFu; }
#define XB_SPIN(cond, bar) do { unsigned _sp = 0; while (cond) { __builtin_amdgcn_s_sleep(1); \
    if ((++_sp & 255u) == 0u) { if (xb_ld(&(bar)[XB_TMO])) break; if (_sp > XB_SPIN_CAP) { atomicAdd(&(bar)[XB_TMO], 1u); break; } } } } while (0)
struct XcdBarrier { unsigned* bar; unsigned x; volatile LAS unsigned* st; };
DI XcdBarrier xcd_barrier_post(unsigned* bar, volatile LAS unsigned* st) {
    XcdBarrier b; b.bar = bar; b.x = xb_xcc_id(); b.st = st;
    if (threadIdx.x == 0) (void)xb_add(&bar[XB_XCNT(b.x)], 1u);
    return b;
}
DI void xcd_barrier_complete(unsigned* bar, unsigned x, unsigned& nloc, unsigned& nx) {
    const unsigned G = gridDim.x * gridDim.y * gridDim.z;
    unsigned sum, cnt, mine, sp = 0u;
    for (;;) {
        sum = 0u; cnt = 0u; mine = 0u;
#pragma unroll
        for (unsigned j = 0; j < 16; ++j) { const unsigned c = xb_ld(&bar[XB_XCNT(j)]); sum += c; cnt += (c > 0u) ? 1u : 0u; mine = (j == x) ? c : mine; }
        if (sum == G) break;
        __builtin_amdgcn_s_sleep(1);
        if ((++sp & 255u) == 0u) { if (xb_ld(&bar[XB_TMO])) break; if (sp > XB_SPIN_CAP) { atomicAdd(&bar[XB_TMO], 1u); break; } }
    }
    nloc = mine > 0u ? mine : 1u; nx = cnt > 0u ? cnt : 1u;
}
DI void xcd_barrier(const XcdBarrier& b) {
    asm volatile("s_waitcnt vmcnt(0)" ::: "memory");
    __syncthreads();
    if (threadIdx.x == 0) {
        unsigned* bar = b.bar;
        __builtin_amdgcn_s_waitcnt(0);
        unsigned nloc = b.st[0], nx = b.st[1];
        if (nloc == 0u) { xcd_barrier_complete(bar, b.x, nloc, nx); b.st[0] = nloc; b.st[1] = nx; }
        const unsigned old = xb_add(&bar[XB_XSUB(b.x)], 1u);
        const unsigned gen = old / nloc;
        if (old + 1u == (gen + 1u) * nloc) {
            __builtin_amdgcn_fence(__ATOMIC_RELEASE, "agent");
            asm volatile("s_waitcnt vmcnt(0)" ::: "memory");
            const unsigned og = xb_add(&bar[XB_TOP], 1u);
            const unsigned tg = og / nx;
            if (og + 1u == (tg + 1u) * nx) xb_add(&bar[XB_TOPGEN], 1u);
            else XB_SPIN(xb_ld(&bar[XB_TOPGEN]) == tg, bar);
            __builtin_amdgcn_fence(__ATOMIC_ACQUIRE, "agent");
            xb_add(&bar[XB_XGEN(b.x)], 1u);
            asm volatile("s_waitcnt vmcnt(0)" ::: "memory");
        } else {
            XB_SPIN(xb_ld(&bar[XB_XGEN(b.x)]) == gen, bar);
            __builtin_amdgcn_fence(__ATOMIC_ACQUIRE, "agent");
            asm volatile("s_waitcnt vmcnt(0)" ::: "memory");
        }
    }
    __syncthreads();
}

namespace pg8 {
constexpr int BM = 256, BK = 64, HALF = 128, HTB = HALF * BK * 2, STAGE_BYTES = 8 * HTB, NXCD = 8, WGM = 8;
DI int lds_byte(int r, int c) { const int st = (r >> 4) * 2 + (c >> 5), rr = r & 15, cc = c & 31, ob = rr * 64 + cc * 2; return st * 1024 + (ob ^ (((ob >> 9) & 1) << 5)); }
DI void stage_rc(int b, int& R, int& C) { const int st = b / 1024, sb = b % 1024, swz = sb ^ (((sb >> 9) & 1) << 5); R = (st >> 1) * 16 + swz / 64; C = (st & 1) * 32 + (swz % 64) / 2; }
DI int perm32(int rho) { const int n = rho >> 4, i = rho & 15; return 8 * (i >> 2) + 4 * n + (i & 3); }
struct Unit { int pm, pn; };
struct Gemm { const bf16_t* A; const bf16_t* Bt; int M, N, K; };
struct StaticOrder {
    int nM, nN, nwg, G, c;
    DI void init(int M, int N, int G_, int c_) { nM = M / BM; nN = N / BM; nwg = nM * nN; G = G_; c = c_; }
    DI bool next(int i, Unit& u) const {
        const long L = (long)i * G + c; if (L >= nwg) return false;
        int wgid = (int)L; { const int q = nwg / NXCD, r = nwg % NXCD, xcd = wgid % NXCD, off = wgid / NXCD; wgid = (xcd < r ? xcd * (q + 1) : r * (q + 1) + (xcd - r) * q) + off; }
        const int nig = WGM * nN, gid = wgid / nig, fm = gid * WGM, gsz = (nM - fm) < WGM ? (nM - fm) : WGM;
        u.pm = fm + ((wgid % nig) % gsz); u.pn = (wgid % nig) / gsz; return true;
    }
};
template <class Epi, class Sched>
DI void gemm_phase(LAS unsigned char* lds, const int tid, const Gemm g, const Sched& S, const Epi& E) {
    const int wid = __builtin_amdgcn_readfirstlane(tid >> 6), lane = tid & 63, wr = wid >> 2, wc = wid & 3, fr = lane & 15, fq = lane >> 4;
    const int K = g.K, nt = K / BK;
    unsigned voffA[2], voffB[2];
#pragma unroll
    for (int i = 0; i < 2; ++i) { int R, C; stage_rc(tid * 16 + i * 8192, R, C); const int Rb = (R & ~31) + perm32(R & 31);
        voffA[i] = (unsigned)(R * K + C) * 2u; voffB[i] = (unsigned)(Rb * K + C) * 2u; }
    const size_t kstep = (size_t)(BK * 2);
    const size_t hstep = (size_t)HALF * K * 2;
    const size_t tstep = 2 * hstep;
    const unsigned ldsw = (unsigned)wid * 1024u;
    const int aoff = lds_byte(wr * 64 + fr, fq * 8), boff = lds_byte(wc * 32 + fr, fq * 8);
#define PG8_SA(b, h) (((b) * 2 + (h)) * HTB)
#define PG8_SB(b, h) ((4 + (b) * 2 + (h)) * HTB)
#define PG8_STAGE(bufoff, gbase, voff) do { _Pragma("unroll") for (int _i = 0; _i < 2; ++_i) \
        __builtin_amdgcn_global_load_lds((const unsigned*)((const char*)(gbase) + (voff)[_i]), (LAS unsigned*)(lds + (bufoff) + ldsw + _i * 8192), 16, 0, 0); } while (0)
#define PG8_LDA(dst, b, h) do { _Pragma("unroll") for (int m = 0; m < 4; ++m) _Pragma("unroll") for (int k = 0; k < 2; ++k) dst[m][k] = *(const LAS bf16x8*)(lds + PG8_SA(b, h) + aoff + m * 2048 + k * 1024); } while (0)
#define PG8_LDB(dst, b, h) do { _Pragma("unroll") for (int n = 0; n < 2; ++n) _Pragma("unroll") for (int k = 0; k < 2; ++k) dst[n][k] = *(const LAS bf16x8*)(lds + PG8_SB(b, h) + boff + n * 2048 + k * 1024); } while (0)
#define PG8_MMA(ai, bj, At, Bt) do { __builtin_amdgcn_s_setprio(1); _Pragma("unroll") for (int m = 0; m < 4; ++m) _Pragma("unroll") for (int n = 0; n < 2; ++n) _Pragma("unroll") for (int k = 0; k < 2; ++k) \
        acc[ai][bj][m][n] = __builtin_amdgcn_mfma_f32_16x16x32_bf16(Bt[n][k], At[m][k], acc[ai][bj][m][n], 0, 0, 0); __builtin_amdgcn_s_setprio(0); } while (0)
#define PG8_WAIT_V(n) asm volatile("s_waitcnt vmcnt(" #n ")" ::: "memory")
#define PG8_WAIT_L(n) asm volatile("s_waitcnt lgkmcnt(" #n ")" ::: "memory")
#define PG8_BAR __builtin_amdgcn_s_barrier()
#define PG8_SCHED __builtin_amdgcn_sched_barrier(0)
    Unit cur, nxt; int ui = 0;
    if (!S.next(0, cur)) return;
    f32x4 acc[2][2][4][2];
#pragma unroll
    for (int a = 0; a < 2; ++a)
#pragma unroll
        for (int b = 0; b < 2; ++b)
#pragma unroll
            for (int m = 0; m < 4; ++m)
#pragma unroll
                for (int n = 0; n < 2; ++n) acc[a][b][m][n] = (f32x4){0.f, 0.f, 0.f, 0.f};
    bf16x8 At[4][2], B0[2][2], B1[2][2];
    const char* cA = (const char*)g.A + (size_t)cur.pm * tstep; const char* cB = (const char*)g.Bt + (size_t)cur.pn * tstep;
    PG8_STAGE(PG8_SB(0, 0), cB, voffB); PG8_STAGE(PG8_SB(0, 1), cB + hstep, voffB); PG8_STAGE(PG8_SA(0, 0), cA, voffA); PG8_STAGE(PG8_SA(0, 1), cA + hstep, voffA);
    if (wr == 1) PG8_BAR;
    PG8_WAIT_V(2); PG8_BAR;
    PG8_STAGE(PG8_SB(1, 0), cB + kstep, voffB); PG8_STAGE(PG8_SA(1, 0), cA + kstep, voffA); PG8_STAGE(PG8_SB(1, 1), cB + hstep + kstep, voffB);
    PG8_WAIT_V(6); PG8_BAR;
    for (;;) {
        const bool has_next = S.next(ui + 1, nxt);
        const char* nA = has_next ? (const char*)g.A + (size_t)nxt.pm * tstep : cA; const char* nB = has_next ? (const char*)g.Bt + (size_t)nxt.pn * tstep : cB;
        for (int t = 0; t < nt; t += 2) {
            const bool last = (t == nt - 2);
            const char* a1 = cA + (size_t)(t + 1) * kstep;
            const char* a2 = last ? nA : cA + (size_t)(t + 2) * kstep; const char* b2 = last ? nB : cB + (size_t)(t + 2) * kstep;
            const char* a3 = a2 + kstep; const char* b3 = b2 + kstep;
            PG8_LDB(B0, 0, 0); PG8_LDB(B1, 0, 1); PG8_SCHED; PG8_LDA(At, 0, 0); PG8_STAGE(PG8_SA(1, 1), a1 + hstep, voffA);
            PG8_WAIT_V(8); PG8_WAIT_L(0); PG8_BAR; PG8_MMA(0, 0, At, B0); PG8_MMA(0, 1, At, B1); PG8_BAR; PG8_SCHED;
            PG8_LDA(At, 0, 1); PG8_STAGE(PG8_SB(0, 0), b2, voffB); PG8_STAGE(PG8_SB(0, 1), b2 + hstep, voffB); PG8_STAGE(PG8_SA(0, 0), a2, voffA);
            PG8_WAIT_V(8); PG8_WAIT_L(0); PG8_BAR; PG8_MMA(1, 0, At, B0); PG8_MMA(1, 1, At, B1); PG8_BAR; PG8_SCHED;
            PG8_LDB(B0, 1, 0); PG8_LDB(B1, 1, 1); PG8_SCHED; PG8_LDA(At, 1, 0); PG8_STAGE(PG8_SA(0, 1), a2 + hstep, voffA);
            PG8_WAIT_V(8); PG8_WAIT_L(0); PG8_BAR; PG8_MMA(0, 0, At, B0); PG8_MMA(0, 1, At, B1); PG8_BAR; PG8_SCHED;
            PG8_LDA(At, 1, 1); PG8_STAGE(PG8_SB(1, 0), b3, voffB); PG8_STAGE(PG8_SB(1, 1), b3 + hstep, voffB); PG8_STAGE(PG8_SA(1, 0), a3, voffA);
            PG8_WAIT_V(8); PG8_WAIT_L(0); PG8_BAR; PG8_MMA(1, 0, At, B0); PG8_MMA(1, 1, At, B1); PG8_BAR; PG8_SCHED;
        }
        if (wr == 0) PG8_BAR;
        E(acc, cur, wr, wc, fr, fq);
        if (!has_next) break;
#pragma unroll
        for (int a = 0; a < 2; ++a)
#pragma unroll
            for (int b = 0; b < 2; ++b)
#pragma unroll
                for (int m = 0; m < 4; ++m)
#pragma unroll
                    for (int n = 0; n < 2; ++n) acc[a][b][m][n] = (f32x4){0.f, 0.f, 0.f, 0.f};
        cur = nxt; cA = nA; cB = nB; ++ui;
        if (wr == 1) PG8_BAR;
    }
    PG8_WAIT_V(0);
    PG8_BAR;
#undef PG8_SA
#undef PG8_SB
#undef PG8_STAGE
#undef PG8_LDA
#undef PG8_LDB
#undef PG8_MMA
#undef PG8_WAIT_V
#undef PG8_WAIT_L
#undef PG8_BAR
#undef PG8_SCHED
}
}

struct EpiCtx {
    const float* rss_in; float* rss_out; float* X; bf16_t* XB; bf16_t* H;
    bf16_t *QS, *KS, *VS, *ZG; float* LR; const float2* rope; const float *gq, *gk;
    float *okp, *ovp, *oks, *ovs; bf16_t* QX; float* MKV; float scale; int l;
};
enum { EK_SWIGLU = 0, EK_RES = 1, EK_WIN = 2, EK_XQ = 3, EK_MEM = 4 };
template <int KIND> struct Epi {
    EpiCtx c;
    DI void operator()(const f32x4 (&acc)[2][2][4][2], const pg8::Unit& u, int wr, int wc, int fr, int fq) const {
        const int row0 = u.pm * 256 + wr * 64 + fr;
        const int cl = wc * 32 + 8 * fq;
        if constexpr (KIND == EK_RES) {
            u32x4 xo[2][4][2];
#pragma unroll
            for (int ai = 0; ai < 2; ++ai)
#pragma unroll
                for (int m = 0; m < 4; ++m)
#pragma unroll
                    for (int bj = 0; bj < 2; ++bj) xo[ai][m][bj] = *(const u32x4*)(c.XB + (size_t)(row0 + ai * 128 + m * 16) * DM + u.pn * 256 + bj * 128 + cl);
#pragma unroll
            for (int ai = 0; ai < 2; ++ai)
#pragma unroll
                for (int m = 0; m < 4; ++m) {
                    const int r = row0 + ai * 128 + m * 16;
                    float ss = 0.f;
#pragma unroll
                    for (int bj = 0; bj < 2; ++bj) {
                        bf16_t* xb = c.XB + (size_t)r * DM + u.pn * 256 + bj * 128 + cl;
                        const u32x4 xv = xo[ai][m][bj];
                        f32x4 x0 = (f32x4){blo(xv[0]), bhi(xv[0]), blo(xv[1]), bhi(xv[1])}, x1 = (f32x4){blo(xv[2]), bhi(xv[2]), blo(xv[3]), bhi(xv[3])};
                        x0 = x0 + acc[ai][bj][m][0] * c.scale; x1 = x1 + acc[ai][bj][m][1] * c.scale;
                        if (c.X) { float* xp = c.X + (size_t)r * DM + u.pn * 256 + bj * 128 + cl; *(f32x4*)xp = x0; *(f32x4*)(xp + 4) = x1; }
                        else {
                            u32x4 w; w.x = pk2(x0[0], x0[1]); w.y = pk2(x0[2], x0[3]); w.z = pk2(x1[0], x1[1]); w.w = pk2(x1[2], x1[3]);
                            *(u32x4*)xb = w;
#pragma unroll
                            for (int e = 0; e < 4; ++e) { const float a0 = blo(w[e]), a1 = bhi(w[e]); ss += a0 * a0 + a1 * a1; }
                        }
                    }
                    if (!c.X) { ss += __shfl_xor(ss, 16); ss += __shfl_xor(ss, 32); if (fq == 0) atomicAdd(c.rss_out + r, ss); }
                }
            return;
        }
#pragma unroll
        for (int ai = 0; ai < 2; ++ai)
#pragma unroll
            for (int m = 0; m < 4; ++m) {
                const int r = row0 + ai * 128 + m * 16;
                if constexpr (KIND == EK_SWIGLU) {
                    const float rs = rsqrtf(c.rss_in[r] * (1.f / 1024.f) + EPS);
                    const float rsn = rs * -1.4426950408889634f, rs2 = rs * rs;
                    float hv[8];
#pragma unroll
                    for (int n = 0; n < 2; ++n)
#pragma unroll
                        for (int j = 0; j < 4; ++j) { const float g0 = acc[ai][0][m][n][j], u0 = acc[ai][1][m][n][j];
                            hv[n * 4 + j] = (g0 * u0) * rs2 * __builtin_amdgcn_rcpf(1.f + __builtin_amdgcn_exp2f(g0 * rsn)); }
                    u32x4 w; w.x = pk2(hv[0], hv[1]); w.y = pk2(hv[2], hv[3]); w.z = pk2(hv[4], hv[5]); w.w = pk2(hv[6], hv[7]);
                    *(u32x4*)(c.H + (size_t)r * FF + u.pn * 128 + cl) = w;
                } else if constexpr (KIND == EK_XQ) {
                    const float rs = rsqrtf(c.rss_in[r] * (1.f / 1024.f) + EPS);
#pragma unroll
                    for (int bj = 0; bj < 2; ++bj) {
                        const f32x4 a0 = acc[ai][bj][m][0] * rs, a1 = acc[ai][bj][m][1] * rs;
                        u32x4 w; w.x = pk2(a0[0], a0[1]); w.y = pk2(a0[2], a0[3]); w.z = pk2(a1[0], a1[1]); w.w = pk2(a1[2], a1[3]);
                        *(u32x4*)(c.QX + (size_t)r * 512 + u.pn * 256 + bj * 128 + cl) = w;
                    }
                } else if constexpr (KIND == EK_MEM) {
                    const float rs = rsqrtf(c.rss_in[r] * (1.f / 1024.f) + EPS);
#pragma unroll
                    for (int bj = 0; bj < 2; ++bj) {
                        float* p = c.MKV + (size_t)r * 2048 + u.pn * 256 + bj * 128 + cl;
                        *(f32x4*)p = acc[ai][bj][m][0] * rs; *(f32x4*)(p + 4) = acc[ai][bj][m][1] * rs;
                    }
                } else {
                    const float rs = rsqrtf(c.rss_in[r] * (1.f / 1024.f) + EPS);
                    const int pn = u.pn;
                    if (pn < 2 || (pn == 2 && wc < 2)) {
                        const bool isq = pn < 2; const int head = isq ? (4 * pn + wc) : wc;
                        const float* gn = isq ? c.gq : c.gk;
                        float ss = 0.f;
#pragma unroll
                        for (int bj = 0; bj < 2; ++bj)
#pragma unroll
                            for (int n = 0; n < 2; ++n)
#pragma unroll
                                for (int j = 0; j < 4; ++j) { const float v = acc[ai][bj][m][n][j] * rs; ss += v * v; }
                        ss += __shfl_xor(ss, 16); ss += __shfl_xor(ss, 32);
                        const float rq = rsqrtf(ss * (1.f / 64.f) + EPS) * rs;
                        const int ridx = r < TP ? (r & (SEQ - 1)) : (4096 + (r & 3));
                        const float2* rp = c.rope + (size_t)ridx * 32 + 8 * fq;
                        float o1[8], o2[8];
#pragma unroll
                        for (int n = 0; n < 2; ++n)
#pragma unroll
                            for (int j = 0; j < 4; ++j) {
                                const int d = 8 * fq + 4 * n + j; const float2 cs = rp[4 * n + j];
                                const float y1 = acc[ai][0][m][n][j] * rq * gn[d], y2 = acc[ai][1][m][n][j] * rq * gn[32 + d];
                                o1[4 * n + j] = y1 * cs.x - y2 * cs.y; o2[4 * n + j] = y2 * cs.x + y1 * cs.y;
                            }
                        u32x4 w1, w2; w1.x = pk2(o1[0], o1[1]); w1.y = pk2(o1[2], o1[3]); w1.z = pk2(o1[4], o1[5]); w1.w = pk2(o1[6], o1[7]);
                        w2.x = pk2(o2[0], o2[1]); w2.y = pk2(o2[2], o2[3]); w2.z = pk2(o2[4], o2[5]); w2.w = pk2(o2[6], o2[7]);
                        if (isq) { bf16_t* p = c.QS + (size_t)r * 512 + head * 64 + 8 * fq; *(u32x4*)p = w1; *(u32x4*)(p + 32) = w2; }
                        else {
                            bf16_t* p = c.KS + (size_t)r * 128 + head * 64 + 8 * fq; *(u32x4*)p = w1; *(u32x4*)(p + 32) = w2;
                            float* op = nullptr;
                            if (r < TP) { const int t = r & (SEQ - 1); if (t >= SEQ - 128) op = c.okp + ((size_t)((c.l * 4 + (r >> 12)) * 128 + (t - (SEQ - 128)))) * 128; }
                            else { const int rr = r - TP; op = c.oks + ((size_t)((c.l * 128 + (rr >> 2)) * 128 + 124 + (rr & 3))) * 128; }
                            if (op) { op += head * 64 + 8 * fq;
                                *(f32x4*)op = (f32x4){o1[0], o1[1], o1[2], o1[3]}; *(f32x4*)(op + 4) = (f32x4){o1[4], o1[5], o1[6], o1[7]};
                                *(f32x4*)(op + 32) = (f32x4){o2[0], o2[1], o2[2], o2[3]}; *(f32x4*)(op + 36) = (f32x4){o2[4], o2[5], o2[6], o2[7]}; }
                        }
                    } else if (pn == 2) {
                        const int head = wc - 2;
                        float* op = nullptr;
                        if (r < TP) { const int t = r & (SEQ - 1); if (t >= SEQ - 128) op = c.ovp + ((size_t)((c.l * 4 + (r >> 12)) * 128 + (t - (SEQ - 128)))) * 128; }
                        else { const int rr = r - TP; op = c.ovs + ((size_t)((c.l * 128 + (rr >> 2)) * 128 + 124 + (rr & 3))) * 128; }
#pragma unroll
                        for (int bj = 0; bj < 2; ++bj) {
                            const f32x4 a0 = acc[ai][bj][m][0] * rs, a1 = acc[ai][bj][m][1] * rs;
                            u32x4 w; w.x = pk2(a0[0], a0[1]); w.y = pk2(a0[2], a0[3]); w.z = pk2(a1[0], a1[1]); w.w = pk2(a1[2], a1[3]);
                            *(u32x4*)(c.VS + (size_t)r * 128 + head * 64 + 32 * bj + 8 * fq) = w;
                            if (op) { float* q = op + head * 64 + 32 * bj + 8 * fq; *(f32x4*)q = a0; *(f32x4*)(q + 4) = a1; }
                        }
                    } else if (pn < 9) {
#pragma unroll
                        for (int bj = 0; bj < 2; ++bj) {
                            const f32x4 a0 = acc[ai][bj][m][0] * rs, a1 = acc[ai][bj][m][1] * rs;
                            u32x4 w; w.x = pk2(a0[0], a0[1]); w.y = pk2(a0[2], a0[3]); w.z = pk2(a1[0], a1[1]); w.w = pk2(a1[2], a1[3]);
                            *(u32x4*)(c.ZG + (size_t)r * 1536 + (pn - 3) * 256 + bj * 128 + cl) = w;
                        }
                    } else {
                        if (wc == 0 && fq < 2) { float* p = c.LR + (size_t)r * 16 + 8 * fq; *(f32x4*)p = acc[ai][0][m][0] * rs; *(f32x4*)(p + 4) = acc[ai][0][m][1] * rs; }
                    }
                }
            }
    }
};

template <int D, int NKT, bool HAS_SINK>
DI void attn16(const bf16x8 (&qf)[D / 32], LAS unsigned char* Kl, int kpitch, LAS unsigned char* Vt, int vpitch, int key0, int jlo, int jhi,
               float scale, float sink, bf16_t* orow, bool wr_ok, int fr, int fq) {
    f32x4 s[NKT];
#pragma unroll
    for (int t = 0; t < NKT; ++t) {
        s[t] = (f32x4){0.f, 0.f, 0.f, 0.f};
#pragma unroll
        for (int ks = 0; ks < D / 32; ++ks) { const bf16x8 kf = *(const LAS bf16x8*)(Kl + (key0 + 16 * t + fr) * kpitch + (32 * ks + 8 * fq) * 2); s[t] = MFMA16(kf, qf[ks], s[t]); }
    }
    float m = -INFINITY;
#pragma unroll
    for (int t = 0; t < NKT; ++t)
#pragma unroll
        for (int r = 0; r < 4; ++r) { const int j = key0 + 16 * t + 4 * fq + r; const float v = (j >= jlo && j <= jhi) ? s[t][r] * scale : -INFINITY; s[t][r] = v; m = fmaxf(m, v); }
    m = fmaxf(m, __shfl_xor(m, 16)); m = fmaxf(m, __shfl_xor(m, 32));
    if (HAS_SINK) m = fmaxf(m, sink);
    if (m == -INFINITY) m = 0.f;
    float sum = 0.f;
#pragma unroll
    for (int t = 0; t < NKT; ++t)
#pragma unroll
        for (int r = 0; r < 4; ++r) { const float e = __expf(s[t][r] - m); s[t][r] = e; sum += e; }
    sum += __shfl_xor(sum, 16); sum += __shfl_xor(sum, 32);
    if (HAS_SINK) sum += __expf(sink - m);
    const float inv = sum > 0.f ? 1.f / sum : 0.f;
    f32x4 o[D / 16];
#pragma unroll
    for (int dt = 0; dt < D / 16; ++dt) o[dt] = (f32x4){0.f, 0.f, 0.f, 0.f};
#pragma unroll
    for (int kk = 0; kk < NKT / 2; ++kk) {
        u32x4 pw; pw.x = pk2(s[2 * kk][0] * inv, s[2 * kk][1] * inv); pw.y = pk2(s[2 * kk][2] * inv, s[2 * kk][3] * inv);
        pw.z = pk2(s[2 * kk + 1][0] * inv, s[2 * kk + 1][1] * inv); pw.w = pk2(s[2 * kk + 1][2] * inv, s[2 * kk + 1][3] * inv);
        const bf16x8 pf = __builtin_bit_cast(bf16x8, pw);
#pragma unroll
        for (int dt = 0; dt < D / 16; ++dt) {
            const LAS unsigned char* vp = Vt + (key0 + 32 * kk + 4 * fq + (fr >> 2)) * vpitch + 32 * dt + 8 * (fr & 3);
            const u32x2 lo = __builtin_bit_cast(u32x2, __builtin_amdgcn_ds_read_tr16_b64_v4i16((LAS v4i16_t*)vp));
            const u32x2 hi = __builtin_bit_cast(u32x2, __builtin_amdgcn_ds_read_tr16_b64_v4i16((LAS v4i16_t*)(vp + 16 * vpitch)));
            const bf16x8 vf = __builtin_bit_cast(bf16x8, (u32x4){lo.x, lo.y, hi.x, hi.y});
            o[dt] = MFMA16(vf, pf, o[dt]);
        }
    }
    if (wr_ok) {
#pragma unroll
        for (int dt = 0; dt < D / 16; ++dt) { u32x2 w; w.x = pk2(o[dt][0], o[dt][1]); w.y = pk2(o[dt][2], o[dt][3]); *(u32x2*)(orow + 16 * dt + 4 * fq) = w; }
    }
}

#define ATTN_SOFTMAX(S, JLO, JHI, INV) do { float m_ = -INFINITY; \
    _Pragma("unroll") for (int t = 0; t < NKT; ++t) _Pragma("unroll") for (int r = 0; r < 4; ++r) { const int j = key0 + 16 * t + 4 * fq + r; const float v = (j >= (JLO) && j <= (JHI)) ? S[t][r] * scale : -INFINITY; S[t][r] = v; m_ = fmaxf(m_, v); } \
    m_ = fmaxf(m_, __shfl_xor(m_, 16)); m_ = fmaxf(m_, __shfl_xor(m_, 32)); if (HAS_SINK) m_ = fmaxf(m_, sink); if (m_ == -INFINITY) m_ = 0.f; \
    float sum_ = 0.f; \
    _Pragma("unroll") for (int t = 0; t < NKT; ++t) _Pragma("unroll") for (int r = 0; r < 4; ++r) { const float e = __expf(S[t][r] - m_); S[t][r] = e; sum_ += e; } \
    sum_ += __shfl_xor(sum_, 16); sum_ += __shfl_xor(sum_, 32); if (HAS_SINK) sum_ += __expf(sink - m_); \
    INV = sum_ > 0.f ? 1.f / sum_ : 0.f; } while (0)
template <int D, int NKT, bool HAS_SINK>
DI void attn16x2(const bf16x8 (&qa)[D / 32], const bf16x8 (&qb)[D / 32], LAS unsigned char* Kl, int kpitch, LAS unsigned char* Vt, int vpitch, int key0,
                 int jloA, int jhiA, int jloB, int jhiB, float scale, float sink, bf16_t* orowA, bf16_t* orowB, int fr, int fq) {
    f32x4 sa[NKT], sb[NKT];
#pragma unroll
    for (int t = 0; t < NKT; ++t) {
        sa[t] = (f32x4){0.f, 0.f, 0.f, 0.f}; sb[t] = sa[t];
#pragma unroll
        for (int ks = 0; ks < D / 32; ++ks) { const bf16x8 kf = *(const LAS bf16x8*)(Kl + (key0 + 16 * t + fr) * kpitch + (32 * ks + 8 * fq) * 2); sa[t] = MFMA16(kf, qa[ks], sa[t]); sb[t] = MFMA16(kf, qb[ks], sb[t]); }
    }
    float inva, invb;
    ATTN_SOFTMAX(sa, jloA, jhiA, inva);
    ATTN_SOFTMAX(sb, jloB, jhiB, invb);
    f32x4 oa[D / 16], ob[D / 16];
#pragma unroll
    for (int dt = 0; dt < D / 16; ++dt) { oa[dt] = (f32x4){0.f, 0.f, 0.f, 0.f}; ob[dt] = oa[dt]; }
#pragma unroll
    for (int kk = 0; kk < NKT / 2; ++kk) {
        u32x4 pw; pw.x = pk2(sa[2 * kk][0] * inva, sa[2 * kk][1] * inva); pw.y = pk2(sa[2 * kk][2] * inva, sa[2 * kk][3] * inva);
        pw.z = pk2(sa[2 * kk + 1][0] * inva, sa[2 * kk + 1][1] * inva); pw.w = pk2(sa[2 * kk + 1][2] * inva, sa[2 * kk + 1][3] * inva);
        const bf16x8 pfa = __builtin_bit_cast(bf16x8, pw);
        pw.x = pk2(sb[2 * kk][0] * invb, sb[2 * kk][1] * invb); pw.y = pk2(sb[2 * kk][2] * invb, sb[2 * kk][3] * invb);
        pw.z = pk2(sb[2 * kk + 1][0] * invb, sb[2 * kk + 1][1] * invb); pw.w = pk2(sb[2 * kk + 1][2] * invb, sb[2 * kk + 1][3] * invb);
        const bf16x8 pfb = __builtin_bit_cast(bf16x8, pw);
#pragma unroll
        for (int dt = 0; dt < D / 16; ++dt) {
            const LAS unsigned char* vp = Vt + (key0 + 32 * kk + 4 * fq + (fr >> 2)) * vpitch + 32 * dt + 8 * (fr & 3);
            const u32x2 lo = __builtin_bit_cast(u32x2, __builtin_amdgcn_ds_read_tr16_b64_v4i16((LAS v4i16_t*)vp));
            const u32x2 hi = __builtin_bit_cast(u32x2, __builtin_amdgcn_ds_read_tr16_b64_v4i16((LAS v4i16_t*)(vp + 16 * vpitch)));
            const bf16x8 vf = __builtin_bit_cast(bf16x8, (u32x4){lo.x, lo.y, hi.x, hi.y});
            oa[dt] = MFMA16(vf, pfa, oa[dt]); ob[dt] = MFMA16(vf, pfb, ob[dt]);
        }
    }
#pragma unroll
    for (int dt = 0; dt < D / 16; ++dt) {
        u32x2 w; w.x = pk2(oa[dt][0], oa[dt][1]); w.y = pk2(oa[dt][2], oa[dt][3]); *(u32x2*)(orowA + 16 * dt + 4 * fq) = w;
        w.x = pk2(ob[dt][0], ob[dt][1]); w.y = pk2(ob[dt][2], ob[dt][3]); *(u32x2*)(orowB + 16 * dt + 4 * fq) = w;
    }
}

struct Params { const float* in[33]; float* out; unsigned char* ws; };

#define CAS __attribute__((address_space(4)))
struct Ctx {
    LAS unsigned char* lds; int tid, lane, wave, G, bx;
    const CAS Params* p; unsigned char* ws; float* out;
};

DI void thin_res_gemm(const Ctx& C, const bf16_t* A, const bf16_t* Bt, int K, float scale, float* rss_out, float* X) {
    const int fr = C.lane & 15, fq = C.lane >> 4;
    LAS float* part = (LAS float*)C.lds;
    bf16_t* XB = (bf16_t*)(C.ws + WS_XB);
    const int kw = K >> 3;
    for (int tile = C.bx; tile < 256; tile += C.G) {
        const int row0 = TP + (tile >> 4) * 32, n0 = (tile & 15) * 64;
        f32x4 acc[2][4];
#pragma unroll
        for (int mt = 0; mt < 2; ++mt)
#pragma unroll
            for (int nt = 0; nt < 4; ++nt) acc[mt][nt] = (f32x4){0.f, 0.f, 0.f, 0.f};
        const bf16_t* ap = A + (size_t)(row0 + fr) * K + C.wave * kw + 8 * fq;
        const bf16_t* bp = Bt + (size_t)(n0 + fr) * K + C.wave * kw + 8 * fq;
#pragma unroll 4
        for (int k = 0; k < kw; k += 32) {
            bf16x8 af[2], bfr[4];
#pragma unroll
            for (int mt = 0; mt < 2; ++mt) af[mt] = *(const bf16x8*)(ap + (size_t)(16 * mt) * K + k);
#pragma unroll
            for (int nt = 0; nt < 4; ++nt) bfr[nt] = *(const bf16x8*)(bp + (size_t)(16 * nt) * K + k);
#pragma unroll
            for (int mt = 0; mt < 2; ++mt)
#pragma unroll
                for (int nt = 0; nt < 4; ++nt) acc[mt][nt] = MFMA16(bfr[nt], af[mt], acc[mt][nt]);
        }
#pragma unroll
        for (int mt = 0; mt < 2; ++mt)
#pragma unroll
            for (int nt = 0; nt < 4; ++nt) *(LAS f32x4*)(part + ((C.wave * 32 + 16 * mt + fr) * 64 + 16 * nt + 4 * fq)) = acc[mt][nt];
        __syncthreads();
        {
            const int row = C.tid >> 4, c4 = C.tid & 15;
            f32x4 v = (f32x4){0.f, 0.f, 0.f, 0.f};
#pragma unroll
            for (int w = 0; w < 8; ++w) v = v + *(const LAS f32x4*)(part + ((w * 32 + row) * 64 + 4 * c4));
            bf16_t* xb = XB + (size_t)(row0 + row) * DM + n0 + 4 * c4;
            const u32x2 xo = *(const u32x2*)xb;
            f32x4 x = (f32x4){blo(xo.x), bhi(xo.x), blo(xo.y), bhi(xo.y)}; x = x + v * scale;
            if (X) *(f32x4*)(X + (size_t)(row0 + row) * DM + n0 + 4 * c4) = x;
            else {
                u32x2 w2; w2.x = pk2(x[0], x[1]); w2.y = pk2(x[2], x[3]); *(u32x2*)xb = w2;
                const float a0 = blo(w2.x), a1 = bhi(w2.x), a2 = blo(w2.y), a3 = bhi(w2.y);
                float ss = a0 * a0 + a1 * a1 + a2 * a2 + a3 * a3;
                ss += __shfl_xor(ss, 1); ss += __shfl_xor(ss, 2); ss += __shfl_xor(ss, 4); ss += __shfl_xor(ss, 8);
                if (c4 == 0) atomicAdd(rss_out + row0 + row, ss);
            }
        }
        __syncthreads();
    }
}

DI void p0_tile(const float* s0, const float* s1, const float* gain, int mode, int K, int Nsrc, bf16_t* dst, int tile, LAS float* tl, int tid) {
    const int nkt = K >> 6; const int ntile = tile / nkt, kt = tile - ntile * nkt; const int n0 = ntile * 256, k0 = kt * 64;
    const int nn = tid & 255, kk0 = tid >> 8;
    const int n = n0 + nn; const float* src = s0; int col = n;
    if (mode == 1) { const int pn = n >> 8, bj = (n >> 7) & 1, cc = n & 127; src = bj ? s1 : s0; col = pn * 128 + cc; }
    else if (mode == 2) {
        const int pn = n >> 8, rem = n & 255, bj = rem >> 7, wc = (rem >> 5) & 3, j = rem & 31;
        if (pn < 2) col = (4 * pn + wc) * 64 + 32 * bj + j;
        else if (pn == 2) col = (wc < 2) ? (512 + wc * 64 + 32 * bj + j) : (640 + (wc - 2) * 64 + 32 * bj + j);
        else if (pn < 9) col = n;
        else col = (rem < 16) ? (2304 + rem) : -1;
    } else if (mode == 3) { if (n >= 512) { src = s1; col = n - 512; } }
    const float* sp = src + (size_t)(k0 + kk0) * Nsrc + (col >= 0 ? col : 0);
    float v[32];
#pragma unroll
    for (int i = 0; i < 32; ++i) v[i] = (col >= 0) ? sp[(size_t)(2 * i) * Nsrc] : 0.f;
    if (gain) {
#pragma unroll
        for (int i = 0; i < 32; ++i) v[i] *= gain[k0 + kk0 + 2 * i];
    }
#pragma unroll
    for (int i = 0; i < 32; ++i) tl[(kk0 + 2 * i) * 257 + nn] = v[i];
    __syncthreads();
#pragma unroll
    for (int j = 0; j < 4; ++j) { const int ch = tid + 512 * j; const int n2 = ch >> 3, ks = ch & 7; const LAS float* s = tl + (8 * ks) * 257 + n2;
      u32x4 o; o.x = pk2(s[0], s[257]); o.y = pk2(s[2 * 257], s[3 * 257]); o.z = pk2(s[4 * 257], s[5 * 257]); o.w = pk2(s[6 * 257], s[7 * 257]);
      *(u32x4*)(dst + (size_t)(n0 + n2) * K + k0 + 8 * ks) = o; }
    __syncthreads();
}

constexpr int TPL = 1408, T_W1 = 0, T_WD1 = 352, T_WKV = 1344;
DI void p0_dispatch(const Ctx& C, int l, int r) {
    const CAS Params& P = *C.p; unsigned char* ws = C.ws;
    unsigned char* wl = ws + WS_WL + (size_t)l * WL_SIZE;
    const float* s0; const float* s1 = nullptr; const float* gain = nullptr; int mode = 0, K = 1024, Nsrc; bf16_t* dst;
    if (r < 352) { s0 = P.in[9] + (size_t)l * 1024 * FF; s1 = P.in[10] + (size_t)l * 1024 * FF; gain = P.in[8] + l * 1024; mode = 1; Nsrc = FF; dst = (bf16_t*)(wl + WL_W1); }
    else if (r < 528) { r -= 352; s0 = P.in[11] + (size_t)l * FF * 1024; K = FF; Nsrc = 1024; dst = (bf16_t*)(wl + WL_WD1); }
    else if (r < 688) { r -= 528; s0 = P.in[13] + (size_t)l * 1024 * 2320; gain = P.in[12] + l * 1024; mode = 2; Nsrc = 2320; dst = (bf16_t*)(wl + WL_WIN); }
    else if (r < 752) { r -= 688; s0 = P.in[20] + (size_t)l * 1024 * 1024; Nsrc = 1024; dst = (bf16_t*)(wl + WL_WOUT); }
    else if (r < 784) { r -= 752; s0 = P.in[23] + (size_t)l * 1024 * 512; gain = P.in[21] + l * 1024; Nsrc = 512; dst = (bf16_t*)(wl + WL_WQ); }
    else if (r < 816) { r -= 784; s0 = P.in[28] + (size_t)l * 512 * 1024; K = 512; Nsrc = 1024; dst = (bf16_t*)(wl + WL_WO); }
    else if (r < 1168) { r -= 816; s0 = P.in[30] + (size_t)l * 1024 * FF; s1 = P.in[31] + (size_t)l * 1024 * FF; gain = P.in[29] + l * 1024; mode = 1; Nsrc = FF; dst = (bf16_t*)(wl + WL_W2); }
    else if (r < 1344) { r -= 1168; s0 = P.in[32] + (size_t)l * FF * 1024; K = FF; Nsrc = 1024; dst = (bf16_t*)(wl + WL_WD2); }
    else { r -= 1344; s0 = P.in[24] + (size_t)l * 1024 * 512; s1 = P.in[25] + (size_t)l * 1024 * 512; gain = P.in[22] + l * 1024; mode = 3; Nsrc = 512; dst = (bf16_t*)(ws + WS_WKV) + (size_t)l * 1024 * 1024; }
    p0_tile(s0, s1, gain, mode, K, Nsrc, dst, r, (LAS float*)C.lds, C.tid);
}
DI void convert_in_slack(const Ctx& C, int l, int lo, int hi, int nun) {
    const int rem = nun % C.G; const int first = rem ? rem : 0, cnt = C.G - first;
    if (C.bx < first) return;
    for (int t = lo + (C.bx - first); t < hi; t += cnt) p0_dispatch(C, l, t);
}

DI void p0_prologue(const Ctx& C) {
    const CAS Params& P = *C.p; unsigned char* ws = C.ws;
    for (int it = C.bx; it < 352 + 128; it += C.G) {
        if (it < 352) p0_dispatch(C, 0, it); else if (it < 416) p0_dispatch(C, 0, T_WKV + it - 352); else p0_dispatch(C, 1, T_WKV + it - 416);
    }
    const int gw = C.bx * 8 + C.wave, NGW = C.G * 8;
    float* RSS = (float*)(ws + WS_RSS);
    for (int r0 = gw; r0 < T + 1024; r0 += 2 * NGW) {
        const float* src[2]; float* df[2]; bf16_t* db[2]; float* rs[2]; f32x4 v[2][4];
#pragma unroll
        for (int q = 0; q < 2; ++q) {
            int r = r0 + q * NGW; if (r >= T + 1024) r = r0;
            if (r < T) { src[q] = (r < TP ? P.in[0] + (size_t)r * 1024 : P.in[1] + (size_t)(r - TP) * 1024); df[q] = nullptr; db[q] = (bf16_t*)(ws + WS_XB) + (size_t)r * 1024; rs[q] = RSS + r; }
            else { src[q] = P.in[7] + (size_t)(r - T) * 1024; df[q] = nullptr; db[q] = (bf16_t*)(ws + WS_MEMB) + (size_t)(r - T) * 1024; rs[q] = (float*)(ws + WS_RSSM) + (r - T); }
#pragma unroll
            for (int j = 0; j < 4; ++j) v[q][j] = *(const f32x4*)(src[q] + 256 * j + 4 * C.lane);
        }
#pragma unroll
        for (int q = 0; q < 2; ++q) {
            float ss = 0.f;
#pragma unroll
            for (int j = 0; j < 4; ++j) {
                const f32x4 x = v[q][j];
                ss += x[0] * x[0] + x[1] * x[1] + x[2] * x[2] + x[3] * x[3];
                if (df[q]) *(f32x4*)(df[q] + 256 * j + 4 * C.lane) = x;
                u32x2 w; w.x = pk2(x[0], x[1]); w.y = pk2(x[2], x[3]); *(u32x2*)(db[q] + 256 * j + 4 * C.lane) = w;
            }
#pragma unroll
            for (int o = 1; o < 64; o <<= 1) ss += __shfl_xor(ss, o);
            if (C.lane == 0) *rs[q] = ss;
        }
    }
    for (int i = C.bx * 512 + C.tid; i < 8 * T; i += C.G * 512) RSS[T + i] = 0.f;
    float2* rope = (float2*)(ws + WS_ROPE);
    for (int i = C.bx * 512 + C.tid; i < 4100 * 32; i += C.G * 512) {
        const int pidx = i >> 5, f = i & 31; const int pos = pidx < 4096 ? pidx : 16384 + (pidx - 4096);
        const float inv = powf(10000.f, -(float)f * (1.f / 32.f));
        const float ang = (float)pos * inv;
        const double a = (double)ang; const double nrev = rint(a * 0.15915494309189535); const float rr = (float)(a - nrev * 6.283185307179586);
        rope[i] = make_float2(cosf(rr), sinf(rr));
    }
}

DI void swa_prompt_unit(const Ctx& C, int l, int unit) {
    unsigned char* ws = C.ws;
    const int b = unit >> 6, n = (unit >> 1) & 31, kvh = unit & 1;
    const bf16_t* QS = (const bf16_t*)(ws + WS_QS); const bf16_t* KS = (const bf16_t*)(ws + WS_KS); const bf16_t* VS = (const bf16_t*)(ws + WS_VS); bf16_t* MIX = (bf16_t*)(ws + WS_MIX);
    LAS unsigned char* Kl = C.lds; LAS unsigned char* Vt = C.lds + 256 * 144;
    constexpr int KP = 144, VP = 144;
#pragma unroll
    for (int i = 0; i < 4; ++i) {
        const int key = (C.tid >> 3) + 64 * i, c8 = C.tid & 7; const int pos = (n - 1) * 128 + key;
        u32x4 kv = (u32x4){0u, 0u, 0u, 0u}, vv = kv;
        if (pos >= 0) { const size_t row = (size_t)b * SEQ + pos; kv = *(const u32x4*)(KS + row * 128 + kvh * 64 + 8 * c8); vv = *(const u32x4*)(VS + row * 128 + kvh * 64 + 8 * c8); }
        *(LAS u32x4*)(Kl + key * KP + c8 * 16) = kv; *(LAS u32x4*)(Vt + key * VP + c8 * 16) = vv;
    }
    __syncthreads();
    const int fr = C.lane & 15, fq = C.lane >> 4; const int g = C.wave >> 1, qh = C.wave & 1; const int head = kvh * 4 + g;
    const float sink = C.p->in[16][l * 8 + head];
    for (int gp = 0; gp < 2; ++gp) {
        const int iA = 64 * qh + 32 * gp + fr, iB = iA + 16; const size_t rowA = (size_t)b * SEQ + n * 128 + iA, rowB = rowA + 16;
        bf16x8 qa[2], qb[2];
#pragma unroll
        for (int ks = 0; ks < 2; ++ks) { qa[ks] = *(const bf16x8*)(QS + rowA * 512 + head * 64 + 32 * ks + 8 * fq); qb[ks] = *(const bf16x8*)(QS + rowB * 512 + head * 64 + 32 * ks + 8 * fq); }
        const int lo0 = n == 0 ? 128 : 0;
        attn16x2<64, 10, true>(qa, qb, Kl, KP, Vt, VP, 64 * qh + 32 * gp, max(iA + 1, lo0), iA + 128, max(iB + 1, lo0), iB + 128, 0.125f, sink,
                               MIX + rowA * 1024 + head * 64, MIX + rowB * 1024 + head * 64, fr, fq);
    }
    __syncthreads();
}

DI void swa_decode_unit(const Ctx& C, int l, int unit) {
    unsigned char* ws = C.ws; const CAS Params& P = *C.p;
    const int b = unit >> 1, kvh = unit & 1;
    const bf16_t* QS = (const bf16_t*)(ws + WS_QS); const bf16_t* KS = (const bf16_t*)(ws + WS_KS); const bf16_t* VS = (const bf16_t*)(ws + WS_VS); bf16_t* MIX = (bf16_t*)(ws + WS_MIX);
    constexpr int KP = 144, VP = 144;
    LAS unsigned char* Kl = C.lds; LAS unsigned char* Vt = C.lds + 160 * KP;
    for (int i = C.tid; i < (160 * KP + 160 * VP) / 16; i += 512) *(LAS u32x4*)(C.lds + i * 16) = (u32x4){0u, 0u, 0u, 0u};
    __syncthreads();
    const float* ck = P.in[2] + ((size_t)(l * 128 + b) * 128) * 128 + kvh * 64; const float* cv = P.in[3] + ((size_t)(l * 128 + b) * 128) * 128 + kvh * 64;
    float* ok = C.out + O_KS + ((size_t)(l * 128 + b) * 128) * 128 + kvh * 64; float* ov = C.out + O_VS + ((size_t)(l * 128 + b) * 128) * 128 + kvh * 64;
#pragma unroll
    for (int i = 0; i < 4; ++i) {
        const int key = (C.tid >> 4) + 32 * i, c16 = C.tid & 15;
        const f32x4 kv = *(const f32x4*)(ck + (size_t)key * 128 + 4 * c16), vv = *(const f32x4*)(cv + (size_t)key * 128 + 4 * c16);
        u32x2 w; w.x = pk2(kv[0], kv[1]); w.y = pk2(kv[2], kv[3]); *(LAS u32x2*)(Kl + key * KP + c16 * 8) = w;
        u32x2 wv; wv.x = pk2(vv[0], vv[1]); wv.y = pk2(vv[2], vv[3]); *(LAS u32x2*)(Vt + key * VP + c16 * 8) = wv;
        if (key >= 4) { *(f32x4*)(ok + (size_t)(key - 4) * 128 + 4 * c16) = kv; *(f32x4*)(ov + (size_t)(key - 4) * 128 + 4 * c16) = vv; }
    }
    if (C.tid < 32) {
        const int tt = C.tid >> 3, c8 = C.tid & 7; const size_t row = (size_t)TP + b * 4 + tt;
        const u32x4 kv = *(const u32x4*)(KS + row * 128 + kvh * 64 + 8 * c8), vv = *(const u32x4*)(VS + row * 128 + kvh * 64 + 8 * c8);
        *(LAS u32x4*)(Kl + (128 + tt) * KP + c8 * 16) = kv; *(LAS u32x4*)(Vt + (128 + tt) * VP + c8 * 16) = vv;
    }
    __syncthreads();
    if (C.wave == 0) {
        const int fr = C.lane & 15, fq = C.lane >> 4; const int g = fr >> 2, tt = fr & 3; const int head = kvh * 4 + g; const size_t row = (size_t)TP + b * 4 + tt;
        bf16x8 qf[2];
#pragma unroll
        for (int ks = 0; ks < 2; ++ks) qf[ks] = *(const bf16x8*)(QS + row * 512 + head * 64 + 32 * ks + 8 * fq);
        const float sink = P.in[16][l * 8 + head];
        attn16<64, 10, true>(qf, Kl, KP, Vt, VP, 0, tt + 1, tt + 128, 0.125f, sink, MIX + row * 1024 + head * 64, true, fr, fq);
    }
    __syncthreads();
}

DI void xattn_unit(const Ctx& C, int l, int unit) {
    unsigned char* ws = C.ws; const CAS Params& P = *C.p;
    constexpr int KP = 272, VP = 288;
    LAS unsigned char* Kl = C.lds; LAS unsigned char* Vt = C.lds + 256 * KP;
    const bool prompt = unit < 128;
    int b, h, qb = 0;
    if (prompt) { b = unit >> 5; h = (unit >> 3) & 3; qb = (unit & 7) * 2; } else { const int u = unit - 128; b = u >> 2; h = u & 3; }
    const float* ksrc; const float* vsrc; size_t kpitch;
    if (prompt) { ksrc = (const float*)(ws + WS_MKV) + (size_t)(b * 256) * 2048 + l * 1024 + h * 128; vsrc = ksrc + 512; kpitch = 2048; }
    else { ksrc = P.in[5] + ((size_t)(l * 128 + b) * 256) * 512 + h * 128; vsrc = P.in[6] + ((size_t)(l * 128 + b) * 256) * 512 + h * 128; kpitch = 512; }
    const int c4 = C.tid & 31;
    const f32x4 gk = *(const f32x4*)(P.in[27] + l * 128 + 4 * c4);
    const bool wout = prompt && qb == 0;
    float* omk = C.out + O_MKP + ((size_t)(l * 4 + b) * 256) * 512 + h * 128; float* omv = C.out + O_MVP + ((size_t)(l * 4 + b) * 256) * 512 + h * 128;
#pragma unroll 4
    for (int i = 0; i < 16; ++i) {
        const int key = (C.tid >> 5) + 16 * i;
        f32x4 kv = *(const f32x4*)(ksrc + (size_t)key * kpitch + 4 * c4); const f32x4 vv = *(const f32x4*)(vsrc + (size_t)key * kpitch + 4 * c4);
        if (prompt) {
            float ss = kv[0] * kv[0] + kv[1] * kv[1] + kv[2] * kv[2] + kv[3] * kv[3];
#pragma unroll
            for (int o = 1; o < 32; o <<= 1) ss += __shfl_xor(ss, o);
            const float rq = rsqrtf(ss * (1.f / 128.f) + EPS);
            kv = kv * rq * gk;
            if (wout) { *(f32x4*)(omk + (size_t)key * 512 + 4 * c4) = kv; *(f32x4*)(omv + (size_t)key * 512 + 4 * c4) = vv; }
        }
        u32x2 w; w.x = pk2(kv[0], kv[1]); w.y = pk2(kv[2], kv[3]); *(LAS u32x2*)(Kl + key * KP + c4 * 8) = w;
        u32x2 wv; wv.x = pk2(vv[0], vv[1]); wv.y = pk2(vv[2], vv[3]); *(LAS u32x2*)(Vt + key * VP + c4 * 8) = wv;
    }
    __syncthreads();
    const bf16_t* QX = (const bf16_t*)(ws + WS_QX); bf16_t* OX = (bf16_t*)(ws + WS_OX);
    const int fr = C.lane & 15, fq = C.lane >> 4;
    const int ngrp = prompt ? 4 : (C.wave == 0 ? 1 : 0);
    for (int grp = 0; grp < ngrp; ++grp) {
        const size_t row = prompt ? ((size_t)b * SEQ + (qb + (grp >> 1)) * 256 + 32 * C.wave + 16 * (grp & 1) + fr) : ((size_t)TP + b * 4 + (fr & 3));
        float qv[32]; float ss = 0.f;
#pragma unroll
        for (int ks = 0; ks < 4; ++ks) {
            const u32x4 w = *(const u32x4*)(QX + row * 512 + h * 128 + 32 * ks + 8 * fq);
#pragma unroll
            for (int e = 0; e < 4; ++e) { qv[8 * ks + 2 * e] = blo(w[e]); qv[8 * ks + 2 * e + 1] = bhi(w[e]); }
        }
#pragma unroll
        for (int e = 0; e < 32; ++e) ss += qv[e] * qv[e];
        ss += __shfl_xor(ss, 16); ss += __shfl_xor(ss, 32);
        const float rq = rsqrtf(ss * (1.f / 128.f) + EPS);
        bf16x8 qf[4];
#pragma unroll
        for (int ks = 0; ks < 4; ++ks) {
            const f32x4 g0 = *(const f32x4*)(P.in[26] + l * 128 + 32 * ks + 8 * fq), g1 = *(const f32x4*)(P.in[26] + l * 128 + 32 * ks + 8 * fq + 4);
            u32x4 w; w.x = pk2(qv[8 * ks] * rq * g0[0], qv[8 * ks + 1] * rq * g0[1]); w.y = pk2(qv[8 * ks + 2] * rq * g0[2], qv[8 * ks + 3] * rq * g0[3]);
            w.z = pk2(qv[8 * ks + 4] * rq * g1[0], qv[8 * ks + 5] * rq * g1[1]); w.w = pk2(qv[8 * ks + 6] * rq * g1[2], qv[8 * ks + 7] * rq * g1[3]);
            qf[ks] = __builtin_bit_cast(bf16x8, w);
        }
        attn16<128, 16, false>(qf, Kl, KP, Vt, VP, 0, 0, 255, 0.08838834764831845f, 0.f, OX + row * 512 + h * 128, prompt || fr < 4, fr, fq);
    }
    __syncthreads();
}

DI void gla_a_phase(const Ctx& C, int l) {
    unsigned char* ws = C.ws; const CAS Params& P = *C.p;
    const bf16_t* ZG = (const bf16_t*)(ws + WS_ZG); const float* LR = (const float*)(ws + WS_LR);
    bf16_t* QT = (bf16_t*)(ws + WS_BCUM); bf16_t* KT = QT + (size_t)TP * 256; float* ST = (float*)(ws + WS_ST); bf16_t* VT = (bf16_t*)(ws + WS_VT); float* DEC = (float*)(ws + WS_DEC);
    LAS float* segsum = (LAS float*)C.lds;
    LAS unsigned char* KdT = C.lds + 2048;
    LAS unsigned char* VtL = C.lds + 2048 + 64 * 144;
    const int dk = C.tid & 63, seg = C.wave, tv = C.tid >> 3, dvs = C.tid & 7;
    int unit = C.bx; if (unit >= 1024) return;
    bf16_t kq[16]; u32x4 vw[2];
#define GLA_A_LOAD(u) do { const int bh_ = (u) >> 6, c_ = (u) & 63, b_ = bh_ >> 2, h_ = bh_ & 3; const size_t t0_ = (size_t)b_ * SEQ + c_ * 64; \
        _Pragma("unroll") for (int i = 0; i < 8; ++i) { kq[i] = ZG[(t0_ + 8 * seg + i) * 1536 + 256 + h_ * 64 + dk]; kq[8 + i] = ZG[(t0_ + 8 * seg + i) * 1536 + h_ * 64 + dk]; } \
        _Pragma("unroll") for (int x = 0; x < 2; ++x) vw[x] = *(const u32x4*)(ZG + (t0_ + tv) * 1536 + 512 + h_ * 128 + 16 * dvs + 8 * x); } while (0)
    GLA_A_LOAD(unit);
    int hcur = -1; float wg[16]; float bg = 0.f;
    for (; unit < 1024; unit += C.G) {
        const int bh = unit >> 6, c = unit & 63, b = bh >> 2, h = bh & 3; const size_t t0 = (size_t)b * SEQ + c * 64;
        if (h != hcur) { hcur = h;
#pragma unroll
            for (int r = 0; r < 16; ++r) wg[r] = P.in[17][(size_t)(l * 16 + r) * 256 + h * 64 + dk];
            bg = P.in[18][l * 256 + h * 64 + dk]; }
        float p[8];
        {
            float run = 0.f;
#pragma unroll
            for (int i = 0; i < 8; ++i) {
                const float* lr = LR + (t0 + 8 * seg + i) * 16; float x = bg;
#pragma unroll
                for (int r = 0; r < 16; ++r) x += lr[r] * wg[r];
                run += logsig(x) * (1.f / 16.f); p[i] = run;
            }
            segsum[seg * 64 + dk] = run;
        }
#pragma unroll
        for (int x = 0; x < 2; ++x) {
            const u32x4 w = vw[x];
#pragma unroll
            for (int e = 0; e < 4; ++e) { *(LAS unsigned short*)(VtL + (16 * dvs + 8 * x + 2 * e) * 144 + tv * 2) = (unsigned short)(w[e] & 0xffffu); *(LAS unsigned short*)(VtL + (16 * dvs + 8 * x + 2 * e + 1) * 144 + tv * 2) = (unsigned short)(w[e] >> 16); }
        }
        __syncthreads();
        {
            float off = 0.f, tot = 0.f;
#pragma unroll
            for (int s2 = 0; s2 < 8; ++s2) { const float v = segsum[s2 * 64 + dk]; tot += v; if (s2 < seg) off += v; }
#pragma unroll
            for (int i = 0; i < 8; ++i) {
                const int t = 8 * seg + i; const float bv = off + p[i];
                const float kraw = bf2f(kq[i]), qraw = bf2f(kq[8 + i]);
                const float kd = kraw * __expf(tot - bv);
                const unsigned qk = pk2(qraw * 0.125f * __expf(bv), kraw * __expf(-bv));
                QT[(t0 + t) * 256 + h * 64 + dk] = (bf16_t)(qk & 0xffffu); KT[(t0 + t) * 256 + h * 64 + dk] = (bf16_t)(qk >> 16);
                *(LAS unsigned short*)(KdT + dk * 144 + t * 2) = (unsigned short)(pk2(kd, 0.f) & 0xffffu);
            }
            if (seg == 0) DEC[unit * 64 + dk] = __expf(tot);
        }
        if (unit + C.G < 1024) GLA_A_LOAD(unit + C.G);
        __syncthreads();
        {
            const int dv = C.tid >> 2, part = C.tid & 3;
            const u32x4 a4 = *(const LAS u32x4*)(VtL + dv * 144 + part * 32), b4 = *(const LAS u32x4*)(VtL + dv * 144 + part * 32 + 16);
            bf16_t* d = VT + ((size_t)unit * 128 + dv) * 64 + part * 16; *(u32x4*)d = a4; *(u32x4*)(d + 8) = b4;
        }
        {
            const int fr = C.lane & 15, fq = C.lane >> 4, w = C.wave;
#pragma unroll
            for (int dkt = 0; dkt < 4; ++dkt) {
                f32x4 acc = (f32x4){0.f, 0.f, 0.f, 0.f};
#pragma unroll
                for (int ks = 0; ks < 2; ++ks) {
                    const bf16x8 kd = *(const LAS bf16x8*)(KdT + (16 * dkt + fr) * 144 + (32 * ks + 8 * fq) * 2);
                    const bf16x8 vt = *(const LAS bf16x8*)(VtL + (16 * w + fr) * 144 + (32 * ks + 8 * fq) * 2);
                    acc = MFMA16(kd, vt, acc);
                }
                *(f32x4*)(ST + ((size_t)unit * 128 + 16 * w + fr) * 64 + 16 * dkt + 4 * fq) = acc;
            }
        }
        __syncthreads();
    }
#undef GLA_A_LOAD
}

DI void gla_scan(const Ctx& C, int l) {
    unsigned char* ws = C.ws;
    const float* ST = (const float*)(ws + WS_ST); const float* DEC = (const float*)(ws + WS_DEC); bf16_t* STB = (bf16_t*)(ws + WS_STB);
    for (int e = C.bx * 512 + C.tid; e < 16 * 8192; e += C.G * 512) {
        const int bh = e >> 13, idx = e & 8191, dk = idx & 63, dv = idx >> 6;
        float S = 0.f;
        for (int c0 = 0; c0 < 64; c0 += 8) {
            float d[8], dc[8];
#pragma unroll
            for (int i = 0; i < 8; ++i) { const int unit = bh * 64 + c0 + i; d[i] = ST[(size_t)unit * 8192 + idx]; dc[i] = DEC[unit * 64 + dk]; }
#pragma unroll
            for (int i = 0; i < 8; ++i) { const int unit = bh * 64 + c0 + i; STB[(size_t)unit * 8192 + idx] = (bf16_t)(pk2(S, 0.f) & 0xffffu); S = dc[i] * S + d[i]; }
        }
        C.out[O_GP + ((size_t)(l * 16 + bh)) * 8192 + dk * 128 + dv] = S;
    }
}

DI void gla_c_wave(const Ctx& C, int l, int unit, int qt) {
    unsigned char* ws = C.ws; const CAS Params& P = *C.p;
    const int bh = unit >> 6, c = unit & 63, b = bh >> 2, h = bh & 3; const size_t t0 = (size_t)b * SEQ + c * 64;
    const bf16_t* ZG = (const bf16_t*)(ws + WS_ZG); const bf16_t* QT = (const bf16_t*)(ws + WS_BCUM); const bf16_t* KT = QT + (size_t)TP * 256; const bf16_t* STB = (const bf16_t*)(ws + WS_STB); const bf16_t* VT = (const bf16_t*)(ws + WS_VT);
    bf16_t* MIX = (bf16_t*)(ws + WS_MIX);
    const int fr = C.lane & 15, fq = C.lane >> 4;
    const size_t rq = t0 + 16 * qt + fr;
    bf16x8 qf[2];
#pragma unroll
    for (int ks = 0; ks < 2; ++ks) qf[ks] = *(const bf16x8*)(QT + rq * 256 + h * 64 + 32 * ks + 8 * fq);
    f32x4 a[4];
#pragma unroll
    for (int kt = 0; kt < 4; ++kt) {
        a[kt] = (f32x4){0.f, 0.f, 0.f, 0.f};
        if (kt <= qt) {
            const size_t rk = t0 + 16 * kt + fr;
#pragma unroll
            for (int ks = 0; ks < 2; ++ks) {
                const bf16x8 kf = *(const bf16x8*)(KT + rk * 256 + h * 64 + 32 * ks + 8 * fq);
                a[kt] = MFMA16(kf, qf[ks], a[kt]);
            }
#pragma unroll
            for (int r = 0; r < 4; ++r) if (16 * kt + 4 * fq + r > 16 * qt + fr) a[kt][r] = 0.f;
        }
    }
    bf16x8 pf[2];
#pragma unroll
    for (int kk = 0; kk < 2; ++kk) { u32x4 w; w.x = pk2(a[2 * kk][0], a[2 * kk][1]); w.y = pk2(a[2 * kk][2], a[2 * kk][3]); w.z = pk2(a[2 * kk + 1][0], a[2 * kk + 1][1]); w.w = pk2(a[2 * kk + 1][2], a[2 * kk + 1][3]); pf[kk] = __builtin_bit_cast(bf16x8, w); }
    f32x4 o[8]; float ss = 0.f;
#pragma unroll
    for (int dt = 0; dt < 8; ++dt) {
        f32x4 acc = (f32x4){0.f, 0.f, 0.f, 0.f};
        const size_t vrow = ((size_t)unit * 128 + 16 * dt + fr) * 64;
#pragma unroll
        for (int kk = 0; kk < 2; ++kk) {
            if (2 * kk <= qt) {
                const bf16_t* vp = VT + vrow + 32 * kk + 4 * fq; const u32x2 lo = *(const u32x2*)vp, hi = *(const u32x2*)(vp + 16);
                acc = MFMA16(__builtin_bit_cast(bf16x8, (u32x4){lo.x, lo.y, hi.x, hi.y}), pf[kk], acc);
            }
        }
#pragma unroll
        for (int ks = 0; ks < 2; ++ks) {
            const bf16x8 sf = *(const bf16x8*)(STB + vrow + 32 * ks + 8 * fq);
            acc = MFMA16(sf, qf[ks], acc);
        }
        o[dt] = acc; ss += acc[0] * acc[0] + acc[1] * acc[1] + acc[2] * acc[2] + acc[3] * acc[3];
    }
    ss += __shfl_xor(ss, 16); ss += __shfl_xor(ss, 32);
    const float rn = rsqrtf(ss * (1.f / 128.f) + EPS);
#pragma unroll
    for (int dt = 0; dt < 8; ++dt) {
        const f32x4 gn = *(const f32x4*)(P.in[19] + l * 128 + 16 * dt + 4 * fq);
        const u32x2 gw = *(const u32x2*)(ZG + rq * 1536 + 1024 + h * 128 + 16 * dt + 4 * fq);
        const float g0 = blo(gw.x), g1 = bhi(gw.x), g2 = blo(gw.y), g3 = bhi(gw.y);
        u32x2 w; w.x = pk2(o[dt][0] * rn * gn[0] * silu(g0), o[dt][1] * rn * gn[1] * silu(g1)); w.y = pk2(o[dt][2] * rn * gn[2] * silu(g2), o[dt][3] * rn * gn[3] * silu(g3));
        *(u32x2*)(MIX + rq * 1024 + 512 + h * 128 + 16 * dt + 4 * fq) = w;
    }
}

DI void gla_c_phase(const Ctx& C, int l) {
    unsigned char* ws = C.ws; const CAS Params& P = *C.p;
    const bf16_t* ZG = (const bf16_t*)(ws + WS_ZG); const bf16_t* QT = (const bf16_t*)(ws + WS_BCUM); const bf16_t* KT = QT + (size_t)TP * 256; const bf16_t* STB = (const bf16_t*)(ws + WS_STB); const bf16_t* VT = (const bf16_t*)(ws + WS_VT);
    bf16_t* MIX = (bf16_t*)(ws + WS_MIX);
    constexpr int PB = 144, U_BYTES = (64 + 128 + 128) * PB;
    const int fr = C.lane & 15, fq = C.lane >> 4, us = C.wave >> 2, qt = C.wave & 3;
    for (int pr = C.bx; pr < 512; pr += C.G) {
#pragma unroll
        for (int uu = 0; uu < 2; ++uu) {
            const int unit = 2 * pr + uu; const int bh = unit >> 6, c = unit & 63, b = bh >> 2, h = bh & 3; const size_t t0 = (size_t)b * SEQ + c * 64;
            LAS unsigned char* base = C.lds + uu * U_BYTES;
            { const int row = C.tid >> 3, c8 = C.tid & 7; *(LAS u32x4*)(base + row * PB + c8 * 16) = *(const u32x4*)(KT + (t0 + row) * 256 + h * 64 + 8 * c8); }
#pragma unroll
            for (int i = 0; i < 2; ++i) {
                const int row = (C.tid >> 3) + 64 * i, c8 = C.tid & 7;
                *(LAS u32x4*)(base + (64 + row) * PB + c8 * 16) = *(const u32x4*)(STB + ((size_t)unit * 128 + row) * 64 + 8 * c8);
                *(LAS u32x4*)(base + (192 + row) * PB + c8 * 16) = *(const u32x4*)(VT + ((size_t)unit * 128 + row) * 64 + 8 * c8);
            }
        }
        const int unit = 2 * pr + us; const int bh = unit >> 6, c = unit & 63, b = bh >> 2, h = bh & 3; const size_t t0 = (size_t)b * SEQ + c * 64;
        const size_t rq = t0 + 16 * qt + fr;
        bf16x8 qf[2];
#pragma unroll
        for (int ks = 0; ks < 2; ++ks) qf[ks] = *(const bf16x8*)(QT + rq * 256 + h * 64 + 32 * ks + 8 * fq);
        __syncthreads();
        LAS unsigned char* Kl = C.lds + us * U_BYTES; LAS unsigned char* Sl = Kl + 64 * PB; LAS unsigned char* Vl = Kl + 192 * PB;
        f32x4 a[4];
#pragma unroll
        for (int kt = 0; kt < 4; ++kt) {
            a[kt] = (f32x4){0.f, 0.f, 0.f, 0.f};
            if (kt <= qt) {
#pragma unroll
                for (int ks = 0; ks < 2; ++ks) {
                    const bf16x8 kf = *(const LAS bf16x8*)(Kl + (16 * kt + fr) * PB + (32 * ks + 8 * fq) * 2);
                    a[kt] = MFMA16(kf, qf[ks], a[kt]);
                }
#pragma unroll
                for (int r = 0; r < 4; ++r) if (16 * kt + 4 * fq + r > 16 * qt + fr) a[kt][r] = 0.f;
            }
        }
        bf16x8 pf[2];
#pragma unroll
        for (int kk = 0; kk < 2; ++kk) { u32x4 w; w.x = pk2(a[2 * kk][0], a[2 * kk][1]); w.y = pk2(a[2 * kk][2], a[2 * kk][3]); w.z = pk2(a[2 * kk + 1][0], a[2 * kk + 1][1]); w.w = pk2(a[2 * kk + 1][2], a[2 * kk + 1][3]); pf[kk] = __builtin_bit_cast(bf16x8, w); }
        f32x4 o[8]; float ss = 0.f;
#pragma unroll
        for (int dt = 0; dt < 8; ++dt) {
            f32x4 acc = (f32x4){0.f, 0.f, 0.f, 0.f};
#pragma unroll
            for (int kk = 0; kk < 2; ++kk) {
                if (2 * kk <= qt) {
                    const LAS unsigned char* vp = Vl + (16 * dt + fr) * PB + (32 * kk + 4 * fq) * 2; const u32x2 lo = *(const LAS u32x2*)vp, hi = *(const LAS u32x2*)(vp + 32);
                    acc = MFMA16(__builtin_bit_cast(bf16x8, (u32x4){lo.x, lo.y, hi.x, hi.y}), pf[kk], acc);
                }
            }
#pragma unroll
            for (int ks = 0; ks < 2; ++ks) {
                const bf16x8 sf = *(const LAS bf16x8*)(Sl + (16 * dt + fr) * PB + (32 * ks + 8 * fq) * 2);
                acc = MFMA16(sf, qf[ks], acc);
            }
            o[dt] = acc; ss += acc[0] * acc[0] + acc[1] * acc[1] + acc[2] * acc[2] + acc[3] * acc[3];
        }
        ss += __shfl_xor(ss, 16); ss += __shfl_xor(ss, 32);
        const float rn = rsqrtf(ss * (1.f / 128.f) + EPS);
#pragma unroll
        for (int dt = 0; dt < 8; ++dt) {
            const f32x4 gn = *(const f32x4*)(P.in[19] + l * 128 + 16 * dt + 4 * fq);
            const u32x2 gw = *(const u32x2*)(ZG + rq * 1536 + 1024 + h * 128 + 16 * dt + 4 * fq);
            const float g0 = blo(gw.x), g1 = bhi(gw.x), g2 = blo(gw.y), g3 = bhi(gw.y);
            u32x2 w; w.x = pk2(o[dt][0] * rn * gn[0] * silu(g0), o[dt][1] * rn * gn[1] * silu(g1)); w.y = pk2(o[dt][2] * rn * gn[2] * silu(g2), o[dt][3] * rn * gn[3] * silu(g3));
            *(u32x2*)(MIX + rq * 1024 + 512 + h * 128 + 16 * dt + 4 * fq) = w;
        }
        __syncthreads();
    }
}

DI void gla_decode_unit(const Ctx& C, int l, int unit) {
    unsigned char* ws = C.ws; const CAS Params& P = *C.p;
    const int b = unit >> 2, h = unit & 3; const size_t rb = (size_t)TP + b * 4;
    const bf16_t* ZG = (const bf16_t*)(ws + WS_ZG); const float* LR = (const float*)(ws + WS_LR); bf16_t* MIX = (bf16_t*)(ws + WS_MIX);
    LAS float* la = (LAS float*)C.lds;
    LAS float* qr = la + 256;
    LAS float* kr = qr + 256;
    LAS float* qe = kr + 256;
    LAS float* ke = qe + 256;
    LAS float* Am = ke + 256;
    LAS float* red = Am + 16;
    LAS float* opart = red + 8;
    if (C.tid < 256) {
        const int tt = C.tid >> 6, dk = C.tid & 63; float x = P.in[18][l * 256 + h * 64 + dk];
        const f32x4 l0 = *(const f32x4*)(LR + (rb + tt) * 16), l1 = *(const f32x4*)(LR + (rb + tt) * 16 + 4), l2 = *(const f32x4*)(LR + (rb + tt) * 16 + 8), l3 = *(const f32x4*)(LR + (rb + tt) * 16 + 12);
        const float* wg = P.in[17] + (size_t)(l * 16) * 256 + h * 64 + dk;
#pragma unroll
        for (int r = 0; r < 4; ++r) { x += l0[r] * wg[r * 256] + l1[r] * wg[(4 + r) * 256] + l2[r] * wg[(8 + r) * 256] + l3[r] * wg[(12 + r) * 256]; }
        la[tt * 64 + dk] = logsig(x) * (1.f / 16.f);
        qr[tt * 64 + dk] = bf2f(ZG[(rb + tt) * 1536 + h * 64 + dk]); kr[tt * 64 + dk] = bf2f(ZG[(rb + tt) * 1536 + 256 + h * 64 + dk]);
    }
    __syncthreads();
    if (C.tid < 64) { float run = 0.f;
#pragma unroll
        for (int tt = 0; tt < 4; ++tt) { run += la[tt * 64 + C.tid]; la[tt * 64 + C.tid] = run; } }
    __syncthreads();
    if (C.tid < 256) {
        const int tt = C.tid >> 6, dk = C.tid & 63; const float bt = la[tt * 64 + dk], b3 = la[3 * 64 + dk];
        qe[tt * 64 + dk] = 0.125f * qr[tt * 64 + dk] * __expf(bt); ke[tt * 64 + dk] = kr[tt * 64 + dk] * __expf(b3 - bt);
    } else if (C.tid < 272) {
        const int tt = (C.tid - 256) >> 2, s = (C.tid - 256) & 3; float sum = 0.f;
        if (s <= tt) for (int dk = 0; dk < 64; ++dk) sum += 0.125f * qr[tt * 64 + dk] * kr[s * 64 + dk] * __expf(la[tt * 64 + dk] - la[s * 64 + dk]);
        Am[C.tid - 256] = sum;
    }
    __syncthreads();
    {
        const int dv = C.tid & 127, dq = C.tid >> 7;
        float v[4], o[4] = {0.f, 0.f, 0.f, 0.f};
#pragma unroll
        for (int tt = 0; tt < 4; ++tt) v[tt] = bf2f(ZG[(rb + tt) * 1536 + 512 + h * 128 + dv]);
        const float* S0p = P.in[4] + ((size_t)(l * 128 + b) * 4 + h) * 8192 + (size_t)(16 * dq) * 128 + dv; float* Sn = C.out + O_GS + ((size_t)(l * 128 + b) * 4 + h) * 8192 + (size_t)(16 * dq) * 128 + dv;
        float S0[16];
#pragma unroll
        for (int i = 0; i < 16; ++i) S0[i] = S0p[i * 128];
#pragma unroll
        for (int i = 0; i < 16; ++i) {
            const int dk = 16 * dq + i;
            float sn = __expf(la[3 * 64 + dk]) * S0[i];
#pragma unroll
            for (int tt = 0; tt < 4; ++tt) { o[tt] += qe[tt * 64 + dk] * S0[i]; sn += ke[tt * 64 + dk] * v[tt]; }
            Sn[i * 128] = sn;
        }
#pragma unroll
        for (int tt = 0; tt < 4; ++tt) opart[(dq * 4 + tt) * 128 + dv] = o[tt];
    }
    __syncthreads();
    {
        const int tt = C.tid >> 7, dv = C.tid & 127;
        float o = opart[(0 * 4 + tt) * 128 + dv] + opart[(1 * 4 + tt) * 128 + dv] + opart[(2 * 4 + tt) * 128 + dv] + opart[(3 * 4 + tt) * 128 + dv];
        for (int s = 0; s <= tt; ++s) o += Am[tt * 4 + s] * bf2f(ZG[(rb + s) * 1536 + 512 + h * 128 + dv]);
        float ss = o * o;
#pragma unroll
        for (int of = 1; of < 64; of <<= 1) ss += __shfl_xor(ss, of);
        if (C.lane == 0) red[C.wave] = ss;
        __syncthreads();
        const float tot = red[2 * tt] + red[2 * tt + 1];
        const float rn = rsqrtf(tot * (1.f / 128.f) + EPS);
        const float gg = bf2f(ZG[(rb + tt) * 1536 + 1024 + h * 128 + dv]);
        const float val = o * rn * P.in[19][l * 128 + dv] * silu(gg);
        MIX[(rb + tt) * 1024 + 512 + h * 128 + dv] = (bf16_t)(pk2(val, 0.f) & 0xffffu);
    }
    __syncthreads();
}

__global__ void __launch_bounds__(512, 2) hymba_fwd(Params prm) {
    extern __shared__ __attribute__((aligned(16))) unsigned char smem[];
    cg::grid_group grid = cg::this_grid();
    Ctx C; C.lds = (LAS unsigned char*)smem; C.tid = threadIdx.x; C.lane = C.tid & 63; C.wave = __builtin_amdgcn_readfirstlane(C.tid >> 6);
    C.G = gridDim.x; C.bx = blockIdx.x; C.p = (const CAS Params*)__builtin_amdgcn_kernarg_segment_ptr(); C.ws = C.p->ws; C.out = C.p->out;
    (void)prm;

    unsigned* barw = (unsigned*)(C.ws + WS_BAR);
    if (C.bx == 0) for (int i = C.tid; i < XCD_BAR_WORDS; i += 512) barw[i] = 0u;
    if (C.tid < 4) ((LAS unsigned*)(C.lds + LDS_BYTES - 16))[C.tid] = 0u;
    grid.sync();
    XcdBarrier xbar = xcd_barrier_post(barw, (volatile LAS unsigned*)(C.lds + LDS_BYTES - 16));
    for (int rep = 0; rep < REP_P0; ++rep) p0_prologue(C);
    xcd_barrier(xbar);
    {   unsigned char* ws = C.ws;
        pg8::Gemm g{(const bf16_t*)(ws + WS_MEMB), (const bf16_t*)(ws + WS_WKV), 1024, 2048, 1024};
        const int n1 = (T / 256) * (5632 / 256);
        pg8::StaticOrder S; S.init(1024, 2048, C.G, (C.bx + C.G - (n1 % C.G)) % C.G);
        Epi<EK_MEM> E; E.c = EpiCtx{}; E.c.rss_in = (const float*)(ws + WS_RSSM); E.c.MKV = (float*)(ws + WS_MKV);
        pg8::gemm_phase(C.lds, C.tid, g, S, E);
    }
    int rep = 0;
    for (int ph = 0; ph < 24; ++ph) {
        { int t_ = threadIdx.x; asm volatile("" : "+v"(t_)); C.tid = t_; C.lane = t_ & 63; C.wave = __builtin_amdgcn_readfirstlane(t_ >> 6); }
        asm volatile("" : "+s"(C.ws), "+s"(C.out), "+s"(C.p));
        unsigned char* ws = C.ws; float* RSS = (float*)(ws + WS_RSS);
        const int l = ph / 12, k = ph - 12 * l;
        unsigned char* wl = ws + WS_WL + (size_t)l * WL_SIZE;
        EpiCtx ec{}; ec.l = l;
        if (k == 0 || k == 10) {
            pg8::Gemm g{(const bf16_t*)(ws + WS_XB), (const bf16_t*)(wl + (k == 0 ? WL_W1 : WL_W2)), T, 5632, 1024};
            pg8::StaticOrder S; S.init(T, 5632, C.G, C.bx);
            ec.rss_in = RSS + (size_t)(4 * l + (k == 0 ? 0 : 3)) * T; ec.H = (bf16_t*)(ws + WS_H);
            Epi<EK_SWIGLU> E; E.c = ec; pg8::gemm_phase(C.lds, C.tid, g, S, E);
            if (ph == 0 && rep == 0) convert_in_slack(C, 0, T_WD1, 688, (T / 256) * 22 + 32);
            if (ph == 10 && rep == 0) convert_in_slack(C, 1, 704, T_WKV, (T / 256) * 22);
        } else if (k == 1 || k == 6 || k == 9 || k == 11) {
            const bf16_t* A; const bf16_t* B; int K; float sc; int ro;
            if (k == 1) { A = (const bf16_t*)(ws + WS_H); B = (const bf16_t*)(wl + WL_WD1); K = FF; sc = 0.5f; ro = 4 * l + 1; }
            else if (k == 6) { A = (const bf16_t*)(ws + WS_MIX); B = (const bf16_t*)(wl + WL_WOUT); K = 1024; sc = 1.f; ro = 4 * l + 2; }
            else if (k == 9) { A = (const bf16_t*)(ws + WS_OX); B = (const bf16_t*)(wl + WL_WO); K = 512; sc = 1.f; ro = 4 * l + 3; }
            else { A = (const bf16_t*)(ws + WS_H); B = (const bf16_t*)(wl + WL_WD2); K = FF; sc = 0.5f; ro = 4 * l + 4; }
            pg8::Gemm g{A, B, TP, 1024, K};
            pg8::StaticOrder S; S.init(TP, 1024, C.G, C.bx);
            ec.rss_out = RSS + (size_t)ro * T; ec.X = (ph == 23) ? C.out : nullptr; ec.XB = (bf16_t*)(ws + WS_XB); ec.scale = sc;
            Epi<EK_RES> E; E.c = ec; pg8::gemm_phase(C.lds, C.tid, g, S, E);
            thin_res_gemm(C, A, B, K, sc, RSS + (size_t)ro * T, (ph == 23) ? C.out : nullptr);
        } else if (k == 2) {
            pg8::Gemm g{(const bf16_t*)(ws + WS_XB), (const bf16_t*)(wl + WL_WIN), T, INWP, 1024};
            pg8::StaticOrder S; S.init(T, INWP, C.G, C.bx);
            ec.rss_in = RSS + (size_t)(4 * l + 1) * T; ec.QS = (bf16_t*)(ws + WS_QS); ec.KS = (bf16_t*)(ws + WS_KS); ec.VS = (bf16_t*)(ws + WS_VS); ec.ZG = (bf16_t*)(ws + WS_ZG);
            ec.LR = (float*)(ws + WS_LR); ec.rope = (const float2*)(ws + WS_ROPE); ec.gq = C.p->in[14] + l * 64; ec.gk = C.p->in[15] + l * 64;
            ec.okp = C.out + O_KP; ec.ovp = C.out + O_VP; ec.oks = C.out + O_KS; ec.ovs = C.out + O_VS;
            Epi<EK_WIN> E; E.c = ec; pg8::gemm_phase(C.lds, C.tid, g, S, E);
            if (ph == 2 && rep == 0) convert_in_slack(C, 0, 688, T_WKV, (T / 256) * 10);
        } else if (k == 3) {
            for (int u = C.bx; u < 256; u += C.G) swa_prompt_unit(C, l, u);
            gla_a_phase(C, l);
        } else if (k == 4) {
            gla_scan(C, l);
            for (int u = C.bx; u < 512; u += C.G) gla_decode_unit(C, l, u);
            for (int u = C.bx; u < 256; u += C.G) swa_decode_unit(C, l, u);
        } else if (k == 5) {
            gla_c_phase(C, l);
        } else if (k == 7) {
            pg8::Gemm g{(const bf16_t*)(ws + WS_XB), (const bf16_t*)(wl + WL_WQ), T, 512, 1024};
            pg8::StaticOrder S; S.init(T, 512, C.G, C.bx);
            ec.rss_in = RSS + (size_t)(4 * l + 2) * T; ec.QX = (bf16_t*)(ws + WS_QX);
            Epi<EK_XQ> E; E.c = ec; pg8::gemm_phase(C.lds, C.tid, g, S, E);
            if (ph == 7 && rep == 0) convert_in_slack(C, 1, 0, 704, (T / 256) * 2);
        } else {
            if (C.G == 256) {
                if (C.bx < 128) { xattn_unit(C, l, C.bx); xattn_unit(C, l, 128 + C.bx); }
                else for (int i = 0; i < 3; ++i) xattn_unit(C, l, 128 + 128 + 3 * (C.bx - 128) + i);
            } else for (int u = C.bx; u < 640; u += C.G) xattn_unit(C, l, u);
        }
        if (ph != 23) for (int r2 = 0; r2 < REP_SYNC; ++r2) xcd_barrier(xbar);
        {
            const int want = (k == 0 || k == 2 || k == 7 || k == 10) ? REP_GEMM : (k == 3 ? REP3 : (k == 4 ? REP4 : k == 5 ? REP5 : (k == 8 ? REP8 : 1)));
            if (rep + 1 < want) { ++rep; --ph; } else rep = 0;
        }
    }
}

extern "C" void kernel_launch(void* const* d_in, const int* in_sizes, int n_in, void* d_out, int out_size, void* d_ws, size_t ws_size, hipStream_t stream) {
    static int grid = 0;
    if (grid == 0) {
        if (n_in != 33 || ws_size < WS_TOTAL) { fprintf(stderr, "kernel_launch: need 33 inputs and %zu bytes of workspace; got %d inputs, %zu bytes\n", (size_t)WS_TOTAL, n_in, ws_size); grid = -1; return; }
        int dev = 0, cus = 0, per_cu = 0;
        (void)hipGetDevice(&dev); (void)hipDeviceGetAttribute(&cus, hipDeviceAttributeMultiprocessorCount, dev);
        if (hipFuncSetAttribute((const void*)hymba_fwd, hipFuncAttributeMaxDynamicSharedMemorySize, LDS_BYTES) != hipSuccess) { fprintf(stderr, "kernel_launch: hipFuncSetAttribute failed\n"); grid = -1; return; }
        if (hipOccupancyMaxActiveBlocksPerMultiprocessor(&per_cu, (const void*)hymba_fwd, 512, LDS_BYTES) != hipSuccess || per_cu < 1) { fprintf(stderr, "kernel_launch: occupancy query gave %d\n", per_cu); grid = -1; return; }
        grid = cus * per_cu;
    }
    if (grid < 0) return;
    Params p{};
    for (int i = 0; i < 33; ++i) p.in[i] = (const float*)d_in[i];
    p.out = (float*)d_out; p.ws = (unsigned char*)d_ws;
    void* args[] = {&p};
    hipError_t e = hipLaunchCooperativeKernel((const void*)hymba_fwd, dim3(grid), dim3(512), args, LDS_BYTES, stream);
    if (e != hipSuccess) fprintf(stderr, "kernel_launch: cooperative launch failed: %s (grid %d)\n", hipGetErrorString(e), grid);
}
```

```cpp
#include <hip/hip_runtime.h>
#include <hip/hip_cooperative_groups.h>
#include <cstdio>
#include <cstdint>
namespace cg = cooperative_groups;

#define LAS __attribute__((address_space(3)))
#define DI __device__ __forceinline__
typedef unsigned short bf16_t;
typedef short bf16x8 __attribute__((ext_vector_type(8)));
typedef float f32x4 __attribute__((ext_vector_type(4)));
typedef unsigned u32x4 __attribute__((ext_vector_type(4)));
typedef unsigned u32x2 __attribute__((ext_vector_type(2)));
typedef short v4i16_t __attribute__((ext_vector_type(4)));
#define MFMA16(a, b, c) __builtin_amdgcn_mfma_f32_16x16x32_bf16((a), (b), (c), 0, 0, 0)

constexpr int TP = 16384, TS = 512, T = TP + TS, DM = 1024, FF = 2816, SEQ = 4096;
constexpr int INWP = 2560;
constexpr float EPS = 1e-6f;
constexpr size_t O_Y = 0, O_KP = 17301504, O_VP = 17432576, O_GP = 17563648, O_MKP = 17825792, O_MVP = 18874368, O_KS = 19922944, O_VS = 24117248, O_GS = 28311552;
constexpr size_t al(size_t x) { return (x + 4095) & ~(size_t)4095; }
constexpr size_t WS_RSS = 0;
constexpr size_t WS_RSSM = al(WS_RSS + (size_t)9 * T * 4);
constexpr size_t WS_ROPE = al(WS_RSSM + 1024 * 4);
constexpr size_t WS_XB = al(WS_ROPE + (size_t)4100 * 32 * 8);
constexpr size_t WS_H = al(WS_XB + (size_t)T * 1024 * 2);
constexpr size_t WS_QS = al(WS_H + (size_t)T * FF * 2);
constexpr size_t WS_KS = al(WS_QS + (size_t)T * 512 * 2);
constexpr size_t WS_VS = al(WS_KS + (size_t)T * 128 * 2);
constexpr size_t WS_ZG = al(WS_VS + (size_t)T * 128 * 2);
constexpr size_t WS_LR = al(WS_ZG + (size_t)T * 1536 * 2);
constexpr size_t WS_MIX = al(WS_LR + (size_t)T * 16 * 4);
constexpr size_t WS_QX = al(WS_MIX + (size_t)T * 1024 * 2);
constexpr size_t WS_OX = al(WS_QX + (size_t)T * 512 * 2);
constexpr size_t WS_MEMB = al(WS_OX + (size_t)T * 512 * 2);
constexpr size_t WS_MKV = al(WS_MEMB + (size_t)1024 * 1024 * 2);
constexpr size_t WS_BCUM = al(WS_MKV + (size_t)1024 * 2048 * 4);
constexpr size_t WS_ST = al(WS_BCUM + (size_t)TP * 256 * 4);
constexpr size_t WS_VT = al(WS_ST + (size_t)1024 * 8192 * 4);
constexpr size_t WS_DEC = al(WS_VT + (size_t)1024 * 8192 * 2);
constexpr size_t WS_WKV = al(WS_DEC + (size_t)1024 * 64 * 4);
constexpr size_t WS_WL = al(WS_WKV + (size_t)2048 * 1024 * 2);
constexpr size_t WL_W1 = 0;
constexpr size_t WL_WD1 = WL_W1 + (size_t)5632 * 1024 * 2;
constexpr size_t WL_WIN = WL_WD1 + (size_t)1024 * FF * 2;
constexpr size_t WL_WOUT = WL_WIN + (size_t)INWP * 1024 * 2;
constexpr size_t WL_WQ = WL_WOUT + (size_t)1024 * 1024 * 2;
constexpr size_t WL_WO = WL_WQ + (size_t)512 * 1024 * 2;
constexpr size_t WL_W2 = WL_WO + (size_t)1024 * 512 * 2;
constexpr size_t WL_WD2 = WL_W2 + (size_t)5632 * 1024 * 2;
constexpr size_t WL_SIZE = al(WL_WD2 + (size_t)1024 * FF * 2);
constexpr size_t WS_STB = WS_WL + 2 * WL_SIZE;
constexpr size_t WS_BAR = al(WS_STB + (size_t)1024 * 8192 * 2);
constexpr size_t WS_TOTAL = WS_BAR + 16384;
constexpr int LDS_BYTES = 147456;
constexpr int REP_GEMM = 1, REP_ATT = 1, REP_P0 = 1, REP_SYNC = 1, REP3 = 1, REP4 = 1, REP5 = 1, REP8 = 1;

DI float bf2f(unsigned h) { return __builtin_bit_cast(float, h << 16); }
typedef float f32x2_t __attribute__((ext_vector_type(2)));
typedef __bf16 bf16x2_t __attribute__((ext_vector_type(2)));
DI unsigned pk2(float lo, float hi) { const f32x2_t v = {lo, hi}; const bf16x2_t b = __builtin_convertvector(v, bf16x2_t); return __builtin_bit_cast(unsigned, b); }
DI float blo(unsigned w) { return __builtin_bit_cast(float, w << 16); }
DI float bhi(unsigned w) { return __builtin_bit_cast(float, w & 0xffff0000u); }
DI float silu(float x) { return x * __builtin_amdgcn_rcpf(1.f + __builtin_amdgcn_exp2f(x * -1.4426950408889634f)); }
DI float logsig(float x) { return fminf(x, 0.f) - log1pf(__expf(-fabsf(x))); }

#define XB_TMO      128
#define XB_XCNT(j)  (256  + 64 * (j))
#define XB_XSUB(j)  (1280 + 64 * (j))
#define XB_XGEN(j)  (2304 + 64 * (j))
#define XB_TOP      3328
#define XB_TOPGEN   3392
#define XCD_BAR_WORDS 3456
#define XB_SPIN_CAP (1u << 18)
DI unsigned xb_ld(unsigned* p)              { return __hip_atomic_load(p, __ATOMIC_RELAXED, __HIP_MEMORY_SCOPE_AGENT); }
DI unsigned xb_add(unsigned* p, unsigned v) { return __hip_atomic_fetch_add(p, v, __ATOMIC_RELAXED, __HIP_MEMORY_SCOPE_AGENT); }
DI unsigned xb_xcc_id() { return (unsigned)__builtin_amdgcn_s_getreg((3 << 11) | 20) & 0xFu; }
#define XB_SPIN(cond, bar) do { unsigned _sp = 0; while (cond) { __builtin_amdgcn_s_sleep(1); \
    if ((++_sp & 255u) == 0u) { if (xb_ld(&(bar)[XB_TMO])) break; if (_sp > XB_SPIN_CAP) { atomicAdd(&(bar)[XB_TMO], 1u); break; } } } } while (0)
struct XcdBarrier { unsigned* bar; unsigned x; volatile LAS unsigned* st; };
DI XcdBarrier xcd_barrier_post(unsigned* bar, volatile LAS unsigned* st) {
    XcdBarrier b; b.bar = bar; b.x = xb_xcc_id(); b.st = st;
    if (threadIdx.x == 0) (void)xb_add(&bar[XB_XCNT(b.x)], 1u);
    return b;
}
DI void xcd_barrier_complete(unsigned* bar, unsigned x, unsigned& nloc, unsigned& nx) {
    const unsigned G = gridDim.x * gridDim.y * gridDim.z;
    unsigned sum, cnt, mine, sp = 0u;
    for (;;) {
        sum = 0u; cnt = 0u; mine = 0u;
#pragma unroll
        for (unsigned j = 0; j < 16; ++j) { const unsigned c = xb_ld(&bar[XB_XCNT(j)]); sum += c; cnt += (c > 0u) ? 1u : 0u; mine = (j == x) ? c : mine; }
        if (sum == G) break;
        __builtin_amdgcn_s_sleep(1);
        if ((++sp & 255u) == 0u) { if (xb_ld(&bar[XB_TMO])) break; if (sp > XB_SPIN_CAP) { atomicAdd(&bar[XB_TMO], 1u); break; } }
    }
    nloc = mine > 0u ? mine : 1u; nx = cnt > 0u ? cnt : 1u;
}
DI void xcd_barrier(const XcdBarrier& b) {
    asm volatile("s_waitcnt vmcnt(0)" ::: "memory");
    __syncthreads();
    if (threadIdx.x == 0) {
        unsigned* bar = b.bar;
        __builtin_amdgcn_s_waitcnt(0);
        unsigned nloc = b.st[0], nx = b.st[1];
        if (nloc == 0u) { xcd_barrier_complete(bar, b.x, nloc, nx); b.st[0] = nloc; b.st[1] = nx; }
        const unsigned old = xb_add(&bar[XB_XSUB(b.x)], 1u);
        const unsigned gen = old / nloc;
        if (old + 1u == (gen + 1u) * nloc) {
            __builtin_amdgcn_fence(__ATOMIC_RELEASE, "agent");
            asm volatile("s_waitcnt vmcnt(0)" ::: "memory");
            const unsigned og = xb_add(&bar[XB_TOP], 1u);
            const unsigned tg = og / nx;
            if (og + 1u == (tg + 1u) * nx) xb_add(&bar[XB_TOPGEN], 1u);
            else XB_SPIN(xb_ld(&bar[XB_TOPGEN]) == tg, bar);
            __builtin_amdgcn_fence(__ATOMIC_ACQUIRE, "agent");
            xb_add(&bar[XB_XGEN(b.x)], 1u);
            asm volatile("s_waitcnt vmcnt(0)" ::: "memory");
        } else {
            XB_SPIN(xb_ld(&bar[XB_XGEN(b.x)]) == gen, bar);
            __builtin_amdgcn_fence(__ATOMIC_ACQUIRE, "agent");
            asm volatile("s_waitcnt vmcnt(0)" ::: "memory");
        }
    }
    __syncthreads();
}

namespace pg8 {
constexpr int BM = 256, BK = 64, HALF = 128, HTB = HALF * BK * 2, STAGE_BYTES = 8 * HTB, NXCD = 8, WGM = 8;
DI int lds_byte(int r, int c) { const int st = (r >> 4) * 2 + (c >> 5), rr = r & 15, cc = c & 31, ob = rr * 64 + cc * 2; return st * 1024 + (ob ^ (((ob >> 9) & 1) << 5)); }
DI void stage_rc(int b, int& R, int& C) { const int st = b / 1024, sb = b % 1024, swz = sb ^ (((sb >> 9) & 1) << 5); R = (st >> 1) * 16 + swz / 64; C = (st & 1) * 32 + (swz % 64) / 2; }
DI int perm32(int rho) { const int n = rho >> 4, i = rho & 15; return 8 * (i >> 2) + 4 * n + (i & 3); }
struct Unit { int pm, pn; };
struct Gemm { const bf16_t* A; const bf16_t* Bt; int M, N, K; };
struct StaticOrder {
    int nM, nN, nwg, G, c;
    DI void init(int M, int N, int G_, int c_) { nM = M / BM; nN = N / BM; nwg = nM * nN; G = G_; c = c_; }
    DI bool next(int i, Unit& u) const {
        const long L = (long)i * G + c; if (L >= nwg) return false;
        int wgid = (int)L; { const int q = nwg / NXCD, r = nwg % NXCD, xcd = wgid % NXCD, off = wgid / NXCD; wgid = (xcd < r ? xcd * (q + 1) : r * (q + 1) + (xcd - r) * q) + off; }
        const int nig = WGM * nN, gid = wgid / nig, fm = gid * WGM, gsz = (nM - fm) < WGM ? (nM - fm) : WGM;
        u.pm = fm + ((wgid % nig) % gsz); u.pn = (wgid % nig) / gsz; return true;
    }
};
template <class Epi, class Sched>
DI void gemm_phase(LAS unsigned char* lds, const int tid, const Gemm g, const Sched& S, const Epi& E) {
    const int wid = __builtin_amdgcn_readfirstlane(tid >> 6), lane = tid & 63, wr = wid >> 2, wc = wid & 3, fr = lane & 15, fq = lane >> 4;
    const int K = g.K, nt = K / BK;
    unsigned voffA[2], voffB[2];
#pragma unroll
    for (int i = 0; i < 2; ++i) { int R, C; stage_rc(tid * 16 + i * 8192, R, C); const int Rb = (R & ~31) + perm32(R & 31);
        voffA[i] = (unsigned)(R * K + C) * 2u; voffB[i] = (unsigned)(Rb * K + C) * 2u; }
    const size_t kstep = (size_t)(BK * 2);
    const size_t hstep = (size_t)HALF * K * 2;
    const size_t tstep = 2 * hstep;
    const unsigned ldsw = (unsigned)wid * 1024u;
    const int aoff = lds_byte(wr * 64 + fr, fq * 8), boff = lds_byte(wc * 32 + fr, fq * 8);
#define PG8_SA(b, h) (((b) * 2 + (h)) * HTB)
#define PG8_SB(b, h) ((4 + (b) * 2 + (h)) * HTB)
#define PG8_STAGE(bufoff, gbase, voff) do { _Pragma("unroll") for (int _i = 0; _i < 2; ++_i) \
        __builtin_amdgcn_global_load_lds((const unsigned*)((const char*)(gbase) + (voff)[_i]), (LAS unsigned*)(lds + (bufoff) + ldsw + _i * 8192), 16, 0, 0); } while (0)
#define PG8_LDA(dst, b, h) do { _Pragma("unroll") for (int m = 0; m < 4; ++m) _Pragma("unroll") for (int k = 0; k < 2; ++k) dst[m][k] = *(const LAS bf16x8*)(lds + PG8_SA(b, h) + aoff + m * 2048 + k * 1024); } while (0)
#define PG8_LDB(dst, b, h) do { _Pragma("unroll") for (int n = 0; n < 2; ++n) _Pragma("unroll") for (int k = 0; k < 2; ++k) dst[n][k] = *(const LAS bf16x8*)(lds + PG8_SB(b, h) + boff + n * 2048 + k * 1024); } while (0)
#define PG8_MMA(ai, bj, At, Bt) do { __builtin_amdgcn_s_setprio(1); _Pragma("unroll") for (int m = 0; m < 4; ++m) _Pragma("unroll") for (int n = 0; n < 2; ++n) _Pragma("unroll") for (int k = 0; k < 2; ++k) \
        acc[ai][bj][m][n] = __builtin_amdgcn_mfma_f32_16x16x32_bf16(Bt[n][k], At[m][k], acc[ai][bj][m][n], 0, 0, 0); __builtin_amdgcn_s_setprio(0); } while (0)
#define PG8_WAIT_V(n) asm volatile("s_waitcnt vmcnt(" #n ")" ::: "memory")
#define PG8_WAIT_L(n) asm volatile("s_waitcnt lgkmcnt(" #n ")" ::: "memory")
#define PG8_BAR __builtin_amdgcn_s_barrier()
#define PG8_SCHED __builtin_amdgcn_sched_barrier(0)
    Unit cur, nxt; int ui = 0;
    if (!S.next(0, cur)) return;
    f32x4 acc[2][2][4][2];
#pragma unroll
    for (int a = 0; a < 2; ++a)
#pragma unroll
        for (int b = 0; b < 2; ++b)
#pragma unroll
            for (int m = 0; m < 4; ++m)
#pragma unroll
                for (int n = 0; n < 2; ++n) acc[a][b][m][n] = (f32x4){0.f, 0.f, 0.f, 0.f};
    bf16x8 At[4][2], B0[2][2], B1[2][2];
    const char* cA = (const char*)g.A + (size_t)cur.pm * tstep; const char* cB = (const char*)g.Bt + (size_t)cur.pn * tstep;
    PG8_STAGE(PG8_SB(0, 0), cB, voffB); PG8_STAGE(PG8_SB(0, 1), cB + hstep, voffB); PG8_STAGE(PG8_SA(0, 0), cA, voffA); PG8_STAGE(PG8_SA(0, 1), cA + hstep, voffA);
    if (wr == 1) PG8_BAR;
    PG8_WAIT_V(2); PG8_BAR;
    PG8_STAGE(PG8_SB(1, 0), cB + kstep, voffB); PG8_STAGE(PG8_SA(1, 0), cA + kstep, voffA); PG8_STAGE(PG8_SB(1, 1), cB + hstep + kstep, voffB);
    PG8_WAIT_V(6); PG8_BAR;
    for (;;) {
        const bool has_next = S.next(ui + 1, nxt);
        const char* nA = has_next ? (const char*)g.A + (size_t)nxt.pm * tstep : cA; const char* nB = has_next ? (const char*)g.Bt + (size_t)nxt.pn * tstep : cB;
        for (int t = 0; t < nt; t += 2) {
            const bool last = (t == nt - 2);
            const char* a1 = cA + (size_t)(t + 1) * kstep;
            const char* a2 = last ? nA : cA + (size_t)(t + 2) * kstep; const char* b2 = last ? nB : cB + (size_t)(t + 2) * kstep;
            const char* a3 = a2 + kstep; const char* b3 = b2 + kstep;
            PG8_LDB(B0, 0, 0); PG8_LDB(B1, 0, 1); PG8_SCHED; PG8_LDA(At, 0, 0); PG8_STAGE(PG8_SA(1, 1), a1 + hstep, voffA);
            PG8_WAIT_V(8); PG8_WAIT_L(0); PG8_BAR; PG8_MMA(0, 0, At, B0); PG8_MMA(0, 1, At, B1); PG8_BAR; PG8_SCHED;
            PG8_LDA(At, 0, 1); PG8_STAGE(PG8_SB(0, 0), b2, voffB); PG8_STAGE(PG8_SB(0, 1), b2 + hstep, voffB); PG8_STAGE(PG8_SA(0, 0), a2, voffA);
            PG8_WAIT_V(8); PG8_WAIT_L(0); PG8_BAR; PG8_MMA(1, 0, At, B0); PG8_MMA(1, 1, At, B1); PG8_BAR; PG8_SCHED;
            PG8_LDB(B0, 1, 0); PG8_LDB(B1, 1, 1); PG8_SCHED; PG8_LDA(At, 1, 0); PG8_STAGE(PG8_SA(0, 1), a2 + hstep, voffA);
            PG8_WAIT_V(8); PG8_WAIT_L(0); PG8_BAR; PG8_MMA(0, 0, At, B0); PG8_MMA(0, 1, At, B1); PG8_BAR; PG8_SCHED;
            PG8_LDA(At, 1, 1); PG8_STAGE(PG8_SB(1, 0), b3, voffB); PG8_STAGE(PG8_SB(1, 1), b3 + hstep, voffB); PG8_STAGE(PG8_SA(1, 0), a3, voffA);
            PG8_WAIT_V(8); PG8_WAIT_L(0); PG8_BAR; PG8_MMA(1, 0, At, B0); PG8_MMA(1, 1, At, B1); PG8_BAR; PG8_SCHED;
        }
        if (wr == 0) PG8_BAR;
        E(acc, cur, wr, wc, fr, fq);
        if (!has_next) break;
#pragma unroll
        for (int a = 0; a < 2; ++a)
#pragma unroll
            for (int b = 0; b < 2; ++b)
#pragma unroll
                for (int m = 0; m < 4; ++m)
#pragma unroll
                    for (int n = 0; n < 2; ++n) acc[a][b][m][n] = (f32x4){0.f, 0.f, 0.f, 0.f};
        cur = nxt; cA = nA; cB = nB; ++ui;
        if (wr == 1) PG8_BAR;
    }
    PG8_WAIT_V(0);
    PG8_BAR;
#undef PG8_SA
#undef PG8_SB
#undef PG8_STAGE
#undef PG8_LDA
#undef PG8_LDB
#undef PG8_MMA
#undef PG8_WAIT_V
#undef PG8_WAIT_L
#undef PG8_BAR
#undef PG8_SCHED
}
}

struct EpiCtx {
    const float* rss_in; float* rss_out; float* X; bf16_t* XB; bf16_t* H;
    bf16_t *QS, *KS, *VS, *ZG; float* LR; const float2* rope; const float *gq, *gk;
    float *okp, *ovp, *oks, *ovs; bf16_t* QX; float* MKV; float scale; int l;
};
enum { EK_SWIGLU = 0, EK_RES = 1, EK_WIN = 2, EK_XQ = 3, EK_MEM = 4 };
template <int KIND> struct Epi {
    EpiCtx c;
    DI void operator()(const f32x4 (&acc)[2][2][4][2], const pg8::Unit& u, int wr, int wc, int fr, int fq) const {
        const int row0 = u.pm * 256 + wr * 64 + fr;
        const int cl = wc * 32 + 8 * fq;
        if constexpr (KIND == EK_RES) {
            u32x4 xo[2][4][2];
#pragma unroll
            for (int ai = 0; ai < 2; ++ai)
#pragma unroll
                for (int m = 0; m < 4; ++m)
#pragma unroll
                    for (int bj = 0; bj < 2; ++bj) xo[ai][m][bj] = *(const u32x4*)(c.XB + (size_t)(row0 + ai * 128 + m * 16) * DM + u.pn * 256 + bj * 128 + cl);
#pragma unroll
            for (int ai = 0; ai < 2; ++ai)
#pragma unroll
                for (int m = 0; m < 4; ++m) {
                    const int r = row0 + ai * 128 + m * 16;
                    float ss = 0.f;
#pragma unroll
                    for (int bj = 0; bj < 2; ++bj) {
                        bf16_t* xb = c.XB + (size_t)r * DM + u.pn * 256 + bj * 128 + cl;
                        const u32x4 xv = xo[ai][m][bj];
                        f32x4 x0 = (f32x4){blo(xv[0]), bhi(xv[0]), blo(xv[1]), bhi(xv[1])}, x1 = (f32x4){blo(xv[2]), bhi(xv[2]), blo(xv[3]), bhi(xv[3])};
                        x0 = x0 + acc[ai][bj][m][0] * c.scale; x1 = x1 + acc[ai][bj][m][1] * c.scale;
                        if (c.X) { float* xp = c.X + (size_t)r * DM + u.pn * 256 + bj * 128 + cl; *(f32x4*)xp = x0; *(f32x4*)(xp + 4) = x1; }
                        else {
                            u32x4 w; w.x = pk2(x0[0], x0[1]); w.y = pk2(x0[2], x0[3]); w.z = pk2(x1[0], x1[1]); w.w = pk2(x1[2], x1[3]);
                            *(u32x4*)xb = w;
#pragma unroll
                            for (int e = 0; e < 4; ++e) { const float a0 = blo(w[e]), a1 = bhi(w[e]); ss += a0 * a0 + a1 * a1; }
                        }
                    }
                    if (!c.X) { ss += __shfl_xor(ss, 16); ss += __shfl_xor(ss, 32); if (fq == 0) atomicAdd(c.rss_out + r, ss); }
                }
            return;
        }
#pragma unroll
        for (int ai = 0; ai < 2; ++ai)
#pragma unroll
            for (int m = 0; m < 4; ++m) {
                const int r = row0 + ai * 128 + m * 16;
                if constexpr (KIND == EK_SWIGLU) {
                    const float rs = rsqrtf(c.rss_in[r] * (1.f / 1024.f) + EPS);
                    const float rsn = rs * -1.4426950408889634f, rs2 = rs * rs;
                    float hv[8];
#pragma unroll
                    for (int n = 0; n < 2; ++n)
#pragma unroll
                        for (int j = 0; j < 4; ++j) { const float g0 = acc[ai][0][m][n][j], u0 = acc[ai][1][m][n][j];
                            hv[n * 4 + j] = (g0 * u0) * rs2 * __builtin_amdgcn_rcpf(1.f + __builtin_amdgcn_exp2f(g0 * rsn)); }
                    u32x4 w; w.x = pk2(hv[0], hv[1]); w.y = pk2(hv[2], hv[3]); w.z = pk2(hv[4], hv[5]); w.w = pk2(hv[6], hv[7]);
                    *(u32x4*)(c.H + (size_t)r * FF + u.pn * 128 + cl) = w;
                } else if constexpr (KIND == EK_XQ) {
                    const float rs = rsqrtf(c.rss_in[r] * (1.f / 1024.f) + EPS);
#pragma unroll
                    for (int bj = 0; bj < 2; ++bj) {
                        const f32x4 a0 = acc[ai][bj][m][0] * rs, a1 = acc[ai][bj][m][1] * rs;
                        u32x4 w; w.x = pk2(a0[0], a0[1]); w.y = pk2(a0[2], a0[3]); w.z = pk2(a1[0], a1[1]); w.w = pk2(a1[2], a1[3]);
                        *(u32x4*)(c.QX + (size_t)r * 512 + u.pn * 256 + bj * 128 + cl) = w;
                    }
                } else if constexpr (KIND == EK_MEM) {
                    const float rs = rsqrtf(c.rss_in[r] * (1.f / 1024.f) + EPS);
#pragma unroll
                    for (int bj = 0; bj < 2; ++bj) {
                        float* p = c.MKV + (size_t)r * 2048 + u.pn * 256 + bj * 128 + cl;
                        *(f32x4*)p = acc[ai][bj][m][0] * rs; *(f32x4*)(p + 4) = acc[ai][bj][m][1] * rs;
                    }
                } else {
                    const float rs = rsqrtf(c.rss_in[r] * (1.f / 1024.f) + EPS);
                    const int pn = u.pn;
                    if (pn < 2 || (pn == 2 && wc < 2)) {
                        const bool isq = pn < 2; const int head = isq ? (4 * pn + wc) : wc;
                        const float* gn = isq ? c.gq : c.gk;
                        float ss = 0.f;
#pragma unroll
                        for (int bj = 0; bj < 2; ++bj)
#pragma unroll
                            for (int n = 0; n < 2; ++n)
#pragma unroll
                                for (int j = 0; j < 4; ++j) { const float v = acc[ai][bj][m][n][j] * rs; ss += v * v; }
                        ss += __shfl_xor(ss, 16); ss += __shfl_xor(ss, 32);
                        const float rq = rsqrtf(ss * (1.f / 64.f) + EPS) * rs;
                        const int ridx = r < TP ? (r & (SEQ - 1)) : (4096 + (r & 3));
                        const float2* rp = c.rope + (size_t)ridx * 32 + 8 * fq;
                        float o1[8], o2[8];
#pragma unroll
                        for (int n = 0; n < 2; ++n)
#pragma unroll
                            for (int j = 0; j < 4; ++j) {
                                const int d = 8 * fq + 4 * n + j; const float2 cs = rp[4 * n + j];
                                const float y1 = acc[ai][0][m][n][j] * rq * gn[d], y2 = acc[ai][1][m][n][j] * rq * gn[32 + d];
                                o1[4 * n + j] = y1 * cs.x - y2 * cs.y; o2[4 * n + j] = y2 * cs.x + y1 * cs.y;
                            }
                        u32x4 w1, w2; w1.x = pk2(o1[0], o1[1]); w1.y = pk2(o1[2], o1[3]); w1.z = pk2(o1[4], o1[5]); w1.w = pk2(o1[6], o1[7]);
                        w2.x = pk2(o2[0], o2[1]); w2.y = pk2(o2[2], o2[3]); w2.z = pk2(o2[4], o2[5]); w2.w = pk2(o2[6], o2[7]);
                        if (isq) { bf16_t* p = c.QS + (size_t)r * 512 + head * 64 + 8 * fq; *(u32x4*)p = w1; *(u32x4*)(p + 32) = w2; }
                        else {
                            bf16_t* p = c.KS + (size_t)r * 128 + head * 64 + 8 * fq; *(u32x4*)p = w1; *(u32x4*)(p + 32) = w2;
                            float* op = nullptr;
                            if (r < TP) { const int t = r & (SEQ - 1); if (t >= SEQ - 128) op = c.okp + ((size_t)((c.l * 4 + (r >> 12)) * 128 + (t - (SEQ - 128)))) * 128; }
                            else { const int rr = r - TP; op = c.oks + ((size_t)((c.l * 128 + (rr >> 2)) * 128 + 124 + (rr & 3))) * 128; }
                            if (op) { op += head * 64 + 8 * fq;
                                *(f32x4*)op = (f32x4){o1[0], o1[1], o1[2], o1[3]}; *(f32x4*)(op + 4) = (f32x4){o1[4], o1[5], o1[6], o1[7]};
                                *(f32x4*)(op + 32) = (f32x4){o2[0], o2[1], o2[2], o2[3]}; *(f32x4*)(op + 36) = (f32x4){o2[4], o2[5], o2[6], o2[7]}; }
                        }
                    } else if (pn == 2) {
                        const int head = wc - 2;
                        float* op = nullptr;
                        if (r < TP) { const int t = r & (SEQ - 1); if (t >= SEQ - 128) op = c.ovp + ((size_t)((c.l * 4 + (r >> 12)) * 128 + (t - (SEQ - 128)))) * 128; }
                        else { const int rr = r - TP; op = c.ovs + ((size_t)((c.l * 128 + (rr >> 2)) * 128 + 124 + (rr & 3))) * 128; }
#pragma unroll
                        for (int bj = 0; bj < 2; ++bj) {
                            const f32x4 a0 = acc[ai][bj][m][0] * rs, a1 = acc[ai][bj][m][1] * rs;
                            u32x4 w; w.x = pk2(a0[0], a0[1]); w.y = pk2(a0[2], a0[3]); w.z = pk2(a1[0], a1[1]); w.w = pk2(a1[2], a1[3]);
                            *(u32x4*)(c.VS + (size_t)r * 128 + head * 64 + 32 * bj + 8 * fq) = w;
                            if (op) { float* q = op + head * 64 + 32 * bj + 8 * fq; *(f32x4*)q = a0; *(f32x4*)(q + 4) = a1; }
                        }
                    } else if (pn < 9) {
#pragma unroll
                        for (int bj = 0; bj < 2; ++bj) {
                            const f32x4 a0 = acc[ai][bj][m][0] * rs, a1 = acc[ai][bj][m][1] * rs;
                            u32x4 w; w.x = pk2(a0[0], a0[1]); w.y = pk2(a0[2], a0[3]); w.z = pk2(a1[0], a1[1]); w.w = pk2(a1[2], a1[3]);
                            *(u32x4*)(c.ZG + (size_t)r * 1536 + (pn - 3) * 256 + bj * 128 + cl) = w;
                        }
                    } else {
                        if (wc == 0 && fq < 2) { float* p = c.LR + (size_t)r * 16 + 8 * fq; *(f32x4*)p = acc[ai][0][m][0] * rs; *(f32x4*)(p + 4) = acc[ai][0][m][1] * rs; }
                    }
                }
            }
    }
};

template <int D, int NKT, bool HAS_SINK>
DI void attn16(const bf16x8 (&qf)[D / 32], LAS unsigned char* Kl, int kpitch, LAS unsigned char* Vt, int vpitch, int key0, int jlo, int jhi,
               float scale, float sink, bf16_t* orow, bool wr_ok, int fr, int fq) {
    f32x4 s[NKT];
#pragma unroll
    for (int t = 0; t < NKT; ++t) {
        s[t] = (f32x4){0.f, 0.f, 0.f, 0.f};
#pragma unroll
        for (int ks = 0; ks < D / 32; ++ks) { const bf16x8 kf = *(const LAS bf16x8*)(Kl + (key0 + 16 * t + fr) * kpitch + (32 * ks + 8 * fq) * 2); s[t] = MFMA16(kf, qf[ks], s[t]); }
    }
    float m = -INFINITY;
#pragma unroll
    for (int t = 0; t < NKT; ++t)
#pragma unroll
        for (int r = 0; r < 4; ++r) { const int j = key0 + 16 * t + 4 * fq + r; const float v = (j >= jlo && j <= jhi) ? s[t][r] * scale : -INFINITY; s[t][r] = v; m = fmaxf(m, v); }
    m = fmaxf(m, __shfl_xor(m, 16)); m = fmaxf(m, __shfl_xor(m, 32));
    if (HAS_SINK) m = fmaxf(m, sink);
    if (m == -INFINITY) m = 0.f;
    float sum = 0.f;
#pragma unroll
    for (int t = 0; t < NKT; ++t)
#pragma unroll
        for (int r = 0; r < 4; ++r) { const float e = __expf(s[t][r] - m); s[t][r] = e; sum += e; }
    sum += __shfl_xor(sum, 16); sum += __shfl_xor(sum, 32);
    if (HAS_SINK) sum += __expf(sink - m);
    const float inv = sum > 0.f ? 1.f / sum : 0.f;
    f32x4 o[D / 16];
#pragma unroll
    for (int dt = 0; dt < D / 16; ++dt) o[dt] = (f32x4){0.f, 0.f, 0.f, 0.f};
#pragma unroll
    for (int kk = 0; kk < NKT / 2; ++kk) {
        u32x4 pw; pw.x = pk2(s[2 * kk][0] * inv, s[2 * kk][1] * inv); pw.y = pk2(s[2 * kk][2] * inv, s[2 * kk][3] * inv);
        pw.z = pk2(s[2 * kk + 1][0] * inv, s[2 * kk + 1][1] * inv); pw.w = pk2(s[2 * kk + 1][2] * inv, s[2 * kk + 1][3] * inv);
        const bf16x8 pf = __builtin_bit_cast(bf16x8, pw);
#pragma unroll
        for (int dt = 0; dt < D / 16; ++dt) {
            const LAS unsigned char* vp = Vt + (key0 + 32 * kk + 4 * fq + (fr >> 2)) * vpitch + 32 * dt + 8 * (fr & 3);
            const u32x2 lo = __builtin_bit_cast(u32x2, __builtin_amdgcn_ds_read_tr16_b64_v4i16((LAS v4i16_t*)vp));
            const u32x2 hi = __builtin_bit_cast(u32x2, __builtin_amdgcn_ds_read_tr16_b64_v4i16((LAS v4i16_t*)(vp + 16 * vpitch)));
            const bf16x8 vf = __builtin_bit_cast(bf16x8, (u32x4){lo.x, lo.y, hi.x, hi.y});
            o[dt] = MFMA16(vf, pf, o[dt]);
        }
    }
    if (wr_ok) {
#pragma unroll
        for (int dt = 0; dt < D / 16; ++dt) { u32x2 w; w.x = pk2(o[dt][0], o[dt][1]); w.y = pk2(o[dt][2], o[dt][3]); *(u32x2*)(orow + 16 * dt + 4 * fq) = w; }
    }
}

struct Params { const float* in[33]; float* out; unsigned char* ws; };

#define CAS __attribute__((address_space(4)))
struct Ctx {
    LAS unsigned char* lds; int tid, lane, wave, G, bx;
    const CAS Params* p; unsigned char* ws; float* out;
};

DI void thin_res_gemm(const Ctx& C, const bf16_t* A, const bf16_t* Bt, int K, float scale, float* rss_out, float* X) {
    const int fr = C.lane & 15, fq = C.lane >> 4;
    LAS float* part = (LAS float*)C.lds;
    bf16_t* XB = (bf16_t*)(C.ws + WS_XB);
    const int kw = K >> 3;
    for (int tile = C.bx; tile < 256; tile += C.G) {
        const int row0 = TP + (tile >> 4) * 32, n0 = (tile & 15) * 64;
        f32x4 acc[2][4];
#pragma unroll
        for (int mt = 0; mt < 2; ++mt)
#pragma unroll
            for (int nt = 0; nt < 4; ++nt) acc[mt][nt] = (f32x4){0.f, 0.f, 0.f, 0.f};
        const bf16_t* ap = A + (size_t)(row0 + fr) * K + C.wave * kw + 8 * fq;
        const bf16_t* bp = Bt + (size_t)(n0 + fr) * K + C.wave * kw + 8 * fq;
#pragma unroll 4
        for (int k = 0; k < kw; k += 32) {
            bf16x8 af[2], bfr[4];
#pragma unroll
            for (int mt = 0; mt < 2; ++mt) af[mt] = *(const bf16x8*)(ap + (size_t)(16 * mt) * K + k);
#pragma unroll
            for (int nt = 0; nt < 4; ++nt) bfr[nt] = *(const bf16x8*)(bp + (size_t)(16 * nt) * K + k);
#pragma unroll
            for (int mt = 0; mt < 2; ++mt)
#pragma unroll
                for (int nt = 0; nt < 4; ++nt) acc[mt][nt] = MFMA16(bfr[nt], af[mt], acc[mt][nt]);
        }
#pragma unroll
        for (int mt = 0; mt < 2; ++mt)
#pragma unroll
            for (int nt = 0; nt < 4; ++nt) *(LAS f32x4*)(part + ((C.wave * 32 + 16 * mt + fr) * 64 + 16 * nt + 4 * fq)) = acc[mt][nt];
        __syncthreads();
        {
            const int row = C.tid >> 4, c4 = C.tid & 15;
            f32x4 v = (f32x4){0.f, 0.f, 0.f, 0.f};
#pragma unroll
            for (int w = 0; w < 8; ++w) v = v + *(const LAS f32x4*)(part + ((w * 32 + row) * 64 + 4 * c4));
            bf16_t* xb = XB + (size_t)(row0 + row) * DM + n0 + 4 * c4;
            const u32x2 xo = *(const u32x2*)xb;
            f32x4 x = (f32x4){blo(xo.x), bhi(xo.x), blo(xo.y), bhi(xo.y)}; x = x + v * scale;
            if (X) *(f32x4*)(X + (size_t)(row0 + row) * DM + n0 + 4 * c4) = x;
            else {
                u32x2 w2; w2.x = pk2(x[0], x[1]); w2.y = pk2(x[2], x[3]); *(u32x2*)xb = w2;
                const float a0 = blo(w2.x), a1 = bhi(w2.x), a2 = blo(w2.y), a3 = bhi(w2.y);
                float ss = a0 * a0 + a1 * a1 + a2 * a2 + a3 * a3;
                ss += __shfl_xor(ss, 1); ss += __shfl_xor(ss, 2); ss += __shfl_xor(ss, 4); ss += __shfl_xor(ss, 8);
                if (c4 == 0) atomicAdd(rss_out + row0 + row, ss);
            }
        }
        __syncthreads();
    }
}

DI void p0_tile(const float* s0, const float* s1, const float* gain, int mode, int K, int Nsrc, bf16_t* dst, int tile, LAS float* tl, int tid) {
    const int nkt = K >> 6; const int ntile = tile / nkt, kt = tile - ntile * nkt; const int n0 = ntile * 256, k0 = kt * 64;
    const int nn = tid & 255, kk0 = tid >> 8;
    const int n = n0 + nn; const float* src = s0; int col = n;
    if (mode == 1) { const int pn = n >> 8, bj = (n >> 7) & 1, cc = n & 127; src = bj ? s1 : s0; col = pn * 128 + cc; }
    else if (mode == 2) {
        const int pn = n >> 8, rem = n & 255, bj = rem >> 7, wc = (rem >> 5) & 3, j = rem & 31;
        if (pn < 2) col = (4 * pn + wc) * 64 + 32 * bj + j;
        else if (pn == 2) col = (wc < 2) ? (512 + wc * 64 + 32 * bj + j) : (640 + (wc - 2) * 64 + 32 * bj + j);
        else if (pn < 9) col = n;
        else col = (rem < 16) ? (2304 + rem) : -1;
    } else if (mode == 3) { if (n >= 512) { src = s1; col = n - 512; } }
    const float* sp = src + (size_t)(k0 + kk0) * Nsrc + (col >= 0 ? col : 0);
    float v[32];
#pragma unroll
    for (int i = 0; i < 32; ++i) v[i] = (col >= 0) ? sp[(size_t)(2 * i) * Nsrc] : 0.f;
    if (gain) {
#pragma unroll
        for (int i = 0; i < 32; ++i) v[i] *= gain[k0 + kk0 + 2 * i];
    }
#pragma unroll
    for (int i = 0; i < 32; ++i) tl[(kk0 + 2 * i) * 257 + nn] = v[i];
    __syncthreads();
#pragma unroll
    for (int j = 0; j < 4; ++j) { const int ch = tid + 512 * j; const int n2 = ch >> 3, ks = ch & 7; const LAS float* s = tl + (8 * ks) * 257 + n2;
      u32x4 o; o.x = pk2(s[0], s[257]); o.y = pk2(s[2 * 257], s[3 * 257]); o.z = pk2(s[4 * 257], s[5 * 257]); o.w = pk2(s[6 * 257], s[7 * 257]);
      *(u32x4*)(dst + (size_t)(n0 + n2) * K + k0 + 8 * ks) = o; }
    __syncthreads();
}

constexpr int TPL = 1408, T_W1 = 0, T_WD1 = 352, T_WKV = 1344;
DI void p0_dispatch(const Ctx& C, int l, int r) {
    const CAS Params& P = *C.p; unsigned char* ws = C.ws;
    unsigned char* wl = ws + WS_WL + (size_t)l * WL_SIZE;
    const float* s0; const float* s1 = nullptr; const float* gain = nullptr; int mode = 0, K = 1024, Nsrc; bf16_t* dst;
    if (r < 352) { s0 = P.in[9] + (size_t)l * 1024 * FF; s1 = P.in[10] + (size_t)l * 1024 * FF; gain = P.in[8] + l * 1024; mode = 1; Nsrc = FF; dst = (bf16_t*)(wl + WL_W1); }
    else if (r < 528) { r -= 352; s0 = P.in[11] + (size_t)l * FF * 1024; K = FF; Nsrc = 1024; dst = (bf16_t*)(wl + WL_WD1); }
    else if (r < 688) { r -= 528; s0 = P.in[13] + (size_t)l * 1024 * 2320; gain = P.in[12] + l * 1024; mode = 2; Nsrc = 2320; dst = (bf16_t*)(wl + WL_WIN); }
    else if (r < 752) { r -= 688; s0 = P.in[20] + (size_t)l * 1024 * 1024; Nsrc = 1024; dst = (bf16_t*)(wl + WL_WOUT); }
    else if (r < 784) { r -= 752; s0 = P.in[23] + (size_t)l * 1024 * 512; gain = P.in[21] + l * 1024; Nsrc = 512; dst = (bf16_t*)(wl + WL_WQ); }
    else if (r < 816) { r -= 784; s0 = P.in[28] + (size_t)l * 512 * 1024; K = 512; Nsrc = 1024; dst = (bf16_t*)(wl + WL_WO); }
    else if (r < 1168) { r -= 816; s0 = P.in[30] + (size_t)l * 1024 * FF; s1 = P.in[31] + (size_t)l * 1024 * FF; gain = P.in[29] + l * 1024; mode = 1; Nsrc = FF; dst = (bf16_t*)(wl + WL_W2); }
    else if (r < 1344) { r -= 1168; s0 = P.in[32] + (size_t)l * FF * 1024; K = FF; Nsrc = 1024; dst = (bf16_t*)(wl + WL_WD2); }
    else { r -= 1344; s0 = P.in[24] + (size_t)l * 1024 * 512; s1 = P.in[25] + (size_t)l * 1024 * 512; gain = P.in[22] + l * 1024; mode = 3; Nsrc = 512; dst = (bf16_t*)(ws + WS_WKV) + (size_t)l * 1024 * 1024; }
    p0_tile(s0, s1, gain, mode, K, Nsrc, dst, r, (LAS float*)C.lds, C.tid);
}
DI void convert_in_slack(const Ctx& C, int l, int lo, int hi, int nun) {
    const int rem = nun % C.G; const int first = rem ? rem : 0, cnt = C.G - first;
    if (C.bx < first) return;
    for (int t = lo + (C.bx - first); t < hi; t += cnt) p0_dispatch(C, l, t);
}

DI void p0_prologue(const Ctx& C) {
    const CAS Params& P = *C.p; unsigned char* ws = C.ws;
    for (int it = C.bx; it < 352 + 128; it += C.G) {
        if (it < 352) p0_dispatch(C, 0, it); else if (it < 416) p0_dispatch(C, 0, T_WKV + it - 352); else p0_dispatch(C, 1, T_WKV + it - 416);
    }
    const int gw = C.bx * 8 + C.wave, NGW = C.G * 8;
    float* RSS = (float*)(ws + WS_RSS);
    for (int r0 = gw; r0 < T + 1024; r0 += 2 * NGW) {
        const float* src[2]; float* df[2]; bf16_t* db[2]; float* rs[2]; f32x4 v[2][4];
#pragma unroll
        for (int q = 0; q < 2; ++q) {
            int r = r0 + q * NGW; if (r >= T + 1024) r = r0;
            if (r < T) { src[q] = (r < TP ? P.in[0] + (size_t)r * 1024 : P.in[1] + (size_t)(r - TP) * 1024); df[q] = nullptr; db[q] = (bf16_t*)(ws + WS_XB) + (size_t)r * 1024; rs[q] = RSS + r; }
            else { src[q] = P.in[7] + (size_t)(r - T) * 1024; df[q] = nullptr; db[q] = (bf16_t*)(ws + WS_MEMB) + (size_t)(r - T) * 1024; rs[q] = (float*)(ws + WS_RSSM) + (r - T); }
#pragma unroll
            for (int j = 0; j < 4; ++j) v[q][j] = *(const f32x4*)(src[q] + 256 * j + 4 * C.lane);
        }
#pragma unroll
        for (int q = 0; q < 2; ++q) {
            float ss = 0.f;
#pragma unroll
            for (int j = 0; j < 4; ++j) {
                const f32x4 x = v[q][j];
                ss += x[0] * x[0] + x[1] * x[1] + x[2] * x[2] + x[3] * x[3];
                if (df[q]) *(f32x4*)(df[q] + 256 * j + 4 * C.lane) = x;
                u32x2 w; w.x = pk2(x[0], x[1]); w.y = pk2(x[2], x[3]); *(u32x2*)(db[q] + 256 * j + 4 * C.lane) = w;
            }
#pragma unroll
            for (int o = 1; o < 64; o <<= 1) ss += __shfl_xor(ss, o);
            if (C.lane == 0) *rs[q] = ss;
        }
    }
    for (int i = C.bx * 512 + C.tid; i < 8 * T; i += C.G * 512) RSS[T + i] = 0.f;
    float2* rope = (float2*)(ws + WS_ROPE);
    for (int i = C.bx * 512 + C.tid; i < 4100 * 32; i += C.G * 512) {
        const int pidx = i >> 5, f = i & 31; const int pos = pidx < 4096 ? pidx : 16384 + (pidx - 4096);
        const float inv = powf(10000.f, -(float)f * (1.f / 32.f));
        const float ang = (float)pos * inv;
        const double a = (double)ang; const double nrev = rint(a * 0.15915494309189535); const float rr = (float)(a - nrev * 6.283185307179586);
        rope[i] = make_float2(cosf(rr), sinf(rr));
    }
}

DI void swa_prompt_unit(const Ctx& C, int l, int unit) {
    unsigned char* ws = C.ws;
    const int b = unit >> 6, n = (unit >> 1) & 31, kvh = unit & 1;
    const bf16_t* QS = (const bf16_t*)(ws + WS_QS); const bf16_t* KS = (const bf16_t*)(ws + WS_KS); const bf16_t* VS = (const bf16_t*)(ws + WS_VS); bf16_t* MIX = (bf16_t*)(ws + WS_MIX);
    LAS unsigned char* Kl = C.lds; LAS unsigned char* Vt = C.lds + 256 * 144;
    constexpr int KP = 144, VP = 144;
#pragma unroll
    for (int i = 0; i < 4; ++i) {
        const int key = (C.tid >> 3) + 64 * i, c8 = C.tid & 7; const int pos = (n - 1) * 128 + key;
        u32x4 kv = (u32x4){0u, 0u, 0u, 0u}, vv = kv;
        if (pos >= 0) { const size_t row = (size_t)b * SEQ + pos; kv = *(const u32x4*)(KS + row * 128 + kvh * 64 + 8 * c8); vv = *(const u32x4*)(VS + row * 128 + kvh * 64 + 8 * c8); }
        *(LAS u32x4*)(Kl + key * KP + c8 * 16) = kv; *(LAS u32x4*)(Vt + key * VP + c8 * 16) = vv;
    }
    __syncthreads();
    const int fr = C.lane & 15, fq = C.lane >> 4; const int g = C.wave >> 1, qh = C.wave & 1; const int head = kvh * 4 + g;
    const float sink = C.p->in[16][l * 8 + head];
    for (int grp = 0; grp < 4; ++grp) {
        const int i = 64 * qh + 16 * grp + fr; const size_t row = (size_t)b * SEQ + n * 128 + i;
        bf16x8 qf[2];
#pragma unroll
        for (int ks = 0; ks < 2; ++ks) qf[ks] = *(const bf16x8*)(QS + row * 512 + head * 64 + 32 * ks + 8 * fq);
        const int jlo = max(i + 1, n == 0 ? 128 : 0), jhi = i + 128;
        attn16<64, 12, true>(qf, Kl, KP, Vt, VP, 64 * qh, jlo, jhi, 0.125f, sink, MIX + row * 1024 + head * 64, true, fr, fq);
    }
    __syncthreads();
}

DI void swa_decode_unit(const Ctx& C, int l, int unit) {
    unsigned char* ws = C.ws; const CAS Params& P = *C.p;
    const int b = unit >> 1, kvh = unit & 1;
    const bf16_t* QS = (const bf16_t*)(ws + WS_QS); const bf16_t* KS = (const bf16_t*)(ws + WS_KS); const bf16_t* VS = (const bf16_t*)(ws + WS_VS); bf16_t* MIX = (bf16_t*)(ws + WS_MIX);
    constexpr int KP = 144, VP = 144;
    LAS unsigned char* Kl = C.lds; LAS unsigned char* Vt = C.lds + 160 * KP;
    for (int i = C.tid; i < (160 * KP + 160 * VP) / 16; i += 512) *(LAS u32x4*)(C.lds + i * 16) = (u32x4){0u, 0u, 0u, 0u};
    __syncthreads();
    const float* ck = P.in[2] + ((size_t)(l * 128 + b) * 128) * 128 + kvh * 64; const float* cv = P.in[3] + ((size_t)(l * 128 + b) * 128) * 128 + kvh * 64;
    float* ok = C.out + O_KS + ((size_t)(l * 128 + b) * 128) * 128 + kvh * 64; float* ov = C.out + O_VS + ((size_t)(l * 128 + b) * 128) * 128 + kvh * 64;
#pragma unroll
    for (int i = 0; i < 4; ++i) {
        const int key = (C.tid >> 4) + 32 * i, c16 = C.tid & 15;
        const f32x4 kv = *(const f32x4*)(ck + (size_t)key * 128 + 4 * c16), vv = *(const f32x4*)(cv + (size_t)key * 128 + 4 * c16);
        u32x2 w; w.x = pk2(kv[0], kv[1]); w.y = pk2(kv[2], kv[3]); *(LAS u32x2*)(Kl + key * KP + c16 * 8) = w;
        u32x2 wv; wv.x = pk2(vv[0], vv[1]); wv.y = pk2(vv[2], vv[3]); *(LAS u32x2*)(Vt + key * VP + c16 * 8) = wv;
        if (key >= 4) { *(f32x4*)(ok + (size_t)(key - 4) * 128 + 4 * c16) = kv; *(f32x4*)(ov + (size_t)(key - 4) * 128 + 4 * c16) = vv; }
    }
    if (C.tid < 32) {
        const int tt = C.tid >> 3, c8 = C.tid & 7; const size_t row = (size_t)TP + b * 4 + tt;
        const u32x4 kv = *(const u32x4*)(KS + row * 128 + kvh * 64 + 8 * c8), vv = *(const u32x4*)(VS + row * 128 + kvh * 64 + 8 * c8);
        *(LAS u32x4*)(Kl + (128 + tt) * KP + c8 * 16) = kv; *(LAS u32x4*)(Vt + (128 + tt) * VP + c8 * 16) = vv;
    }
    __syncthreads();
    if (C.wave == 0) {
        const int fr = C.lane & 15, fq = C.lane >> 4; const int g = fr >> 2, tt = fr & 3; const int head = kvh * 4 + g; const size_t row = (size_t)TP + b * 4 + tt;
        bf16x8 qf[2];
#pragma unroll
        for (int ks = 0; ks < 2; ++ks) qf[ks] = *(const bf16x8*)(QS + row * 512 + head * 64 + 32 * ks + 8 * fq);
        const float sink = P.in[16][l * 8 + head];
        attn16<64, 10, true>(qf, Kl, KP, Vt, VP, 0, tt + 1, tt + 128, 0.125f, sink, MIX + row * 1024 + head * 64, true, fr, fq);
    }
    __syncthreads();
}

DI void xattn_unit(const Ctx& C, int l, int unit) {
    unsigned char* ws = C.ws; const CAS Params& P = *C.p;
    constexpr int KP = 272, VP = 288;
    LAS unsigned char* Kl = C.lds; LAS unsigned char* Vt = C.lds + 256 * KP;
    const bool prompt = unit < 128;
    int b, h, qb = 0;
    if (prompt) { b = unit >> 5; h = (unit >> 3) & 3; qb = (unit & 7) * 2; } else { const int u = unit - 128; b = u >> 2; h = u & 3; }
    const float* ksrc; const float* vsrc; size_t kpitch;
    if (prompt) { ksrc = (const float*)(ws + WS_MKV) + (size_t)(b * 256) * 2048 + l * 1024 + h * 128; vsrc = ksrc + 512; kpitch = 2048; }
    else { ksrc = P.in[5] + ((size_t)(l * 128 + b) * 256) * 512 + h * 128; vsrc = P.in[6] + ((size_t)(l * 128 + b) * 256) * 512 + h * 128; kpitch = 512; }
    const int c4 = C.tid & 31;
    const f32x4 gk = *(const f32x4*)(P.in[27] + l * 128 + 4 * c4);
    const bool wout = prompt && qb == 0;
    float* omk = C.out + O_MKP + ((size_t)(l * 4 + b) * 256) * 512 + h * 128; float* omv = C.out + O_MVP + ((size_t)(l * 4 + b) * 256) * 512 + h * 128;
#pragma unroll 4
    for (int i = 0; i < 16; ++i) {
        const int key = (C.tid >> 5) + 16 * i;
        f32x4 kv = *(const f32x4*)(ksrc + (size_t)key * kpitch + 4 * c4); const f32x4 vv = *(const f32x4*)(vsrc + (size_t)key * kpitch + 4 * c4);
        if (prompt) {
            float ss = kv[0] * kv[0] + kv[1] * kv[1] + kv[2] * kv[2] + kv[3] * kv[3];
#pragma unroll
            for (int o = 1; o < 32; o <<= 1) ss += __shfl_xor(ss, o);
            const float rq = rsqrtf(ss * (1.f / 128.f) + EPS);
            kv = kv * rq * gk;
            if (wout) { *(f32x4*)(omk + (size_t)key * 512 + 4 * c4) = kv; *(f32x4*)(omv + (size_t)key * 512 + 4 * c4) = vv; }
        }
        u32x2 w; w.x = pk2(kv[0], kv[1]); w.y = pk2(kv[2], kv[3]); *(LAS u32x2*)(Kl + key * KP + c4 * 8) = w;
        u32x2 wv; wv.x = pk2(vv[0], vv[1]); wv.y = pk2(vv[2], vv[3]); *(LAS u32x2*)(Vt + key * VP + c4 * 8) = wv;
    }
    __syncthreads();
    const bf16_t* QX = (const bf16_t*)(ws + WS_QX); bf16_t* OX = (bf16_t*)(ws + WS_OX);
    const int fr = C.lane & 15, fq = C.lane >> 4;
    const int ngrp = prompt ? 4 : (C.wave == 0 ? 1 : 0);
    for (int grp = 0; grp < ngrp; ++grp) {
        const size_t row = prompt ? ((size_t)b * SEQ + (qb + (grp >> 1)) * 256 + 32 * C.wave + 16 * (grp & 1) + fr) : ((size_t)TP + b * 4 + (fr & 3));
        float qv[32]; float ss = 0.f;
#pragma unroll
        for (int ks = 0; ks < 4; ++ks) {
            const u32x4 w = *(const u32x4*)(QX + row * 512 + h * 128 + 32 * ks + 8 * fq);
#pragma unroll
            for (int e = 0; e < 4; ++e) { qv[8 * ks + 2 * e] = blo(w[e]); qv[8 * ks + 2 * e + 1] = bhi(w[e]); }
        }
#pragma unroll
        for (int e = 0; e < 32; ++e) ss += qv[e] * qv[e];
        ss += __shfl_xor(ss, 16); ss += __shfl_xor(ss, 32);
        const float rq = rsqrtf(ss * (1.f / 128.f) + EPS);
        bf16x8 qf[4];
#pragma unroll
        for (int ks = 0; ks < 4; ++ks) {
            const f32x4 g0 = *(const f32x4*)(P.in[26] + l * 128 + 32 * ks + 8 * fq), g1 = *(const f32x4*)(P.in[26] + l * 128 + 32 * ks + 8 * fq + 4);
            u32x4 w; w.x = pk2(qv[8 * ks] * rq * g0[0], qv[8 * ks + 1] * rq * g0[1]); w.y = pk2(qv[8 * ks + 2] * rq * g0[2], qv[8 * ks + 3] * rq * g0[3]);
            w.z = pk2(qv[8 * ks + 4] * rq * g1[0], qv[8 * ks + 5] * rq * g1[1]); w.w = pk2(qv[8 * ks + 6] * rq * g1[2], qv[8 * ks + 7] * rq * g1[3]);
            qf[ks] = __builtin_bit_cast(bf16x8, w);
        }
        attn16<128, 16, false>(qf, Kl, KP, Vt, VP, 0, 0, 255, 0.08838834764831845f, 0.f, OX + row * 512 + h * 128, prompt || fr < 4, fr, fq);
    }
    __syncthreads();
}

DI void gla_a_phase(const Ctx& C, int l) {
    unsigned char* ws = C.ws; const CAS Params& P = *C.p;
    const bf16_t* ZG = (const bf16_t*)(ws + WS_ZG); const float* LR = (const float*)(ws + WS_LR);
    bf16_t* QT = (bf16_t*)(ws + WS_BCUM); bf16_t* KT = QT + (size_t)TP * 256; float* ST = (float*)(ws + WS_ST); bf16_t* VT = (bf16_t*)(ws + WS_VT); float* DEC = (float*)(ws + WS_DEC);
    LAS float* segsum = (LAS float*)C.lds;
    LAS unsigned char* KdT = C.lds + 2048;
    LAS unsigned char* VtL = C.lds + 2048 + 64 * 144;
    const int dk = C.tid & 63, seg = C.wave, tv = C.tid >> 3, dvs = C.tid & 7;
    int unit = C.bx; if (unit >= 1024) return;
    bf16_t kq[16]; u32x4 vw[2];
#define GLA_A_LOAD(u) do { const int bh_ = (u) >> 6, c_ = (u) & 63, b_ = bh_ >> 2, h_ = bh_ & 3; const size_t t0_ = (size_t)b_ * SEQ + c_ * 64; \
        _Pragma("unroll") for (int i = 0; i < 8; ++i) { kq[i] = ZG[(t0_ + 8 * seg + i) * 1536 + 256 + h_ * 64 + dk]; kq[8 + i] = ZG[(t0_ + 8 * seg + i) * 1536 + h_ * 64 + dk]; } \
        _Pragma("unroll") for (int x = 0; x < 2; ++x) vw[x] = *(const u32x4*)(ZG + (t0_ + tv) * 1536 + 512 + h_ * 128 + 16 * dvs + 8 * x); } while (0)
    GLA_A_LOAD(unit);
    int hcur = -1; float wg[16]; float bg = 0.f;
    for (; unit < 1024; unit += C.G) {
        const int bh = unit >> 6, c = unit & 63, b = bh >> 2, h = bh & 3; const size_t t0 = (size_t)b * SEQ + c * 64;
        if (h != hcur) { hcur = h;
#pragma unroll
            for (int r = 0; r < 16; ++r) wg[r] = P.in[17][(size_t)(l * 16 + r) * 256 + h * 64 + dk];
            bg = P.in[18][l * 256 + h * 64 + dk]; }
        float p[8];
        {
            float run = 0.f;
#pragma unroll
            for (int i = 0; i < 8; ++i) {
                const float* lr = LR + (t0 + 8 * seg + i) * 16; float x = bg;
#pragma unroll
                for (int r = 0; r < 16; ++r) x += lr[r] * wg[r];
                run += logsig(x) * (1.f / 16.f); p[i] = run;
            }
            segsum[seg * 64 + dk] = run;
        }
#pragma unroll
        for (int x = 0; x < 2; ++x) *(LAS u32x4*)(VtL + tv * 288 + (16 * dvs + 8 * x) * 2) = vw[x];
        __syncthreads();
        {
            float off = 0.f, tot = 0.f;
#pragma unroll
            for (int s2 = 0; s2 < 8; ++s2) { const float v = segsum[s2 * 64 + dk]; tot += v; if (s2 < seg) off += v; }
#pragma unroll
            for (int i = 0; i < 8; ++i) {
                const int t = 8 * seg + i; const float bv = off + p[i];
                const float kraw = bf2f(kq[i]), qraw = bf2f(kq[8 + i]);
                const float kd = kraw * __expf(tot - bv);
                const unsigned qk = pk2(qraw * 0.125f * __expf(bv), kraw * __expf(-bv));
                QT[(t0 + t) * 256 + h * 64 + dk] = (bf16_t)(qk & 0xffffu); KT[(t0 + t) * 256 + h * 64 + dk] = (bf16_t)(qk >> 16);
                *(LAS unsigned short*)(KdT + t * 144 + dk * 2) = (unsigned short)(pk2(kd, 0.f) & 0xffffu);
            }
            if (seg == 0) DEC[unit * 64 + dk] = __expf(tot);
        }
        if (unit + C.G < 1024) GLA_A_LOAD(unit + C.G);
        __syncthreads();
        {
            const int fr = C.lane & 15, fq = C.lane >> 4, w = C.wave;
            bf16x8 vt[2];
#pragma unroll
            for (int ks = 0; ks < 2; ++ks) {
                const LAS unsigned char* vp = VtL + (32 * ks + 8 * fq + (fr >> 2)) * 288 + 32 * w + 8 * (fr & 3);
                const u32x2 lo = __builtin_bit_cast(u32x2, __builtin_amdgcn_ds_read_tr16_b64_v4i16((LAS v4i16_t*)vp));
                const u32x2 hi = __builtin_bit_cast(u32x2, __builtin_amdgcn_ds_read_tr16_b64_v4i16((LAS v4i16_t*)(vp + 4 * 288)));
                vt[ks] = __builtin_bit_cast(bf16x8, (u32x4){lo.x, lo.y, hi.x, hi.y});
            }
#pragma unroll
            for (int dkt = 0; dkt < 4; ++dkt) {
                f32x4 acc = (f32x4){0.f, 0.f, 0.f, 0.f};
#pragma unroll
                for (int ks = 0; ks < 2; ++ks) {
                    const LAS unsigned char* kp = KdT + (32 * ks + 8 * fq + (fr >> 2)) * 144 + 32 * dkt + 8 * (fr & 3);
                    const u32x2 lo = __builtin_bit_cast(u32x2, __builtin_amdgcn_ds_read_tr16_b64_v4i16((LAS v4i16_t*)kp));
                    const u32x2 hi = __builtin_bit_cast(u32x2, __builtin_amdgcn_ds_read_tr16_b64_v4i16((LAS v4i16_t*)(kp + 4 * 144)));
                    const bf16x8 kd = __builtin_bit_cast(bf16x8, (u32x4){lo.x, lo.y, hi.x, hi.y});
                    acc = MFMA16(kd, vt[ks], acc);
                }
                *(f32x4*)(ST + ((size_t)unit * 128 + 16 * w + fr) * 64 + 16 * dkt + 4 * fq) = acc;
            }
        }
        __syncthreads();
    }
#undef GLA_A_LOAD
}

DI void gla_scan(const Ctx& C, int l) {
    unsigned char* ws = C.ws;
    const float* ST = (const float*)(ws + WS_ST); const float* DEC = (const float*)(ws + WS_DEC); bf16_t* STB = (bf16_t*)(ws + WS_STB);
    for (int e = C.bx * 512 + C.tid; e < 16 * 8192; e += C.G * 512) {
        const int bh = e >> 13, idx = e & 8191, dk = idx & 63, dv = idx >> 6;
        float S = 0.f;
        for (int c0 = 0; c0 < 64; c0 += 8) {
            float d[8], dc[8];
#pragma unroll
            for (int i = 0; i < 8; ++i) { const int unit = bh * 64 + c0 + i; d[i] = ST[(size_t)unit * 8192 + idx]; dc[i] = DEC[unit * 64 + dk]; }
#pragma unroll
            for (int i = 0; i < 8; ++i) { const int unit = bh * 64 + c0 + i; STB[(size_t)unit * 8192 + idx] = (bf16_t)(pk2(S, 0.f) & 0xffffu); S = dc[i] * S + d[i]; }
        }
        C.out[O_GP + ((size_t)(l * 16 + bh)) * 8192 + dk * 128 + dv] = S;
    }
}

DI void gla_c_wave(const Ctx& C, int l, int unit, int qt) {
    unsigned char* ws = C.ws; const CAS Params& P = *C.p;
    const int bh = unit >> 6, c = unit & 63, b = bh >> 2, h = bh & 3; const size_t t0 = (size_t)b * SEQ + c * 64;
    const bf16_t* ZG = (const bf16_t*)(ws + WS_ZG); const bf16_t* QT = (const bf16_t*)(ws + WS_BCUM); const bf16_t* KT = QT + (size_t)TP * 256; const bf16_t* STB = (const bf16_t*)(ws + WS_STB); const bf16_t* VT = (const bf16_t*)(ws + WS_VT);
    bf16_t* MIX = (bf16_t*)(ws + WS_MIX);
    const int fr = C.lane & 15, fq = C.lane >> 4;
    const size_t rq = t0 + 16 * qt + fr;
    bf16x8 qf[2];
#pragma unroll
    for (int ks = 0; ks < 2; ++ks) qf[ks] = *(const bf16x8*)(QT + rq * 256 + h * 64 + 32 * ks + 8 * fq);
    f32x4 a[4];
#pragma unroll
    for (int kt = 0; kt < 4; ++kt) {
        a[kt] = (f32x4){0.f, 0.f, 0.f, 0.f};
        if (kt <= qt) {
            const size_t rk = t0 + 16 * kt + fr;
#pragma unroll
            for (int ks = 0; ks < 2; ++ks) {
                const bf16x8 kf = *(const bf16x8*)(KT + rk * 256 + h * 64 + 32 * ks + 8 * fq);
                a[kt] = MFMA16(kf, qf[ks], a[kt]);
            }
#pragma unroll
            for (int r = 0; r < 4; ++r) if (16 * kt + 4 * fq + r > 16 * qt + fr) a[kt][r] = 0.f;
        }
    }
    bf16x8 pf[2];
#pragma unroll
    for (int kk = 0; kk < 2; ++kk) { u32x4 w; w.x = pk2(a[2 * kk][0], a[2 * kk][1]); w.y = pk2(a[2 * kk][2], a[2 * kk][3]); w.z = pk2(a[2 * kk + 1][0], a[2 * kk + 1][1]); w.w = pk2(a[2 * kk + 1][2], a[2 * kk + 1][3]); pf[kk] = __builtin_bit_cast(bf16x8, w); }
    f32x4 o[8]; float ss = 0.f;
#pragma unroll
    for (int dt = 0; dt < 8; ++dt) {
        f32x4 acc = (f32x4){0.f, 0.f, 0.f, 0.f};
        const size_t vrow = ((size_t)unit * 128 + 16 * dt + fr) * 64;
#pragma unroll
        for (int kk = 0; kk < 2; ++kk) {
            if (2 * kk <= qt) {
                const bf16_t* vp = VT + vrow + 32 * kk + 4 * fq; const u32x2 lo = *(const u32x2*)vp, hi = *(const u32x2*)(vp + 16);
                acc = MFMA16(__builtin_bit_cast(bf16x8, (u32x4){lo.x, lo.y, hi.x, hi.y}), pf[kk], acc);
            }
        }
#pragma unroll
        for (int ks = 0; ks < 2; ++ks) {
            const bf16x8 sf = *(const bf16x8*)(STB + vrow + 32 * ks + 8 * fq);
            acc = MFMA16(sf, qf[ks], acc);
        }
        o[dt] = acc; ss += acc[0] * acc[0] + acc[1] * acc[1] + acc[2] * acc[2] + acc[3] * acc[3];
    }
    ss += __shfl_xor(ss, 16); ss += __shfl_xor(ss, 32);
    const float rn = rsqrtf(ss * (1.f / 128.f) + EPS);
#pragma unroll
    for (int dt = 0; dt < 8; ++dt) {
        const f32x4 gn = *(const f32x4*)(P.in[19] + l * 128 + 16 * dt + 4 * fq);
        const u32x2 gw = *(const u32x2*)(ZG + rq * 1536 + 1024 + h * 128 + 16 * dt + 4 * fq);
        const float g0 = blo(gw.x), g1 = bhi(gw.x), g2 = blo(gw.y), g3 = bhi(gw.y);
        u32x2 w; w.x = pk2(o[dt][0] * rn * gn[0] * silu(g0), o[dt][1] * rn * gn[1] * silu(g1)); w.y = pk2(o[dt][2] * rn * gn[2] * silu(g2), o[dt][3] * rn * gn[3] * silu(g3));
        *(u32x2*)(MIX + rq * 1024 + 512 + h * 128 + 16 * dt + 4 * fq) = w;
    }
}

DI void gla_c_phase(const Ctx& C, int l) {
    unsigned char* ws = C.ws; const CAS Params& P = *C.p;
    const bf16_t* ZG = (const bf16_t*)(ws + WS_ZG); const bf16_t* QT = (const bf16_t*)(ws + WS_BCUM); const bf16_t* KT = QT + (size_t)TP * 256; const bf16_t* STB = (const bf16_t*)(ws + WS_STB); const bf16_t* VT = (const bf16_t*)(ws + WS_VT);
    bf16_t* MIX = (bf16_t*)(ws + WS_MIX);
    constexpr int PB = 144, U_BYTES = (64 + 128 + 128) * PB;
    const int fr = C.lane & 15, fq = C.lane >> 4, us = C.wave >> 2, qt = C.wave & 3;
    for (int pr = C.bx; pr < 512; pr += C.G) {
#pragma unroll
        for (int uu = 0; uu < 2; ++uu) {
            const int unit = 2 * pr + uu; const int bh = unit >> 6, c = unit & 63, b = bh >> 2, h = bh & 3; const size_t t0 = (size_t)b * SEQ + c * 64;
            LAS unsigned char* base = C.lds + uu * U_BYTES;
            { const int row = C.tid >> 3, c8 = C.tid & 7; *(LAS u32x4*)(base + row * PB + c8 * 16) = *(const u32x4*)(KT + (t0 + row) * 256 + h * 64 + 8 * c8); }
#pragma unroll
            for (int i = 0; i < 2; ++i) {
                const int row = (C.tid >> 3) + 64 * i, c8 = C.tid & 7;
                *(LAS u32x4*)(base + (64 + row) * PB + c8 * 16) = *(const u32x4*)(STB + ((size_t)unit * 128 + row) * 64 + 8 * c8);
                const int vr = (C.tid >> 4) + 32 * i, c16 = C.tid & 15;
                *(LAS u32x4*)(base + 192 * PB + vr * 288 + c16 * 16) = *(const u32x4*)(ZG + (t0 + vr) * 1536 + 512 + h * 128 + 8 * c16);
            }
        }
        const int unit = 2 * pr + us; const int bh = unit >> 6, c = unit & 63, b = bh >> 2, h = bh & 3; const size_t t0 = (size_t)b * SEQ + c * 64;
        const size_t rq = t0 + 16 * qt + fr;
        bf16x8 qf[2];
#pragma unroll
        for (int ks = 0; ks < 2; ++ks) qf[ks] = *(const bf16x8*)(QT + rq * 256 + h * 64 + 32 * ks + 8 * fq);
        __syncthreads();
        LAS unsigned char* Kl = C.lds + us * U_BYTES; LAS unsigned char* Sl = Kl + 64 * PB; LAS unsigned char* Vl = Kl + 192 * PB;
        f32x4 a[4];
#pragma unroll
        for (int kt = 0; kt < 4; ++kt) {
            a[kt] = (f32x4){0.f, 0.f, 0.f, 0.f};
            if (kt <= qt) {
#pragma unroll
                for (int ks = 0; ks < 2; ++ks) {
                    const bf16x8 kf = *(const LAS bf16x8*)(Kl + (16 * kt + fr) * PB + (32 * ks + 8 * fq) * 2);
                    a[kt] = MFMA16(kf, qf[ks], a[kt]);
                }
#pragma unroll
                for (int r = 0; r < 4; ++r) if (16 * kt + 4 * fq + r > 16 * qt + fr) a[kt][r] = 0.f;
            }
        }
        bf16x8 pf[2];
#pragma unroll
        for (int kk = 0; kk < 2; ++kk) { u32x4 w; w.x = pk2(a[2 * kk][0], a[2 * kk][1]); w.y = pk2(a[2 * kk][2], a[2 * kk][3]); w.z = pk2(a[2 * kk + 1][0], a[2 * kk + 1][1]); w.w = pk2(a[2 * kk + 1][2], a[2 * kk + 1][3]); pf[kk] = __builtin_bit_cast(bf16x8, w); }
        f32x4 o[8]; float ss = 0.f;
#pragma unroll
        for (int dt = 0; dt < 8; ++dt) {
            f32x4 acc = (f32x4){0.f, 0.f, 0.f, 0.f};
#pragma unroll
            for (int kk = 0; kk < 2; ++kk) {
                if (2 * kk <= qt) {
                    const LAS unsigned char* vp = Vl + (32 * kk + 4 * fq + (fr >> 2)) * 288 + 32 * dt + 8 * (fr & 3);
                    const u32x2 lo = __builtin_bit_cast(u32x2, __builtin_amdgcn_ds_read_tr16_b64_v4i16((LAS v4i16_t*)vp));
                    const u32x2 hi = __builtin_bit_cast(u32x2, __builtin_amdgcn_ds_read_tr16_b64_v4i16((LAS v4i16_t*)(vp + 16 * 288)));
                    acc = MFMA16(__builtin_bit_cast(bf16x8, (u32x4){lo.x, lo.y, hi.x, hi.y}), pf[kk], acc);
                }
            }
#pragma unroll
            for (int ks = 0; ks < 2; ++ks) {
                const bf16x8 sf = *(const LAS bf16x8*)(Sl + (16 * dt + fr) * PB + (32 * ks + 8 * fq) * 2);
                acc = MFMA16(sf, qf[ks], acc);
            }
            o[dt] = acc; ss += acc[0] * acc[0] + acc[1] * acc[1] + acc[2] * acc[2] + acc[3] * acc[3];
        }
        ss += __shfl_xor(ss, 16); ss += __shfl_xor(ss, 32);
        const float rn = rsqrtf(ss * (1.f / 128.f) + EPS);
#pragma unroll
        for (int dt = 0; dt < 8; ++dt) {
            const f32x4 gn = *(const f32x4*)(P.in[19] + l * 128 + 16 * dt + 4 * fq);
            const u32x2 gw = *(const u32x2*)(ZG + rq * 1536 + 1024 + h * 128 + 16 * dt + 4 * fq);
            const float g0 = blo(gw.x), g1 = bhi(gw.x), g2 = blo(gw.y), g3 = bhi(gw.y);
            u32x2 w; w.x = pk2(o[dt][0] * rn * gn[0] * silu(g0), o[dt][1] * rn * gn[1] * silu(g1)); w.y = pk2(o[dt][2] * rn * gn[2] * silu(g2), o[dt][3] * rn * gn[3] * silu(g3));
            *(u32x2*)(MIX + rq * 1024 + 512 + h * 128 + 16 * dt + 4 * fq) = w;
        }
        __syncthreads();
    }
}

DI void gla_decode_unit(const Ctx& C, int l, int unit) {
    unsigned char* ws = C.ws; const CAS Params& P = *C.p;
    const int b = unit >> 2, h = unit & 3; const size_t rb = (size_t)TP + b * 4;
    const bf16_t* ZG = (const bf16_t*)(ws + WS_ZG); const float* LR = (const float*)(ws + WS_LR); bf16_t* MIX = (bf16_t*)(ws + WS_MIX);
    LAS float* la = (LAS float*)C.lds;
    LAS float* qr = la + 256;
    LAS float* kr = qr + 256;
    LAS float* qe = kr + 256;
    LAS float* ke = qe + 256;
    LAS float* Am = ke + 256;
    LAS float* red = Am + 16;
    LAS float* opart = red + 8;
    if (C.tid < 256) {
        const int tt = C.tid >> 6, dk = C.tid & 63; float x = P.in[18][l * 256 + h * 64 + dk];
        const f32x4 l0 = *(const f32x4*)(LR + (rb + tt) * 16), l1 = *(const f32x4*)(LR + (rb + tt) * 16 + 4), l2 = *(const f32x4*)(LR + (rb + tt) * 16 + 8), l3 = *(const f32x4*)(LR + (rb + tt) * 16 + 12);
        const float* wg = P.in[17] + (size_t)(l * 16) * 256 + h * 64 + dk;
#pragma unroll
        for (int r = 0; r < 4; ++r) { x += l0[r] * wg[r * 256] + l1[r] * wg[(4 + r) * 256] + l2[r] * wg[(8 + r) * 256] + l3[r] * wg[(12 + r) * 256]; }
        la[tt * 64 + dk] = logsig(x) * (1.f / 16.f);
        qr[tt * 64 + dk] = bf2f(ZG[(rb + tt) * 1536 + h * 64 + dk]); kr[tt * 64 + dk] = bf2f(ZG[(rb + tt) * 1536 + 256 + h * 64 + dk]);
    }
    __syncthreads();
    if (C.tid < 64) { float run = 0.f;
#pragma unroll
        for (int tt = 0; tt < 4; ++tt) { run += la[tt * 64 + C.tid]; la[tt * 64 + C.tid] = run; } }
    __syncthreads();
    if (C.tid < 256) {
        const int tt = C.tid >> 6, dk = C.tid & 63; const float bt = la[tt * 64 + dk], b3 = la[3 * 64 + dk];
        qe[tt * 64 + dk] = 0.125f * qr[tt * 64 + dk] * __expf(bt); ke[tt * 64 + dk] = kr[tt * 64 + dk] * __expf(b3 - bt);
    } else if (C.tid < 272) {
        const int tt = (C.tid - 256) >> 2, s = (C.tid - 256) & 3; float sum = 0.f;
        if (s <= tt) for (int dk = 0; dk < 64; ++dk) sum += 0.125f * qr[tt * 64 + dk] * kr[s * 64 + dk] * __expf(la[tt * 64 + dk] - la[s * 64 + dk]);
        Am[C.tid - 256] = sum;
    }
    __syncthreads();
    {
        const int dv = C.tid & 127, dq = C.tid >> 7;
        float v[4], o[4] = {0.f, 0.f, 0.f, 0.f};
#pragma unroll
        for (int tt = 0; tt < 4; ++tt) v[tt] = bf2f(ZG[(rb + tt) * 1536 + 512 + h * 128 + dv]);
        const float* S0p = P.in[4] + ((size_t)(l * 128 + b) * 4 + h) * 8192 + (size_t)(16 * dq) * 128 + dv; float* Sn = C.out + O_GS + ((size_t)(l * 128 + b) * 4 + h) * 8192 + (size_t)(16 * dq) * 128 + dv;
        float S0[16];
#pragma unroll
        for (int i = 0; i < 16; ++i) S0[i] = S0p[i * 128];
#pragma unroll
        for (int i = 0; i < 16; ++i) {
            const int dk = 16 * dq + i;
            float sn = __expf(la[3 * 64 + dk]) * S0[i];
#pragma unroll
            for (int tt = 0; tt < 4; ++tt) { o[tt] += qe[tt * 64 + dk] * S0[i]; sn += ke[tt * 64 + dk] * v[tt]; }
            Sn[i * 128] = sn;
        }
#pragma unroll
        for (int tt = 0; tt < 4; ++tt) opart[(dq * 4 + tt) * 128 + dv] = o[tt];
    }
    __syncthreads();
    {
        const int tt = C.tid >> 7, dv = C.tid & 127;
        float o = opart[(0 * 4 + tt) * 128 + dv] + opart[(1 * 4 + tt) * 128 + dv] + opart[(2 * 4 + tt) * 128 + dv] + opart[(3 * 4 + tt) * 128 + dv];
        for (int s = 0; s <= tt; ++s) o += Am[tt * 4 + s] * bf2f(ZG[(rb + s) * 1536 + 512 + h * 128 + dv]);
        float ss = o * o;
#pragma unroll
        for (int of = 1; of < 64; of <<= 1) ss += __shfl_xor(ss, of);
        if (C.lane == 0) red[C.wave] = ss;
        __syncthreads();
        const float tot = red[2 * tt] + red[2 * tt + 1];
        const float rn = rsqrtf(tot * (1.f / 128.f) + EPS);
        const float gg = bf2f(ZG[(rb + tt) * 1536 + 1024 + h * 128 + dv]);
        const float val = o * rn * P.in[19][l * 128 + dv] * silu(gg);
        MIX[(rb + tt) * 1024 + 512 + h * 128 + dv] = (bf16_t)(pk2(val, 0.f) & 0xffffu);
    }
    __syncthreads();
}

__global__ void __launch_bounds__(512, 2) hymba_fwd(Params prm) {
    extern __shared__ __attribute__((aligned(16))) unsigned char smem[];
    cg::grid_group grid = cg::this_grid();
    Ctx C; C.lds = (LAS unsigned char*)smem; C.tid = threadIdx.x; C.lane = C.tid & 63; C.wave = __builtin_amdgcn_readfirstlane(C.tid >> 6);
    C.G = gridDim.x; C.bx = blockIdx.x; C.p = (const CAS Params*)__builtin_amdgcn_kernarg_segment_ptr(); C.ws = C.p->ws; C.out = C.p->out;
    (void)prm;

    unsigned* barw = (unsigned*)(C.ws + WS_BAR);
    if (C.bx == 0) for (int i = C.tid; i < XCD_BAR_WORDS; i += 512) barw[i] = 0u;
    if (C.tid < 4) ((LAS unsigned*)(C.lds + LDS_BYTES - 16))[C.tid] = 0u;
    grid.sync();
    XcdBarrier xbar = xcd_barrier_post(barw, (volatile LAS unsigned*)(C.lds + LDS_BYTES - 16));
    for (int rep = 0; rep < REP_P0; ++rep) p0_prologue(C);
    xcd_barrier(xbar);
    {   unsigned char* ws = C.ws;
        pg8::Gemm g{(const bf16_t*)(ws + WS_MEMB), (const bf16_t*)(ws + WS_WKV), 1024, 2048, 1024};
        const int n1 = (T / 256) * (5632 / 256);
        pg8::StaticOrder S; S.init(1024, 2048, C.G, (C.bx + C.G - (n1 % C.G)) % C.G);
        Epi<EK_MEM> E; E.c = EpiCtx{}; E.c.rss_in = (const float*)(ws + WS_RSSM); E.c.MKV = (float*)(ws + WS_MKV);
        pg8::gemm_phase(C.lds, C.tid, g, S, E);
    }
    int rep = 0;
    for (int ph = 0; ph < 24; ++ph) {
        { int t_ = threadIdx.x; asm volatile("" : "+v"(t_)); C.tid = t_; C.lane = t_ & 63; C.wave = __builtin_amdgcn_readfirstlane(t_ >> 6); }
        asm volatile("" : "+s"(C.ws), "+s"(C.out), "+s"(C.p));
        unsigned char* ws = C.ws; float* RSS = (float*)(ws + WS_RSS);
        const int l = ph / 12, k = ph - 12 * l;
        unsigned char* wl = ws + WS_WL + (size_t)l * WL_SIZE;
        EpiCtx ec{}; ec.l = l;
        if (k == 0 || k == 10) {
            pg8::Gemm g{(const bf16_t*)(ws + WS_XB), (const bf16_t*)(wl + (k == 0 ? WL_W1 : WL_W2)), T, 5632, 1024};
            pg8::StaticOrder S; S.init(T, 5632, C.G, C.bx);
            ec.rss_in = RSS + (size_t)(4 * l + (k == 0 ? 0 : 3)) * T; ec.H = (bf16_t*)(ws + WS_H);
            Epi<EK_SWIGLU> E; E.c = ec; pg8::gemm_phase(C.lds, C.tid, g, S, E);
            if (ph == 0 && rep == 0) convert_in_slack(C, 0, T_WD1, 688, (T / 256) * 22 + 32);
            if (ph == 10 && rep == 0) convert_in_slack(C, 1, 704, T_WKV, (T / 256) * 22);
        } else if (k == 1 || k == 6 || k == 9 || k == 11) {
            const bf16_t* A; const bf16_t* B; int K; float sc; int ro;
            if (k == 1) { A = (const bf16_t*)(ws + WS_H); B = (const bf16_t*)(wl + WL_WD1); K = FF; sc = 0.5f; ro = 4 * l + 1; }
            else if (k == 6) { A = (const bf16_t*)(ws + WS_MIX); B = (const bf16_t*)(wl + WL_WOUT); K = 1024; sc = 1.f; ro = 4 * l + 2; }
            else if (k == 9) { A = (const bf16_t*)(ws + WS_OX); B = (const bf16_t*)(wl + WL_WO); K = 512; sc = 1.f; ro = 4 * l + 3; }
            else { A = (const bf16_t*)(ws + WS_H); B = (const bf16_t*)(wl + WL_WD2); K = FF; sc = 0.5f; ro = 4 * l + 4; }
            pg8::Gemm g{A, B, TP, 1024, K};
            pg8::StaticOrder S; S.init(TP, 1024, C.G, C.bx);
            ec.rss_out = RSS + (size_t)ro * T; ec.X = (ph == 23) ? C.out : nullptr; ec.XB = (bf16_t*)(ws + WS_XB); ec.scale = sc;
            Epi<EK_RES> E; E.c = ec; pg8::gemm_phase(C.lds, C.tid, g, S, E);
            thin_res_gemm(C, A, B, K, sc, RSS + (size_t)ro * T, (ph == 23) ? C.out : nullptr);
        } else if (k == 2) {
            pg8::Gemm g{(const bf16_t*)(ws + WS_XB), (const bf16_t*)(wl + WL_WIN), T, INWP, 1024};
            pg8::StaticOrder S; S.init(T, INWP, C.G, C.bx);
            ec.rss_in = RSS + (size_t)(4 * l + 1) * T; ec.QS = (bf16_t*)(ws + WS_QS); ec.KS = (bf16_t*)(ws + WS_KS); ec.VS = (bf16_t*)(ws + WS_VS); ec.ZG = (bf16_t*)(ws + WS_ZG);
            ec.LR = (float*)(ws + WS_LR); ec.rope = (const float2*)(ws + WS_ROPE); ec.gq = C.p->in[14] + l * 64; ec.gk = C.p->in[15] + l * 64;
            ec.okp = C.out + O_KP; ec.ovp = C.out + O_VP; ec.oks = C.out + O_KS; ec.ovs = C.out + O_VS;
            Epi<EK_WIN> E; E.c = ec; pg8::gemm_phase(C.lds, C.tid, g, S, E);
            if (ph == 2 && rep == 0) convert_in_slack(C, 0, 688, T_WKV, (T / 256) * 10);
        } else if (k == 3) {
            for (int u = C.bx; u < 256; u += C.G) swa_prompt_unit(C, l, u);
            gla_a_phase(C, l);
        } else if (k == 4) {
            gla_scan(C, l);
            for (int u = C.bx; u < 512; u += C.G) gla_decode_unit(C, l, u);
            for (int u = C.bx; u < 256; u += C.G) swa_decode_unit(C, l, u);
        } else if (k == 5) {
            gla_c_phase(C, l);
        } else if (k == 7) {
            pg8::Gemm g{(const bf16_t*)(ws + WS_XB), (const bf16_t*)(wl + WL_WQ), T, 512, 1024};
            pg8::StaticOrder S; S.init(T, 512, C.G, C.bx);
            ec.rss_in = RSS + (size_t)(4 * l + 2) * T; ec.QX = (bf16_t*)(ws + WS_QX);
            Epi<EK_XQ> E; E.c = ec; pg8::gemm_phase(C.lds, C.tid, g, S, E);
            if (ph == 7 && rep == 0) convert_in_slack(C, 1, 0, 704, (T / 256) * 2);
        } else {
            if (C.G == 256) {
                if (C.bx < 128) { xattn_unit(C, l, C.bx); xattn_unit(C, l, 128 + C.bx); }
                else for (int i = 0; i < 3; ++i) xattn_unit(C, l, 128 + 128 + 3 * (C.bx - 128) + i);
            } else for (int u = C.bx; u < 640; u += C.G) xattn_unit(C, l, u);
        }
        if (ph != 23) for (int r2 = 0; r2 < REP_SYNC; ++r2) xcd_barrier(xbar);
        {
            const int want = (k == 0 || k == 2 || k == 7 || k == 10) ? REP_GEMM : (k == 3 ? REP3 : (k == 4 ? REP4 : k == 5 ? REP5 : (k == 8 ? REP8 : 1)));
            if (rep + 1 < want) { ++rep; --ph; } else rep = 0;
        }
    }
}

extern "C" void kernel_launch(void* const* d_in, const int* in_sizes, int n_in, void* d_out, int out_size, void* d_ws, size_t ws_size, hipStream_t stream) {
    static int grid = 0;
    if (grid == 0) {
        if (n_in != 33 || ws_size < WS_TOTAL) { fprintf(stderr, "kernel_launch: need 33 inputs and %zu bytes of workspace; got %d inputs, %zu bytes\n", (size_t)WS_TOTAL, n_in, ws_size); grid = -1; return; }
        int dev = 0, cus = 0, per_cu = 0;
        (void)hipGetDevice(&dev); (void)hipDeviceGetAttribute(&cus, hipDeviceAttributeMultiprocessorCount, dev);
        if (hipFuncSetAttribute((const void*)hymba_fwd, hipFuncAttributeMaxDynamicSharedMemorySize, LDS_BYTES) != hipSuccess) { fprintf(stderr, "kernel_launch: hipFuncSetAttribute failed\n"); grid = -1; return; }
        if (hipOccupancyMaxActiveBlocksPerMultiprocessor(&per_cu, (const void*)hymba_fwd, 512, LDS_BYTES) != hipSuccess || per_cu < 1) { fprintf(stderr, "kernel_launch: occupancy query gave %d\n", per_cu); grid = -1; return; }
        grid = cus * per_cu;
    }
    if (grid < 0) return;
    Params p{};
    for (int i = 0; i < 33; ++i) p.in[i] = (const float*)d_in[i];
    p.out = (float*)d_out; p.ws = (unsigned char*)d_ws;
    void* args[] = {&p};
    hipError_t e = hipLaunchCooperativeKernel((const void*)hymba_fwd, dim3(grid), dim3(512), args, LDS_BYTES, stream);
    if (e != hipSuccess) fprintf(stderr, "kernel_launch: cooperative launch failed: %s (grid %d)\n", hipGetErrorString(e), grid);
}
```

```cpp
#include <hip/hip_runtime.h>
#include <hip/hip_cooperative_groups.h>
#include <cstdio>
#include <cstdint>
namespace cg = cooperative_groups;

#define LAS __attribute__((address_space(3)))
#define DI __device__ __forceinline__
typedef unsigned short bf16_t;
typedef short bf16x8 __attribute__((ext_vector_type(8)));
typedef float f32x4 __attribute__((ext_vector_type(4)));
typedef unsigned u32x4 __attribute__((ext_vector_type(4)));
typedef unsigned u32x2 __attribute__((ext_vector_type(2)));
typedef short v4i16_t __attribute__((ext_vector_type(4)));
#define MFMA16(a, b, c) __builtin_amdgcn_mfma_f32_16x16x32_bf16((a), (b), (c), 0, 0, 0)

constexpr int TP = 16384, TS = 512, T = TP + TS, DM = 1024, FF = 2816, SEQ = 4096;
constexpr int INWP = 2560;
constexpr float EPS = 1e-6f;
constexpr size_t O_Y = 0, O_KP = 17301504, O_VP = 17432576, O_GP = 17563648, O_MKP = 17825792, O_MVP = 18874368, O_KS = 19922944, O_VS = 24117248, O_GS = 28311552;
constexpr size_t al(size_t x) { return (x + 4095) & ~(size_t)4095; }
constexpr size_t WS_RSS = 0;
constexpr size_t WS_RSSM = al(WS_RSS + (size_t)9 * T * 4);
constexpr size_t WS_ROPE = al(WS_RSSM + 1024 * 4);
constexpr size_t WS_XB = al(WS_ROPE + (size_t)4100 * 32 * 8);
constexpr size_t WS_H = al(WS_XB + (size_t)T * 1024 * 2);
constexpr size_t WS_QS = al(WS_H + (size_t)T * FF * 2);
constexpr size_t WS_KS = al(WS_QS + (size_t)T * 512 * 2);
constexpr size_t WS_VS = al(WS_KS + (size_t)T * 128 * 2);
constexpr size_t WS_ZG = al(WS_VS + (size_t)T * 128 * 2);
constexpr size_t WS_LR = al(WS_ZG + (size_t)T * 1536 * 2);
constexpr size_t WS_MIX = al(WS_LR + (size_t)T * 16 * 4);
constexpr size_t WS_QX = al(WS_MIX + (size_t)T * 1024 * 2);
constexpr size_t WS_OX = al(WS_QX + (size_t)T * 512 * 2);
constexpr size_t WS_MEMB = al(WS_OX + (size_t)T * 512 * 2);
constexpr size_t WS_MKV = al(WS_MEMB + (size_t)1024 * 1024 * 2);
constexpr size_t WS_BCUM = al(WS_MKV + (size_t)1024 * 2048 * 4);
constexpr size_t WS_ST = al(WS_BCUM + (size_t)TP * 256 * 4);
constexpr size_t WS_VT = al(WS_ST + (size_t)1024 * 8192 * 4);
constexpr size_t WS_DEC = al(WS_VT + (size_t)1024 * 8192 * 2);
constexpr size_t WS_WKV = al(WS_DEC + (size_t)1024 * 64 * 4);
constexpr size_t WS_WL = al(WS_WKV + (size_t)2048 * 1024 * 2);
constexpr size_t WL_W1 = 0;
constexpr size_t WL_WD1 = WL_W1 + (size_t)5632 * 1024 * 2;
constexpr size_t WL_WIN = WL_WD1 + (size_t)1024 * FF * 2;
constexpr size_t WL_WOUT = WL_WIN + (size_t)INWP * 1024 * 2;
constexpr size_t WL_WQ = WL_WOUT + (size_t)1024 * 1024 * 2;
constexpr size_t WL_WO = WL_WQ + (size_t)512 * 1024 * 2;
constexpr size_t WL_W2 = WL_WO + (size_t)1024 * 512 * 2;
constexpr size_t WL_WD2 = WL_W2 + (size_t)5632 * 1024 * 2;
constexpr size_t WL_SIZE = al(WL_WD2 + (size_t)1024 * FF * 2);
constexpr size_t WS_STB = WS_WL + 2 * WL_SIZE;
constexpr size_t WS_BAR = al(WS_STB + (size_t)1024 * 8192 * 2);
constexpr size_t WS_TOTAL = WS_BAR + 16384;
constexpr int LDS_BYTES = 147456;
constexpr int REP_GEMM = 1, REP_ATT = 1, REP_P0 = 1, REP_SYNC = 1, REP3 = 1, REP4 = 1, REP5 = 1, REP8 = 1;

DI float bf2f(unsigned h) { return __builtin_bit_cast(float, h << 16); }
typedef float f32x2_t __attribute__((ext_vector_type(2)));
typedef __bf16 bf16x2_t __attribute__((ext_vector_type(2)));
DI unsigned pk2(float lo, float hi) { const f32x2_t v = {lo, hi}; const bf16x2_t b = __builtin_convertvector(v, bf16x2_t); return __builtin_bit_cast(unsigned, b); }
DI float blo(unsigned w) { return __builtin_bit_cast(float, w << 16); }
DI float bhi(unsigned w) { return __builtin_bit_cast(float, w & 0xffff0000u); }
DI float silu(float x) { return x * __builtin_amdgcn_rcpf(1.f + __builtin_amdgcn_exp2f(x * -1.4426950408889634f)); }
DI float logsig(float x) { return fminf(x, 0.f) - __logf(1.f + __expf(-fabsf(x))); }

#define XB_TMO      128
#define XB_XCNT(j)  (256  + 64 * (j))
#define XB_XSUB(j)  (1280 + 64 * (j))
#define XB_XGEN(j)  (2304 + 64 * (j))
#define XB_TOP      3328
#define XB_TOPGEN   3392
#define XCD_BAR_WORDS 3456
#define XB_SPIN_CAP (1u << 18)
DI unsigned xb_ld(unsigned* p)              { return __hip_atomic_load(p, __ATOMIC_RELAXED, __HIP_MEMORY_SCOPE_AGENT); }
DI unsigned xb_add(unsigned* p, unsigned v) { return __hip_atomic_fetch_add(p, v, __ATOMIC_RELAXED, __HIP_MEMORY_SCOPE_AGENT); }
DI unsigned xb_xcc_id() { return (unsigned)__builtin_amdgcn_s_getreg((3 << 11) | 20) & 0xFu; }
#define XB_SPIN(cond, bar) do { unsigned _sp = 0; while (cond) { __builtin_amdgcn_s_sleep(1); \
    if ((++_sp & 255u) == 0u) { if (xb_ld(&(bar)[XB_TMO])) break; if (_sp > XB_SPIN_CAP) { atomicAdd(&(bar)[XB_TMO], 1u); break; } } } } while (0)
struct XcdBarrier { unsigned* bar; unsigned x; volatile LAS unsigned* st; };
DI XcdBarrier xcd_barrier_post(unsigned* bar, volatile LAS unsigned* st) {
    XcdBarrier b; b.bar = bar; b.x = xb_xcc_id(); b.st = st;
    if (threadIdx.x == 0) (void)xb_add(&bar[XB_XCNT(b.x)], 1u);
    return b;
}
DI void xcd_barrier_complete(unsigned* bar, unsigned x, unsigned& nloc, unsigned& nx) {
    const unsigned G = gridDim.x * gridDim.y * gridDim.z;
    unsigned sum, cnt, mine, sp = 0u;
    for (;;) {
        sum = 0u; cnt = 0u; mine = 0u;
#pragma unroll
        for (unsigned j = 0; j < 16; ++j) { const unsigned c = xb_ld(&bar[XB_XCNT(j)]); sum += c; cnt += (c > 0u) ? 1u : 0u; mine = (j == x) ? c : mine; }
        if (sum == G) break;
        __builtin_amdgcn_s_sleep(1);
        if ((++sp & 255u) == 0u) { if (xb_ld(&bar[XB_TMO])) break; if (sp > XB_SPIN_CAP) { atomicAdd(&bar[XB_TMO], 1u); break; } }
    }
    nloc = mine > 0u ? mine : 1u; nx = cnt > 0u ? cnt : 1u;
}
DI void xcd_barrier(const XcdBarrier& b) {
    asm volatile("s_waitcnt vmcnt(0)" ::: "memory");
    __syncthreads();
    if (threadIdx.x == 0) {
        unsigned* bar = b.bar;
        __builtin_amdgcn_s_waitcnt(0);
        unsigned nloc = b.st[0], nx = b.st[1];
        if (nloc == 0u) { xcd_barrier_complete(bar, b.x, nloc, nx); b.st[0] = nloc; b.st[1] = nx; }
        const unsigned old = xb_add(&bar[XB_XSUB(b.x)], 1u);
        const unsigned gen = old / nloc;
        if (old + 1u == (gen + 1u) * nloc) {
            __builtin_amdgcn_fence(__ATOMIC_RELEASE, "agent");
            asm volatile("s_waitcnt vmcnt(0)" ::: "memory");
            const unsigned og = xb_add(&bar[XB_TOP], 1u);
            const unsigned tg = og / nx;
            if (og + 1u == (tg + 1u) * nx) xb_add(&bar[XB_TOPGEN], 1u);
            else XB_SPIN(xb_ld(&bar[XB_TOPGEN]) == tg, bar);
            __builtin_amdgcn_fence(__ATOMIC_ACQUIRE, "agent");
            xb_add(&bar[XB_XGEN(b.x)], 1u);
            asm volatile("s_waitcnt vmcnt(0)" ::: "memory");
        } else {
            XB_SPIN(xb_ld(&bar[XB_XGEN(b.x)]) == gen, bar);
            __builtin_amdgcn_fence(__ATOMIC_ACQUIRE, "agent");
            asm volatile("s_waitcnt vmcnt(0)" ::: "memory");
        }
    }
    __syncthreads();
}

namespace pg8 {
constexpr int BM = 256, BK = 64, HALF = 128, HTB = HALF * BK * 2, STAGE_BYTES = 8 * HTB, NXCD = 8, WGM = 8;
DI int lds_byte(int r, int c) { const int st = (r >> 4) * 2 + (c >> 5), rr = r & 15, cc = c & 31, ob = rr * 64 + cc * 2; return st * 1024 + (ob ^ (((ob >> 9) & 1) << 5)); }
DI void stage_rc(int b, int& R, int& C) { const int st = b / 1024, sb = b % 1024, swz = sb ^ (((sb >> 9) & 1) << 5); R = (st >> 1) * 16 + swz / 64; C = (st & 1) * 32 + (swz % 64) / 2; }
DI int perm32(int rho) { const int n = rho >> 4, i = rho & 15; return 8 * (i >> 2) + 4 * n + (i & 3); }
struct Unit { int pm, pn; };
struct Gemm { const bf16_t* A; const bf16_t* Bt; int M, N, K; };
struct StaticOrder {
    int nM, nN, nwg, G, c;
    DI void init(int M, int N, int G_, int c_) { nM = M / BM; nN = N / BM; nwg = nM * nN; G = G_; c = c_; }
    DI bool next(int i, Unit& u) const {
        const long L = (long)i * G + c; if (L >= nwg) return false;
        int wgid = (int)L; { const int q = nwg / NXCD, r = nwg % NXCD, xcd = wgid % NXCD, off = wgid / NXCD; wgid = (xcd < r ? xcd * (q + 1) : r * (q + 1) + (xcd - r) * q) + off; }
        const int nig = WGM * nN, gid = wgid / nig, fm = gid * WGM, gsz = (nM - fm) < WGM ? (nM - fm) : WGM;
        u.pm = fm + ((wgid % nig) % gsz); u.pn = (wgid % nig) / gsz; return true;
    }
};
template <class Epi, class Sched>
DI void gemm_phase(LAS unsigned char* lds, const int tid, const Gemm g, const Sched& S, const Epi& E) {
    const int wid = __builtin_amdgcn_readfirstlane(tid >> 6), lane = tid & 63, wr = wid >> 2, wc = wid & 3, fr = lane & 15, fq = lane >> 4;
    const int K = g.K, nt = K / BK;
    unsigned voffA[2], voffB[2];
#pragma unroll
    for (int i = 0; i < 2; ++i) { int R, C; stage_rc(tid * 16 + i * 8192, R, C); const int Rb = (R & ~31) + perm32(R & 31);
        voffA[i] = (unsigned)(R * K + C) * 2u; voffB[i] = (unsigned)(Rb * K + C) * 2u; }
    const size_t kstep = (size_t)(BK * 2);
    const size_t hstep = (size_t)HALF * K * 2;
    const size_t tstep = 2 * hstep;
    const unsigned ldsw = (unsigned)wid * 1024u;
    const int aoff = lds_byte(wr * 64 + fr, fq * 8), boff = lds_byte(wc * 32 + fr, fq * 8);
#define PG8_SA(b, h) (((b) * 2 + (h)) * HTB)
#define PG8_SB(b, h) ((4 + (b) * 2 + (h)) * HTB)
#define PG8_STAGE(bufoff, gbase, voff) do { _Pragma("unroll") for (int _i = 0; _i < 2; ++_i) \
        __builtin_amdgcn_global_load_lds((const unsigned*)((const char*)(gbase) + (voff)[_i]), (LAS unsigned*)(lds + (bufoff) + ldsw + _i * 8192), 16, 0, 0); } while (0)
#define PG8_LDA(dst, b, h) do { _Pragma("unroll") for (int m = 0; m < 4; ++m) _Pragma("unroll") for (int k = 0; k < 2; ++k) dst[m][k] = *(const LAS bf16x8*)(lds + PG8_SA(b, h) + aoff + m * 2048 + k * 1024); } while (0)
#define PG8_LDB(dst, b, h) do { _Pragma("unroll") for (int n = 0; n < 2; ++n) _Pragma("unroll") for (int k = 0; k < 2; ++k) dst[n][k] = *(const LAS bf16x8*)(lds + PG8_SB(b, h) + boff + n * 2048 + k * 1024); } while (0)
#define PG8_MMA(ai, bj, At, Bt) do { __builtin_amdgcn_s_setprio(1); _Pragma("unroll") for (int m = 0; m < 4; ++m) _Pragma("unroll") for (int n = 0; n < 2; ++n) _Pragma("unroll") for (int k = 0; k < 2; ++k) \
        acc[ai][bj][m][n] = __builtin_amdgcn_mfma_f32_16x16x32_bf16(Bt[n][k], At[m][k], acc[ai][bj][m][n], 0, 0, 0); __builtin_amdgcn_s_setprio(0); } while (0)
#define PG8_WAIT_V(n) asm volatile("s_waitcnt vmcnt(" #n ")" ::: "memory")
#define PG8_WAIT_L(n) asm volatile("s_waitcnt lgkmcnt(" #n ")" ::: "memory")
#define PG8_BAR __builtin_amdgcn_s_barrier()
#define PG8_SCHED __builtin_amdgcn_sched_barrier(0)
    Unit cur, nxt; int ui = 0;
    if (!S.next(0, cur)) return;
    f32x4 acc[2][2][4][2];
#pragma unroll
    for (int a = 0; a < 2; ++a)
#pragma unroll
        for (int b = 0; b < 2; ++b)
#pragma unroll
            for (int m = 0; m < 4; ++m)
#pragma unroll
                for (int n = 0; n < 2; ++n) acc[a][b][m][n] = (f32x4){0.f, 0.f, 0.f, 0.f};
    bf16x8 At[4][2], B0[2][2], B1[2][2];
    const char* cA = (const char*)g.A + (size_t)cur.pm * tstep; const char* cB = (const char*)g.Bt + (size_t)cur.pn * tstep;
    PG8_STAGE(PG8_SB(0, 0), cB, voffB); PG8_STAGE(PG8_SB(0, 1), cB + hstep, voffB); PG8_STAGE(PG8_SA(0, 0), cA, voffA); PG8_STAGE(PG8_SA(0, 1), cA + hstep, voffA);
    if (wr == 1) PG8_BAR;
    PG8_WAIT_V(2); PG8_BAR;
    PG8_STAGE(PG8_SB(1, 0), cB + kstep, voffB); PG8_STAGE(PG8_SA(1, 0), cA + kstep, voffA); PG8_STAGE(PG8_SB(1, 1), cB + hstep + kstep, voffB);
    PG8_WAIT_V(6); PG8_BAR;
    for (;;) {
        const bool has_next = S.next(ui + 1, nxt);
        const char* nA = has_next ? (const char*)g.A + (size_t)nxt.pm * tstep : cA; const char* nB = has_next ? (const char*)g.Bt + (size_t)nxt.pn * tstep : cB;
        for (int t = 0; t < nt; t += 2) {
            const bool last = (t == nt - 2);
            const char* a1 = cA + (size_t)(t + 1) * kstep;
            const char* a2 = last ? nA : cA + (size_t)(t + 2) * kstep; const char* b2 = last ? nB : cB + (size_t)(t + 2) * kstep;
            const char* a3 = a2 + kstep; const char* b3 = b2 + kstep;
            PG8_LDB(B0, 0, 0); PG8_LDB(B1, 0, 1); PG8_SCHED; PG8_LDA(At, 0, 0); PG8_STAGE(PG8_SA(1, 1), a1 + hstep, voffA);
            PG8_WAIT_V(8); PG8_WAIT_L(0); PG8_BAR; PG8_MMA(0, 0, At, B0); PG8_MMA(0, 1, At, B1); PG8_BAR; PG8_SCHED;
            PG8_LDA(At, 0, 1); PG8_STAGE(PG8_SB(0, 0), b2, voffB); PG8_STAGE(PG8_SB(0, 1), b2 + hstep, voffB); PG8_STAGE(PG8_SA(0, 0), a2, voffA);
            PG8_WAIT_V(8); PG8_WAIT_L(0); PG8_BAR; PG8_MMA(1, 0, At, B0); PG8_MMA(1, 1, At, B1); PG8_BAR; PG8_SCHED;
            PG8_LDB(B0, 1, 0); PG8_LDB(B1, 1, 1); PG8_SCHED; PG8_LDA(At, 1, 0); PG8_STAGE(PG8_SA(0, 1), a2 + hstep, voffA);
            PG8_WAIT_V(8); PG8_WAIT_L(0); PG8_BAR; PG8_MMA(0, 0, At, B0); PG8_MMA(0, 1, At, B1); PG8_BAR; PG8_SCHED;
            PG8_LDA(At, 1, 1); PG8_STAGE(PG8_SB(1, 0), b3, voffB); PG8_STAGE(PG8_SB(1, 1), b3 + hstep, voffB); PG8_STAGE(PG8_SA(1, 0), a3, voffA);
            PG8_WAIT_V(8); PG8_WAIT_L(0); PG8_BAR; PG8_MMA(1, 0, At, B0); PG8_MMA(1, 1, At, B1); PG8_BAR; PG8_SCHED;
        }
        if (wr == 0) PG8_BAR;
        E(acc, cur, wr, wc, fr, fq);
        if (!has_next) break;
#pragma unroll
        for (int a = 0; a < 2; ++a)
#pragma unroll
            for (int b = 0; b < 2; ++b)
#pragma unroll
                for (int m = 0; m < 4; ++m)
#pragma unroll
                    for (int n = 0; n < 2; ++n) acc[a][b][m][n] = (f32x4){0.f, 0.f, 0.f, 0.f};
        cur = nxt; cA = nA; cB = nB; ++ui;
        if (wr == 1) PG8_BAR;
    }
    PG8_WAIT_V(0);
    PG8_BAR;
#undef PG8_SA
#undef PG8_SB
#undef PG8_STAGE
#undef PG8_LDA
#undef PG8_LDB
#undef PG8_MMA
#undef PG8_WAIT_V
#undef PG8_WAIT_L
#undef PG8_BAR
#undef PG8_SCHED
}
}

struct EpiCtx {
    const float* rss_in; float* rss_out; float* X; bf16_t* XB; bf16_t* H;
    bf16_t *QS, *KS, *VS, *ZG; float* LR; const float2* rope; const float *gq, *gk;
    float *okp, *ovp, *oks, *ovs; bf16_t* QX; float* MKV; float scale; int l;
};
enum { EK_SWIGLU = 0, EK_RES = 1, EK_WIN = 2, EK_XQ = 3, EK_MEM = 4 };
template <int KIND> struct Epi {
    EpiCtx c;
    DI void operator()(const f32x4 (&acc)[2][2][4][2], const pg8::Unit& u, int wr, int wc, int fr, int fq) const {
        const int row0 = u.pm * 256 + wr * 64 + fr;
        const int cl = wc * 32 + 8 * fq;
        if constexpr (KIND == EK_RES) {
            u32x4 xo[2][4][2];
#pragma unroll
            for (int ai = 0; ai < 2; ++ai)
#pragma unroll
                for (int m = 0; m < 4; ++m)
#pragma unroll
                    for (int bj = 0; bj < 2; ++bj) xo[ai][m][bj] = *(const u32x4*)(c.XB + (size_t)(row0 + ai * 128 + m * 16) * DM + u.pn * 256 + bj * 128 + cl);
#pragma unroll
            for (int ai = 0; ai < 2; ++ai)
#pragma unroll
                for (int m = 0; m < 4; ++m) {
                    const int r = row0 + ai * 128 + m * 16;
                    float ss = 0.f;
#pragma unroll
                    for (int bj = 0; bj < 2; ++bj) {
                        bf16_t* xb = c.XB + (size_t)r * DM + u.pn * 256 + bj * 128 + cl;
                        const u32x4 xv = xo[ai][m][bj];
                        f32x4 x0 = (f32x4){blo(xv[0]), bhi(xv[0]), blo(xv[1]), bhi(xv[1])}, x1 = (f32x4){blo(xv[2]), bhi(xv[2]), blo(xv[3]), bhi(xv[3])};
                        x0 = x0 + acc[ai][bj][m][0] * c.scale; x1 = x1 + acc[ai][bj][m][1] * c.scale;
                        if (c.X) { float* xp = c.X + (size_t)r * DM + u.pn * 256 + bj * 128 + cl; *(f32x4*)xp = x0; *(f32x4*)(xp + 4) = x1; }
                        else {
                            u32x4 w; w.x = pk2(x0[0], x0[1]); w.y = pk2(x0[2], x0[3]); w.z = pk2(x1[0], x1[1]); w.w = pk2(x1[2], x1[3]);
                            *(u32x4*)xb = w;
#pragma unroll
                            for (int e = 0; e < 4; ++e) { const float a0 = blo(w[e]), a1 = bhi(w[e]); ss += a0 * a0 + a1 * a1; }
                        }
                    }
                    if (!c.X) { ss += __shfl_xor(ss, 16); ss += __shfl_xor(ss, 32); if (fq == 0) atomicAdd(c.rss_out + r, ss); }
                }
            return;
        }
#pragma unroll
        for (int ai = 0; ai < 2; ++ai)
#pragma unroll
            for (int m = 0; m < 4; ++m) {
                const int r = row0 + ai * 128 + m * 16;
                if constexpr (KIND == EK_SWIGLU) {
                    const float rs = rsqrtf(c.rss_in[r] * (1.f / 1024.f) + EPS);
                    const float rsn = rs * -1.4426950408889634f, rs2 = rs * rs;
                    float hv[8];
#pragma unroll
                    for (int n = 0; n < 2; ++n)
#pragma unroll
                        for (int j = 0; j < 4; ++j) { const float g0 = acc[ai][0][m][n][j], u0 = acc[ai][1][m][n][j];
                            hv[n * 4 + j] = (g0 * u0) * rs2 * __builtin_amdgcn_rcpf(1.f + __builtin_amdgcn_exp2f(g0 * rsn)); }
                    u32x4 w; w.x = pk2(hv[0], hv[1]); w.y = pk2(hv[2], hv[3]); w.z = pk2(hv[4], hv[5]); w.w = pk2(hv[6], hv[7]);
                    *(u32x4*)(c.H + (size_t)r * FF + u.pn * 128 + cl) = w;
                } else if constexpr (KIND == EK_XQ) {
                    const float rs = rsqrtf(c.rss_in[r] * (1.f / 1024.f) + EPS);
#pragma unroll
                    for (int bj = 0; bj < 2; ++bj) {
                        const f32x4 a0 = acc[ai][bj][m][0] * rs, a1 = acc[ai][bj][m][1] * rs;
                        u32x4 w; w.x = pk2(a0[0], a0[1]); w.y = pk2(a0[2], a0[3]); w.z = pk2(a1[0], a1[1]); w.w = pk2(a1[2], a1[3]);
                        *(u32x4*)(c.QX + (size_t)r * 512 + u.pn * 256 + bj * 128 + cl) = w;
                    }
                } else if constexpr (KIND == EK_MEM) {
                    const float rs = rsqrtf(c.rss_in[r] * (1.f / 1024.f) + EPS);
#pragma unroll
                    for (int bj = 0; bj < 2; ++bj) {
                        float* p = c.MKV + (size_t)r * 2048 + u.pn * 256 + bj * 128 + cl;
                        *(f32x4*)p = acc[ai][bj][m][0] * rs; *(f32x4*)(p + 4) = acc[ai][bj][m][1] * rs;
                    }
                } else {
                    const float rs = rsqrtf(c.rss_in[r] * (1.f / 1024.f) + EPS);
                    const int pn = u.pn;
                    if (pn < 2 || (pn == 2 && wc < 2)) {
                        const bool isq = pn < 2; const int head = isq ? (4 * pn + wc) : wc;
                        const float* gn = isq ? c.gq : c.gk;
                        float ss = 0.f;
#pragma unroll
                        for (int bj = 0; bj < 2; ++bj)
#pragma unroll
                            for (int n = 0; n < 2; ++n)
#pragma unroll
                                for (int j = 0; j < 4; ++j) { const float v = acc[ai][bj][m][n][j] * rs; ss += v * v; }
                        ss += __shfl_xor(ss, 16); ss += __shfl_xor(ss, 32);
                        const float rq = rsqrtf(ss * (1.f / 64.f) + EPS) * rs;
                        const int ridx = r < TP ? (r & (SEQ - 1)) : (4096 + (r & 3));
                        const float2* rp = c.rope + (size_t)ridx * 32 + 8 * fq;
                        float o1[8], o2[8];
#pragma unroll
                        for (int n = 0; n < 2; ++n)
#pragma unroll
                            for (int j = 0; j < 4; ++j) {
                                const int d = 8 * fq + 4 * n + j; const float2 cs = rp[4 * n + j];
                                const float y1 = acc[ai][0][m][n][j] * rq * gn[d], y2 = acc[ai][1][m][n][j] * rq * gn[32 + d];
                                o1[4 * n + j] = y1 * cs.x - y2 * cs.y; o2[4 * n + j] = y2 * cs.x + y1 * cs.y;
                            }
                        u32x4 w1, w2; w1.x = pk2(o1[0], o1[1]); w1.y = pk2(o1[2], o1[3]); w1.z = pk2(o1[4], o1[5]); w1.w = pk2(o1[6], o1[7]);
                        w2.x = pk2(o2[0], o2[1]); w2.y = pk2(o2[2], o2[3]); w2.z = pk2(o2[4], o2[5]); w2.w = pk2(o2[6], o2[7]);
                        if (isq) { bf16_t* p = c.QS + (size_t)r * 512 + head * 64 + 8 * fq; *(u32x4*)p = w1; *(u32x4*)(p + 32) = w2; }
                        else {
                            bf16_t* p = c.KS + (size_t)r * 128 + head * 64 + 8 * fq; *(u32x4*)p = w1; *(u32x4*)(p + 32) = w2;
                            float* op = nullptr;
                            if (r < TP) { const int t = r & (SEQ - 1); if (t >= SEQ - 128) op = c.okp + ((size_t)((c.l * 4 + (r >> 12)) * 128 + (t - (SEQ - 128)))) * 128; }
                            else { const int rr = r - TP; op = c.oks + ((size_t)((c.l * 128 + (rr >> 2)) * 128 + 124 + (rr & 3))) * 128; }
                            if (op) { op += head * 64 + 8 * fq;
                                *(f32x4*)op = (f32x4){o1[0], o1[1], o1[2], o1[3]}; *(f32x4*)(op + 4) = (f32x4){o1[4], o1[5], o1[6], o1[7]};
                                *(f32x4*)(op + 32) = (f32x4){o2[0], o2[1], o2[2], o2[3]}; *(f32x4*)(op + 36) = (f32x4){o2[4], o2[5], o2[6], o2[7]}; }
                        }
                    } else if (pn == 2) {
                        const int head = wc - 2;
                        float* op = nullptr;
                        if (r < TP) { const int t = r & (SEQ - 1); if (t >= SEQ - 128) op = c.ovp + ((size_t)((c.l * 4 + (r >> 12)) * 128 + (t - (SEQ - 128)))) * 128; }
                        else { const int rr = r - TP; op = c.ovs + ((size_t)((c.l * 128 + (rr >> 2)) * 128 + 124 + (rr & 3))) * 128; }
#pragma unroll
                        for (int bj = 0; bj < 2; ++bj) {
                            const f32x4 a0 = acc[ai][bj][m][0] * rs, a1 = acc[ai][bj][m][1] * rs;
                            u32x4 w; w.x = pk2(a0[0], a0[1]); w.y = pk2(a0[2], a0[3]); w.z = pk2(a1[0], a1[1]); w.w = pk2(a1[2], a1[3]);
                            *(u32x4*)(c.VS + (size_t)r * 128 + head * 64 + 32 * bj + 8 * fq) = w;
                            if (op) { float* q = op + head * 64 + 32 * bj + 8 * fq; *(f32x4*)q = a0; *(f32x4*)(q + 4) = a1; }
                        }
                    } else if (pn < 9) {
#pragma unroll
                        for (int bj = 0; bj < 2; ++bj) {
                            const f32x4 a0 = acc[ai][bj][m][0] * rs, a1 = acc[ai][bj][m][1] * rs;
                            u32x4 w; w.x = pk2(a0[0], a0[1]); w.y = pk2(a0[2], a0[3]); w.z = pk2(a1[0], a1[1]); w.w = pk2(a1[2], a1[3]);
                            *(u32x4*)(c.ZG + (size_t)r * 1536 + (pn - 3) * 256 + bj * 128 + cl) = w;
                        }
                    } else {
                        if (wc == 0 && fq < 2) { float* p = c.LR + (size_t)r * 16 + 8 * fq; *(f32x4*)p = acc[ai][0][m][0] * rs; *(f32x4*)(p + 4) = acc[ai][0][m][1] * rs; }
                    }
                }
            }
    }
};

template <int D, int NKT, bool HAS_SINK>
DI void attn16(const bf16x8 (&qf)[D / 32], LAS unsigned char* Kl, int kpitch, LAS unsigned char* Vt, int vpitch, int key0, int jlo, int jhi,
               float scale, float sink, bf16_t* orow, bool wr_ok, int fr, int fq) {
    f32x4 s[NKT];
#pragma unroll
    for (int t = 0; t < NKT; ++t) {
        s[t] = (f32x4){0.f, 0.f, 0.f, 0.f};
#pragma unroll
        for (int ks = 0; ks < D / 32; ++ks) { const bf16x8 kf = *(const LAS bf16x8*)(Kl + (key0 + 16 * t + fr) * kpitch + (32 * ks + 8 * fq) * 2); s[t] = MFMA16(kf, qf[ks], s[t]); }
    }
    float m = -INFINITY;
#pragma unroll
    for (int t = 0; t < NKT; ++t)
#pragma unroll
        for (int r = 0; r < 4; ++r) { const int j = key0 + 16 * t + 4 * fq + r; const float v = (j >= jlo && j <= jhi) ? s[t][r] * scale : -INFINITY; s[t][r] = v; m = fmaxf(m, v); }
    m = fmaxf(m, __shfl_xor(m, 16)); m = fmaxf(m, __shfl_xor(m, 32));
    if (HAS_SINK) m = fmaxf(m, sink);
    if (m == -INFINITY) m = 0.f;
    float sum = 0.f;
#pragma unroll
    for (int t = 0; t < NKT; ++t)
#pragma unroll
        for (int r = 0; r < 4; ++r) { const float e = __expf(s[t][r] - m); s[t][r] = e; sum += e; }
    sum += __shfl_xor(sum, 16); sum += __shfl_xor(sum, 32);
    if (HAS_SINK) sum += __expf(sink - m);
    const float inv = sum > 0.f ? 1.f / sum : 0.f;
    f32x4 o[D / 16];
#pragma unroll
    for (int dt = 0; dt < D / 16; ++dt) o[dt] = (f32x4){0.f, 0.f, 0.f, 0.f};
#pragma unroll
    for (int kk = 0; kk < NKT / 2; ++kk) {
        u32x4 pw; pw.x = pk2(s[2 * kk][0] * inv, s[2 * kk][1] * inv); pw.y = pk2(s[2 * kk][2] * inv, s[2 * kk][3] * inv);
        pw.z = pk2(s[2 * kk + 1][0] * inv, s[2 * kk + 1][1] * inv); pw.w = pk2(s[2 * kk + 1][2] * inv, s[2 * kk + 1][3] * inv);
        const bf16x8 pf = __builtin_bit_cast(bf16x8, pw);
#pragma unroll
        for (int dt = 0; dt < D / 16; ++dt) {
            const LAS unsigned char* vp = Vt + (key0 + 32 * kk + 4 * fq + (fr >> 2)) * vpitch + 32 * dt + 8 * (fr & 3);
            const u32x2 lo = __builtin_bit_cast(u32x2, __builtin_amdgcn_ds_read_tr16_b64_v4i16((LAS v4i16_t*)vp));
            const u32x2 hi = __builtin_bit_cast(u32x2, __builtin_amdgcn_ds_read_tr16_b64_v4i16((LAS v4i16_t*)(vp + 16 * vpitch)));
            const bf16x8 vf = __builtin_bit_cast(bf16x8, (u32x4){lo.x, lo.y, hi.x, hi.y});
            o[dt] = MFMA16(vf, pf, o[dt]);
        }
    }
    if (wr_ok) {
#pragma unroll
        for (int dt = 0; dt < D / 16; ++dt) { u32x2 w; w.x = pk2(o[dt][0], o[dt][1]); w.y = pk2(o[dt][2], o[dt][3]); *(u32x2*)(orow + 16 * dt + 4 * fq) = w; }
    }
}

struct Params { const float* in[33]; float* out; unsigned char* ws; };

#define CAS __attribute__((address_space(4)))
struct Ctx {
    LAS unsigned char* lds; int tid, lane, wave, G, bx;
    const CAS Params* p; unsigned char* ws; float* out;
};

DI void thin_res_gemm(const Ctx& C, const bf16_t* A, const bf16_t* Bt, int K, float scale, float* rss_out, float* X) {
    const int fr = C.lane & 15, fq = C.lane >> 4;
    LAS float* part = (LAS float*)C.lds;
    bf16_t* XB = (bf16_t*)(C.ws + WS_XB);
    const int kw = K >> 3;
    for (int tile = C.bx; tile < 256; tile += C.G) {
        const int row0 = TP + (tile >> 4) * 32, n0 = (tile & 15) * 64;
        f32x4 acc[2][4];
#pragma unroll
        for (int mt = 0; mt < 2; ++mt)
#pragma unroll
            for (int nt = 0; nt < 4; ++nt) acc[mt][nt] = (f32x4){0.f, 0.f, 0.f, 0.f};
        const bf16_t* ap = A + (size_t)(row0 + fr) * K + C.wave * kw + 8 * fq;
        const bf16_t* bp = Bt + (size_t)(n0 + fr) * K + C.wave * kw + 8 * fq;
#pragma unroll 4
        for (int k = 0; k < kw; k += 32) {
            bf16x8 af[2], bfr[4];
#pragma unroll
            for (int mt = 0; mt < 2; ++mt) af[mt] = *(const bf16x8*)(ap + (size_t)(16 * mt) * K + k);
#pragma unroll
            for (int nt = 0; nt < 4; ++nt) bfr[nt] = *(const bf16x8*)(bp + (size_t)(16 * nt) * K + k);
#pragma unroll
            for (int mt = 0; mt < 2; ++mt)
#pragma unroll
                for (int nt = 0; nt < 4; ++nt) acc[mt][nt] = MFMA16(bfr[nt], af[mt], acc[mt][nt]);
        }
#pragma unroll
        for (int mt = 0; mt < 2; ++mt)
#pragma unroll
            for (int nt = 0; nt < 4; ++nt) *(LAS f32x4*)(part + ((C.wave * 32 + 16 * mt + fr) * 64 + 16 * nt + 4 * fq)) = acc[mt][nt];
        __syncthreads();
        {
            const int row = C.tid >> 4, c4 = C.tid & 15;
            f32x4 v = (f32x4){0.f, 0.f, 0.f, 0.f};
#pragma unroll
            for (int w = 0; w < 8; ++w) v = v + *(const LAS f32x4*)(part + ((w * 32 + row) * 64 + 4 * c4));
            bf16_t* xb = XB + (size_t)(row0 + row) * DM + n0 + 4 * c4;
            const u32x2 xo = *(const u32x2*)xb;
            f32x4 x = (f32x4){blo(xo.x), bhi(xo.x), blo(xo.y), bhi(xo.y)}; x = x + v * scale;
            if (X) *(f32x4*)(X + (size_t)(row0 + row) * DM + n0 + 4 * c4) = x;
            else {
                u32x2 w2; w2.x = pk2(x[0], x[1]); w2.y = pk2(x[2], x[3]); *(u32x2*)xb = w2;
                const float a0 = blo(w2.x), a1 = bhi(w2.x), a2 = blo(w2.y), a3 = bhi(w2.y);
                float ss = a0 * a0 + a1 * a1 + a2 * a2 + a3 * a3;
                ss += __shfl_xor(ss, 1); ss += __shfl_xor(ss, 2); ss += __shfl_xor(ss, 4); ss += __shfl_xor(ss, 8);
                if (c4 == 0) atomicAdd(rss_out + row0 + row, ss);
            }
        }
        __syncthreads();
    }
}

DI void p0_tile(const float* s0, const float* s1, const float* gain, int mode, int K, int Nsrc, bf16_t* dst, int tile, LAS float* tl, int tid) {
    const int nkt = K >> 6; const int ntile = tile / nkt, kt = tile - ntile * nkt; const int n0 = ntile * 256, k0 = kt * 64;
    const int nn = tid & 255, kk0 = tid >> 8;
    const int n = n0 + nn; const float* src = s0; int col = n;
    if (mode == 1) { const int pn = n >> 8, bj = (n >> 7) & 1, cc = n & 127; src = bj ? s1 : s0; col = pn * 128 + cc; }
    else if (mode == 2) {
        const int pn = n >> 8, rem = n & 255, bj = rem >> 7, wc = (rem >> 5) & 3, j = rem & 31;
        if (pn < 2) col = (4 * pn + wc) * 64 + 32 * bj + j;
        else if (pn == 2) col = (wc < 2) ? (512 + wc * 64 + 32 * bj + j) : (640 + (wc - 2) * 64 + 32 * bj + j);
        else if (pn < 9) col = n;
        else col = (rem < 16) ? (2304 + rem) : -1;
    } else if (mode == 3) { if (n >= 512) { src = s1; col = n - 512; } }
    const float* sp = src + (size_t)(k0 + kk0) * Nsrc + (col >= 0 ? col : 0);
    float v[32];
#pragma unroll
    for (int i = 0; i < 32; ++i) v[i] = (col >= 0) ? sp[(size_t)(2 * i) * Nsrc] : 0.f;
    if (gain) {
#pragma unroll
        for (int i = 0; i < 32; ++i) v[i] *= gain[k0 + kk0 + 2 * i];
    }
#pragma unroll
    for (int i = 0; i < 32; ++i) tl[(kk0 + 2 * i) * 257 + nn] = v[i];
    __syncthreads();
#pragma unroll
    for (int j = 0; j < 4; ++j) { const int ch = tid + 512 * j; const int n2 = ch >> 3, ks = ch & 7; const LAS float* s = tl + (8 * ks) * 257 + n2;
      u32x4 o; o.x = pk2(s[0], s[257]); o.y = pk2(s[2 * 257], s[3 * 257]); o.z = pk2(s[4 * 257], s[5 * 257]); o.w = pk2(s[6 * 257], s[7 * 257]);
      *(u32x4*)(dst + (size_t)(n0 + n2) * K + k0 + 8 * ks) = o; }
    __syncthreads();
}

constexpr int TPL = 1408, T_W1 = 0, T_WD1 = 352, T_WKV = 1344;
DI void p0_dispatch(const Ctx& C, int l, int r) {
    const CAS Params& P = *C.p; unsigned char* ws = C.ws;
    unsigned char* wl = ws + WS_WL + (size_t)l * WL_SIZE;
    const float* s0; const float* s1 = nullptr; const float* gain = nullptr; int mode = 0, K = 1024, Nsrc; bf16_t* dst;
    if (r < 352) { s0 = P.in[9] + (size_t)l * 1024 * FF; s1 = P.in[10] + (size_t)l * 1024 * FF; gain = P.in[8] + l * 1024; mode = 1; Nsrc = FF; dst = (bf16_t*)(wl + WL_W1); }
    else if (r < 528) { r -= 352; s0 = P.in[11] + (size_t)l * FF * 1024; K = FF; Nsrc = 1024; dst = (bf16_t*)(wl + WL_WD1); }
    else if (r < 688) { r -= 528; s0 = P.in[13] + (size_t)l * 1024 * 2320; gain = P.in[12] + l * 1024; mode = 2; Nsrc = 2320; dst = (bf16_t*)(wl + WL_WIN); }
    else if (r < 752) { r -= 688; s0 = P.in[20] + (size_t)l * 1024 * 1024; Nsrc = 1024; dst = (bf16_t*)(wl + WL_WOUT); }
    else if (r < 784) { r -= 752; s0 = P.in[23] + (size_t)l * 1024 * 512; gain = P.in[21] + l * 1024; Nsrc = 512; dst = (bf16_t*)(wl + WL_WQ); }
    else if (r < 816) { r -= 784; s0 = P.in[28] + (size_t)l * 512 * 1024; K = 512; Nsrc = 1024; dst = (bf16_t*)(wl + WL_WO); }
    else if (r < 1168) { r -= 816; s0 = P.in[30] + (size_t)l * 1024 * FF; s1 = P.in[31] + (size_t)l * 1024 * FF; gain = P.in[29] + l * 1024; mode = 1; Nsrc = FF; dst = (bf16_t*)(wl + WL_W2); }
    else if (r < 1344) { r -= 1168; s0 = P.in[32] + (size_t)l * FF * 1024; K = FF; Nsrc = 1024; dst = (bf16_t*)(wl + WL_WD2); }
    else { r -= 1344; s0 = P.in[24] + (size_t)l * 1024 * 512; s1 = P.in[25] + (size_t)l * 1024 * 512; gain = P.in[22] + l * 1024; mode = 3; Nsrc = 512; dst = (bf16_t*)(ws + WS_WKV) + (size_t)l * 1024 * 1024; }
    p0_tile(s0, s1, gain, mode, K, Nsrc, dst, r, (LAS float*)C.lds, C.tid);
}
DI void convert_in_slack(const Ctx& C, int l, int lo, int hi, int nun) {
    const int rem = nun % C.G; const int first = rem ? rem : 0, cnt = C.G - first;
    if (C.bx < first) return;
    for (int t = lo + (C.bx - first); t < hi; t += cnt) p0_dispatch(C, l, t);
}

DI void p0_prologue(const Ctx& C) {
    const CAS Params& P = *C.p; unsigned char* ws = C.ws;
    for (int it = C.bx; it < 352 + 128; it += C.G) {
        if (it < 352) p0_dispatch(C, 0, it); else if (it < 416) p0_dispatch(C, 0, T_WKV + it - 352); else p0_dispatch(C, 1, T_WKV + it - 416);
    }
    const int gw = C.bx * 8 + C.wave, NGW = C.G * 8;
    float* RSS = (float*)(ws + WS_RSS);
    for (int r0 = gw; r0 < T + 1024; r0 += 2 * NGW) {
        const float* src[2]; float* df[2]; bf16_t* db[2]; float* rs[2]; f32x4 v[2][4];
#pragma unroll
        for (int q = 0; q < 2; ++q) {
            int r = r0 + q * NGW; if (r >= T + 1024) r = r0;
            if (r < T) { src[q] = (r < TP ? P.in[0] + (size_t)r * 1024 : P.in[1] + (size_t)(r - TP) * 1024); df[q] = nullptr; db[q] = (bf16_t*)(ws + WS_XB) + (size_t)r * 1024; rs[q] = RSS + r; }
            else { src[q] = P.in[7] + (size_t)(r - T) * 1024; df[q] = nullptr; db[q] = (bf16_t*)(ws + WS_MEMB) + (size_t)(r - T) * 1024; rs[q] = (float*)(ws + WS_RSSM) + (r - T); }
#pragma unroll
            for (int j = 0; j < 4; ++j) v[q][j] = *(const f32x4*)(src[q] + 256 * j + 4 * C.lane);
        }
#pragma unroll
        for (int q = 0; q < 2; ++q) {
            float ss = 0.f;
#pragma unroll
            for (int j = 0; j < 4; ++j) {
                const f32x4 x = v[q][j];
                ss += x[0] * x[0] + x[1] * x[1] + x[2] * x[2] + x[3] * x[3];
                if (df[q]) *(f32x4*)(df[q] + 256 * j + 4 * C.lane) = x;
                u32x2 w; w.x = pk2(x[0], x[1]); w.y = pk2(x[2], x[3]); *(u32x2*)(db[q] + 256 * j + 4 * C.lane) = w;
            }
#pragma unroll
            for (int o = 1; o < 64; o <<= 1) ss += __shfl_xor(ss, o);
            if (C.lane == 0) *rs[q] = ss;
        }
    }
    for (int i = C.bx * 512 + C.tid; i < 8 * T; i += C.G * 512) RSS[T + i] = 0.f;
    float2* rope = (float2*)(ws + WS_ROPE);
    for (int i = C.bx * 512 + C.tid; i < 4100 * 32; i += C.G * 512) {
        const int pidx = i >> 5, f = i & 31; const int pos = pidx < 4096 ? pidx : 16384 + (pidx - 4096);
        const float inv = powf(10000.f, -(float)f * (1.f / 32.f));
        const float ang = (float)pos * inv;
        const double a = (double)ang; const double nrev = rint(a * 0.15915494309189535); const float rr = (float)(a - nrev * 6.283185307179586);
        rope[i] = make_float2(cosf(rr), sinf(rr));
    }
}

DI void swa_prompt_unit(const Ctx& C, int l, int unit) {
    unsigned char* ws = C.ws;
    const int b = unit >> 6, n = (unit >> 1) & 31, kvh = unit & 1;
    const bf16_t* QS = (const bf16_t*)(ws + WS_QS); const bf16_t* KS = (const bf16_t*)(ws + WS_KS); const bf16_t* VS = (const bf16_t*)(ws + WS_VS); bf16_t* MIX = (bf16_t*)(ws + WS_MIX);
    LAS unsigned char* Kl = C.lds; LAS unsigned char* Vt = C.lds + 256 * 144;
    constexpr int KP = 144, VP = 144;
#pragma unroll
    for (int i = 0; i < 4; ++i) {
        const int key = (C.tid >> 3) + 64 * i, c8 = C.tid & 7; const int pos = (n - 1) * 128 + key;
        u32x4 kv = (u32x4){0u, 0u, 0u, 0u}, vv = kv;
        if (pos >= 0) { const size_t row = (size_t)b * SEQ + pos; kv = *(const u32x4*)(KS + row * 128 + kvh * 64 + 8 * c8); vv = *(const u32x4*)(VS + row * 128 + kvh * 64 + 8 * c8); }
        *(LAS u32x4*)(Kl + key * KP + c8 * 16) = kv; *(LAS u32x4*)(Vt + key * VP + c8 * 16) = vv;
    }
    __syncthreads();
    const int fr = C.lane & 15, fq = C.lane >> 4; const int g = C.wave >> 1, qh = C.wave & 1; const int head = kvh * 4 + g;
    const float sink = C.p->in[16][l * 8 + head];
    for (int grp = 0; grp < 4; ++grp) {
        const int i = 64 * qh + 16 * grp + fr; const size_t row = (size_t)b * SEQ + n * 128 + i;
        bf16x8 qf[2];
#pragma unroll
        for (int ks = 0; ks < 2; ++ks) qf[ks] = *(const bf16x8*)(QS + row * 512 + head * 64 + 32 * ks + 8 * fq);
        const int jlo = max(i + 1, n == 0 ? 128 : 0), jhi = i + 128;
        attn16<64, 12, true>(qf, Kl, KP, Vt, VP, 64 * qh, jlo, jhi, 0.125f, sink, MIX + row * 1024 + head * 64, true, fr, fq);
    }
    __syncthreads();
}

DI void swa_decode_unit(const Ctx& C, int l, int unit) {
    unsigned char* ws = C.ws; const CAS Params& P = *C.p;
    const int b = unit >> 1, kvh = unit & 1;
    const bf16_t* QS = (const bf16_t*)(ws + WS_QS); const bf16_t* KS = (const bf16_t*)(ws + WS_KS); const bf16_t* VS = (const bf16_t*)(ws + WS_VS); bf16_t* MIX = (bf16_t*)(ws + WS_MIX);
    constexpr int KP = 144, VP = 144;
    LAS unsigned char* Kl = C.lds; LAS unsigned char* Vt = C.lds + 160 * KP;
    for (int i = C.tid; i < (160 * KP + 160 * VP) / 16; i += 512) *(LAS u32x4*)(C.lds + i * 16) = (u32x4){0u, 0u, 0u, 0u};
    __syncthreads();
    const float* ck = P.in[2] + ((size_t)(l * 128 + b) * 128) * 128 + kvh * 64; const float* cv = P.in[3] + ((size_t)(l * 128 + b) * 128) * 128 + kvh * 64;
    float* ok = C.out + O_KS + ((size_t)(l * 128 + b) * 128) * 128 + kvh * 64; float* ov = C.out + O_VS + ((size_t)(l * 128 + b) * 128) * 128 + kvh * 64;
#pragma unroll
    for (int i = 0; i < 4; ++i) {
        const int key = (C.tid >> 4) + 32 * i, c16 = C.tid & 15;
        const f32x4 kv = *(const f32x4*)(ck + (size_t)key * 128 + 4 * c16), vv = *(const f32x4*)(cv + (size_t)key * 128 + 4 * c16);
        u32x2 w; w.x = pk2(kv[0], kv[1]); w.y = pk2(kv[2], kv[3]); *(LAS u32x2*)(Kl + key * KP + c16 * 8) = w;
        u32x2 wv; wv.x = pk2(vv[0], vv[1]); wv.y = pk2(vv[2], vv[3]); *(LAS u32x2*)(Vt + key * VP + c16 * 8) = wv;
        if (key >= 4) { *(f32x4*)(ok + (size_t)(key - 4) * 128 + 4 * c16) = kv; *(f32x4*)(ov + (size_t)(key - 4) * 128 + 4 * c16) = vv; }
    }
    if (C.tid < 32) {
        const int tt = C.tid >> 3, c8 = C.tid & 7; const size_t row = (size_t)TP + b * 4 + tt;
        const u32x4 kv = *(const u32x4*)(KS + row * 128 + kvh * 64 + 8 * c8), vv = *(const u32x4*)(VS + row * 128 + kvh * 64 + 8 * c8);
        *(LAS u32x4*)(Kl + (128 + tt) * KP + c8 * 16) = kv; *(LAS u32x4*)(Vt + (128 + tt) * VP + c8 * 16) = vv;
    }
    __syncthreads();
    if (C.wave == 0) {
        const int fr = C.lane & 15, fq = C.lane >> 4; const int g = fr >> 2, tt = fr & 3; const int head = kvh * 4 + g; const size_t row = (size_t)TP + b * 4 + tt;
        bf16x8 qf[2];
#pragma unroll
        for (int ks = 0; ks < 2; ++ks) qf[ks] = *(const bf16x8*)(QS + row * 512 + head * 64 + 32 * ks + 8 * fq);
        const float sink = P.in[16][l * 8 + head];
        attn16<64, 10, true>(qf, Kl, KP, Vt, VP, 0, tt + 1, tt + 128, 0.125f, sink, MIX + row * 1024 + head * 64, true, fr, fq);
    }
    __syncthreads();
}

DI void xattn_unit(const Ctx& C, int l, int unit) {
    unsigned char* ws = C.ws; const CAS Params& P = *C.p;
    constexpr int KP = 272, VP = 288;
    LAS unsigned char* Kl = C.lds; LAS unsigned char* Vt = C.lds + 256 * KP;
    const bool prompt = unit < 128;
    int b, h, qb = 0;
    if (prompt) { b = unit >> 5; h = (unit >> 3) & 3; qb = (unit & 7) * 2; } else { const int u = unit - 128; b = u >> 2; h = u & 3; }
    const float* ksrc; const float* vsrc; size_t kpitch;
    if (prompt) { ksrc = (const float*)(ws + WS_MKV) + (size_t)(b * 256) * 2048 + l * 1024 + h * 128; vsrc = ksrc + 512; kpitch = 2048; }
    else { ksrc = P.in[5] + ((size_t)(l * 128 + b) * 256) * 512 + h * 128; vsrc = P.in[6] + ((size_t)(l * 128 + b) * 256) * 512 + h * 128; kpitch = 512; }
    const int c4 = C.tid & 31;
    const f32x4 gk = *(const f32x4*)(P.in[27] + l * 128 + 4 * c4);
    const bool wout = prompt && qb == 0;
    float* omk = C.out + O_MKP + ((size_t)(l * 4 + b) * 256) * 512 + h * 128; float* omv = C.out + O_MVP + ((size_t)(l * 4 + b) * 256) * 512 + h * 128;
#pragma unroll 4
    for (int i = 0; i < 16; ++i) {
        const int key = (C.tid >> 5) + 16 * i;
        f32x4 kv = *(const f32x4*)(ksrc + (size_t)key * kpitch + 4 * c4); const f32x4 vv = *(const f32x4*)(vsrc + (size_t)key * kpitch + 4 * c4);
        if (prompt) {
            float ss = kv[0] * kv[0] + kv[1] * kv[1] + kv[2] * kv[2] + kv[3] * kv[3];
#pragma unroll
            for (int o = 1; o < 32; o <<= 1) ss += __shfl_xor(ss, o);
            const float rq = rsqrtf(ss * (1.f / 128.f) + EPS);
            kv = kv * rq * gk;
            if (wout) { *(f32x4*)(omk + (size_t)key * 512 + 4 * c4) = kv; *(f32x4*)(omv + (size_t)key * 512 + 4 * c4) = vv; }
        }
        u32x2 w; w.x = pk2(kv[0], kv[1]); w.y = pk2(kv[2], kv[3]); *(LAS u32x2*)(Kl + key * KP + c4 * 8) = w;
        u32x2 wv; wv.x = pk2(vv[0], vv[1]); wv.y = pk2(vv[2], vv[3]); *(LAS u32x2*)(Vt + key * VP + c4 * 8) = wv;
    }
    __syncthreads();
    const bf16_t* QX = (const bf16_t*)(ws + WS_QX); bf16_t* OX = (bf16_t*)(ws + WS_OX);
    const int fr = C.lane & 15, fq = C.lane >> 4;
    const int ngrp = prompt ? 4 : (C.wave == 0 ? 1 : 0);
    for (int grp = 0; grp < ngrp; ++grp) {
        const size_t row = prompt ? ((size_t)b * SEQ + (qb + (grp >> 1)) * 256 + 32 * C.wave + 16 * (grp & 1) + fr) : ((size_t)TP + b * 4 + (fr & 3));
        float qv[32]; float ss = 0.f;
#pragma unroll
        for (int ks = 0; ks < 4; ++ks) {
            const u32x4 w = *(const u32x4*)(QX + row * 512 + h * 128 + 32 * ks + 8 * fq);
#pragma unroll
            for (int e = 0; e < 4; ++e) { qv[8 * ks + 2 * e] = blo(w[e]); qv[8 * ks + 2 * e + 1] = bhi(w[e]); }
        }
#pragma unroll
        for (int e = 0; e < 32; ++e) ss += qv[e] * qv[e];
        ss += __shfl_xor(ss, 16); ss += __shfl_xor(ss, 32);
        const float rq = rsqrtf(ss * (1.f / 128.f) + EPS);
        bf16x8 qf[4];
#pragma unroll
        for (int ks = 0; ks < 4; ++ks) {
            const f32x4 g0 = *(const f32x4*)(P.in[26] + l * 128 + 32 * ks + 8 * fq), g1 = *(const f32x4*)(P.in[26] + l * 128 + 32 * ks + 8 * fq + 4);
            u32x4 w; w.x = pk2(qv[8 * ks] * rq * g0[0], qv[8 * ks + 1] * rq * g0[1]); w.y = pk2(qv[8 * ks + 2] * rq * g0[2], qv[8 * ks + 3] * rq * g0[3]);
            w.z = pk2(qv[8 * ks + 4] * rq * g1[0], qv[8 * ks + 5] * rq * g1[1]); w.w = pk2(qv[8 * ks + 6] * rq * g1[2], qv[8 * ks + 7] * rq * g1[3]);
            qf[ks] = __builtin_bit_cast(bf16x8, w);
        }
        attn16<128, 16, false>(qf, Kl, KP, Vt, VP, 0, 0, 255, 0.08838834764831845f, 0.f, OX + row * 512 + h * 128, prompt || fr < 4, fr, fq);
    }
    __syncthreads();
}

DI void gla_a_phase(const Ctx& C, int l) {
    unsigned char* ws = C.ws; const CAS Params& P = *C.p;
    const bf16_t* ZG = (const bf16_t*)(ws + WS_ZG); const float* LR = (const float*)(ws + WS_LR);
    bf16_t* QT = (bf16_t*)(ws + WS_BCUM); bf16_t* KT = QT + (size_t)TP * 256; float* ST = (float*)(ws + WS_ST); bf16_t* VT = (bf16_t*)(ws + WS_VT); float* DEC = (float*)(ws + WS_DEC);
    LAS float* segsum = (LAS float*)C.lds;
    LAS unsigned char* KdT = C.lds + 2048;
    LAS unsigned char* VtL = C.lds + 2048 + 64 * 144;
    const int dk = C.tid & 63, seg = C.wave, tv = C.tid >> 3, dvs = C.tid & 7;
    int unit = C.bx; if (unit >= 1024) return;
    bf16_t kq[16]; u32x4 vw[2];
#define GLA_A_LOAD(u) do { const int bh_ = (u) >> 6, c_ = (u) & 63, b_ = bh_ >> 2, h_ = bh_ & 3; const size_t t0_ = (size_t)b_ * SEQ + c_ * 64; \
        _Pragma("unroll") for (int i = 0; i < 8; ++i) { kq[i] = ZG[(t0_ + 8 * seg + i) * 1536 + 256 + h_ * 64 + dk]; kq[8 + i] = ZG[(t0_ + 8 * seg + i) * 1536 + h_ * 64 + dk]; } \
        _Pragma("unroll") for (int x = 0; x < 2; ++x) vw[x] = *(const u32x4*)(ZG + (t0_ + tv) * 1536 + 512 + h_ * 128 + 16 * dvs + 8 * x); } while (0)
    GLA_A_LOAD(unit);
    int hcur = -1; float wg[16]; float bg = 0.f;
    for (; unit < 1024; unit += C.G) {
        const int bh = unit >> 6, c = unit & 63, b = bh >> 2, h = bh & 3; const size_t t0 = (size_t)b * SEQ + c * 64;
        if (h != hcur) { hcur = h;
#pragma unroll
            for (int r = 0; r < 16; ++r) wg[r] = P.in[17][(size_t)(l * 16 + r) * 256 + h * 64 + dk];
            bg = P.in[18][l * 256 + h * 64 + dk]; }
        float p[8];
        {
            float run = 0.f;
#pragma unroll
            for (int i = 0; i < 8; ++i) {
                const float* lr = LR + (t0 + 8 * seg + i) * 16; float x = bg;
#pragma unroll
                for (int r = 0; r < 16; ++r) x += lr[r] * wg[r];
                run += logsig(x) * (1.f / 16.f); p[i] = run;
            }
            segsum[seg * 64 + dk] = run;
        }
#pragma unroll
        for (int x = 0; x < 2; ++x) *(LAS u32x4*)(VtL + tv * 288 + (16 * dvs + 8 * x) * 2) = vw[x];
        __syncthreads();
        {
            float off = 0.f, tot = 0.f;
#pragma unroll
            for (int s2 = 0; s2 < 8; ++s2) { const float v = segsum[s2 * 64 + dk]; tot += v; if (s2 < seg) off += v; }
#pragma unroll
            for (int i = 0; i < 8; ++i) {
                const int t = 8 * seg + i; const float bv = off + p[i];
                const float kraw = bf2f(kq[i]), qraw = bf2f(kq[8 + i]);
                const float kd = kraw * __expf(tot - bv);
                const unsigned qk = pk2(qraw * 0.125f * __expf(bv), kraw * __expf(-bv));
                QT[(t0 + t) * 256 + h * 64 + dk] = (bf16_t)(qk & 0xffffu); KT[(t0 + t) * 256 + h * 64 + dk] = (bf16_t)(qk >> 16);
                *(LAS unsigned short*)(KdT + t * 144 + dk * 2) = (unsigned short)(pk2(kd, 0.f) & 0xffffu);
            }
            if (seg == 0) DEC[unit * 64 + dk] = __expf(tot);
        }
        if (unit + C.G < 1024) GLA_A_LOAD(unit + C.G);
        __syncthreads();
        {
            const int fr = C.lane & 15, fq = C.lane >> 4, w = C.wave;
            bf16x8 vt[2];
#pragma unroll
            for (int ks = 0; ks < 2; ++ks) {
                const LAS unsigned char* vp = VtL + (32 * ks + 8 * fq + (fr >> 2)) * 288 + 32 * w + 8 * (fr & 3);
                const u32x2 lo = __builtin_bit_cast(u32x2, __builtin_amdgcn_ds_read_tr16_b64_v4i16((LAS v4i16_t*)vp));
                const u32x2 hi = __builtin_bit_cast(u32x2, __builtin_amdgcn_ds_read_tr16_b64_v4i16((LAS v4i16_t*)(vp + 4 * 288)));
                vt[ks] = __builtin_bit_cast(bf16x8, (u32x4){lo.x, lo.y, hi.x, hi.y});
            }
#pragma unroll
            for (int dkt = 0; dkt < 4; ++dkt) {
                f32x4 acc = (f32x4){0.f, 0.f, 0.f, 0.f};
#pragma unroll
                for (int ks = 0; ks < 2; ++ks) {
                    const LAS unsigned char* kp = KdT + (32 * ks + 8 * fq + (fr >> 2)) * 144 + 32 * dkt + 8 * (fr & 3);
                    const u32x2 lo = __builtin_bit_cast(u32x2, __builtin_amdgcn_ds_read_tr16_b64_v4i16((LAS v4i16_t*)kp));
                    const u32x2 hi = __builtin_bit_cast(u32x2, __builtin_amdgcn_ds_read_tr16_b64_v4i16((LAS v4i16_t*)(kp + 4 * 144)));
                    const bf16x8 kd = __builtin_bit_cast(bf16x8, (u32x4){lo.x, lo.y, hi.x, hi.y});
                    acc = MFMA16(kd, vt[ks], acc);
                }
                *(f32x4*)(ST + ((size_t)unit * 128 + 16 * w + fr) * 64 + 16 * dkt + 4 * fq) = acc;
            }
        }
        __syncthreads();
    }
#undef GLA_A_LOAD
}

DI void gla_scan(const Ctx& C, int l) {
    unsigned char* ws = C.ws;
    const float* ST = (const float*)(ws + WS_ST); const float* DEC = (const float*)(ws + WS_DEC); bf16_t* STB = (bf16_t*)(ws + WS_STB);
    for (int e = C.bx * 512 + C.tid; e < 16 * 8192; e += C.G * 512) {
        const int bh = e >> 13, idx = e & 8191, dk = idx & 63, dv = idx >> 6;
        float S = 0.f;
        for (int c0 = 0; c0 < 64; c0 += 8) {
            float d[8], dc[8];
#pragma unroll
            for (int i = 0; i < 8; ++i) { const int unit = bh * 64 + c0 + i; d[i] = ST[(size_t)unit * 8192 + idx]; dc[i] = DEC[unit * 64 + dk]; }
#pragma unroll
            for (int i = 0; i < 8; ++i) { const int unit = bh * 64 + c0 + i; STB[(size_t)unit * 8192 + idx] = (bf16_t)(pk2(S, 0.f) & 0xffffu); S = dc[i] * S + d[i]; }
        }
        C.out[O_GP + ((size_t)(l * 16 + bh)) * 8192 + dk * 128 + dv] = S;
    }
}

DI void gla_c_wave(const Ctx& C, int l, int unit, int qt) {
    unsigned char* ws = C.ws; const CAS Params& P = *C.p;
    const int bh = unit >> 6, c = unit & 63, b = bh >> 2, h = bh & 3; const size_t t0 = (size_t)b * SEQ + c * 64;
    const bf16_t* ZG = (const bf16_t*)(ws + WS_ZG); const bf16_t* QT = (const bf16_t*)(ws + WS_BCUM); const bf16_t* KT = QT + (size_t)TP * 256; const bf16_t* STB = (const bf16_t*)(ws + WS_STB); const bf16_t* VT = (const bf16_t*)(ws + WS_VT);
    bf16_t* MIX = (bf16_t*)(ws + WS_MIX);
    const int fr = C.lane & 15, fq = C.lane >> 4;
    const size_t rq = t0 + 16 * qt + fr;
    bf16x8 qf[2];
#pragma unroll
    for (int ks = 0; ks < 2; ++ks) qf[ks] = *(const bf16x8*)(QT + rq * 256 + h * 64 + 32 * ks + 8 * fq);
    f32x4 a[4];
#pragma unroll
    for (int kt = 0; kt < 4; ++kt) {
        a[kt] = (f32x4){0.f, 0.f, 0.f, 0.f};
        if (kt <= qt) {
            const size_t rk = t0 + 16 * kt + fr;
#pragma unroll
            for (int ks = 0; ks < 2; ++ks) {
                const bf16x8 kf = *(const bf16x8*)(KT + rk * 256 + h * 64 + 32 * ks + 8 * fq);
                a[kt] = MFMA16(kf, qf[ks], a[kt]);
            }
#pragma unroll
            for (int r = 0; r < 4; ++r) if (16 * kt + 4 * fq + r > 16 * qt + fr) a[kt][r] = 0.f;
        }
    }
    bf16x8 pf[2];
#pragma unroll
    for (int kk = 0; kk < 2; ++kk) { u32x4 w; w.x = pk2(a[2 * kk][0], a[2 * kk][1]); w.y = pk2(a[2 * kk][2], a[2 * kk][3]); w.z = pk2(a[2 * kk + 1][0], a[2 * kk + 1][1]); w.w = pk2(a[2 * kk + 1][2], a[2 * kk + 1][3]); pf[kk] = __builtin_bit_cast(bf16x8, w); }
    f32x4 o[8]; float ss = 0.f;
#pragma unroll
    for (int dt = 0; dt < 8; ++dt) {
        f32x4 acc = (f32x4){0.f, 0.f, 0.f, 0.f};
        const size_t vrow = ((size_t)unit * 128 + 16 * dt + fr) * 64;
#pragma unroll
        for (int kk = 0; kk < 2; ++kk) {
            if (2 * kk <= qt) {
                const bf16_t* vp = VT + vrow + 32 * kk + 4 * fq; const u32x2 lo = *(const u32x2*)vp, hi = *(const u32x2*)(vp + 16);
                acc = MFMA16(__builtin_bit_cast(bf16x8, (u32x4){lo.x, lo.y, hi.x, hi.y}), pf[kk], acc);
            }
        }
#pragma unroll
        for (int ks = 0; ks < 2; ++ks) {
            const bf16x8 sf = *(const bf16x8*)(STB + vrow + 32 * ks + 8 * fq);
            acc = MFMA16(sf, qf[ks], acc);
        }
        o[dt] = acc; ss += acc[0] * acc[0] + acc[1] * acc[1] + acc[2] * acc[2] + acc[3] * acc[3];
    }
    ss += __shfl_xor(ss, 16); ss += __shfl_xor(ss, 32);
    const float rn = rsqrtf(ss * (1.f / 128.f) + EPS);
#pragma unroll
    for (int dt = 0; dt < 8; ++dt) {
        const f32x4 gn = *(const f32x4*)(P.in[19] + l * 128 + 16 * dt + 4 * fq);
        const u32x2 gw = *(const u32x2*)(ZG + rq * 1536 + 1024 + h * 128 + 16 * dt + 4 * fq);
        const float g0 = blo(gw.x), g1 = bhi(gw.x), g2 = blo(gw.y), g3 = bhi(gw.y);
        u32x2 w; w.x = pk2(o[dt][0] * rn * gn[0] * silu(g0), o[dt][1] * rn * gn[1] * silu(g1)); w.y = pk2(o[dt][2] * rn * gn[2] * silu(g2), o[dt][3] * rn * gn[3] * silu(g3));
        *(u32x2*)(MIX + rq * 1024 + 512 + h * 128 + 16 * dt + 4 * fq) = w;
    }
}

DI void gla_c_phase(const Ctx& C, int l) {
    unsigned char* ws = C.ws; const CAS Params& P = *C.p;
    const bf16_t* ZG = (const bf16_t*)(ws + WS_ZG); const bf16_t* QT = (const bf16_t*)(ws + WS_BCUM); const bf16_t* KT = QT + (size_t)TP * 256; const bf16_t* STB = (const bf16_t*)(ws + WS_STB); const bf16_t* VT = (const bf16_t*)(ws + WS_VT);
    bf16_t* MIX = (bf16_t*)(ws + WS_MIX);
    constexpr int PB = 144, U_BYTES = (64 + 128 + 128) * PB;
    const int fr = C.lane & 15, fq = C.lane >> 4, us = C.wave >> 2, qt = C.wave & 3;
    for (int pr = C.bx; pr < 512; pr += C.G) {
#pragma unroll
        for (int uu = 0; uu < 2; ++uu) {
            const int unit = 2 * pr + uu; const int bh = unit >> 6, c = unit & 63, b = bh >> 2, h = bh & 3; const size_t t0 = (size_t)b * SEQ + c * 64;
            LAS unsigned char* base = C.lds + uu * U_BYTES;
            { const int row = C.tid >> 3, c8 = C.tid & 7; *(LAS u32x4*)(base + row * PB + c8 * 16) = *(const u32x4*)(KT + (t0 + row) * 256 + h * 64 + 8 * c8); }
#pragma unroll
            for (int i = 0; i < 2; ++i) {
                const int row = (C.tid >> 3) + 64 * i, c8 = C.tid & 7;
                *(LAS u32x4*)(base + (64 + row) * PB + c8 * 16) = *(const u32x4*)(STB + ((size_t)unit * 128 + row) * 64 + 8 * c8);
                const int vr = (C.tid >> 4) + 32 * i, c16 = C.tid & 15;
                *(LAS u32x4*)(base + 192 * PB + vr * 288 + c16 * 16) = *(const u32x4*)(ZG + (t0 + vr) * 1536 + 512 + h * 128 + 8 * c16);
            }
        }
        const int unit = 2 * pr + us; const int bh = unit >> 6, c = unit & 63, b = bh >> 2, h = bh & 3; const size_t t0 = (size_t)b * SEQ + c * 64;
        const size_t rq = t0 + 16 * qt + fr;
        bf16x8 qf[2];
#pragma unroll
        for (int ks = 0; ks < 2; ++ks) qf[ks] = *(const bf16x8*)(QT + rq * 256 + h * 64 + 32 * ks + 8 * fq);
        __syncthreads();
        LAS unsigned char* Kl = C.lds + us * U_BYTES; LAS unsigned char* Sl = Kl + 64 * PB; LAS unsigned char* Vl = Kl + 192 * PB;
        f32x4 a[4];
#pragma unroll
        for (int kt = 0; kt < 4; ++kt) {
            a[kt] = (f32x4){0.f, 0.f, 0.f, 0.f};
            if (kt <= qt) {
#pragma unroll
                for (int ks = 0; ks < 2; ++ks) {
                    const bf16x8 kf = *(const LAS bf16x8*)(Kl + (16 * kt + fr) * PB + (32 * ks + 8 * fq) * 2);
                    a[kt] = MFMA16(kf, qf[ks], a[kt]);
                }
#pragma unroll
                for (int r = 0; r < 4; ++r) if (16 * kt + 4 * fq + r > 16 * qt + fr) a[kt][r] = 0.f;
            }
        }
        bf16x8 pf[2];
#pragma unroll
        for (int kk = 0; kk < 2; ++kk) { u32x4 w; w.x = pk2(a[2 * kk][0], a[2 * kk][1]); w.y = pk2(a[2 * kk][2], a[2 * kk][3]); w.z = pk2(a[2 * kk + 1][0], a[2 * kk + 1][1]); w.w = pk2(a[2 * kk + 1][2], a[2 * kk + 1][3]); pf[kk] = __builtin_bit_cast(bf16x8, w); }
        f32x4 o[8]; float ss = 0.f;
#pragma unroll
        for (int dt = 0; dt < 8; ++dt) {
            f32x4 acc = (f32x4){0.f, 0.f, 0.f, 0.f};
#pragma unroll
            for (int kk = 0; kk < 2; ++kk) {
                if (2 * kk <= qt) {
                    const LAS unsigned char* vp = Vl + (32 * kk + 4 * fq + (fr >> 2)) * 288 + 32 * dt + 8 * (fr & 3);
                    const u32x2 lo = __builtin_bit_cast(u32x2, __builtin_amdgcn_ds_read_tr16_b64_v4i16((LAS v4i16_t*)vp));
                    const u32x2 hi = __builtin_bit_cast(u32x2, __builtin_amdgcn_ds_read_tr16_b64_v4i16((LAS v4i16_t*)(vp + 16 * 288)));
                    acc = MFMA16(__builtin_bit_cast(bf16x8, (u32x4){lo.x, lo.y, hi.x, hi.y}), pf[kk], acc);
                }
            }
#pragma unroll
            for (int ks = 0; ks < 2; ++ks) {
                const bf16x8 sf = *(const LAS bf16x8*)(Sl + (16 * dt + fr) * PB + (32 * ks + 8 * fq) * 2);
                acc = MFMA16(sf, qf[ks], acc);
            }
            o[dt] = acc; ss += acc[0] * acc[0] + acc[1] * acc[1] + acc[2] * acc[2] + acc[3] * acc[3];
        }
        ss += __shfl_xor(ss, 16); ss += __shfl_xor(ss, 32);
        const float rn = rsqrtf(ss * (1.f / 128.f) + EPS);
#pragma unroll
        for (int dt = 0; dt < 8; ++dt) {
            const f32x4 gn = *(const f32x4*)(P.in[19] + l * 128 + 16 * dt + 4 * fq);
            const u32x2 gw = *(const u32x2*)(ZG + rq * 1536 + 1024 + h * 128 + 16 * dt + 4 * fq);
            const float g0 = blo(gw.x), g1 = bhi(gw.x), g2 = blo(gw.y), g3 = bhi(gw.y);
            u32x2 w; w.x = pk2(o[dt][0] * rn * gn[0] * silu(g0), o[dt][1] * rn * gn[1] * silu(g1)); w.y = pk2(o[dt][2] * rn * gn[2] * silu(g2), o[dt][3] * rn * gn[3] * silu(g3));
            *(u32x2*)(MIX + rq * 1024 + 512 + h * 128 + 16 * dt + 4 * fq) = w;
        }
        __syncthreads();
    }
}

DI void gla_decode_unit(const Ctx& C, int l, int unit) {
    unsigned char* ws = C.ws; const CAS Params& P = *C.p;
    const int b = unit >> 2, h = unit & 3; const size_t rb = (size_t)TP + b * 4;
    const bf16_t* ZG = (const bf16_t*)(ws + WS_ZG); const float* LR = (const float*)(ws + WS_LR); bf16_t* MIX = (bf16_t*)(ws + WS_MIX);
    LAS float* la = (LAS float*)C.lds;
    LAS float* qr = la + 256;
    LAS float* kr = qr + 256;
    LAS float* qe = kr + 256;
    LAS float* ke = qe + 256;
    LAS float* Am = ke + 256;
    LAS float* red = Am + 16;
    LAS float* opart = red + 8;
    if (C.tid < 256) {
        const int tt = C.tid >> 6, dk = C.tid & 63; float x = P.in[18][l * 256 + h * 64 + dk];
        const f32x4 l0 = *(const f32x4*)(LR + (rb + tt) * 16), l1 = *(const f32x4*)(LR + (rb + tt) * 16 + 4), l2 = *(const f32x4*)(LR + (rb + tt) * 16 + 8), l3 = *(const f32x4*)(LR + (rb + tt) * 16 + 12);
        const float* wg = P.in[17] + (size_t)(l * 16) * 256 + h * 64 + dk;
#pragma unroll
        for (int r = 0; r < 4; ++r) { x += l0[r] * wg[r * 256] + l1[r] * wg[(4 + r) * 256] + l2[r] * wg[(8 + r) * 256] + l3[r] * wg[(12 + r) * 256]; }
        la[tt * 64 + dk] = logsig(x) * (1.f / 16.f);
        qr[tt * 64 + dk] = bf2f(ZG[(rb + tt) * 1536 + h * 64 + dk]); kr[tt * 64 + dk] = bf2f(ZG[(rb + tt) * 1536 + 256 + h * 64 + dk]);
    }
    __syncthreads();
    if (C.tid < 64) { float run = 0.f;
#pragma unroll
        for (int tt = 0; tt < 4; ++tt) { run += la[tt * 64 + C.tid]; la[tt * 64 + C.tid] = run; } }
    __syncthreads();
    if (C.tid < 256) {
        const int tt = C.tid >> 6, dk = C.tid & 63; const float bt = la[tt * 64 + dk], b3 = la[3 * 64 + dk];
        qe[tt * 64 + dk] = 0.125f * qr[tt * 64 + dk] * __expf(bt); ke[tt * 64 + dk] = kr[tt * 64 + dk] * __expf(b3 - bt);
    } else if (C.tid < 272) {
        const int tt = (C.tid - 256) >> 2, s = (C.tid - 256) & 3; float sum = 0.f;
        if (s <= tt) for (int dk = 0; dk < 64; ++dk) sum += 0.125f * qr[tt * 64 + dk] * kr[s * 64 + dk] * __expf(la[tt * 64 + dk] - la[s * 64 + dk]);
        Am[C.tid - 256] = sum;
    }
    __syncthreads();
    {
        const int dv = C.tid & 127, dq = C.tid >> 7;
        float v[4], o[4] = {0.f, 0.f, 0.f, 0.f};
#pragma unroll
        for (int tt = 0; tt < 4; ++tt) v[tt] = bf2f(ZG[(rb + tt) * 1536 + 512 + h * 128 + dv]);
        const float* S0p = P.in[4] + ((size_t)(l * 128 + b) * 4 + h) * 8192 + (size_t)(16 * dq) * 128 + dv; float* Sn = C.out + O_GS + ((size_t)(l * 128 + b) * 4 + h) * 8192 + (size_t)(16 * dq) * 128 + dv;
        float S0[16];
#pragma unroll
        for (int i = 0; i < 16; ++i) S0[i] = S0p[i * 128];
#pragma unroll
        for (int i = 0; i < 16; ++i) {
            const int dk = 16 * dq + i;
            float sn = __expf(la[3 * 64 + dk]) * S0[i];
#pragma unroll
            for (int tt = 0; tt < 4; ++tt) { o[tt] += qe[tt * 64 + dk] * S0[i]; sn += ke[tt * 64 + dk] * v[tt]; }
            Sn[i * 128] = sn;
        }
#pragma unroll
        for (int tt = 0; tt < 4; ++tt) opart[(dq * 4 + tt) * 128 + dv] = o[tt];
    }
    __syncthreads();
    {
        const int tt = C.tid >> 7, dv = C.tid & 127;
        float o = opart[(0 * 4 + tt) * 128 + dv] + opart[(1 * 4 + tt) * 128 + dv] + opart[(2 * 4 + tt) * 128 + dv] + opart[(3 * 4 + tt) * 128 + dv];
        for (int s = 0; s <= tt; ++s) o += Am[tt * 4 + s] * bf2f(ZG[(rb + s) * 1536 + 512 + h * 128 + dv]);
        float ss = o * o;
#pragma unroll
        for (int of = 1; of < 64; of <<= 1) ss += __shfl_xor(ss, of);
        if (C.lane == 0) red[C.wave] = ss;
        __syncthreads();
        const float tot = red[2 * tt] + red[2 * tt + 1];
        const float rn = rsqrtf(tot * (1.f / 128.f) + EPS);
        const float gg = bf2f(ZG[(rb + tt) * 1536 + 1024 + h * 128 + dv]);
        const float val = o * rn * P.in[19][l * 128 + dv] * silu(gg);
        MIX[(rb + tt) * 1024 + 512 + h * 128 + dv] = (bf16_t)(pk2(val, 0.f) & 0xffffu);
    }
    __syncthreads();
}

__global__ void __launch_bounds__(512, 2) hymba_fwd(Params prm) {
    extern __shared__ __attribute__((aligned(16))) unsigned char smem[];
    cg::grid_group grid = cg::this_grid();
    Ctx C; C.lds = (LAS unsigned char*)smem; C.tid = threadIdx.x; C.lane = C.tid & 63; C.wave = __builtin_amdgcn_readfirstlane(C.tid >> 6);
    C.G = gridDim.x; C.bx = blockIdx.x; C.p = (const CAS Params*)__builtin_amdgcn_kernarg_segment_ptr(); C.ws = C.p->ws; C.out = C.p->out;
    (void)prm;

    unsigned* barw = (unsigned*)(C.ws + WS_BAR);
    if (C.bx == 0) for (int i = C.tid; i < XCD_BAR_WORDS; i += 512) barw[i] = 0u;
    if (C.tid < 4) ((LAS unsigned*)(C.lds + LDS_BYTES - 16))[C.tid] = 0u;
    grid.sync();
    XcdBarrier xbar = xcd_barrier_post(barw, (volatile LAS unsigned*)(C.lds + LDS_BYTES - 16));
    for (int rep = 0; rep < REP_P0; ++rep) p0_prologue(C);
    xcd_barrier(xbar);
    {   unsigned char* ws = C.ws;
        pg8::Gemm g{(const bf16_t*)(ws + WS_MEMB), (const bf16_t*)(ws + WS_WKV), 1024, 2048, 1024};
        const int n1 = (T / 256) * (5632 / 256);
        pg8::StaticOrder S; S.init(1024, 2048, C.G, (C.bx + C.G - (n1 % C.G)) % C.G);
        Epi<EK_MEM> E; E.c = EpiCtx{}; E.c.rss_in = (const float*)(ws + WS_RSSM); E.c.MKV = (float*)(ws + WS_MKV);
        pg8::gemm_phase(C.lds, C.tid, g, S, E);
    }
    int rep = 0;
    for (int ph = 0; ph < 24; ++ph) {
        { int t_ = threadIdx.x; asm volatile("" : "+v"(t_)); C.tid = t_; C.lane = t_ & 63; C.wave = __builtin_amdgcn_readfirstlane(t_ >> 6); }
        asm volatile("" : "+s"(C.ws), "+s"(C.out), "+s"(C.p));
        unsigned char* ws = C.ws; float* RSS = (float*)(ws + WS_RSS);
        const int l = ph / 12, k = ph - 12 * l;
        unsigned char* wl = ws + WS_WL + (size_t)l * WL_SIZE;
        EpiCtx ec{}; ec.l = l;
        if (k == 0 || k == 10) {
            pg8::Gemm g{(const bf16_t*)(ws + WS_XB), (const bf16_t*)(wl + (k == 0 ? WL_W1 : WL_W2)), T, 5632, 1024};
            pg8::StaticOrder S; S.init(T, 5632, C.G, C.bx);
            ec.rss_in = RSS + (size_t)(4 * l + (k == 0 ? 0 : 3)) * T; ec.H = (bf16_t*)(ws + WS_H);
            Epi<EK_SWIGLU> E; E.c = ec; pg8::gemm_phase(C.lds, C.tid, g, S, E);
            if (ph == 0 && rep == 0) convert_in_slack(C, 0, T_WD1, 688, (T / 256) * 22 + 32);
            if (ph == 10 && rep == 0) convert_in_slack(C, 1, 704, T_WKV, (T / 256) * 22);
        } else if (k == 1 || k == 6 || k == 9 || k == 11) {
            const bf16_t* A; const bf16_t* B; int K; float sc; int ro;
            if (k == 1) { A = (const bf16_t*)(ws + WS_H); B = (const bf16_t*)(wl + WL_WD1); K = FF; sc = 0.5f; ro = 4 * l + 1; }
            else if (k == 6) { A = (const bf16_t*)(ws + WS_MIX); B = (const bf16_t*)(wl + WL_WOUT); K = 1024; sc = 1.f; ro = 4 * l + 2; }
            else if (k == 9) { A = (const bf16_t*)(ws + WS_OX); B = (const bf16_t*)(wl + WL_WO); K = 512; sc = 1.f; ro = 4 * l + 3; }
            else { A = (const bf16_t*)(ws + WS_H); B = (const bf16_t*)(wl + WL_WD2); K = FF; sc = 0.5f; ro = 4 * l + 4; }
            pg8::Gemm g{A, B, TP, 1024, K};
            pg8::StaticOrder S; S.init(TP, 1024, C.G, C.bx);
            ec.rss_out = RSS + (size_t)ro * T; ec.X = (ph == 23) ? C.out : nullptr; ec.XB = (bf16_t*)(ws + WS_XB); ec.scale = sc;
            Epi<EK_RES> E; E.c = ec; pg8::gemm_phase(C.lds, C.tid, g, S, E);
            thin_res_gemm(C, A, B, K, sc, RSS + (size_t)ro * T, (ph == 23) ? C.out : nullptr);
        } else if (k == 2) {
            pg8::Gemm g{(const bf16_t*)(ws + WS_XB), (const bf16_t*)(wl + WL_WIN), T, INWP, 1024};
            pg8::StaticOrder S; S.init(T, INWP, C.G, C.bx);
            ec.rss_in = RSS + (size_t)(4 * l + 1) * T; ec.QS = (bf16_t*)(ws + WS_QS); ec.KS = (bf16_t*)(ws + WS_KS); ec.VS = (bf16_t*)(ws + WS_VS); ec.ZG = (bf16_t*)(ws + WS_ZG);
            ec.LR = (float*)(ws + WS_LR); ec.rope = (const float2*)(ws + WS_ROPE); ec.gq = C.p->in[14] + l * 64; ec.gk = C.p->in[15] + l * 64;
            ec.okp = C.out + O_KP; ec.ovp = C.out + O_VP; ec.oks = C.out + O_KS; ec.ovs = C.out + O_VS;
            Epi<EK_WIN> E; E.c = ec; pg8::gemm_phase(C.lds, C.tid, g, S, E);
            if (ph == 2 && rep == 0) convert_in_slack(C, 0, 688, T_WKV, (T / 256) * 10);
        } else if (k == 3) {
            for (int u = C.bx; u < 256; u += C.G) swa_prompt_unit(C, l, u);
            gla_a_phase(C, l);
        } else if (k == 4) {
            gla_scan(C, l);
            for (int u = C.bx; u < 512; u += C.G) gla_decode_unit(C, l, u);
            for (int u = C.bx; u < 256; u += C.G) swa_decode_unit(C, l, u);
        } else if (k == 5) {
            gla_c_phase(C, l);
        } else if (k == 7) {
            pg8::Gemm g{(const bf16_t*)(ws + WS_XB), (const bf16_t*)(wl + WL_WQ), T, 512, 1024};
            pg8::StaticOrder S; S.init(T, 512, C.G, C.bx);
            ec.rss_in = RSS + (size_t)(4 * l + 2) * T; ec.QX = (bf16_t*)(ws + WS_QX);
            Epi<EK_XQ> E; E.c = ec; pg8::gemm_phase(C.lds, C.tid, g, S, E);
            if (ph == 7 && rep == 0) convert_in_slack(C, 1, 0, 704, (T / 256) * 2);
        } else {
            if (C.G == 256) {
                if (C.bx < 128) { xattn_unit(C, l, C.bx); xattn_unit(C, l, 128 + C.bx); }
                else for (int i = 0; i < 3; ++i) xattn_unit(C, l, 128 + 128 + 3 * (C.bx - 128) + i);
            } else for (int u = C.bx; u < 640; u += C.G) xattn_unit(C, l, u);
        }
        if (ph != 23) for (int r2 = 0; r2 < REP_SYNC; ++r2) xcd_barrier(xbar);
        {
            const int want = (k == 0 || k == 2 || k == 7 || k == 10) ? REP_GEMM : (k == 3 ? REP3 : (k == 4 ? REP4 : k == 5 ? REP5 : (k == 8 ? REP8 : 1)));
            if (rep + 1 < want) { ++rep; --ph; } else rep = 0;
        }
    }
}

extern "C" void kernel_launch(void* const* d_in, const int* in_sizes, int n_in, void* d_out, int out_size, void* d_ws, size_t ws_size, hipStream_t stream) {
    static int grid = 0;
    if (grid == 0) {
        if (n_in != 33 || ws_size < WS_TOTAL) { fprintf(stderr, "kernel_launch: need 33 inputs and %zu bytes of workspace; got %d inputs, %zu bytes\n", (size_t)WS_TOTAL, n_in, ws_size); grid = -1; return; }
        int dev = 0, cus = 0, per_cu = 0;
        (void)hipGetDevice(&dev); (void)hipDeviceGetAttribute(&cus, hipDeviceAttributeMultiprocessorCount, dev);
        if (hipFuncSetAttribute((const void*)hymba_fwd, hipFuncAttributeMaxDynamicSharedMemorySize, LDS_BYTES) != hipSuccess) { fprintf(stderr, "kernel_launch: hipFuncSetAttribute failed\n"); grid = -1; return; }
        if (hipOccupancyMaxActiveBlocksPerMultiprocessor(&per_cu, (const void*)hymba_fwd, 512, LDS_BYTES) != hipSuccess || per_cu < 1) { fprintf(stderr, "kernel_launch: occupancy query gave %d\n", per_cu); grid = -1; return; }
        grid = cus * per_cu;
    }
    if (grid < 0) return;
    Params p{};
    for (int i = 0; i < 33; ++i) p.in[i] = (const float*)d_in[i];
    p.out = (float*)d_out; p.ws = (unsigned char*)d_ws;
    void* args[] = {&p};
    hipError_t e = hipLaunchCooperativeKernel((const void*)hymba_fwd, dim3(grid), dim3(512), args, LDS_BYTES, stream);
    if (e != hipSuccess) fprintf(stderr, "kernel_launch: cooperative launch failed: %s (grid %d)\n", hipGetErrorString(e), grid);
}
```

```cpp
#include <hip/hip_runtime.h>
#include <hip/hip_cooperative_groups.h>
#include <cstdio>
#include <cstdint>
namespace cg = cooperative_groups;

#define LAS __attribute__((address_space(3)))
#define DI __device__ __forceinline__
typedef unsigned short bf16_t;
typedef short bf16x8 __attribute__((ext_vector_type(8)));
typedef float f32x4 __attribute__((ext_vector_type(4)));
typedef unsigned u32x4 __attribute__((ext_vector_type(4)));
typedef unsigned u32x2 __attribute__((ext_vector_type(2)));
typedef short v4i16_t __attribute__((ext_vector_type(4)));
#define MFMA16(a, b, c) __builtin_amdgcn_mfma_f32_16x16x32_bf16((a), (b), (c), 0, 0, 0)

constexpr int TP = 16384, TS = 512, T = TP + TS, DM = 1024, FF = 2816, SEQ = 4096;
constexpr int INWP = 2560;
constexpr float EPS = 1e-6f;
constexpr size_t O_Y = 0, O_KP = 17301504, O_VP = 17432576, O_GP = 17563648, O_MKP = 17825792, O_MVP = 18874368, O_KS = 19922944, O_VS = 24117248, O_GS = 28311552;
constexpr size_t al(size_t x) { return (x + 4095) & ~(size_t)4095; }
constexpr size_t WS_RSS = 0;
constexpr size_t WS_RSSM = al(WS_RSS + (size_t)9 * T * 4);
constexpr size_t WS_ROPE = al(WS_RSSM + 1024 * 4);
constexpr size_t WS_XB = al(WS_ROPE + (size_t)4100 * 32 * 8);
constexpr size_t WS_H = al(WS_XB + (size_t)T * 1024 * 2);
constexpr size_t WS_QS = al(WS_H + (size_t)T * FF * 2);
constexpr size_t WS_KS = al(WS_QS + (size_t)T * 512 * 2);
constexpr size_t WS_VS = al(WS_KS + (size_t)T * 128 * 2);
constexpr size_t WS_ZG = al(WS_VS + (size_t)T * 128 * 2);
constexpr size_t WS_LR = al(WS_ZG + (size_t)T * 1536 * 2);
constexpr size_t WS_MIX = al(WS_LR + (size_t)T * 16 * 4);
constexpr size_t WS_QX = al(WS_MIX + (size_t)T * 1024 * 2);
constexpr size_t WS_OX = al(WS_QX + (size_t)T * 512 * 2);
constexpr size_t WS_MEMB = al(WS_OX + (size_t)T * 512 * 2);
constexpr size_t WS_MKV = al(WS_MEMB + (size_t)1024 * 1024 * 2);
constexpr size_t WS_BCUM = al(WS_MKV + (size_t)1024 * 2048 * 4);
constexpr size_t WS_ST = al(WS_BCUM + (size_t)TP * 256 * 4);
constexpr size_t WS_VT = al(WS_ST + (size_t)1024 * 8192 * 4);
constexpr size_t WS_DEC = al(WS_VT + (size_t)1024 * 8192 * 2);
constexpr size_t WS_WKV = al(WS_DEC + (size_t)1024 * 64 * 4);
constexpr size_t WS_WL = al(WS_WKV + (size_t)2048 * 1024 * 2);
constexpr size_t WL_W1 = 0;
constexpr size_t WL_WD1 = WL_W1 + (size_t)5632 * 1024 * 2;
constexpr size_t WL_WIN = WL_WD1 + (size_t)1024 * FF * 2;
constexpr size_t WL_WOUT = WL_WIN + (size_t)INWP * 1024 * 2;
constexpr size_t WL_WQ = WL_WOUT + (size_t)1024 * 1024 * 2;
constexpr size_t WL_WO = WL_WQ + (size_t)512 * 1024 * 2;
constexpr size_t WL_W2 = WL_WO + (size_t)1024 * 512 * 2;
constexpr size_t WL_WD2 = WL_W2 + (size_t)5632 * 1024 * 2;
constexpr size_t WL_SIZE = al(WL_WD2 + (size_t)1024 * FF * 2);
constexpr size_t WS_STB = WS_WL + 2 * WL_SIZE;
constexpr size_t WS_BAR = al(WS_STB + (size_t)1024 * 8192 * 2);
constexpr size_t WS_TOTAL = WS_BAR + 16384;
constexpr int LDS_BYTES = 147456;
constexpr int REP_GEMM = 1, REP_ATT = 1, REP_P0 = 1, REP_SYNC = 1, REP3 = 1, REP4 = 1, REP5 = 1, REP8 = 1;

DI float bf2f(unsigned h) { return __builtin_bit_cast(float, h << 16); }
typedef float f32x2_t __attribute__((ext_vector_type(2)));
typedef __bf16 bf16x2_t __attribute__((ext_vector_type(2)));
DI unsigned pk2(float lo, float hi) { const f32x2_t v = {lo, hi}; const bf16x2_t b = __builtin_convertvector(v, bf16x2_t); return __builtin_bit_cast(unsigned, b); }
DI float blo(unsigned w) { return __builtin_bit_cast(float, w << 16); }
DI float bhi(unsigned w) { return __builtin_bit_cast(float, w & 0xffff0000u); }
DI float silu(float x) { return x * __builtin_amdgcn_rcpf(1.f + __builtin_amdgcn_exp2f(x * -1.4426950408889634f)); }
DI float logsig(float x) { return fminf(x, 0.f) - __logf(1.f + __expf(-fabsf(x))); }

#define XB_TMO      128
#define XB_XCNT(j)  (256  + 64 * (j))
#define XB_XSUB(j)  (1280 + 64 * (j))
#define XB_XGEN(j)  (2304 + 64 * (j))
#define XB_TOP      3328
#define XB_TOPGEN   3392
#define XCD_BAR_WORDS 3456
#define XB_SPIN_CAP (1u << 18)
DI unsigned xb_ld(unsigned* p)              { return __hip_atomic_load(p, __ATOMIC_RELAXED, __HIP_MEMORY_SCOPE_AGENT); }
DI unsigned xb_add(unsigned* p, unsigned v) { return __hip_atomic_fetch_add(p, v, __ATOMIC_RELAXED, __HIP_MEMORY_SCOPE_AGENT); }
DI unsigned xb_xcc_id() { return (unsigned)__builtin_amdgcn_s_getreg((3 << 11) | 20) & 0xFu; }
#define XB_SPIN(cond, bar) do { unsigned _sp = 0; while (cond) { __builtin_amdgcn_s_sleep(1); \
    if ((++_sp & 255u) == 0u) { if (xb_ld(&(bar)[XB_TMO])) break; if (_sp > XB_SPIN_CAP) { atomicAdd(&(bar)[XB_TMO], 1u); break; } } } } while (0)
struct XcdBarrier { unsigned* bar; unsigned x; volatile LAS unsigned* st; };
DI XcdBarrier xcd_barrier_post(unsigned* bar, volatile LAS unsigned* st) {
    XcdBarrier b; b.bar = bar; b.x = xb_xcc_id(); b.st = st;
    if (threadIdx.x == 0) (void)xb_add(&bar[XB_XCNT(b.x)], 1u);
    return b;
}
DI void xcd_barrier_complete(unsigned* bar, unsigned x, unsigned& nloc, unsigned& nx) {
    const unsigned G = gridDim.x * gridDim.y * gridDim.z;
    unsigned sum, cnt, mine, sp = 0u;
    for (;;) {
        sum = 0u; cnt = 0u; mine = 0u;
#pragma unroll
        for (unsigned j = 0; j < 16; ++j) { const unsigned c = xb_ld(&bar[XB_XCNT(j)]); sum += c; cnt += (c > 0u) ? 1u : 0u; mine = (j == x) ? c : mine; }
        if (sum == G) break;
        __builtin_amdgcn_s_sleep(1);
        if ((++sp & 255u) == 0u) { if (xb_ld(&bar[XB_TMO])) break; if (sp > XB_SPIN_CAP) { atomicAdd(&bar[XB_TMO], 1u); break; } }
    }
    nloc = mine > 0u ? mine : 1u; nx = cnt > 0u ? cnt : 1u;
}
DI void xcd_barrier(const XcdBarrier& b) {
    asm volatile("s_waitcnt vmcnt(0)" ::: "memory");
    __syncthreads();
    if (threadIdx.x == 0) {
        unsigned* bar = b.bar;
        __builtin_amdgcn_s_waitcnt(0);
        unsigned nloc = b.st[0], nx = b.st[1];
        if (nloc == 0u) { xcd_barrier_complete(bar, b.x, nloc, nx); b.st[0] = nloc; b.st[1] = nx; }
        const unsigned old = xb_add(&bar[XB_XSUB(b.x)], 1u);
        const unsigned gen = old / nloc;
        if (old + 1u == (gen + 1u) * nloc) {
            __builtin_amdgcn_fence(__ATOMIC_RELEASE, "agent");
            asm volatile("s_waitcnt vmcnt(0)" ::: "memory");
            const unsigned og = xb_add(&bar[XB_TOP], 1u);
            const unsigned tg = og / nx;
            if (og + 1u == (tg + 1u) * nx) xb_add(&bar[XB_TOPGEN], 1u);
            else XB_SPIN(xb_ld(&bar[XB_TOPGEN]) == tg, bar);
            __builtin_amdgcn_fence(__ATOMIC_ACQUIRE, "agent");
            xb_add(&bar[XB_XGEN(b.x)], 1u);
            asm volatile("s_waitcnt vmcnt(0)" ::: "memory");
        } else {
            XB_SPIN(xb_ld(&bar[XB_XGEN(b.x)]) == gen, bar);
            __builtin_amdgcn_fence(__ATOMIC_ACQUIRE, "agent");
            asm volatile("s_waitcnt vmcnt(0)" ::: "memory");
        }
    }
    __syncthreads();
}

namespace pg8 {
constexpr int BM = 256, BK = 64, HALF = 128, HTB = HALF * BK * 2, STAGE_BYTES = 8 * HTB, NXCD = 8, WGM = 8;
DI int lds_byte(int r, int c) { const int st = (r >> 4) * 2 + (c >> 5), rr = r & 15, cc = c & 31, ob = rr * 64 + cc * 2; return st * 1024 + (ob ^ (((ob >> 9) & 1) << 5)); }
DI void stage_rc(int b, int& R, int& C) { const int st = b / 1024, sb = b % 1024, swz = sb ^ (((sb >> 9) & 1) << 5); R = (st >> 1) * 16 + swz / 64; C = (st & 1) * 32 + (swz % 64) / 2; }
DI int perm32(int rho) { const int n = rho >> 4, i = rho & 15; return 8 * (i >> 2) + 4 * n + (i & 3); }
struct Unit { int pm, pn; };
struct Gemm { const bf16_t* A; const bf16_t* Bt; int M, N, K; };
struct StaticOrder {
    int nM, nN, nwg, G, c;
    DI void init(int M, int N, int G_, int c_) { nM = M / BM; nN = N / BM; nwg = nM * nN; G = G_; c = c_; }
    DI bool next(int i, Unit& u) const {
        const long L = (long)i * G + c; if (L >= nwg) return false;
        int wgid = (int)L; { const int q = nwg / NXCD, r = nwg % NXCD, xcd = wgid % NXCD, off = wgid / NXCD; wgid = (xcd < r ? xcd * (q + 1) : r * (q + 1) + (xcd - r) * q) + off; }
        const int nig = WGM * nN, gid = wgid / nig, fm = gid * WGM, gsz = (nM - fm) < WGM ? (nM - fm) : WGM;
        u.pm = fm + ((wgid % nig) % gsz); u.pn = (wgid % nig) / gsz; return true;
    }
};
template <class Epi, class Sched>
DI void gemm_phase(LAS unsigned char* lds, const int tid, const Gemm g, const Sched& S, const Epi& E) {
    const int wid = __builtin_amdgcn_readfirstlane(tid >> 6), lane = tid & 63, wr = wid >> 2, wc = wid & 3, fr = lane & 15, fq = lane >> 4;
    const int K = g.K, nt = K / BK;
    unsigned voffA[2], voffB[2];
#pragma unroll
    for (int i = 0; i < 2; ++i) { int R, C; stage_rc(tid * 16 + i * 8192, R, C); const int Rb = (R & ~31) + perm32(R & 31);
        voffA[i] = (unsigned)(R * K + C) * 2u; voffB[i] = (unsigned)(Rb * K + C) * 2u; }
    const size_t kstep = (size_t)(BK * 2);
    const size_t hstep = (size_t)HALF * K * 2;
    const size_t tstep = 2 * hstep;
    const unsigned ldsw = (unsigned)wid * 1024u;
    const int aoff = lds_byte(wr * 64 + fr, fq * 8), boff = lds_byte(wc * 32 + fr, fq * 8);
#define PG8_SA(b, h) (((b) * 2 + (h)) * HTB)
#define PG8_SB(b, h) ((4 + (b) * 2 + (h)) * HTB)
#define PG8_STAGE(bufoff, gbase, voff) do { _Pragma("unroll") for (int _i = 0; _i < 2; ++_i) \
        __builtin_amdgcn_global_load_lds((const unsigned*)((const char*)(gbase) + (voff)[_i]), (LAS unsigned*)(lds + (bufoff) + ldsw + _i * 8192), 16, 0, 0); } while (0)
#define PG8_LDA(dst, b, h) do { _Pragma("unroll") for (int m = 0; m < 4; ++m) _Pragma("unroll") for (int k = 0; k < 2; ++k) dst[m][k] = *(const LAS bf16x8*)(lds + PG8_SA(b, h) + aoff + m * 2048 + k * 1024); } while (0)
#define PG8_LDB(dst, b, h) do { _Pragma("unroll") for (int n = 0; n < 2; ++n) _Pragma("unroll") for (int k = 0; k < 2; ++k) dst[n][k] = *(const LAS bf16x8*)(lds + PG8_SB(b, h) + boff + n * 2048 + k * 1024); } while (0)
#define PG8_MMA(ai, bj, At, Bt) do { __builtin_amdgcn_s_setprio(1); _Pragma("unroll") for (int m = 0; m < 4; ++m) _Pragma("unroll") for (int n = 0; n < 2; ++n) _Pragma("unroll") for (int k = 0; k < 2; ++k) \
        acc[ai][bj][m][n] = __builtin_amdgcn_mfma_f32_16x16x32_bf16(Bt[n][k], At[m][k], acc[ai][bj][m][n], 0, 0, 0); __builtin_amdgcn_s_setprio(0); } while (0)
#define PG8_WAIT_V(n) asm volatile("s_waitcnt vmcnt(" #n ")" ::: "memory")
#define PG8_WAIT_L(n) asm volatile("s_waitcnt lgkmcnt(" #n ")" ::: "memory")
#define PG8_BAR __builtin_amdgcn_s_barrier()
#define PG8_SCHED __builtin_amdgcn_sched_barrier(0)
    Unit cur, nxt; int ui = 0;
    if (!S.next(0, cur)) return;
    f32x4 acc[2][2][4][2];
#pragma unroll
    for (int a = 0; a < 2; ++a)
#pragma unroll
        for (int b = 0; b < 2; ++b)
#pragma unroll
            for (int m = 0; m < 4; ++m)
#pragma unroll
                for (int n = 0; n < 2; ++n) acc[a][b][m][n] = (f32x4){0.f, 0.f, 0.f, 0.f};
    bf16x8 At[4][2], B0[2][2], B1[2][2];
    const char* cA = (const char*)g.A + (size_t)cur.pm * tstep; const char* cB = (const char*)g.Bt + (size_t)cur.pn * tstep;
    PG8_STAGE(PG8_SB(0, 0), cB, voffB); PG8_STAGE(PG8_SB(0, 1), cB + hstep, voffB); PG8_STAGE(PG8_SA(0, 0), cA, voffA); PG8_STAGE(PG8_SA(0, 1), cA + hstep, voffA);
    if (wr == 1) PG8_BAR;
    PG8_WAIT_V(2); PG8_BAR;
    PG8_STAGE(PG8_SB(1, 0), cB + kstep, voffB); PG8_STAGE(PG8_SA(1, 0), cA + kstep, voffA); PG8_STAGE(PG8_SB(1, 1), cB + hstep + kstep, voffB);
    PG8_WAIT_V(6); PG8_BAR;
    for (;;) {
        const bool has_next = S.next(ui + 1, nxt);
        const char* nA = has_next ? (const char*)g.A + (size_t)nxt.pm * tstep : cA; const char* nB = has_next ? (const char*)g.Bt + (size_t)nxt.pn * tstep : cB;
        for (int t = 0; t < nt; t += 2) {
            const bool last = (t == nt - 2);
            const char* a1 = cA + (size_t)(t + 1) * kstep;
            const char* a2 = last ? nA : cA + (size_t)(t + 2) * kstep; const char* b2 = last ? nB : cB + (size_t)(t + 2) * kstep;
            const char* a3 = a2 + kstep; const char* b3 = b2 + kstep;
            PG8_LDB(B0, 0, 0); PG8_LDB(B1, 0, 1); PG8_SCHED; PG8_LDA(At, 0, 0); PG8_STAGE(PG8_SA(1, 1), a1 + hstep, voffA);
            PG8_WAIT_V(8); PG8_WAIT_L(0); PG8_BAR; PG8_MMA(0, 0, At, B0); PG8_MMA(0, 1, At, B1); PG8_BAR; PG8_SCHED;
            PG8_LDA(At, 0, 1); PG8_STAGE(PG8_SB(0, 0), b2, voffB); PG8_STAGE(PG8_SB(0, 1), b2 + hstep, voffB); PG8_STAGE(PG8_SA(0, 0), a2, voffA);
            PG8_WAIT_V(8); PG8_WAIT_L(0); PG8_BAR; PG8_MMA(1, 0, At, B0); PG8_MMA(1, 1, At, B1); PG8_BAR; PG8_SCHED;
            PG8_LDB(B0, 1, 0); PG8_LDB(B1, 1, 1); PG8_SCHED; PG8_LDA(At, 1, 0); PG8_STAGE(PG8_SA(0, 1), a2 + hstep, voffA);
            PG8_WAIT_V(8); PG8_WAIT_L(0); PG8_BAR; PG8_MMA(0, 0, At, B0); PG8_MMA(0, 1, At, B1); PG8_BAR; PG8_SCHED;
            PG8_LDA(At, 1, 1); PG8_STAGE(PG8_SB(1, 0), b3, voffB); PG8_STAGE(PG8_SB(1, 1), b3 + hstep, voffB); PG8_STAGE(PG8_SA(1, 0), a3, voffA);
            PG8_WAIT_V(8); PG8_WAIT_L(0); PG8_BAR; PG8_MMA(1, 0, At, B0); PG8_MMA(1, 1, At, B1); PG8_BAR; PG8_SCHED;
        }
        if (wr == 0) PG8_BAR;
        E(acc, cur, wr, wc, fr, fq);
        if (!has_next) break;
#pragma unroll
        for (int a = 0; a < 2; ++a)
#pragma unroll
            for (int b = 0; b < 2; ++b)
#pragma unroll
                for (int m = 0; m < 4; ++m)
#pragma unroll
                    for (int n = 0; n < 2; ++n) acc[a][b][m][n] = (f32x4){0.f, 0.f, 0.f, 0.f};
        cur = nxt; cA = nA; cB = nB; ++ui;
        if (wr == 1) PG8_BAR;
    }
    PG8_WAIT_V(0);
    PG8_BAR;
#undef PG8_SA
#undef PG8_SB
#undef PG8_STAGE
#undef PG8_LDA
#undef PG8_LDB
#undef PG8_MMA
#undef PG8_WAIT_V
#undef PG8_WAIT_L
#undef PG8_BAR
#undef PG8_SCHED
}
}

struct EpiCtx {
    const float* rss_in; float* rss_out; float* X; bf16_t* XB; bf16_t* H;
    bf16_t *QS, *KS, *VS, *ZG; float* LR; const float2* rope; const float *gq, *gk;
    float *okp, *ovp, *oks, *ovs; bf16_t* QX; float* MKV; float scale; int l;
};
enum { EK_SWIGLU = 0, EK_RES = 1, EK_WIN = 2, EK_XQ = 3, EK_MEM = 4 };
template <int KIND> struct Epi {
    EpiCtx c;
    DI void operator()(const f32x4 (&acc)[2][2][4][2], const pg8::Unit& u, int wr, int wc, int fr, int fq) const {
        const int row0 = u.pm * 256 + wr * 64 + fr;
        const int cl = wc * 32 + 8 * fq;
        if constexpr (KIND == EK_RES) {
            u32x4 xo[2][4][2];
#pragma unroll
            for (int ai = 0; ai < 2; ++ai)
#pragma unroll
                for (int m = 0; m < 4; ++m)
#pragma unroll
                    for (int bj = 0; bj < 2; ++bj) xo[ai][m][bj] = *(const u32x4*)(c.XB + (size_t)(row0 + ai * 128 + m * 16) * DM + u.pn * 256 + bj * 128 + cl);
#pragma unroll
            for (int ai = 0; ai < 2; ++ai)
#pragma unroll
                for (int m = 0; m < 4; ++m) {
                    const int r = row0 + ai * 128 + m * 16;
                    float ss = 0.f;
#pragma unroll
                    for (int bj = 0; bj < 2; ++bj) {
                        bf16_t* xb = c.XB + (size_t)r * DM + u.pn * 256 + bj * 128 + cl;
                        const u32x4 xv = xo[ai][m][bj];
                        f32x4 x0 = (f32x4){blo(xv[0]), bhi(xv[0]), blo(xv[1]), bhi(xv[1])}, x1 = (f32x4){blo(xv[2]), bhi(xv[2]), blo(xv[3]), bhi(xv[3])};
                        x0 = x0 + acc[ai][bj][m][0] * c.scale; x1 = x1 + acc[ai][bj][m][1] * c.scale;
                        if (c.X) { float* xp = c.X + (size_t)r * DM + u.pn * 256 + bj * 128 + cl; *(f32x4*)xp = x0; *(f32x4*)(xp + 4) = x1; }
                        else {
                            u32x4 w; w.x = pk2(x0[0], x0[1]); w.y = pk2(x0[2], x0[3]); w.z = pk2(x1[0], x1[1]); w.w = pk2(x1[2], x1[3]);
                            *(u32x4*)xb = w;
#pragma unroll
                            for (int e = 0; e < 4; ++e) { const float a0 = blo(w[e]), a1 = bhi(w[e]); ss += a0 * a0 + a1 * a1; }
                        }
                    }
                    if (!c.X) { ss += __shfl_xor(ss, 16); ss += __shfl_xor(ss, 32); if (fq == 0) atomicAdd(c.rss_out + r, ss); }
                }
            return;
        }
#pragma unroll
        for (int ai = 0; ai < 2; ++ai)
#pragma unroll
            for (int m = 0; m < 4; ++m) {
                const int r = row0 + ai * 128 + m * 16;
                if constexpr (KIND == EK_SWIGLU) {
                    const float rs = rsqrtf(c.rss_in[r] * (1.f / 1024.f) + EPS);
                    const float rsn = rs * -1.4426950408889634f, rs2 = rs * rs;
                    float hv[8];
#pragma unroll
                    for (int n = 0; n < 2; ++n)
#pragma unroll
                        for (int j = 0; j < 4; ++j) { const float g0 = acc[ai][0][m][n][j], u0 = acc[ai][1][m][n][j];
                            hv[n * 4 + j] = (g0 * u0) * rs2 * __builtin_amdgcn_rcpf(1.f + __builtin_amdgcn_exp2f(g0 * rsn)); }
                    u32x4 w; w.x = pk2(hv[0], hv[1]); w.y = pk2(hv[2], hv[3]); w.z = pk2(hv[4], hv[5]); w.w = pk2(hv[6], hv[7]);
                    *(u32x4*)(c.H + (size_t)r * FF + u.pn * 128 + cl) = w;
                } else if constexpr (KIND == EK_XQ) {
                    const float rs = rsqrtf(c.rss_in[r] * (1.f / 1024.f) + EPS);
#pragma unroll
                    for (int bj = 0; bj < 2; ++bj) {
                        const f32x4 a0 = acc[ai][bj][m][0] * rs, a1 = acc[ai][bj][m][1] * rs;
                        u32x4 w; w.x = pk2(a0[0], a0[1]); w.y = pk2(a0[2], a0[3]); w.z = pk2(a1[0], a1[1]); w.w = pk2(a1[2], a1[3]);
                        *(u32x4*)(c.QX + (size_t)r * 512 + u.pn * 256 + bj * 128 + cl) = w;
                    }
                } else if constexpr (KIND == EK_MEM) {
                    const float rs = rsqrtf(c.rss_in[r] * (1.f / 1024.f) + EPS);
#pragma unroll
                    for (int bj = 0; bj < 2; ++bj) {
                        float* p = c.MKV + (size_t)r * 2048 + u.pn * 256 + bj * 128 + cl;
                        *(f32x4*)p = acc[ai][bj][m][0] * rs; *(f32x4*)(p + 4) = acc[ai][bj][m][1] * rs;
                    }
                } else {
                    const float rs = rsqrtf(c.rss_in[r] * (1.f / 1024.f) + EPS);
                    const int pn = u.pn;
                    if (pn < 2 || (pn == 2 && wc < 2)) {
                        const bool isq = pn < 2; const int head = isq ? (4 * pn + wc) : wc;
                        const float* gn = isq ? c.gq : c.gk;
                        float ss = 0.f;
#pragma unroll
                        for (int bj = 0; bj < 2; ++bj)
#pragma unroll
                            for (int n = 0; n < 2; ++n)
#pragma unroll
                                for (int j = 0; j < 4; ++j) { const float v = acc[ai][bj][m][n][j] * rs; ss += v * v; }
                        ss += __shfl_xor(ss, 16); ss += __shfl_xor(ss, 32);
                        const float rq = rsqrtf(ss * (1.f / 64.f) + EPS) * rs;
                        const int ridx = r < TP ? (r & (SEQ - 1)) : (4096 + (r & 3));
                        const float2* rp = c.rope + (size_t)ridx * 32 + 8 * fq;
                        float o1[8], o2[8];
#pragma unroll
                        for (int n = 0; n < 2; ++n)
#pragma unroll
                            for (int j = 0; j < 4; ++j) {
                                const int d = 8 * fq + 4 * n + j; const float2 cs = rp[4 * n + j];
                                const float y1 = acc[ai][0][m][n][j] * rq * gn[d], y2 = acc[ai][1][m][n][j] * rq * gn[32 + d];
                                o1[4 * n + j] = y1 * cs.x - y2 * cs.y; o2[4 * n + j] = y2 * cs.x + y1 * cs.y;
                            }
                        if (isq) {
#pragma unroll
                            for (int e = 0; e < 8; ++e) { o1[e] *= 0.125f; o2[e] *= 0.125f; }
                        }
                        u32x4 w1, w2; w1.x = pk2(o1[0], o1[1]); w1.y = pk2(o1[2], o1[3]); w1.z = pk2(o1[4], o1[5]); w1.w = pk2(o1[6], o1[7]);
                        w2.x = pk2(o2[0], o2[1]); w2.y = pk2(o2[2], o2[3]); w2.z = pk2(o2[4], o2[5]); w2.w = pk2(o2[6], o2[7]);
                        if (isq) { bf16_t* p = c.QS + (size_t)r * 512 + head * 64 + 8 * fq; *(u32x4*)p = w1; *(u32x4*)(p + 32) = w2; }
                        else {
                            bf16_t* p = c.KS + (size_t)r * 128 + head * 64 + 8 * fq; *(u32x4*)p = w1; *(u32x4*)(p + 32) = w2;
                            float* op = nullptr;
                            if (r < TP) { const int t = r & (SEQ - 1); if (t >= SEQ - 128) op = c.okp + ((size_t)((c.l * 4 + (r >> 12)) * 128 + (t - (SEQ - 128)))) * 128; }
                            else { const int rr = r - TP; op = c.oks + ((size_t)((c.l * 128 + (rr >> 2)) * 128 + 124 + (rr & 3))) * 128; }
                            if (op) { op += head * 64 + 8 * fq;
                                *(f32x4*)op = (f32x4){o1[0], o1[1], o1[2], o1[3]}; *(f32x4*)(op + 4) = (f32x4){o1[4], o1[5], o1[6], o1[7]};
                                *(f32x4*)(op + 32) = (f32x4){o2[0], o2[1], o2[2], o2[3]}; *(f32x4*)(op + 36) = (f32x4){o2[4], o2[5], o2[6], o2[7]}; }
                        }
                    } else if (pn == 2) {
                        const int head = wc - 2;
                        float* op = nullptr;
                        if (r < TP) { const int t = r & (SEQ - 1); if (t >= SEQ - 128) op = c.ovp + ((size_t)((c.l * 4 + (r >> 12)) * 128 + (t - (SEQ - 128)))) * 128; }
                        else { const int rr = r - TP; op = c.ovs + ((size_t)((c.l * 128 + (rr >> 2)) * 128 + 124 + (rr & 3))) * 128; }
#pragma unroll
                        for (int bj = 0; bj < 2; ++bj) {
                            const f32x4 a0 = acc[ai][bj][m][0] * rs, a1 = acc[ai][bj][m][1] * rs;
                            u32x4 w; w.x = pk2(a0[0], a0[1]); w.y = pk2(a0[2], a0[3]); w.z = pk2(a1[0], a1[1]); w.w = pk2(a1[2], a1[3]);
                            *(u32x4*)(c.VS + (size_t)r * 128 + head * 64 + 32 * bj + 8 * fq) = w;
                            if (op) { float* q = op + head * 64 + 32 * bj + 8 * fq; *(f32x4*)q = a0; *(f32x4*)(q + 4) = a1; }
                        }
                    } else if (pn < 9) {
#pragma unroll
                        for (int bj = 0; bj < 2; ++bj) {
                            const f32x4 a0 = acc[ai][bj][m][0] * rs, a1 = acc[ai][bj][m][1] * rs;
                            u32x4 w; w.x = pk2(a0[0], a0[1]); w.y = pk2(a0[2], a0[3]); w.z = pk2(a1[0], a1[1]); w.w = pk2(a1[2], a1[3]);
                            *(u32x4*)(c.ZG + (size_t)r * 1536 + (pn - 3) * 256 + bj * 128 + cl) = w;
                        }
                    } else {
                        if (wc == 0 && fq < 2) { float* p = c.LR + (size_t)r * 16 + 8 * fq; *(f32x4*)p = acc[ai][0][m][0] * rs; *(f32x4*)(p + 4) = acc[ai][0][m][1] * rs; }
                    }
                }
            }
    }
};

template <int D, int NKT, bool HAS_SINK, bool NOSCALE = false>
DI void attn16(const bf16x8 (&qf)[D / 32], LAS unsigned char* Kl, int kpitch, LAS unsigned char* Vt, int vpitch, int key0, int jlo, int jhi,
               float scale, float sink, bf16_t* orow, bool wr_ok, int fr, int fq) {
    f32x4 s[NKT];
#pragma unroll
    for (int t = 0; t < NKT; ++t) {
        s[t] = (f32x4){0.f, 0.f, 0.f, 0.f};
#pragma unroll
        for (int ks = 0; ks < D / 32; ++ks) { const bf16x8 kf = *(const LAS bf16x8*)(Kl + (key0 + 16 * t + fr) * kpitch + (32 * ks + 8 * fq) * 2); s[t] = MFMA16(kf, qf[ks], s[t]); }
    }
    float m = -INFINITY;
    const unsigned jrel = (unsigned)(jlo - key0 - 4 * fq), span = (unsigned)(jhi - jlo);
#pragma unroll
    for (int t = 0; t < NKT; ++t)
#pragma unroll
        for (int r = 0; r < 4; ++r) { const unsigned dj = (unsigned)(16 * t + r) - jrel; const float sv = NOSCALE ? s[t][r] : s[t][r] * scale; const float v = dj <= span ? sv : -INFINITY; s[t][r] = v; m = fmaxf(m, v); }
    m = fmaxf(m, __shfl_xor(m, 16)); m = fmaxf(m, __shfl_xor(m, 32));
    if (HAS_SINK) m = fmaxf(m, sink);
    if (m == -INFINITY) m = 0.f;
    float sum = 0.f;
#pragma unroll
    for (int t = 0; t < NKT; ++t)
#pragma unroll
        for (int r = 0; r < 4; ++r) { const float e = __expf(s[t][r] - m); s[t][r] = e; sum += e; }
    sum += __shfl_xor(sum, 16); sum += __shfl_xor(sum, 32);
    if (HAS_SINK) sum += __expf(sink - m);
    const float inv = sum > 0.f ? 1.f / sum : 0.f;
    f32x4 o[D / 16];
#pragma unroll
    for (int dt = 0; dt < D / 16; ++dt) o[dt] = (f32x4){0.f, 0.f, 0.f, 0.f};
#pragma unroll
    for (int kk = 0; kk < NKT / 2; ++kk) {
        u32x4 pw; pw.x = pk2(s[2 * kk][0], s[2 * kk][1]); pw.y = pk2(s[2 * kk][2], s[2 * kk][3]);
        pw.z = pk2(s[2 * kk + 1][0], s[2 * kk + 1][1]); pw.w = pk2(s[2 * kk + 1][2], s[2 * kk + 1][3]);
        const bf16x8 pf = __builtin_bit_cast(bf16x8, pw);
#pragma unroll
        for (int dt = 0; dt < D / 16; ++dt) {
            const LAS unsigned char* vp = Vt + (key0 + 32 * kk + 4 * fq + (fr >> 2)) * vpitch + 32 * dt + 8 * (fr & 3);
            const u32x2 lo = __builtin_bit_cast(u32x2, __builtin_amdgcn_ds_read_tr16_b64_v4i16((LAS v4i16_t*)vp));
            const u32x2 hi = __builtin_bit_cast(u32x2, __builtin_amdgcn_ds_read_tr16_b64_v4i16((LAS v4i16_t*)(vp + 16 * vpitch)));
            const bf16x8 vf = __builtin_bit_cast(bf16x8, (u32x4){lo.x, lo.y, hi.x, hi.y});
            o[dt] = MFMA16(vf, pf, o[dt]);
        }
    }
    if (wr_ok) {
#pragma unroll
        for (int dt = 0; dt < D / 16; ++dt) { u32x2 w; w.x = pk2(o[dt][0] * inv, o[dt][1] * inv); w.y = pk2(o[dt][2] * inv, o[dt][3] * inv); *(u32x2*)(orow + 16 * dt + 4 * fq) = w; }
    }
}

struct Params { const float* in[33]; float* out; unsigned char* ws; };

#define CAS __attribute__((address_space(4)))
struct Ctx {
    LAS unsigned char* lds; int tid, lane, wave, G, bx;
    const CAS Params* p; unsigned char* ws; float* out;
};

DI void thin_res_gemm(const Ctx& C, const bf16_t* A, const bf16_t* Bt, int K, float scale, float* rss_out, float* X) {
    const int fr = C.lane & 15, fq = C.lane >> 4;
    LAS float* part = (LAS float*)C.lds;
    bf16_t* XB = (bf16_t*)(C.ws + WS_XB);
    const int kw = K >> 3;
    for (int tile = C.bx; tile < 256; tile += C.G) {
        const int row0 = TP + (tile >> 4) * 32, n0 = (tile & 15) * 64;
        f32x4 acc[2][4];
#pragma unroll
        for (int mt = 0; mt < 2; ++mt)
#pragma unroll
            for (int nt = 0; nt < 4; ++nt) acc[mt][nt] = (f32x4){0.f, 0.f, 0.f, 0.f};
        const bf16_t* ap = A + (size_t)(row0 + fr) * K + C.wave * kw + 8 * fq;
        const bf16_t* bp = Bt + (size_t)(n0 + fr) * K + C.wave * kw + 8 * fq;
#pragma unroll 4
        for (int k = 0; k < kw; k += 32) {
            bf16x8 af[2], bfr[4];
#pragma unroll
            for (int mt = 0; mt < 2; ++mt) af[mt] = *(const bf16x8*)(ap + (size_t)(16 * mt) * K + k);
#pragma unroll
            for (int nt = 0; nt < 4; ++nt) bfr[nt] = *(const bf16x8*)(bp + (size_t)(16 * nt) * K + k);
#pragma unroll
            for (int mt = 0; mt < 2; ++mt)
#pragma unroll
                for (int nt = 0; nt < 4; ++nt) acc[mt][nt] = MFMA16(bfr[nt], af[mt], acc[mt][nt]);
        }
#pragma unroll
        for (int mt = 0; mt < 2; ++mt)
#pragma unroll
            for (int nt = 0; nt < 4; ++nt) *(LAS f32x4*)(part + ((C.wave * 32 + 16 * mt + fr) * 64 + 16 * nt + 4 * fq)) = acc[mt][nt];
        __syncthreads();
        {
            const int row = C.tid >> 4, c4 = C.tid & 15;
            f32x4 v = (f32x4){0.f, 0.f, 0.f, 0.f};
#pragma unroll
            for (int w = 0; w < 8; ++w) v = v + *(const LAS f32x4*)(part + ((w * 32 + row) * 64 + 4 * c4));
            bf16_t* xb = XB + (size_t)(row0 + row) * DM + n0 + 4 * c4;
            const u32x2 xo = *(const u32x2*)xb;
            f32x4 x = (f32x4){blo(xo.x), bhi(xo.x), blo(xo.y), bhi(xo.y)}; x = x + v * scale;
            if (X) *(f32x4*)(X + (size_t)(row0 + row) * DM + n0 + 4 * c4) = x;
            else {
                u32x2 w2; w2.x = pk2(x[0], x[1]); w2.y = pk2(x[2], x[3]); *(u32x2*)xb = w2;
                const float a0 = blo(w2.x), a1 = bhi(w2.x), a2 = blo(w2.y), a3 = bhi(w2.y);
                float ss = a0 * a0 + a1 * a1 + a2 * a2 + a3 * a3;
                ss += __shfl_xor(ss, 1); ss += __shfl_xor(ss, 2); ss += __shfl_xor(ss, 4); ss += __shfl_xor(ss, 8);
                if (c4 == 0) atomicAdd(rss_out + row0 + row, ss);
            }
        }
        __syncthreads();
    }
}

DI void p0_tile(const float* s0, const float* s1, const float* gain, int mode, int K, int Nsrc, bf16_t* dst, int tile, LAS float* tl, int tid) {
    const int nkt = K >> 6; const int ntile = tile / nkt, kt = tile - ntile * nkt; const int n0 = ntile * 256, k0 = kt * 64;
    const int nn = tid & 255, kk0 = tid >> 8;
    const int n = n0 + nn; const float* src = s0; int col = n;
    if (mode == 1) { const int pn = n >> 8, bj = (n >> 7) & 1, cc = n & 127; src = bj ? s1 : s0; col = pn * 128 + cc; }
    else if (mode == 2) {
        const int pn = n >> 8, rem = n & 255, bj = rem >> 7, wc = (rem >> 5) & 3, j = rem & 31;
        if (pn < 2) col = (4 * pn + wc) * 64 + 32 * bj + j;
        else if (pn == 2) col = (wc < 2) ? (512 + wc * 64 + 32 * bj + j) : (640 + (wc - 2) * 64 + 32 * bj + j);
        else if (pn < 9) col = n;
        else col = (rem < 16) ? (2304 + rem) : -1;
    } else if (mode == 3) { if (n >= 512) { src = s1; col = n - 512; } }
    const float* sp = src + (size_t)(k0 + kk0) * Nsrc + (col >= 0 ? col : 0);
    float v[32];
#pragma unroll
    for (int i = 0; i < 32; ++i) v[i] = (col >= 0) ? sp[(size_t)(2 * i) * Nsrc] : 0.f;
    if (gain) {
#pragma unroll
        for (int i = 0; i < 32; ++i) v[i] *= gain[k0 + kk0 + 2 * i];
    }
#pragma unroll
    for (int i = 0; i < 32; ++i) tl[(kk0 + 2 * i) * 257 + nn] = v[i];
    __syncthreads();
#pragma unroll
    for (int j = 0; j < 4; ++j) { const int ch = tid + 512 * j; const int n2 = ch >> 3, ks = ch & 7; const LAS float* s = tl + (8 * ks) * 257 + n2;
      u32x4 o; o.x = pk2(s[0], s[257]); o.y = pk2(s[2 * 257], s[3 * 257]); o.z = pk2(s[4 * 257], s[5 * 257]); o.w = pk2(s[6 * 257], s[7 * 257]);
      *(u32x4*)(dst + (size_t)(n0 + n2) * K + k0 + 8 * ks) = o; }
    __syncthreads();
}

constexpr int TPL = 1408, T_W1 = 0, T_WD1 = 352, T_WKV = 1344;
DI void p0_dispatch(const Ctx& C, int l, int r) {
    const CAS Params& P = *C.p; unsigned char* ws = C.ws;
    unsigned char* wl = ws + WS_WL + (size_t)l * WL_SIZE;
    const float* s0; const float* s1 = nullptr; const float* gain = nullptr; int mode = 0, K = 1024, Nsrc; bf16_t* dst;
    if (r < 352) { s0 = P.in[9] + (size_t)l * 1024 * FF; s1 = P.in[10] + (size_t)l * 1024 * FF; gain = P.in[8] + l * 1024; mode = 1; Nsrc = FF; dst = (bf16_t*)(wl + WL_W1); }
    else if (r < 528) { r -= 352; s0 = P.in[11] + (size_t)l * FF * 1024; K = FF; Nsrc = 1024; dst = (bf16_t*)(wl + WL_WD1); }
    else if (r < 688) { r -= 528; s0 = P.in[13] + (size_t)l * 1024 * 2320; gain = P.in[12] + l * 1024; mode = 2; Nsrc = 2320; dst = (bf16_t*)(wl + WL_WIN); }
    else if (r < 752) { r -= 688; s0 = P.in[20] + (size_t)l * 1024 * 1024; Nsrc = 1024; dst = (bf16_t*)(wl + WL_WOUT); }
    else if (r < 784) { r -= 752; s0 = P.in[23] + (size_t)l * 1024 * 512; gain = P.in[21] + l * 1024; Nsrc = 512; dst = (bf16_t*)(wl + WL_WQ); }
    else if (r < 816) { r -= 784; s0 = P.in[28] + (size_t)l * 512 * 1024; K = 512; Nsrc = 1024; dst = (bf16_t*)(wl + WL_WO); }
    else if (r < 1168) { r -= 816; s0 = P.in[30] + (size_t)l * 1024 * FF; s1 = P.in[31] + (size_t)l * 1024 * FF; gain = P.in[29] + l * 1024; mode = 1; Nsrc = FF; dst = (bf16_t*)(wl + WL_W2); }
    else if (r < 1344) { r -= 1168; s0 = P.in[32] + (size_t)l * FF * 1024; K = FF; Nsrc = 1024; dst = (bf16_t*)(wl + WL_WD2); }
    else { r -= 1344; s0 = P.in[24] + (size_t)l * 1024 * 512; s1 = P.in[25] + (size_t)l * 1024 * 512; gain = P.in[22] + l * 1024; mode = 3; Nsrc = 512; dst = (bf16_t*)(ws + WS_WKV) + (size_t)l * 1024 * 1024; }
    p0_tile(s0, s1, gain, mode, K, Nsrc, dst, r, (LAS float*)C.lds, C.tid);
}
DI void convert_in_slack(const Ctx& C, int l, int lo, int hi, int nun) {
    const int rem = nun % C.G; const int first = rem ? rem : 0, cnt = C.G - first;
    if (C.bx < first) return;
    for (int t = lo + (C.bx - first); t < hi; t += cnt) p0_dispatch(C, l, t);
}

DI void p0_prologue(const Ctx& C) {
    const CAS Params& P = *C.p; unsigned char* ws = C.ws;
    for (int it = C.bx; it < 352 + 128; it += C.G) {
        if (it < 352) p0_dispatch(C, 0, it); else if (it < 416) p0_dispatch(C, 0, T_WKV + it - 352); else p0_dispatch(C, 1, T_WKV + it - 416);
    }
    const int gw = C.bx * 8 + C.wave, NGW = C.G * 8;
    float* RSS = (float*)(ws + WS_RSS);
    for (int r0 = gw; r0 < T + 1024; r0 += 2 * NGW) {
        const float* src[2]; float* df[2]; bf16_t* db[2]; float* rs[2]; f32x4 v[2][4];
#pragma unroll
        for (int q = 0; q < 2; ++q) {
            int r = r0 + q * NGW; if (r >= T + 1024) r = r0;
            if (r < T) { src[q] = (r < TP ? P.in[0] + (size_t)r * 1024 : P.in[1] + (size_t)(r - TP) * 1024); df[q] = nullptr; db[q] = (bf16_t*)(ws + WS_XB) + (size_t)r * 1024; rs[q] = RSS + r; }
            else { src[q] = P.in[7] + (size_t)(r - T) * 1024; df[q] = nullptr; db[q] = (bf16_t*)(ws + WS_MEMB) + (size_t)(r - T) * 1024; rs[q] = (float*)(ws + WS_RSSM) + (r - T); }
#pragma unroll
            for (int j = 0; j < 4; ++j) v[q][j] = *(const f32x4*)(src[q] + 256 * j + 4 * C.lane);
        }
#pragma unroll
        for (int q = 0; q < 2; ++q) {
            float ss = 0.f;
#pragma unroll
            for (int j = 0; j < 4; ++j) {
                const f32x4 x = v[q][j];
                ss += x[0] * x[0] + x[1] * x[1] + x[2] * x[2] + x[3] * x[3];
                if (df[q]) *(f32x4*)(df[q] + 256 * j + 4 * C.lane) = x;
                u32x2 w; w.x = pk2(x[0], x[1]); w.y = pk2(x[2], x[3]); *(u32x2*)(db[q] + 256 * j + 4 * C.lane) = w;
            }
#pragma unroll
            for (int o = 1; o < 64; o <<= 1) ss += __shfl_xor(ss, o);
            if (C.lane == 0) *rs[q] = ss;
        }
    }
    for (int i = C.bx * 512 + C.tid; i < 8 * T; i += C.G * 512) RSS[T + i] = 0.f;
    float2* rope = (float2*)(ws + WS_ROPE);
    for (int i = C.bx * 512 + C.tid; i < 4100 * 32; i += C.G * 512) {
        const int pidx = i >> 5, f = i & 31; const int pos = pidx < 4096 ? pidx : 16384 + (pidx - 4096);
        const float inv = powf(10000.f, -(float)f * (1.f / 32.f));
        const float ang = (float)pos * inv;
        const double a = (double)ang; const double nrev = rint(a * 0.15915494309189535); const float rr = (float)(a - nrev * 6.283185307179586);
        rope[i] = make_float2(cosf(rr), sinf(rr));
    }
}

DI void swa_prompt_unit(const Ctx& C, int l, int unit) {
    unsigned char* ws = C.ws;
    const int b = unit >> 6, n = (unit >> 1) & 31, kvh = unit & 1;
    const bf16_t* QS = (const bf16_t*)(ws + WS_QS); const bf16_t* KS = (const bf16_t*)(ws + WS_KS); const bf16_t* VS = (const bf16_t*)(ws + WS_VS); bf16_t* MIX = (bf16_t*)(ws + WS_MIX);
    LAS unsigned char* Kl = C.lds; LAS unsigned char* Vt = C.lds + 256 * 144;
    constexpr int KP = 144, VP = 144;
#pragma unroll
    for (int i = 0; i < 4; ++i) {
        const int key = (C.tid >> 3) + 64 * i, c8 = C.tid & 7; const int pos = (n - 1) * 128 + key;
        u32x4 kv = (u32x4){0u, 0u, 0u, 0u}, vv = kv;
        if (pos >= 0) { const size_t row = (size_t)b * SEQ + pos; kv = *(const u32x4*)(KS + row * 128 + kvh * 64 + 8 * c8); vv = *(const u32x4*)(VS + row * 128 + kvh * 64 + 8 * c8); }
        *(LAS u32x4*)(Kl + key * KP + c8 * 16) = kv; *(LAS u32x4*)(Vt + key * VP + c8 * 16) = vv;
    }
    __syncthreads();
    const int fr = C.lane & 15, fq = C.lane >> 4; const int g = C.wave >> 1, qh = C.wave & 1; const int head = kvh * 4 + g;
    const float sink = C.p->in[16][l * 8 + head];
    for (int grp = 0; grp < 4; ++grp) {
        const int i = 64 * qh + 16 * grp + fr; const size_t row = (size_t)b * SEQ + n * 128 + i;
        bf16x8 qf[2];
#pragma unroll
        for (int ks = 0; ks < 2; ++ks) qf[ks] = *(const bf16x8*)(QS + row * 512 + head * 64 + 32 * ks + 8 * fq);
        const int jlo = max(i + 1, n == 0 ? 128 : 0), jhi = i + 128;
        attn16<64, 12, true, true>(qf, Kl, KP, Vt, VP, 64 * qh, jlo, jhi, 0.125f, sink, MIX + row * 1024 + head * 64, true, fr, fq);
    }
    __syncthreads();
}

DI void swa_decode_unit(const Ctx& C, int l, int unit) {
    unsigned char* ws = C.ws; const CAS Params& P = *C.p;
    const int b = unit >> 1, kvh = unit & 1;
    const bf16_t* QS = (const bf16_t*)(ws + WS_QS); const bf16_t* KS = (const bf16_t*)(ws + WS_KS); const bf16_t* VS = (const bf16_t*)(ws + WS_VS); bf16_t* MIX = (bf16_t*)(ws + WS_MIX);
    constexpr int KP = 144, VP = 144;
    LAS unsigned char* Kl = C.lds; LAS unsigned char* Vt = C.lds + 160 * KP;
    for (int i = C.tid; i < (160 * KP + 160 * VP) / 16; i += 512) *(LAS u32x4*)(C.lds + i * 16) = (u32x4){0u, 0u, 0u, 0u};
    __syncthreads();
    const float* ck = P.in[2] + ((size_t)(l * 128 + b) * 128) * 128 + kvh * 64; const float* cv = P.in[3] + ((size_t)(l * 128 + b) * 128) * 128 + kvh * 64;
    float* ok = C.out + O_KS + ((size_t)(l * 128 + b) * 128) * 128 + kvh * 64; float* ov = C.out + O_VS + ((size_t)(l * 128 + b) * 128) * 128 + kvh * 64;
#pragma unroll
    for (int i = 0; i < 4; ++i) {
        const int key = (C.tid >> 4) + 32 * i, c16 = C.tid & 15;
        const f32x4 kv = *(const f32x4*)(ck + (size_t)key * 128 + 4 * c16), vv = *(const f32x4*)(cv + (size_t)key * 128 + 4 * c16);
        u32x2 w; w.x = pk2(kv[0], kv[1]); w.y = pk2(kv[2], kv[3]); *(LAS u32x2*)(Kl + key * KP + c16 * 8) = w;
        u32x2 wv; wv.x = pk2(vv[0], vv[1]); wv.y = pk2(vv[2], vv[3]); *(LAS u32x2*)(Vt + key * VP + c16 * 8) = wv;
        if (key >= 4) { *(f32x4*)(ok + (size_t)(key - 4) * 128 + 4 * c16) = kv; *(f32x4*)(ov + (size_t)(key - 4) * 128 + 4 * c16) = vv; }
    }
    if (C.tid < 32) {
        const int tt = C.tid >> 3, c8 = C.tid & 7; const size_t row = (size_t)TP + b * 4 + tt;
        const u32x4 kv = *(const u32x4*)(KS + row * 128 + kvh * 64 + 8 * c8), vv = *(const u32x4*)(VS + row * 128 + kvh * 64 + 8 * c8);
        *(LAS u32x4*)(Kl + (128 + tt) * KP + c8 * 16) = kv; *(LAS u32x4*)(Vt + (128 + tt) * VP + c8 * 16) = vv;
    }
    __syncthreads();
    if (C.wave == 0) {
        const int fr = C.lane & 15, fq = C.lane >> 4; const int g = fr >> 2, tt = fr & 3; const int head = kvh * 4 + g; const size_t row = (size_t)TP + b * 4 + tt;
        bf16x8 qf[2];
#pragma unroll
        for (int ks = 0; ks < 2; ++ks) qf[ks] = *(const bf16x8*)(QS + row * 512 + head * 64 + 32 * ks + 8 * fq);
        const float sink = P.in[16][l * 8 + head];
        attn16<64, 10, true, true>(qf, Kl, KP, Vt, VP, 0, tt + 1, tt + 128, 0.125f, sink, MIX + row * 1024 + head * 64, true, fr, fq);
    }
    __syncthreads();
}

DI void xattn_unit(const Ctx& C, int l, int unit) {
    unsigned char* ws = C.ws; const CAS Params& P = *C.p;
    constexpr int KP = 272, VP = 288;
    LAS unsigned char* Kl = C.lds; LAS unsigned char* Vt = C.lds + 256 * KP;
    const bool prompt = unit < 128;
    int b, h, qb = 0;
    if (prompt) { b = unit >> 5; h = (unit >> 3) & 3; qb = (unit & 7) * 2; } else { const int u = unit - 128; b = u >> 2; h = u & 3; }
    const float* ksrc; const float* vsrc; size_t kpitch;
    if (prompt) { ksrc = (const float*)(ws + WS_MKV) + (size_t)(b * 256) * 2048 + l * 1024 + h * 128; vsrc = ksrc + 512; kpitch = 2048; }
    else { ksrc = P.in[5] + ((size_t)(l * 128 + b) * 256) * 512 + h * 128; vsrc = P.in[6] + ((size_t)(l * 128 + b) * 256) * 512 + h * 128; kpitch = 512; }
    const int c4 = C.tid & 31;
    const f32x4 gk = *(const f32x4*)(P.in[27] + l * 128 + 4 * c4);
    const bool wout = prompt && qb == 0;
    float* omk = C.out + O_MKP + ((size_t)(l * 4 + b) * 256) * 512 + h * 128; float* omv = C.out + O_MVP + ((size_t)(l * 4 + b) * 256) * 512 + h * 128;
#pragma unroll 4
    for (int i = 0; i < 16; ++i) {
        const int key = (C.tid >> 5) + 16 * i;
        f32x4 kv = *(const f32x4*)(ksrc + (size_t)key * kpitch + 4 * c4); const f32x4 vv = *(const f32x4*)(vsrc + (size_t)key * kpitch + 4 * c4);
        if (prompt) {
            float ss = kv[0] * kv[0] + kv[1] * kv[1] + kv[2] * kv[2] + kv[3] * kv[3];
#pragma unroll
            for (int o = 1; o < 32; o <<= 1) ss += __shfl_xor(ss, o);
            const float rq = rsqrtf(ss * (1.f / 128.f) + EPS);
            kv = kv * rq * gk;
            if (wout) { *(f32x4*)(omk + (size_t)key * 512 + 4 * c4) = kv; *(f32x4*)(omv + (size_t)key * 512 + 4 * c4) = vv; }
        }
        u32x2 w; w.x = pk2(kv[0], kv[1]); w.y = pk2(kv[2], kv[3]); *(LAS u32x2*)(Kl + key * KP + c4 * 8) = w;
        u32x2 wv; wv.x = pk2(vv[0], vv[1]); wv.y = pk2(vv[2], vv[3]); *(LAS u32x2*)(Vt + key * VP + c4 * 8) = wv;
    }
    __syncthreads();
    const bf16_t* QX = (const bf16_t*)(ws + WS_QX); bf16_t* OX = (bf16_t*)(ws + WS_OX);
    const int fr = C.lane & 15, fq = C.lane >> 4;
    const int ngrp = prompt ? 4 : (C.wave == 0 ? 1 : 0);
    for (int grp = 0; grp < ngrp; ++grp) {
        const size_t row = prompt ? ((size_t)b * SEQ + (qb + (grp >> 1)) * 256 + 32 * C.wave + 16 * (grp & 1) + fr) : ((size_t)TP + b * 4 + (fr & 3));
        float qv[32]; float ss = 0.f;
#pragma unroll
        for (int ks = 0; ks < 4; ++ks) {
            const u32x4 w = *(const u32x4*)(QX + row * 512 + h * 128 + 32 * ks + 8 * fq);
#pragma unroll
            for (int e = 0; e < 4; ++e) { qv[8 * ks + 2 * e] = blo(w[e]); qv[8 * ks + 2 * e + 1] = bhi(w[e]); }
        }
#pragma unroll
        for (int e = 0; e < 32; ++e) ss += qv[e] * qv[e];
        ss += __shfl_xor(ss, 16); ss += __shfl_xor(ss, 32);
        const float rq = rsqrtf(ss * (1.f / 128.f) + EPS);
        bf16x8 qf[4];
#pragma unroll
        for (int ks = 0; ks < 4; ++ks) {
            const f32x4 g0 = *(const f32x4*)(P.in[26] + l * 128 + 32 * ks + 8 * fq), g1 = *(const f32x4*)(P.in[26] + l * 128 + 32 * ks + 8 * fq + 4);
            u32x4 w; w.x = pk2(qv[8 * ks] * rq * g0[0], qv[8 * ks + 1] * rq * g0[1]); w.y = pk2(qv[8 * ks + 2] * rq * g0[2], qv[8 * ks + 3] * rq * g0[3]);
            w.z = pk2(qv[8 * ks + 4] * rq * g1[0], qv[8 * ks + 5] * rq * g1[1]); w.w = pk2(qv[8 * ks + 6] * rq * g1[2], qv[8 * ks + 7] * rq * g1[3]);
            qf[ks] = __builtin_bit_cast(bf16x8, w);
        }
        attn16<128, 16, false>(qf, Kl, KP, Vt, VP, 0, 0, 255, 0.08838834764831845f, 0.f, OX + row * 512 + h * 128, prompt || fr < 4, fr, fq);
    }
    __syncthreads();
}

DI void gla_a_phase(const Ctx& C, int l) {
    unsigned char* ws = C.ws; const CAS Params& P = *C.p;
    const bf16_t* ZG = (const bf16_t*)(ws + WS_ZG); const float* LR = (const float*)(ws + WS_LR);
    bf16_t* QT = (bf16_t*)(ws + WS_BCUM); bf16_t* KT = QT + (size_t)TP * 256; float* ST = (float*)(ws + WS_ST); bf16_t* VT = (bf16_t*)(ws + WS_VT); float* DEC = (float*)(ws + WS_DEC);
    LAS float* segsum = (LAS float*)C.lds;
    LAS unsigned char* KdT = C.lds + 2048;
    LAS unsigned char* VtL = C.lds + 2048 + 64 * 144;
    const int dk = C.tid & 63, seg = C.wave, tv = C.tid >> 3, dvs = C.tid & 7;
    int unit = C.bx; if (unit >= 1024) return;
    bf16_t kq[16]; u32x4 vw[2];
#define GLA_A_LOAD(u) do { const int bh_ = (u) >> 6, c_ = (u) & 63, b_ = bh_ >> 2, h_ = bh_ & 3; const size_t t0_ = (size_t)b_ * SEQ + c_ * 64; \
        _Pragma("unroll") for (int i = 0; i < 8; ++i) { kq[i] = ZG[(t0_ + 8 * seg + i) * 1536 + 256 + h_ * 64 + dk]; kq[8 + i] = ZG[(t0_ + 8 * seg + i) * 1536 + h_ * 64 + dk]; } \
        _Pragma("unroll") for (int x = 0; x < 2; ++x) vw[x] = *(const u32x4*)(ZG + (t0_ + tv) * 1536 + 512 + h_ * 128 + 16 * dvs + 8 * x); } while (0)
    GLA_A_LOAD(unit);
    int hcur = -1; float wg[16]; float bg = 0.f;
    for (; unit < 1024; unit += C.G) {
        const int bh = unit >> 6, c = unit & 63, b = bh >> 2, h = bh & 3; const size_t t0 = (size_t)b * SEQ + c * 64;
        if (h != hcur) { hcur = h;
#pragma unroll
            for (int r = 0; r < 16; ++r) wg[r] = P.in[17][(size_t)(l * 16 + r) * 256 + h * 64 + dk];
            bg = P.in[18][l * 256 + h * 64 + dk]; }
        float p[8];
        {
            float run = 0.f;
#pragma unroll
            for (int i = 0; i < 8; ++i) {
                const float* lr = LR + (t0 + 8 * seg + i) * 16; float x = bg;
#pragma unroll
                for (int r = 0; r < 16; ++r) x += lr[r] * wg[r];
                run += logsig(x) * (1.f / 16.f); p[i] = run;
            }
            segsum[seg * 64 + dk] = run;
        }
#pragma unroll
        for (int x = 0; x < 2; ++x) *(LAS u32x4*)(VtL + tv * 288 + (16 * dvs + 8 * x) * 2) = vw[x];
        __syncthreads();
        {
            float off = 0.f, tot = 0.f;
#pragma unroll
            for (int s2 = 0; s2 < 8; ++s2) { const float v = segsum[s2 * 64 + dk]; tot += v; if (s2 < seg) off += v; }
#pragma unroll
            for (int i = 0; i < 8; ++i) {
                const int t = 8 * seg + i; const float bv = off + p[i];
                const float kraw = bf2f(kq[i]), qraw = bf2f(kq[8 + i]);
                const float kd = kraw * __expf(tot - bv);
                const unsigned qk = pk2(qraw * 0.125f * __expf(bv), kraw * __expf(-bv));
                QT[(t0 + t) * 256 + h * 64 + dk] = (bf16_t)(qk & 0xffffu); KT[(t0 + t) * 256 + h * 64 + dk] = (bf16_t)(qk >> 16);
                *(LAS unsigned short*)(KdT + t * 144 + dk * 2) = (unsigned short)(pk2(kd, 0.f) & 0xffffu);
            }
            if (seg == 0) DEC[unit * 64 + dk] = __expf(tot);
        }
        if (unit + C.G < 1024) GLA_A_LOAD(unit + C.G);
        __syncthreads();
        {
            const int fr = C.lane & 15, fq = C.lane >> 4, w = C.wave;
            bf16x8 vt[2];
#pragma unroll
            for (int ks = 0; ks < 2; ++ks) {
                const LAS unsigned char* vp = VtL + (32 * ks + 8 * fq + (fr >> 2)) * 288 + 32 * w + 8 * (fr & 3);
                const u32x2 lo = __builtin_bit_cast(u32x2, __builtin_amdgcn_ds_read_tr16_b64_v4i16((LAS v4i16_t*)vp));
                const u32x2 hi = __builtin_bit_cast(u32x2, __builtin_amdgcn_ds_read_tr16_b64_v4i16((LAS v4i16_t*)(vp + 4 * 288)));
                vt[ks] = __builtin_bit_cast(bf16x8, (u32x4){lo.x, lo.y, hi.x, hi.y});
            }
#pragma unroll
            for (int dkt = 0; dkt < 4; ++dkt) {
                f32x4 acc = (f32x4){0.f, 0.f, 0.f, 0.f};
#pragma unroll
                for (int ks = 0; ks < 2; ++ks) {
                    const LAS unsigned char* kp = KdT + (32 * ks + 8 * fq + (fr >> 2)) * 144 + 32 * dkt + 8 * (fr & 3);
                    const u32x2 lo = __builtin_bit_cast(u32x2, __builtin_amdgcn_ds_read_tr16_b64_v4i16((LAS v4i16_t*)kp));
                    const u32x2 hi = __builtin_bit_cast(u32x2, __builtin_amdgcn_ds_read_tr16_b64_v4i16((LAS v4i16_t*)(kp + 4 * 144)));
                    const bf16x8 kd = __builtin_bit_cast(bf16x8, (u32x4){lo.x, lo.y, hi.x, hi.y});
                    acc = MFMA16(kd, vt[ks], acc);
                }
                *(f32x4*)(ST + ((size_t)unit * 128 + 16 * w + fr) * 64 + 16 * dkt + 4 * fq) = acc;
            }
        }
        __syncthreads();
    }
#undef GLA_A_LOAD
}

DI void gla_scan(const Ctx& C, int l) {
    unsigned char* ws = C.ws;
    const float* ST = (const float*)(ws + WS_ST); const float* DEC = (const float*)(ws + WS_DEC); bf16_t* STB = (bf16_t*)(ws + WS_STB);
    for (int e = C.bx * 512 + C.tid; e < 16 * 8192; e += C.G * 512) {
        const int bh = e >> 13, idx = e & 8191, dk = idx & 63, dv = idx >> 6;
        float S = 0.f;
        for (int c0 = 0; c0 < 64; c0 += 8) {
            float d[8], dc[8];
#pragma unroll
            for (int i = 0; i < 8; ++i) { const int unit = bh * 64 + c0 + i; d[i] = ST[(size_t)unit * 8192 + idx]; dc[i] = DEC[unit * 64 + dk]; }
#pragma unroll
            for (int i = 0; i < 8; ++i) { const int unit = bh * 64 + c0 + i; STB[(size_t)unit * 8192 + idx] = (bf16_t)(pk2(S, 0.f) & 0xffffu); S = dc[i] * S + d[i]; }
        }
        C.out[O_GP + ((size_t)(l * 16 + bh)) * 8192 + dk * 128 + dv] = S;
    }
}

DI void gla_c_wave(const Ctx& C, int l, int unit, int qt) {
    unsigned char* ws = C.ws; const CAS Params& P = *C.p;
    const int bh = unit >> 6, c = unit & 63, b = bh >> 2, h = bh & 3; const size_t t0 = (size_t)b * SEQ + c * 64;
    const bf16_t* ZG = (const bf16_t*)(ws + WS_ZG); const bf16_t* QT = (const bf16_t*)(ws + WS_BCUM); const bf16_t* KT = QT + (size_t)TP * 256; const bf16_t* STB = (const bf16_t*)(ws + WS_STB); const bf16_t* VT = (const bf16_t*)(ws + WS_VT);
    bf16_t* MIX = (bf16_t*)(ws + WS_MIX);
    const int fr = C.lane & 15, fq = C.lane >> 4;
    const size_t rq = t0 + 16 * qt + fr;
    bf16x8 qf[2];
#pragma unroll
    for (int ks = 0; ks < 2; ++ks) qf[ks] = *(const bf16x8*)(QT + rq * 256 + h * 64 + 32 * ks + 8 * fq);
    f32x4 a[4];
#pragma unroll
    for (int kt = 0; kt < 4; ++kt) {
        a[kt] = (f32x4){0.f, 0.f, 0.f, 0.f};
        if (kt <= qt) {
            const size_t rk = t0 + 16 * kt + fr;
#pragma unroll
            for (int ks = 0; ks < 2; ++ks) {
                const bf16x8 kf = *(const bf16x8*)(KT + rk * 256 + h * 64 + 32 * ks + 8 * fq);
                a[kt] = MFMA16(kf, qf[ks], a[kt]);
            }
#pragma unroll
            for (int r = 0; r < 4; ++r) if (16 * kt + 4 * fq + r > 16 * qt + fr) a[kt][r] = 0.f;
        }
    }
    bf16x8 pf[2];
#pragma unroll
    for (int kk = 0; kk < 2; ++kk) { u32x4 w; w.x = pk2(a[2 * kk][0], a[2 * kk][1]); w.y = pk2(a[2 * kk][2], a[2 * kk][3]); w.z = pk2(a[2 * kk + 1][0], a[2 * kk + 1][1]); w.w = pk2(a[2 * kk + 1][2], a[2 * kk + 1][3]); pf[kk] = __builtin_bit_cast(bf16x8, w); }
    f32x4 o[8]; float ss = 0.f;
#pragma unroll
    for (int dt = 0; dt < 8; ++dt) {
        f32x4 acc = (f32x4){0.f, 0.f, 0.f, 0.f};
        const size_t vrow = ((size_t)unit * 128 + 16 * dt + fr) * 64;
#pragma unroll
        for (int kk = 0; kk < 2; ++kk) {
            if (2 * kk <= qt) {
                const bf16_t* vp = VT + vrow + 32 * kk + 4 * fq; const u32x2 lo = *(const u32x2*)vp, hi = *(const u32x2*)(vp + 16);
                acc = MFMA16(__builtin_bit_cast(bf16x8, (u32x4){lo.x, lo.y, hi.x, hi.y}), pf[kk], acc);
            }
        }
#pragma unroll
        for (int ks = 0; ks < 2; ++ks) {
            const bf16x8 sf = *(const bf16x8*)(STB + vrow + 32 * ks + 8 * fq);
            acc = MFMA16(sf, qf[ks], acc);
        }
        o[dt] = acc; ss += acc[0] * acc[0] + acc[1] * acc[1] + acc[2] * acc[2] + acc[3] * acc[3];
    }
    ss += __shfl_xor(ss, 16); ss += __shfl_xor(ss, 32);
    const float rn = rsqrtf(ss * (1.f / 128.f) + EPS);
#pragma unroll
    for (int dt = 0; dt < 8; ++dt) {
        const f32x4 gn = *(const f32x4*)(P.in[19] + l * 128 + 16 * dt + 4 * fq);
        const u32x2 gw = *(const u32x2*)(ZG + rq * 1536 + 1024 + h * 128 + 16 * dt + 4 * fq);
        const float g0 = blo(gw.x), g1 = bhi(gw.x), g2 = blo(gw.y), g3 = bhi(gw.y);
        u32x2 w; w.x = pk2(o[dt][0] * rn * gn[0] * silu(g0), o[dt][1] * rn * gn[1] * silu(g1)); w.y = pk2(o[dt][2] * rn * gn[2] * silu(g2), o[dt][3] * rn * gn[3] * silu(g3));
        *(u32x2*)(MIX + rq * 1024 + 512 + h * 128 + 16 * dt + 4 * fq) = w;
    }
}

DI void gla_c_phase(const Ctx& C, int l) {
    unsigned char* ws = C.ws; const CAS Params& P = *C.p;
    const bf16_t* ZG = (const bf16_t*)(ws + WS_ZG); const bf16_t* QT = (const bf16_t*)(ws + WS_BCUM); const bf16_t* KT = QT + (size_t)TP * 256; const bf16_t* STB = (const bf16_t*)(ws + WS_STB); const bf16_t* VT = (const bf16_t*)(ws + WS_VT);
    bf16_t* MIX = (bf16_t*)(ws + WS_MIX);
    constexpr int PB = 144, U_BYTES = (64 + 128 + 128) * PB;
    const int fr = C.lane & 15, fq = C.lane >> 4, us = C.wave >> 2, qt = C.wave & 3;
    for (int pr = C.bx; pr < 512; pr += C.G) {
#pragma unroll
        for (int uu = 0; uu < 2; ++uu) {
            const int unit = 2 * pr + uu; const int bh = unit >> 6, c = unit & 63, b = bh >> 2, h = bh & 3; const size_t t0 = (size_t)b * SEQ + c * 64;
            LAS unsigned char* base = C.lds + uu * U_BYTES;
            { const int row = C.tid >> 3, c8 = C.tid & 7; *(LAS u32x4*)(base + row * PB + c8 * 16) = *(const u32x4*)(KT + (t0 + row) * 256 + h * 64 + 8 * c8); }
#pragma unroll
            for (int i = 0; i < 2; ++i) {
                const int row = (C.tid >> 3) + 64 * i, c8 = C.tid & 7;
                *(LAS u32x4*)(base + (64 + row) * PB + c8 * 16) = *(const u32x4*)(STB + ((size_t)unit * 128 + row) * 64 + 8 * c8);
                const int vr = (C.tid >> 4) + 32 * i, c16 = C.tid & 15;
                *(LAS u32x4*)(base + 192 * PB + vr * 288 + c16 * 16) = *(const u32x4*)(ZG + (t0 + vr) * 1536 + 512 + h * 128 + 8 * c16);
            }
        }
        const int unit = 2 * pr + us; const int bh = unit >> 6, c = unit & 63, b = bh >> 2, h = bh & 3; const size_t t0 = (size_t)b * SEQ + c * 64;
        const size_t rq = t0 + 16 * qt + fr;
        bf16x8 qf[2];
#pragma unroll
        for (int ks = 0; ks < 2; ++ks) qf[ks] = *(const bf16x8*)(QT + rq * 256 + h * 64 + 32 * ks + 8 * fq);
        __syncthreads();
        LAS unsigned char* Kl = C.lds + us * U_BYTES; LAS unsigned char* Sl = Kl + 64 * PB; LAS unsigned char* Vl = Kl + 192 * PB;
        f32x4 a[4];
#pragma unroll
        for (int kt = 0; kt < 4; ++kt) {
            a[kt] = (f32x4){0.f, 0.f, 0.f, 0.f};
            if (kt <= qt) {
#pragma unroll
                for (int ks = 0; ks < 2; ++ks) {
                    const bf16x8 kf = *(const LAS bf16x8*)(Kl + (16 * kt + fr) * PB + (32 * ks + 8 * fq) * 2);
                    a[kt] = MFMA16(kf, qf[ks], a[kt]);
                }
#pragma unroll
                for (int r = 0; r < 4; ++r) if (16 * kt + 4 * fq + r > 16 * qt + fr) a[kt][r] = 0.f;
            }
        }
        bf16x8 pf[2];
#pragma unroll
        for (int kk = 0; kk < 2; ++kk) { u32x4 w; w.x = pk2(a[2 * kk][0], a[2 * kk][1]); w.y = pk2(a[2 * kk][2], a[2 * kk][3]); w.z = pk2(a[2 * kk + 1][0], a[2 * kk + 1][1]); w.w = pk2(a[2 * kk + 1][2], a[2 * kk + 1][3]); pf[kk] = __builtin_bit_cast(bf16x8, w); }
        f32x4 o[8]; float ss = 0.f;
#pragma unroll
        for (int dt = 0; dt < 8; ++dt) {
            f32x4 acc = (f32x4){0.f, 0.f, 0.f, 0.f};
#pragma unroll
            for (int kk = 0; kk < 2; ++kk) {
                if (2 * kk <= qt) {
                    const LAS unsigned char* vp = Vl + (32 * kk + 4 * fq + (fr >> 2)) * 288 + 32 * dt + 8 * (fr & 3);
                    const u32x2 lo = __builtin_bit_cast(u32x2, __builtin_amdgcn_ds_read_tr16_b64_v4i16((LAS v4i16_t*)vp));
                    const u32x2 hi = __builtin_bit_cast(u32x2, __builtin_amdgcn_ds_read_tr16_b64_v4i16((LAS v4i16_t*)(vp + 16 * 288)));
                    acc = MFMA16(__builtin_bit_cast(bf16x8, (u32x4){lo.x, lo.y, hi.x, hi.y}), pf[kk], acc);
                }
            }
#pragma unroll
            for (int ks = 0; ks < 2; ++ks) {
                const bf16x8 sf = *(const LAS bf16x8*)(Sl + (16 * dt + fr) * PB + (32 * ks + 8 * fq) * 2);
                acc = MFMA16(sf, qf[ks], acc);
            }
            o[dt] = acc; ss += acc[0] * acc[0] + acc[1] * acc[1] + acc[2] * acc[2] + acc[3] * acc[3];
        }
        ss += __shfl_xor(ss, 16); ss += __shfl_xor(ss, 32);
        const float rn = rsqrtf(ss * (1.f / 128.f) + EPS);
#pragma unroll
        for (int dt = 0; dt < 8; ++dt) {
            const f32x4 gn = *(const f32x4*)(P.in[19] + l * 128 + 16 * dt + 4 * fq);
            const u32x2 gw = *(const u32x2*)(ZG + rq * 1536 + 1024 + h * 128 + 16 * dt + 4 * fq);
            const float g0 = blo(gw.x), g1 = bhi(gw.x), g2 = blo(gw.y), g3 = bhi(gw.y);
            u32x2 w; w.x = pk2(o[dt][0] * rn * gn[0] * silu(g0), o[dt][1] * rn * gn[1] * silu(g1)); w.y = pk2(o[dt][2] * rn * gn[2] * silu(g2), o[dt][3] * rn * gn[3] * silu(g3));
            *(u32x2*)(MIX + rq * 1024 + 512 + h * 128 + 16 * dt + 4 * fq) = w;
        }
        __syncthreads();
    }
}

DI void gla_decode_unit(const Ctx& C, int l, int unit) {
    unsigned char* ws = C.ws; const CAS Params& P = *C.p;
    const int b = unit >> 2, h = unit & 3; const size_t rb = (size_t)TP + b * 4;
    const bf16_t* ZG = (const bf16_t*)(ws + WS_ZG); const float* LR = (const float*)(ws + WS_LR); bf16_t* MIX = (bf16_t*)(ws + WS_MIX);
    LAS float* la = (LAS float*)C.lds;
    LAS float* qr = la + 256;
    LAS float* kr = qr + 256;
    LAS float* qe = kr + 256;
    LAS float* ke = qe + 256;
    LAS float* Am = ke + 256;
    LAS float* red = Am + 16;
    LAS float* opart = red + 8;
    if (C.tid < 256) {
        const int tt = C.tid >> 6, dk = C.tid & 63; float x = P.in[18][l * 256 + h * 64 + dk];
        const f32x4 l0 = *(const f32x4*)(LR + (rb + tt) * 16), l1 = *(const f32x4*)(LR + (rb + tt) * 16 + 4), l2 = *(const f32x4*)(LR + (rb + tt) * 16 + 8), l3 = *(const f32x4*)(LR + (rb + tt) * 16 + 12);
        const float* wg = P.in[17] + (size_t)(l * 16) * 256 + h * 64 + dk;
#pragma unroll
        for (int r = 0; r < 4; ++r) { x += l0[r] * wg[r * 256] + l1[r] * wg[(4 + r) * 256] + l2[r] * wg[(8 + r) * 256] + l3[r] * wg[(12 + r) * 256]; }
        la[tt * 64 + dk] = logsig(x) * (1.f / 16.f);
        qr[tt * 64 + dk] = bf2f(ZG[(rb + tt) * 1536 + h * 64 + dk]); kr[tt * 64 + dk] = bf2f(ZG[(rb + tt) * 1536 + 256 + h * 64 + dk]);
    }
    __syncthreads();
    if (C.tid < 64) { float run = 0.f;
#pragma unroll
        for (int tt = 0; tt < 4; ++tt) { run += la[tt * 64 + C.tid]; la[tt * 64 + C.tid] = run; } }
    __syncthreads();
    if (C.tid < 256) {
        const int tt = C.tid >> 6, dk = C.tid & 63; const float bt = la[tt * 64 + dk], b3 = la[3 * 64 + dk];
        qe[tt * 64 + dk] = 0.125f * qr[tt * 64 + dk] * __expf(bt); ke[tt * 64 + dk] = kr[tt * 64 + dk] * __expf(b3 - bt);
    } else if (C.tid < 272) {
        const int tt = (C.tid - 256) >> 2, s = (C.tid - 256) & 3; float sum = 0.f;
        if (s <= tt) for (int dk = 0; dk < 64; ++dk) sum += 0.125f * qr[tt * 64 + dk] * kr[s * 64 + dk] * __expf(la[tt * 64 + dk] - la[s * 64 + dk]);
        Am[C.tid - 256] = sum;
    }
    __syncthreads();
    {
        const int dv = C.tid & 127, dq = C.tid >> 7;
        float v[4], o[4] = {0.f, 0.f, 0.f, 0.f};
#pragma unroll
        for (int tt = 0; tt < 4; ++tt) v[tt] = bf2f(ZG[(rb + tt) * 1536 + 512 + h * 128 + dv]);
        const float* S0p = P.in[4] + ((size_t)(l * 128 + b) * 4 + h) * 8192 + (size_t)(16 * dq) * 128 + dv; float* Sn = C.out + O_GS + ((size_t)(l * 128 + b) * 4 + h) * 8192 + (size_t)(16 * dq) * 128 + dv;
        float S0[16];
#pragma unroll
        for (int i = 0; i < 16; ++i) S0[i] = S0p[i * 128];
#pragma unroll
        for (int i = 0; i < 16; ++i) {
            const int dk = 16 * dq + i;
            float sn = __expf(la[3 * 64 + dk]) * S0[i];
#pragma unroll
            for (int tt = 0; tt < 4; ++tt) { o[tt] += qe[tt * 64 + dk] * S0[i]; sn += ke[tt * 64 + dk] * v[tt]; }
            Sn[i * 128] = sn;
        }
#pragma unroll
        for (int tt = 0; tt < 4; ++tt) opart[(dq * 4 + tt) * 128 + dv] = o[tt];
    }
    __syncthreads();
    {
        const int tt = C.tid >> 7, dv = C.tid & 127;
        float o = opart[(0 * 4 + tt) * 128 + dv] + opart[(1 * 4 + tt) * 128 + dv] + opart[(2 * 4 + tt) * 128 + dv] + opart[(3 * 4 + tt) * 128 + dv];
        for (int s = 0; s <= tt; ++s) o += Am[tt * 4 + s] * bf2f(ZG[(rb + s) * 1536 + 512 + h * 128 + dv]);
        float ss = o * o;
#pragma unroll
        for (int of = 1; of < 64; of <<= 1) ss += __shfl_xor(ss, of);
        if (C.lane == 0) red[C.wave] = ss;
        __syncthreads();
        const float tot = red[2 * tt] + red[2 * tt + 1];
        const float rn = rsqrtf(tot * (1.f / 128.f) + EPS);
        const float gg = bf2f(ZG[(rb + tt) * 1536 + 1024 + h * 128 + dv]);
        const float val = o * rn * P.in[19][l * 128 + dv] * silu(gg);
        MIX[(rb + tt) * 1024 + 512 + h * 128 + dv] = (bf16_t)(pk2(val, 0.f) & 0xffffu);
    }
    __syncthreads();
}

__global__ void __launch_bounds__(512, 2) hymba_fwd(Params prm) {
    extern __shared__ __attribute__((aligned(16))) unsigned char smem[];
    cg::grid_group grid = cg::this_grid();
    Ctx C; C.lds = (LAS unsigned char*)smem; C.tid = threadIdx.x; C.lane = C.tid & 63; C.wave = __builtin_amdgcn_readfirstlane(C.tid >> 6);
    C.G = gridDim.x; C.bx = blockIdx.x; C.p = (const CAS Params*)__builtin_amdgcn_kernarg_segment_ptr(); C.ws = C.p->ws; C.out = C.p->out;
    (void)prm;

    unsigned* barw = (unsigned*)(C.ws + WS_BAR);
    if (C.bx == 0) for (int i = C.tid; i < XCD_BAR_WORDS; i += 512) barw[i] = 0u;
    if (C.tid < 4) ((LAS unsigned*)(C.lds + LDS_BYTES - 16))[C.tid] = 0u;
    grid.sync();
    XcdBarrier xbar = xcd_barrier_post(barw, (volatile LAS unsigned*)(C.lds + LDS_BYTES - 16));
    for (int rep = 0; rep < REP_P0; ++rep) p0_prologue(C);
    xcd_barrier(xbar);
    {   unsigned char* ws = C.ws;
        pg8::Gemm g{(const bf16_t*)(ws + WS_MEMB), (const bf16_t*)(ws + WS_WKV), 1024, 2048, 1024};
        const int n1 = (T / 256) * (5632 / 256);
        pg8::StaticOrder S; S.init(1024, 2048, C.G, (C.bx + C.G - (n1 % C.G)) % C.G);
        Epi<EK_MEM> E; E.c = EpiCtx{}; E.c.rss_in = (const float*)(ws + WS_RSSM); E.c.MKV = (float*)(ws + WS_MKV);
        pg8::gemm_phase(C.lds, C.tid, g, S, E);
    }
    int rep = 0;
    for (int ph = 0; ph < 24; ++ph) {
        { int t_ = threadIdx.x; asm volatile("" : "+v"(t_)); C.tid = t_; C.lane = t_ & 63; C.wave = __builtin_amdgcn_readfirstlane(t_ >> 6); }
        asm volatile("" : "+s"(C.ws), "+s"(C.out), "+s"(C.p));
        unsigned char* ws = C.ws; float* RSS = (float*)(ws + WS_RSS);
        const int l = ph / 12, k = ph - 12 * l;
        unsigned char* wl = ws + WS_WL + (size_t)l * WL_SIZE;
        EpiCtx ec{}; ec.l = l;
        if (k == 0 || k == 10) {
            pg8::Gemm g{(const bf16_t*)(ws + WS_XB), (const bf16_t*)(wl + (k == 0 ? WL_W1 : WL_W2)), T, 5632, 1024};
            pg8::StaticOrder S; S.init(T, 5632, C.G, C.bx);
            ec.rss_in = RSS + (size_t)(4 * l + (k == 0 ? 0 : 3)) * T; ec.H = (bf16_t*)(ws + WS_H);
            Epi<EK_SWIGLU> E; E.c = ec; pg8::gemm_phase(C.lds, C.tid, g, S, E);
            if (ph == 0 && rep == 0) convert_in_slack(C, 0, T_WD1, 688, (T / 256) * 22 + 32);
            if (ph == 10 && rep == 0) convert_in_slack(C, 1, 704, T_WKV, (T / 256) * 22);
        } else if (k == 1 || k == 6 || k == 9 || k == 11) {
            const bf16_t* A; const bf16_t* B; int K; float sc; int ro;
            if (k == 1) { A = (const bf16_t*)(ws + WS_H); B = (const bf16_t*)(wl + WL_WD1); K = FF; sc = 0.5f; ro = 4 * l + 1; }
            else if (k == 6) { A = (const bf16_t*)(ws + WS_MIX); B = (const bf16_t*)(wl + WL_WOUT); K = 1024; sc = 1.f; ro = 4 * l + 2; }
            else if (k == 9) { A = (const bf16_t*)(ws + WS_OX); B = (const bf16_t*)(wl + WL_WO); K = 512; sc = 1.f; ro = 4 * l + 3; }
            else { A = (const bf16_t*)(ws + WS_H); B = (const bf16_t*)(wl + WL_WD2); K = FF; sc = 0.5f; ro = 4 * l + 4; }
            pg8::Gemm g{A, B, TP, 1024, K};
            pg8::StaticOrder S; S.init(TP, 1024, C.G, C.bx);
            ec.rss_out = RSS + (size_t)ro * T; ec.X = (ph == 23) ? C.out : nullptr; ec.XB = (bf16_t*)(ws + WS_XB); ec.scale = sc;
            Epi<EK_RES> E; E.c = ec; pg8::gemm_phase(C.lds, C.tid, g, S, E);
            thin_res_gemm(C, A, B, K, sc, RSS + (size_t)ro * T, (ph == 23) ? C.out : nullptr);
        } else if (k == 2) {
            pg8::Gemm g{(const bf16_t*)(ws + WS_XB), (const bf16_t*)(wl + WL_WIN), T, INWP, 1024};
            pg8::StaticOrder S; S.init(T, INWP, C.G, C.bx);
            ec.rss_in = RSS + (size_t)(4 * l + 1) * T; ec.QS = (bf16_t*)(ws + WS_QS); ec.KS = (bf16_t*)(ws + WS_KS); ec.VS = (bf16_t*)(ws + WS_VS); ec.ZG = (bf16_t*)(ws + WS_ZG);
            ec.LR = (float*)(ws + WS_LR); ec.rope = (const float2*)(ws + WS_ROPE); ec.gq = C.p->in[14] + l * 64; ec.gk = C.p->in[15] + l * 64;
            ec.okp = C.out + O_KP; ec.ovp = C.out + O_VP; ec.oks = C.out + O_KS; ec.ovs = C.out + O_VS;
            Epi<EK_WIN> E; E.c = ec; pg8::gemm_phase(C.lds, C.tid, g, S, E);
            if (ph == 2 && rep == 0) convert_in_slack(C, 0, 688, T_WKV, (T / 256) * 10);
        } else if (k == 3) {
            for (int u = C.bx; u < 256; u += C.G) swa_prompt_unit(C, l, u);
            gla_a_phase(C, l);
        } else if (k == 4) {
            gla_scan(C, l);
            for (int u = C.bx; u < 512; u += C.G) gla_decode_unit(C, l, u);
            for (int u = C.bx; u < 256; u += C.G) swa_decode_unit(C, l, u);
        } else if (k == 5) {
            gla_c_phase(C, l);
        } else if (k == 7) {
            pg8::Gemm g{(const bf16_t*)(ws + WS_XB), (const bf16_t*)(wl + WL_WQ), T, 512, 1024};
            pg8::StaticOrder S; S.init(T, 512, C.G, C.bx);
            ec.rss_in = RSS + (size_t)(4 * l + 2) * T; ec.QX = (bf16_t*)(ws + WS_QX);
            Epi<EK_XQ> E; E.c = ec; pg8::gemm_phase(C.lds, C.tid, g, S, E);
            if (ph == 7 && rep == 0) convert_in_slack(C, 1, 0, 704, (T / 256) * 2);
        } else {
            if (C.G == 256) {
                if (C.bx < 128) { xattn_unit(C, l, C.bx); xattn_unit(C, l, 128 + C.bx); }
                else for (int i = 0; i < 3; ++i) xattn_unit(C, l, 128 + 128 + 3 * (C.bx - 128) + i);
            } else for (int u = C.bx; u < 640; u += C.G) xattn_unit(C, l, u);
        }
        if (ph != 23) for (int r2 = 0; r2 < REP_SYNC; ++r2) xcd_barrier(xbar);
        {
            const int want = (k == 0 || k == 2 || k == 7 || k == 10) ? REP_GEMM : (k == 3 ? REP3 : (k == 4 ? REP4 : k == 5 ? REP5 : (k == 8 ? REP8 : 1)));
            if (rep + 1 < want) { ++rep; --ph; } else rep = 0;
        }
    }
}

extern "C" void kernel_launch(void* const* d_in, const int* in_sizes, int n_in, void* d_out, int out_size, void* d_ws, size_t ws_size, hipStream_t stream) {
    static int grid = 0;
    if (grid == 0) {
        if (n_in != 33 || ws_size < WS_TOTAL) { fprintf(stderr, "kernel_launch: need 33 inputs and %zu bytes of workspace; got %d inputs, %zu bytes\n", (size_t)WS_TOTAL, n_in, ws_size); grid = -1; return; }
        int dev = 0, cus = 0, per_cu = 0;
        (void)hipGetDevice(&dev); (void)hipDeviceGetAttribute(&cus, hipDeviceAttributeMultiprocessorCount, dev);
        if (hipFuncSetAttribute((const void*)hymba_fwd, hipFuncAttributeMaxDynamicSharedMemorySize, LDS_BYTES) != hipSuccess) { fprintf(stderr, "kernel_launch: hipFuncSetAttribute failed\n"); grid = -1; return; }
        if (hipOccupancyMaxActiveBlocksPerMultiprocessor(&per_cu, (const void*)hymba_fwd, 512, LDS_BYTES) != hipSuccess || per_cu < 1) { fprintf(stderr, "kernel_launch: occupancy query gave %d\n", per_cu); grid = -1; return; }
        grid = cus * per_cu;
    }
    if (grid < 0) return;
    Params p{};
    for (int i = 0; i < 33; ++i) p.in[i] = (const float*)d_in[i];
    p.out = (float*)d_out; p.ws = (unsigned char*)d_ws;
    void* args[] = {&p};
    hipError_t e = hipLaunchCooperativeKernel((const void*)hymba_fwd, dim3(grid), dim3(512), args, LDS_BYTES, stream);
    if (e != hipSuccess) fprintf(stderr, "kernel_launch: cooperative launch failed: %s (grid %d)\n", hipGetErrorString(e), grid);
}
```

```cpp
#include <hip/hip_runtime.h>
#include <hip/hip_cooperative_groups.h>
#include <cstdio>
#include <cstdint>
namespace cg = cooperative_groups;

#define LAS __attribute__((address_space(3)))
#define DI __device__ __forceinline__
typedef unsigned short bf16_t;
typedef short bf16x8 __attribute__((ext_vector_type(8)));
typedef float f32x4 __attribute__((ext_vector_type(4)));
typedef unsigned u32x4 __attribute__((ext_vector_type(4)));
typedef unsigned u32x2 __attribute__((ext_vector_type(2)));
typedef short v4i16_t __attribute__((ext_vector_type(4)));
#define MFMA16(a, b, c) __builtin_amdgcn_mfma_f32_16x16x32_bf16((a), (b), (c), 0, 0, 0)

constexpr int TP = 16384, TS = 512, T = TP + TS, DM = 1024, FF = 2816, SEQ = 4096;
constexpr int INWP = 2560;
constexpr float EPS = 1e-6f;
constexpr size_t O_Y = 0, O_KP = 17301504, O_VP = 17432576, O_GP = 17563648, O_MKP = 17825792, O_MVP = 18874368, O_KS = 19922944, O_VS = 24117248, O_GS = 28311552;
constexpr size_t al(size_t x) { return (x + 4095) & ~(size_t)4095; }
constexpr size_t WS_RSS = 0;
constexpr size_t WS_RSSM = al(WS_RSS + (size_t)9 * T * 4);
constexpr size_t WS_ROPE = al(WS_RSSM + 1024 * 4);
constexpr size_t WS_XB = al(WS_ROPE + (size_t)4100 * 32 * 8);
constexpr size_t WS_H = al(WS_XB + (size_t)T * 1024 * 2);
constexpr size_t WS_QS = al(WS_H + (size_t)T * FF * 2);
constexpr size_t WS_KS = al(WS_QS + (size_t)T * 512 * 2);
constexpr size_t WS_VS = al(WS_KS + (size_t)T * 128 * 2);
constexpr size_t WS_ZG = al(WS_VS + (size_t)T * 128 * 2);
constexpr size_t WS_LR = al(WS_ZG + (size_t)T * 1536 * 2);
constexpr size_t WS_MIX = al(WS_LR + (size_t)T * 16 * 4);
constexpr size_t WS_QX = al(WS_MIX + (size_t)T * 1024 * 2);
constexpr size_t WS_OX = al(WS_QX + (size_t)T * 512 * 2);
constexpr size_t WS_MEMB = al(WS_OX + (size_t)T * 512 * 2);
constexpr size_t WS_MKV = al(WS_MEMB + (size_t)1024 * 1024 * 2);
constexpr size_t WS_BCUM = al(WS_MKV + (size_t)1024 * 2048 * 4);
constexpr size_t WS_ST = al(WS_BCUM + (size_t)TP * 256 * 4);
constexpr size_t WS_VT = al(WS_ST + (size_t)1024 * 8192 * 4);
constexpr size_t WS_DEC = al(WS_VT + (size_t)1024 * 8192 * 2);
constexpr size_t WS_WKV = al(WS_DEC + (size_t)1024 * 64 * 4);
constexpr size_t WS_WL = al(WS_WKV + (size_t)2048 * 1024 * 2);
constexpr size_t WL_W1 = 0;
constexpr size_t WL_WD1 = WL_W1 + (size_t)5632 * 1024 * 2;
constexpr size_t WL_WIN = WL_WD1 + (size_t)1024 * FF * 2;
constexpr size_t WL_WOUT = WL_WIN + (size_t)INWP * 1024 * 2;
constexpr size_t WL_WQ = WL_WOUT + (size_t)1024 * 1024 * 2;
constexpr size_t WL_WO = WL_WQ + (size_t)512 * 1024 * 2;
constexpr size_t WL_W2 = WL_WO + (size_t)1024 * 512 * 2;
constexpr size_t WL_WD2 = WL_W2 + (size_t)5632 * 1024 * 2;
constexpr size_t WL_SIZE = al(WL_WD2 + (size_t)1024 * FF * 2);
constexpr size_t WS_STB = WS_WL + 2 * WL_SIZE;
constexpr size_t WS_BAR = al(WS_STB + (size_t)1024 * 8192 * 2);
constexpr size_t WS_TOTAL = WS_BAR + 16384;
constexpr int LDS_BYTES = 147456;
constexpr int REP_GEMM = 1, REP_ATT = 1, REP_P0 = 1, REP_SYNC = 1, REP3 = 1, REP4 = 1, REP5 = 1, REP8 = 1;

DI float bf2f(unsigned h) { return __builtin_bit_cast(float, h << 16); }
typedef float f32x2_t __attribute__((ext_vector_type(2)));
typedef __bf16 bf16x2_t __attribute__((ext_vector_type(2)));
DI unsigned pk2(float lo, float hi) { const f32x2_t v = {lo, hi}; const bf16x2_t b = __builtin_convertvector(v, bf16x2_t); return __builtin_bit_cast(unsigned, b); }
DI float blo(unsigned w) { return __builtin_bit_cast(float, w << 16); }
DI float bhi(unsigned w) { return __builtin_bit_cast(float, w & 0xffff0000u); }
DI float silu(float x) { return x * __builtin_amdgcn_rcpf(1.f + __builtin_amdgcn_exp2f(x * -1.4426950408889634f)); }
DI float logsig(float x) { return fminf(x, 0.f) - __logf(1.f + __expf(-fabsf(x))); }

#define XB_TMO      128
#define XB_XCNT(j)  (256  + 64 * (j))
#define XB_XSUB(j)  (1280 + 64 * (j))
#define XB_XGEN(j)  (2304 + 64 * (j))
#define XB_TOP      3328
#define XB_TOPGEN   3392
#define XCD_BAR_WORDS 3456
#define XB_SPIN_CAP (1u << 18)
DI unsigned xb_ld(unsigned* p)              { return __hip_atomic_load(p, __ATOMIC_RELAXED, __HIP_MEMORY_SCOPE_AGENT); }
DI unsigned xb_add(unsigned* p, unsigned v) { return __hip_atomic_fetch_add(p, v, __ATOMIC_RELAXED, __HIP_MEMORY_SCOPE_AGENT); }
DI unsigned xb_xcc_id() { return (unsigned)__builtin_amdgcn_s_getreg((3 << 11) | 20) & 0xFu; }
#define XB_SPIN(cond, bar) do { unsigned _sp = 0; while (cond) { __builtin_amdgcn_s_sleep(1); \
    if ((++_sp & 255u) == 0u) { if (xb_ld(&(bar)[XB_TMO])) break; if (_sp > XB_SPIN_CAP) { atomicAdd(&(bar)[XB_TMO], 1u); break; } } } } while (0)
struct XcdBarrier { unsigned* bar; unsigned x; volatile LAS unsigned* st; };
DI XcdBarrier xcd_barrier_post(unsigned* bar, volatile LAS unsigned* st) {
    XcdBarrier b; b.bar = bar; b.x = xb_xcc_id(); b.st = st;
    if (threadIdx.x == 0) (void)xb_add(&bar[XB_XCNT(b.x)], 1u);
    return b;
}
DI void xcd_barrier_complete(unsigned* bar, unsigned x, unsigned& nloc, unsigned& nx) {
    const unsigned G = gridDim.x * gridDim.y * gridDim.z;
    unsigned sum, cnt, mine, sp = 0u;
    for (;;) {
        sum = 0u; cnt = 0u; mine = 0u;
#pragma unroll
        for (unsigned j = 0; j < 16; ++j) { const unsigned c = xb_ld(&bar[XB_XCNT(j)]); sum += c; cnt += (c > 0u) ? 1u : 0u; mine = (j == x) ? c : mine; }
        if (sum == G) break;
        __builtin_amdgcn_s_sleep(1);
        if ((++sp & 255u) == 0u) { if (xb_ld(&bar[XB_TMO])) break; if (sp > XB_SPIN_CAP) { atomicAdd(&bar[XB_TMO], 1u); break; } }
    }
    nloc = mine > 0u ? mine : 1u; nx = cnt > 0u ? cnt : 1u;
}
DI void xcd_barrier(const XcdBarrier& b) {
    asm volatile("s_waitcnt vmcnt(0)" ::: "memory");
    __syncthreads();
    if (threadIdx.x == 0) {
        unsigned* bar = b.bar;
        __builtin_amdgcn_s_waitcnt(0);
        unsigned nloc = b.st[0], nx = b.st[1];
        if (nloc == 0u) { xcd_barrier_complete(bar, b.x, nloc, nx); b.st[0] = nloc; b.st[1] = nx; }
        const unsigned old = xb_add(&bar[XB_XSUB(b.x)], 1u);
        const unsigned gen = old / nloc;
        if (old + 1u == (gen + 1u) * nloc) {
            __builtin_amdgcn_fence(__ATOMIC_RELEASE, "agent");
            asm volatile("s_waitcnt vmcnt(0)" ::: "memory");
            const unsigned og = xb_add(&bar[XB_TOP], 1u);
            const unsigned tg = og / nx;
            if (og + 1u == (tg + 1u) * nx) xb_add(&bar[XB_TOPGEN], 1u);
            else XB_SPIN(xb_ld(&bar[XB_TOPGEN]) == tg, bar);
            __builtin_amdgcn_fence(__ATOMIC_ACQUIRE, "agent");
            xb_add(&bar[XB_XGEN(b.x)], 1u);
            asm volatile("s_waitcnt vmcnt(0)" ::: "memory");
        } else {
            XB_SPIN(xb_ld(&bar[XB_XGEN(b.x)]) == gen, bar);
            __builtin_amdgcn_fence(__ATOMIC_ACQUIRE, "agent");
            asm volatile("s_waitcnt vmcnt(0)" ::: "memory");
        }
    }
    __syncthreads();
}

namespace pg8 {
constexpr int BM = 256, BK = 64, HALF = 128, HTB = HALF * BK * 2, STAGE_BYTES = 8 * HTB, NXCD = 8, WGM = 8;
DI int lds_byte(int r, int c) { const int st = (r >> 4) * 2 + (c >> 5), rr = r & 15, cc = c & 31, ob = rr * 64 + cc * 2; return st * 1024 + (ob ^ (((ob >> 9) & 1) << 5)); }
DI void stage_rc(int b, int& R, int& C) { const int st = b / 1024, sb = b % 1024, swz = sb ^ (((sb >> 9) & 1) << 5); R = (st >> 1) * 16 + swz / 64; C = (st & 1) * 32 + (swz % 64) / 2; }
DI int perm32(int rho) { const int n = rho >> 4, i = rho & 15; return 8 * (i >> 2) + 4 * n + (i & 3); }
struct Unit { int pm, pn; };
struct Gemm { const bf16_t* A; const bf16_t* Bt; int M, N, K; };
struct StaticOrder {
    int nM, nN, nwg, G, c;
    DI void init(int M, int N, int G_, int c_) { nM = M / BM; nN = N / BM; nwg = nM * nN; G = G_; c = c_; }
    DI bool next(int i, Unit& u) const {
        const long L = (long)i * G + c; if (L >= nwg) return false;
        int wgid = (int)L; { const int q = nwg / NXCD, r = nwg % NXCD, xcd = wgid % NXCD, off = wgid / NXCD; wgid = (xcd < r ? xcd * (q + 1) : r * (q + 1) + (xcd - r) * q) + off; }
        const int nig = WGM * nN, gid = wgid / nig, fm = gid * WGM, gsz = (nM - fm) < WGM ? (nM - fm) : WGM;
        u.pm = fm + ((wgid % nig) % gsz); u.pn = (wgid % nig) / gsz; return true;
    }
};
template <class Epi, class Sched>
DI void gemm_phase(LAS unsigned char* lds, const int tid, const Gemm g, const Sched& S, const Epi& E) {
    const int wid = __builtin_amdgcn_readfirstlane(tid >> 6), lane = tid & 63, wr = wid >> 2, wc = wid & 3, fr = lane & 15, fq = lane >> 4;
    const int K = g.K, nt = K / BK;
    unsigned voffA[2], voffB[2];
#pragma unroll
    for (int i = 0; i < 2; ++i) { int R, C; stage_rc(tid * 16 + i * 8192, R, C); const int Rb = (R & ~31) + perm32(R & 31);
        voffA[i] = (unsigned)(R * K + C) * 2u; voffB[i] = (unsigned)(Rb * K + C) * 2u; }
    const size_t kstep = (size_t)(BK * 2);
    const size_t hstep = (size_t)HALF * K * 2;
    const size_t tstep = 2 * hstep;
    const unsigned ldsw = (unsigned)wid * 1024u;
    const int aoff = lds_byte(wr * 64 + fr, fq * 8), boff = lds_byte(wc * 32 + fr, fq * 8);
#define PG8_SA(b, h) (((b) * 2 + (h)) * HTB)
#define PG8_SB(b, h) ((4 + (b) * 2 + (h)) * HTB)
#define PG8_STAGE(bufoff, gbase, voff) do { _Pragma("unroll") for (int _i = 0; _i < 2; ++_i) \
        __builtin_amdgcn_global_load_lds((const unsigned*)((const char*)(gbase) + (voff)[_i]), (LAS unsigned*)(lds + (bufoff) + ldsw + _i * 8192), 16, 0, 0); } while (0)
#define PG8_LDA(dst, b, h) do { _Pragma("unroll") for (int m = 0; m < 4; ++m) _Pragma("unroll") for (int k = 0; k < 2; ++k) dst[m][k] = *(const LAS bf16x8*)(lds + PG8_SA(b, h) + aoff + m * 2048 + k * 1024); } while (0)
#define PG8_LDB(dst, b, h) do { _Pragma("unroll") for (int n = 0; n < 2; ++n) _Pragma("unroll") for (int k = 0; k < 2; ++k) dst[n][k] = *(const LAS bf16x8*)(lds + PG8_SB(b, h) + boff + n * 2048 + k * 1024); } while (0)
#define PG8_MMA(ai, bj, At, Bt) do { __builtin_amdgcn_s_setprio(1); _Pragma("unroll") for (int m = 0; m < 4; ++m) _Pragma("unroll") for (int n = 0; n < 2; ++n) _Pragma("unroll") for (int k = 0; k < 2; ++k) \
        acc[ai][bj][m][n] = __builtin_amdgcn_mfma_f32_16x16x32_bf16(Bt[n][k], At[m][k], acc[ai][bj][m][n], 0, 0, 0); __builtin_amdgcn_s_setprio(0); } while (0)
#define PG8_WAIT_V(n) asm volatile("s_waitcnt vmcnt(" #n ")" ::: "memory")
#define PG8_WAIT_L(n) asm volatile("s_waitcnt lgkmcnt(" #n ")" ::: "memory")
#define PG8_BAR __builtin_amdgcn_s_barrier()
#define PG8_SCHED __builtin_amdgcn_sched_barrier(0)
    Unit cur, nxt; int ui = 0;
    if (!S.next(0, cur)) return;
    f32x4 acc[2][2][4][2];
#pragma unroll
    for (int a = 0; a < 2; ++a)
#pragma unroll
        for (int b = 0; b < 2; ++b)
#pragma unroll
            for (int m = 0; m < 4; ++m)
#pragma unroll
                for (int n = 0; n < 2; ++n) acc[a][b][m][n] = (f32x4){0.f, 0.f, 0.f, 0.f};
    bf16x8 At[4][2], B0[2][2], B1[2][2];
    const char* cA = (const char*)g.A + (size_t)cur.pm * tstep; const char* cB = (const char*)g.Bt + (size_t)cur.pn * tstep;
    PG8_STAGE(PG8_SB(0, 0), cB, voffB); PG8_STAGE(PG8_SB(0, 1), cB + hstep, voffB); PG8_STAGE(PG8_SA(0, 0), cA, voffA); PG8_STAGE(PG8_SA(0, 1), cA + hstep, voffA);
    if (wr == 1) PG8_BAR;
    PG8_WAIT_V(2); PG8_BAR;
    PG8_STAGE(PG8_SB(1, 0), cB + kstep, voffB); PG8_STAGE(PG8_SA(1, 0), cA + kstep, voffA); PG8_STAGE(PG8_SB(1, 1), cB + hstep + kstep, voffB);
    PG8_WAIT_V(6); PG8_BAR;
    for (;;) {
        const bool has_next = S.next(ui + 1, nxt);
        const char* nA = has_next ? (const char*)g.A + (size_t)nxt.pm * tstep : cA; const char* nB = has_next ? (const char*)g.Bt + (size_t)nxt.pn * tstep : cB;
        for (int t = 0; t < nt; t += 2) {
            const bool last = (t == nt - 2);
            const char* a1 = cA + (size_t)(t + 1) * kstep;
            const char* a2 = last ? nA : cA + (size_t)(t + 2) * kstep; const char* b2 = last ? nB : cB + (size_t)(t + 2) * kstep;
            const char* a3 = a2 + kstep; const char* b3 = b2 + kstep;
            PG8_LDB(B0, 0, 0); PG8_LDB(B1, 0, 1); PG8_SCHED; PG8_LDA(At, 0, 0); PG8_STAGE(PG8_SA(1, 1), a1 + hstep, voffA);
            PG8_WAIT_V(8); PG8_WAIT_L(0); PG8_BAR; PG8_MMA(0, 0, At, B0); PG8_MMA(0, 1, At, B1); PG8_BAR; PG8_SCHED;
            PG8_LDA(At, 0, 1); PG8_STAGE(PG8_SB(0, 0), b2, voffB); PG8_STAGE(PG8_SB(0, 1), b2 + hstep, voffB); PG8_STAGE(PG8_SA(0, 0), a2, voffA);
            PG8_WAIT_V(8); PG8_WAIT_L(0); PG8_BAR; PG8_MMA(1, 0, At, B0); PG8_MMA(1, 1, At, B1); PG8_BAR; PG8_SCHED;
            PG8_LDB(B0, 1, 0); PG8_LDB(B1, 1, 1); PG8_SCHED; PG8_LDA(At, 1, 0); PG8_STAGE(PG8_SA(0, 1), a2 + hstep, voffA);
            PG8_WAIT_V(8); PG8_WAIT_L(0); PG8_BAR; PG8_MMA(0, 0, At, B0); PG8_MMA(0, 1, At, B1); PG8_BAR; PG8_SCHED;
            PG8_LDA(At, 1, 1); PG8_STAGE(PG8_SB(1, 0), b3, voffB); PG8_STAGE(PG8_SB(1, 1), b3 + hstep, voffB); PG8_STAGE(PG8_SA(1, 0), a3, voffA);
            PG8_WAIT_V(8); PG8_WAIT_L(0); PG8_BAR; PG8_MMA(1, 0, At, B0); PG8_MMA(1, 1, At, B1); PG8_BAR; PG8_SCHED;
        }
        if (wr == 0) PG8_BAR;
        E(acc, cur, wr, wc, fr, fq);
        if (!has_next) break;
#pragma unroll
        for (int a = 0; a < 2; ++a)
#pragma unroll
            for (int b = 0; b < 2; ++b)
#pragma unroll
                for (int m = 0; m < 4; ++m)
#pragma unroll
                    for (int n = 0; n < 2; ++n) acc[a][b][m][n] = (f32x4){0.f, 0.f, 0.f, 0.f};
        cur = nxt; cA = nA; cB = nB; ++ui;
        if (wr == 1) PG8_BAR;
    }
    PG8_WAIT_V(0);
    PG8_BAR;
#undef PG8_SA
#undef PG8_SB
#undef PG8_STAGE
#undef PG8_LDA
#undef PG8_LDB
#undef PG8_MMA
#undef PG8_WAIT_V
#undef PG8_WAIT_L
#undef PG8_BAR
#undef PG8_SCHED
}
}

struct EpiCtx {
    const float* rss_in; float* rss_out; float* X; bf16_t* XB; bf16_t* H;
    bf16_t *QS, *KS, *VS, *ZG; float* LR; const float2* rope; const float *gq, *gk;
    float *okp, *ovp, *oks, *ovs; bf16_t* QX; float* MKV; float scale; int l;
};
enum { EK_SWIGLU = 0, EK_RES = 1, EK_WIN = 2, EK_XQ = 3, EK_MEM = 4 };
template <int KIND> struct Epi {
    EpiCtx c;
    DI void operator()(const f32x4 (&acc)[2][2][4][2], const pg8::Unit& u, int wr, int wc, int fr, int fq) const {
        const int row0 = u.pm * 256 + wr * 64 + fr;
        const int cl = wc * 32 + 8 * fq;
        if constexpr (KIND == EK_RES) {
            u32x4 xo[2][4][2];
#pragma unroll
            for (int ai = 0; ai < 2; ++ai)
#pragma unroll
                for (int m = 0; m < 4; ++m)
#pragma unroll
                    for (int bj = 0; bj < 2; ++bj) xo[ai][m][bj] = *(const u32x4*)(c.XB + (size_t)(row0 + ai * 128 + m * 16) * DM + u.pn * 256 + bj * 128 + cl);
#pragma unroll
            for (int ai = 0; ai < 2; ++ai)
#pragma unroll
                for (int m = 0; m < 4; ++m) {
                    const int r = row0 + ai * 128 + m * 16;
                    float ss = 0.f;
#pragma unroll
                    for (int bj = 0; bj < 2; ++bj) {
                        bf16_t* xb = c.XB + (size_t)r * DM + u.pn * 256 + bj * 128 + cl;
                        const u32x4 xv = xo[ai][m][bj];
                        f32x4 x0 = (f32x4){blo(xv[0]), bhi(xv[0]), blo(xv[1]), bhi(xv[1])}, x1 = (f32x4){blo(xv[2]), bhi(xv[2]), blo(xv[3]), bhi(xv[3])};
                        x0 = x0 + acc[ai][bj][m][0] * c.scale; x1 = x1 + acc[ai][bj][m][1] * c.scale;
                        if (c.X) { float* xp = c.X + (size_t)r * DM + u.pn * 256 + bj * 128 + cl; *(f32x4*)xp = x0; *(f32x4*)(xp + 4) = x1; }
                        else {
                            u32x4 w; w.x = pk2(x0[0], x0[1]); w.y = pk2(x0[2], x0[3]); w.z = pk2(x1[0], x1[1]); w.w = pk2(x1[2], x1[3]);
                            *(u32x4*)xb = w;
#pragma unroll
                            for (int e = 0; e < 4; ++e) { const float a0 = blo(w[e]), a1 = bhi(w[e]); ss += a0 * a0 + a1 * a1; }
                        }
                    }
                    if (!c.X) { ss += __shfl_xor(ss, 16); ss += __shfl_xor(ss, 32); if (fq == 0) atomicAdd(c.rss_out + r, ss); }
                }
            return;
        }
#pragma unroll
        for (int ai = 0; ai < 2; ++ai)
#pragma unroll
            for (int m = 0; m < 4; ++m) {
                const int r = row0 + ai * 128 + m * 16;
                if constexpr (KIND == EK_SWIGLU) {
                    const float rs = rsqrtf(c.rss_in[r] * (1.f / 1024.f) + EPS);
                    const float rsn = rs * -1.4426950408889634f, rs2 = rs * rs;
                    float hv[8];
#pragma unroll
                    for (int n = 0; n < 2; ++n)
#pragma unroll
                        for (int j = 0; j < 4; ++j) { const float g0 = acc[ai][0][m][n][j], u0 = acc[ai][1][m][n][j];
                            hv[n * 4 + j] = (g0 * u0) * rs2 * __builtin_amdgcn_rcpf(1.f + __builtin_amdgcn_exp2f(g0 * rsn)); }
                    u32x4 w; w.x = pk2(hv[0], hv[1]); w.y = pk2(hv[2], hv[3]); w.z = pk2(hv[4], hv[5]); w.w = pk2(hv[6], hv[7]);
                    *(u32x4*)(c.H + (size_t)r * FF + u.pn * 128 + cl) = w;
                } else if constexpr (KIND == EK_XQ) {
                    const float rs = rsqrtf(c.rss_in[r] * (1.f / 1024.f) + EPS);
#pragma unroll
                    for (int bj = 0; bj < 2; ++bj) {
                        const f32x4 a0 = acc[ai][bj][m][0] * rs, a1 = acc[ai][bj][m][1] * rs;
                        u32x4 w; w.x = pk2(a0[0], a0[1]); w.y = pk2(a0[2], a0[3]); w.z = pk2(a1[0], a1[1]); w.w = pk2(a1[2], a1[3]);
                        *(u32x4*)(c.QX + (size_t)r * 512 + u.pn * 256 + bj * 128 + cl) = w;
                    }
                } else if constexpr (KIND == EK_MEM) {
                    const float rs = rsqrtf(c.rss_in[r] * (1.f / 1024.f) + EPS);
#pragma unroll
                    for (int bj = 0; bj < 2; ++bj) {
                        float* p = c.MKV + (size_t)r * 2048 + u.pn * 256 + bj * 128 + cl;
                        *(f32x4*)p = acc[ai][bj][m][0] * rs; *(f32x4*)(p + 4) = acc[ai][bj][m][1] * rs;
                    }
                } else {
                    const float rs = rsqrtf(c.rss_in[r] * (1.f / 1024.f) + EPS);
                    const int pn = u.pn;
                    if (pn < 2 || (pn == 2 && wc < 2)) {
                        const bool isq = pn < 2; const int head = isq ? (4 * pn + wc) : wc;
                        const float* gn = isq ? c.gq : c.gk;
                        float ss = 0.f;
#pragma unroll
                        for (int bj = 0; bj < 2; ++bj)
#pragma unroll
                            for (int n = 0; n < 2; ++n)
#pragma unroll
                                for (int j = 0; j < 4; ++j) { const float v = acc[ai][bj][m][n][j] * rs; ss += v * v; }
                        ss += __shfl_xor(ss, 16); ss += __shfl_xor(ss, 32);
                        const float rq = rsqrtf(ss * (1.f / 64.f) + EPS) * rs;
                        const int ridx = r < TP ? (r & (SEQ - 1)) : (4096 + (r & 3));
                        const float2* rp = c.rope + (size_t)ridx * 32 + 8 * fq;
                        float o1[8], o2[8];
#pragma unroll
                        for (int n = 0; n < 2; ++n)
#pragma unroll
                            for (int j = 0; j < 4; ++j) {
                                const int d = 8 * fq + 4 * n + j; const float2 cs = rp[4 * n + j];
                                const float y1 = acc[ai][0][m][n][j] * rq * gn[d], y2 = acc[ai][1][m][n][j] * rq * gn[32 + d];
                                o1[4 * n + j] = y1 * cs.x - y2 * cs.y; o2[4 * n + j] = y2 * cs.x + y1 * cs.y;
                            }
                        if (isq) {
#pragma unroll
                            for (int e = 0; e < 8; ++e) { o1[e] *= 0.125f; o2[e] *= 0.125f; }
                        }
                        u32x4 w1, w2; w1.x = pk2(o1[0], o1[1]); w1.y = pk2(o1[2], o1[3]); w1.z = pk2(o1[4], o1[5]); w1.w = pk2(o1[6], o1[7]);
                        w2.x = pk2(o2[0], o2[1]); w2.y = pk2(o2[2], o2[3]); w2.z = pk2(o2[4], o2[5]); w2.w = pk2(o2[6], o2[7]);
                        if (isq) { bf16_t* p = c.QS + (size_t)r * 512 + head * 64 + 8 * fq; *(u32x4*)p = w1; *(u32x4*)(p + 32) = w2; }
                        else {
                            bf16_t* p = c.KS + (size_t)r * 128 + head * 64 + 8 * fq; *(u32x4*)p = w1; *(u32x4*)(p + 32) = w2;
                            float* op = nullptr;
                            if (r < TP) { const int t = r & (SEQ - 1); if (t >= SEQ - 128) op = c.okp + ((size_t)((c.l * 4 + (r >> 12)) * 128 + (t - (SEQ - 128)))) * 128; }
                            else { const int rr = r - TP; op = c.oks + ((size_t)((c.l * 128 + (rr >> 2)) * 128 + 124 + (rr & 3))) * 128; }
                            if (op) { op += head * 64 + 8 * fq;
                                *(f32x4*)op = (f32x4){o1[0], o1[1], o1[2], o1[3]}; *(f32x4*)(op + 4) = (f32x4){o1[4], o1[5], o1[6], o1[7]};
                                *(f32x4*)(op + 32) = (f32x4){o2[0], o2[1], o2[2], o2[3]}; *(f32x4*)(op + 36) = (f32x4){o2[4], o2[5], o2[6], o2[7]}; }
                        }
                    } else if (pn == 2) {
                        const int head = wc - 2;
                        float* op = nullptr;
                        if (r < TP) { const int t = r & (SEQ - 1); if (t >= SEQ - 128) op = c.ovp + ((size_t)((c.l * 4 + (r >> 12)) * 128 + (t - (SEQ - 128)))) * 128; }
                        else { const int rr = r - TP; op = c.ovs + ((size_t)((c.l * 128 + (rr >> 2)) * 128 + 124 + (rr & 3))) * 128; }
#pragma unroll
                        for (int bj = 0; bj < 2; ++bj) {
                            const f32x4 a0 = acc[ai][bj][m][0] * rs, a1 = acc[ai][bj][m][1] * rs;
                            u32x4 w; w.x = pk2(a0[0], a0[1]); w.y = pk2(a0[2], a0[3]); w.z = pk2(a1[0], a1[1]); w.w = pk2(a1[2], a1[3]);
                            *(u32x4*)(c.VS + (size_t)r * 128 + head * 64 + 32 * bj + 8 * fq) = w;
                            if (op) { float* q = op + head * 64 + 32 * bj + 8 * fq; *(f32x4*)q = a0; *(f32x4*)(q + 4) = a1; }
                        }
                    } else if (pn < 9) {
#pragma unroll
                        for (int bj = 0; bj < 2; ++bj) {
                            const f32x4 a0 = acc[ai][bj][m][0] * rs, a1 = acc[ai][bj][m][1] * rs;
                            u32x4 w; w.x = pk2(a0[0], a0[1]); w.y = pk2(a0[2], a0[3]); w.z = pk2(a1[0], a1[1]); w.w = pk2(a1[2], a1[3]);
                            *(u32x4*)(c.ZG + (size_t)r * 1536 + (pn - 3) * 256 + bj * 128 + cl) = w;
                        }
                    } else {
                        if (wc == 0 && fq < 2) { float* p = c.LR + (size_t)r * 16 + 8 * fq; *(f32x4*)p = acc[ai][0][m][0] * rs; *(f32x4*)(p + 4) = acc[ai][0][m][1] * rs; }
                    }
                }
            }
    }
};

template <int D, int NKT, bool HAS_SINK, bool NOSCALE = false, bool NOMASK = false>
DI void attn16(const bf16x8 (&qf)[D / 32], LAS unsigned char* Kl, int kpitch, LAS unsigned char* Vt, int vpitch, int key0, int jlo, int jhi,
               float scale, float sink, bf16_t* orow, bool wr_ok, int fr, int fq) {
    f32x4 s[NKT];
#pragma unroll
    for (int t = 0; t < NKT; ++t) {
        s[t] = (f32x4){0.f, 0.f, 0.f, 0.f};
#pragma unroll
        for (int ks = 0; ks < D / 32; ++ks) { const bf16x8 kf = *(const LAS bf16x8*)(Kl + (key0 + 16 * t + fr) * kpitch + (32 * ks + 8 * fq) * 2); s[t] = MFMA16(kf, qf[ks], s[t]); }
    }
    float m = -INFINITY;
    const unsigned jrel = (unsigned)(jlo - key0 - 4 * fq), span = (unsigned)(jhi - jlo);
#pragma unroll
    for (int t = 0; t < NKT; ++t)
#pragma unroll
        for (int r = 0; r < 4; ++r) { const unsigned dj = (unsigned)(16 * t + r) - jrel; const float sv = NOSCALE ? s[t][r] : s[t][r] * scale; const float v = (NOMASK || dj <= span) ? sv : -INFINITY; s[t][r] = v; m = fmaxf(m, v); }
    m = fmaxf(m, __shfl_xor(m, 16)); m = fmaxf(m, __shfl_xor(m, 32));
    if (HAS_SINK) m = fmaxf(m, sink);
    if (m == -INFINITY) m = 0.f;
    float sum = 0.f;
#pragma unroll
    for (int t = 0; t < NKT; ++t)
#pragma unroll
        for (int r = 0; r < 4; ++r) { const float e = __expf(s[t][r] - m); s[t][r] = e; sum += e; }
    sum += __shfl_xor(sum, 16); sum += __shfl_xor(sum, 32);
    if (HAS_SINK) sum += __expf(sink - m);
    const float inv = sum > 0.f ? 1.f / sum : 0.f;
    f32x4 o[D / 16];
#pragma unroll
    for (int dt = 0; dt < D / 16; ++dt) o[dt] = (f32x4){0.f, 0.f, 0.f, 0.f};
#pragma unroll
    for (int kk = 0; kk < NKT / 2; ++kk) {
        u32x4 pw; pw.x = pk2(s[2 * kk][0], s[2 * kk][1]); pw.y = pk2(s[2 * kk][2], s[2 * kk][3]);
        pw.z = pk2(s[2 * kk + 1][0], s[2 * kk + 1][1]); pw.w = pk2(s[2 * kk + 1][2], s[2 * kk + 1][3]);
        const bf16x8 pf = __builtin_bit_cast(bf16x8, pw);
#pragma unroll
        for (int dt = 0; dt < D / 16; ++dt) {
            const LAS unsigned char* vp = Vt + (key0 + 32 * kk + 4 * fq + (fr >> 2)) * vpitch + 32 * dt + 8 * (fr & 3);
            const u32x2 lo = __builtin_bit_cast(u32x2, __builtin_amdgcn_ds_read_tr16_b64_v4i16((LAS v4i16_t*)vp));
            const u32x2 hi = __builtin_bit_cast(u32x2, __builtin_amdgcn_ds_read_tr16_b64_v4i16((LAS v4i16_t*)(vp + 16 * vpitch)));
            const bf16x8 vf = __builtin_bit_cast(bf16x8, (u32x4){lo.x, lo.y, hi.x, hi.y});
            o[dt] = MFMA16(vf, pf, o[dt]);
        }
    }
    if (wr_ok) {
#pragma unroll
        for (int dt = 0; dt < D / 16; ++dt) { u32x2 w; w.x = pk2(o[dt][0] * inv, o[dt][1] * inv); w.y = pk2(o[dt][2] * inv, o[dt][3] * inv); *(u32x2*)(orow + 16 * dt + 4 * fq) = w; }
    }
}

struct Params { const float* in[33]; float* out; unsigned char* ws; };

#define CAS __attribute__((address_space(4)))
struct Ctx {
    LAS unsigned char* lds; int tid, lane, wave, G, bx;
    const CAS Params* p; unsigned char* ws; float* out;
};

DI void thin_res_gemm(const Ctx& C, const bf16_t* A, const bf16_t* Bt, int K, float scale, float* rss_out, float* X) {
    const int fr = C.lane & 15, fq = C.lane >> 4;
    LAS float* part = (LAS float*)C.lds;
    bf16_t* XB = (bf16_t*)(C.ws + WS_XB);
    const int kw = K >> 3;
    for (int tile = C.bx; tile < 256; tile += C.G) {
        const int row0 = TP + (tile >> 4) * 32, n0 = (tile & 15) * 64;
        f32x4 acc[2][4];
#pragma unroll
        for (int mt = 0; mt < 2; ++mt)
#pragma unroll
            for (int nt = 0; nt < 4; ++nt) acc[mt][nt] = (f32x4){0.f, 0.f, 0.f, 0.f};
        const bf16_t* ap = A + (size_t)(row0 + fr) * K + C.wave * kw + 8 * fq;
        const bf16_t* bp = Bt + (size_t)(n0 + fr) * K + C.wave * kw + 8 * fq;
#pragma unroll 4
        for (int k = 0; k < kw; k += 32) {
            bf16x8 af[2], bfr[4];
#pragma unroll
            for (int mt = 0; mt < 2; ++mt) af[mt] = *(const bf16x8*)(ap + (size_t)(16 * mt) * K + k);
#pragma unroll
            for (int nt = 0; nt < 4; ++nt) bfr[nt] = *(const bf16x8*)(bp + (size_t)(16 * nt) * K + k);
#pragma unroll
            for (int mt = 0; mt < 2; ++mt)
#pragma unroll
                for (int nt = 0; nt < 4; ++nt) acc[mt][nt] = MFMA16(bfr[nt], af[mt], acc[mt][nt]);
        }
#pragma unroll
        for (int mt = 0; mt < 2; ++mt)
#pragma unroll
            for (int nt = 0; nt < 4; ++nt) *(LAS f32x4*)(part + ((C.wave * 32 + 16 * mt + fr) * 64 + 16 * nt + 4 * fq)) = acc[mt][nt];
        __syncthreads();
        {
            const int row = C.tid >> 4, c4 = C.tid & 15;
            f32x4 v = (f32x4){0.f, 0.f, 0.f, 0.f};
#pragma unroll
            for (int w = 0; w < 8; ++w) v = v + *(const LAS f32x4*)(part + ((w * 32 + row) * 64 + 4 * c4));
            bf16_t* xb = XB + (size_t)(row0 + row) * DM + n0 + 4 * c4;
            const u32x2 xo = *(const u32x2*)xb;
            f32x4 x = (f32x4){blo(xo.x), bhi(xo.x), blo(xo.y), bhi(xo.y)}; x = x + v * scale;
            if (X) *(f32x4*)(X + (size_t)(row0 + row) * DM + n0 + 4 * c4) = x;
            else {
                u32x2 w2; w2.x = pk2(x[0], x[1]); w2.y = pk2(x[2], x[3]); *(u32x2*)xb = w2;
                const float a0 = blo(w2.x), a1 = bhi(w2.x), a2 = blo(w2.y), a3 = bhi(w2.y);
                float ss = a0 * a0 + a1 * a1 + a2 * a2 + a3 * a3;
                ss += __shfl_xor(ss, 1); ss += __shfl_xor(ss, 2); ss += __shfl_xor(ss, 4); ss += __shfl_xor(ss, 8);
                if (c4 == 0) atomicAdd(rss_out + row0 + row, ss);
            }
        }
        __syncthreads();
    }
}

DI void p0_tile(const float* s0, const float* s1, const float* gain, int mode, int K, int Nsrc, bf16_t* dst, int tile, LAS float* tl, int tid) {
    const int nkt = K >> 6; const int ntile = tile / nkt, kt = tile - ntile * nkt; const int n0 = ntile * 256, k0 = kt * 64;
    const int nn = tid & 255, kk0 = tid >> 8;
    const int n = n0 + nn; const float* src = s0; int col = n;
    if (mode == 1) { const int pn = n >> 8, bj = (n >> 7) & 1, cc = n & 127; src = bj ? s1 : s0; col = pn * 128 + cc; }
    else if (mode == 2) {
        const int pn = n >> 8, rem = n & 255, bj = rem >> 7, wc = (rem >> 5) & 3, j = rem & 31;
        if (pn < 2) col = (4 * pn + wc) * 64 + 32 * bj + j;
        else if (pn == 2) col = (wc < 2) ? (512 + wc * 64 + 32 * bj + j) : (640 + (wc - 2) * 64 + 32 * bj + j);
        else if (pn < 9) col = n;
        else col = (rem < 16) ? (2304 + rem) : -1;
    } else if (mode == 3) { if (n >= 512) { src = s1; col = n - 512; } }
    const float* sp = src + (size_t)(k0 + kk0) * Nsrc + (col >= 0 ? col : 0);
    float v[32];
#pragma unroll
    for (int i = 0; i < 32; ++i) v[i] = (col >= 0) ? sp[(size_t)(2 * i) * Nsrc] : 0.f;
    if (gain) {
#pragma unroll
        for (int i = 0; i < 32; ++i) v[i] *= gain[k0 + kk0 + 2 * i];
    }
#pragma unroll
    for (int i = 0; i < 32; ++i) tl[(kk0 + 2 * i) * 257 + nn] = v[i];
    __syncthreads();
#pragma unroll
    for (int j = 0; j < 4; ++j) { const int ch = tid + 512 * j; const int n2 = ch >> 3, ks = ch & 7; const LAS float* s = tl + (8 * ks) * 257 + n2;
      u32x4 o; o.x = pk2(s[0], s[257]); o.y = pk2(s[2 * 257], s[3 * 257]); o.z = pk2(s[4 * 257], s[5 * 257]); o.w = pk2(s[6 * 257], s[7 * 257]);
      *(u32x4*)(dst + (size_t)(n0 + n2) * K + k0 + 8 * ks) = o; }
    __syncthreads();
}

constexpr int TPL = 1408, T_W1 = 0, T_WD1 = 352, T_WKV = 1344;
DI void p0_dispatch(const Ctx& C, int l, int r) {
    const CAS Params& P = *C.p; unsigned char* ws = C.ws;
    unsigned char* wl = ws + WS_WL + (size_t)l * WL_SIZE;
    const float* s0; const float* s1 = nullptr; const float* gain = nullptr; int mode = 0, K = 1024, Nsrc; bf16_t* dst;
    if (r < 352) { s0 = P.in[9] + (size_t)l * 1024 * FF; s1 = P.in[10] + (size_t)l * 1024 * FF; gain = P.in[8] + l * 1024; mode = 1; Nsrc = FF; dst = (bf16_t*)(wl + WL_W1); }
    else if (r < 528) { r -= 352; s0 = P.in[11] + (size_t)l * FF * 1024; K = FF; Nsrc = 1024; dst = (bf16_t*)(wl + WL_WD1); }
    else if (r < 688) { r -= 528; s0 = P.in[13] + (size_t)l * 1024 * 2320; gain = P.in[12] + l * 1024; mode = 2; Nsrc = 2320; dst = (bf16_t*)(wl + WL_WIN); }
    else if (r < 752) { r -= 688; s0 = P.in[20] + (size_t)l * 1024 * 1024; Nsrc = 1024; dst = (bf16_t*)(wl + WL_WOUT); }
    else if (r < 784) { r -= 752; s0 = P.in[23] + (size_t)l * 1024 * 512; gain = P.in[21] + l * 1024; Nsrc = 512; dst = (bf16_t*)(wl + WL_WQ); }
    else if (r < 816) { r -= 784; s0 = P.in[28] + (size_t)l * 512 * 1024; K = 512; Nsrc = 1024; dst = (bf16_t*)(wl + WL_WO); }
    else if (r < 1168) { r -= 816; s0 = P.in[30] + (size_t)l * 1024 * FF; s1 = P.in[31] + (size_t)l * 1024 * FF; gain = P.in[29] + l * 1024; mode = 1; Nsrc = FF; dst = (bf16_t*)(wl + WL_W2); }
    else if (r < 1344) { r -= 1168; s0 = P.in[32] + (size_t)l * FF * 1024; K = FF; Nsrc = 1024; dst = (bf16_t*)(wl + WL_WD2); }
    else { r -= 1344; s0 = P.in[24] + (size_t)l * 1024 * 512; s1 = P.in[25] + (size_t)l * 1024 * 512; gain = P.in[22] + l * 1024; mode = 3; Nsrc = 512; dst = (bf16_t*)(ws + WS_WKV) + (size_t)l * 1024 * 1024; }
    p0_tile(s0, s1, gain, mode, K, Nsrc, dst, r, (LAS float*)C.lds, C.tid);
}
DI void convert_in_slack(const Ctx& C, int l, int lo, int hi, int nun) {
    const int rem = nun % C.G; const int first = rem ? rem : 0, cnt = C.G - first;
    if (C.bx < first) return;
    for (int t = lo + (C.bx - first); t < hi; t += cnt) p0_dispatch(C, l, t);
}

DI void p0_prologue(const Ctx& C) {
    const CAS Params& P = *C.p; unsigned char* ws = C.ws;
    for (int it = C.bx; it < 352 + 128; it += C.G) {
        if (it < 352) p0_dispatch(C, 0, it); else if (it < 416) p0_dispatch(C, 0, T_WKV + it - 352); else p0_dispatch(C, 1, T_WKV + it - 416);
    }
    const int gw = C.bx * 8 + C.wave, NGW = C.G * 8;
    float* RSS = (float*)(ws + WS_RSS);
    for (int r0 = gw; r0 < T + 1024; r0 += 2 * NGW) {
        const float* src[2]; float* df[2]; bf16_t* db[2]; float* rs[2]; f32x4 v[2][4];
#pragma unroll
        for (int q = 0; q < 2; ++q) {
            int r = r0 + q * NGW; if (r >= T + 1024) r = r0;
            if (r < T) { src[q] = (r < TP ? P.in[0] + (size_t)r * 1024 : P.in[1] + (size_t)(r - TP) * 1024); df[q] = nullptr; db[q] = (bf16_t*)(ws + WS_XB) + (size_t)r * 1024; rs[q] = RSS + r; }
            else { src[q] = P.in[7] + (size_t)(r - T) * 1024; df[q] = nullptr; db[q] = (bf16_t*)(ws + WS_MEMB) + (size_t)(r - T) * 1024; rs[q] = (float*)(ws + WS_RSSM) + (r - T); }
#pragma unroll
            for (int j = 0; j < 4; ++j) v[q][j] = *(const f32x4*)(src[q] + 256 * j + 4 * C.lane);
        }
#pragma unroll
        for (int q = 0; q < 2; ++q) {
            float ss = 0.f;
#pragma unroll
            for (int j = 0; j < 4; ++j) {
                const f32x4 x = v[q][j];
                ss += x[0] * x[0] + x[1] * x[1] + x[2] * x[2] + x[3] * x[3];
                if (df[q]) *(f32x4*)(df[q] + 256 * j + 4 * C.lane) = x;
                u32x2 w; w.x = pk2(x[0], x[1]); w.y = pk2(x[2], x[3]); *(u32x2*)(db[q] + 256 * j + 4 * C.lane) = w;
            }
#pragma unroll
            for (int o = 1; o < 64; o <<= 1) ss += __shfl_xor(ss, o);
            if (C.lane == 0) *rs[q] = ss;
        }
    }
    for (int i = C.bx * 512 + C.tid; i < 8 * T; i += C.G * 512) RSS[T + i] = 0.f;
    float2* rope = (float2*)(ws + WS_ROPE);
    for (int i = C.bx * 512 + C.tid; i < 4100 * 32; i += C.G * 512) {
        const int pidx = i >> 5, f = i & 31; const int pos = pidx < 4096 ? pidx : 16384 + (pidx - 4096);
        const float inv = powf(10000.f, -(float)f * (1.f / 32.f));
        const float ang = (float)pos * inv;
        const double a = (double)ang; const double nrev = rint(a * 0.15915494309189535); const float rr = (float)(a - nrev * 6.283185307179586);
        rope[i] = make_float2(cosf(rr), sinf(rr));
    }
}

DI void swa_prompt_unit(const Ctx& C, int l, int unit) {
    unsigned char* ws = C.ws;
    const int b = unit >> 6, n = (unit >> 1) & 31, kvh = unit & 1;
    const bf16_t* QS = (const bf16_t*)(ws + WS_QS); const bf16_t* KS = (const bf16_t*)(ws + WS_KS); const bf16_t* VS = (const bf16_t*)(ws + WS_VS); bf16_t* MIX = (bf16_t*)(ws + WS_MIX);
    LAS unsigned char* Kl = C.lds; LAS unsigned char* Vt = C.lds + 256 * 144;
    constexpr int KP = 144, VP = 144;
#pragma unroll
    for (int i = 0; i < 4; ++i) {
        const int key = (C.tid >> 3) + 64 * i, c8 = C.tid & 7; const int pos = (n - 1) * 128 + key;
        u32x4 kv = (u32x4){0u, 0u, 0u, 0u}, vv = kv;
        if (pos >= 0) { const size_t row = (size_t)b * SEQ + pos; kv = *(const u32x4*)(KS + row * 128 + kvh * 64 + 8 * c8); vv = *(const u32x4*)(VS + row * 128 + kvh * 64 + 8 * c8); }
        *(LAS u32x4*)(Kl + key * KP + c8 * 16) = kv; *(LAS u32x4*)(Vt + key * VP + c8 * 16) = vv;
    }
    __syncthreads();
    const int fr = C.lane & 15, fq = C.lane >> 4; const int g = C.wave >> 1, qh = C.wave & 1; const int head = kvh * 4 + g;
    const float sink = C.p->in[16][l * 8 + head];
    for (int grp = 0; grp < 4; ++grp) {
        const int i = 64 * qh + 16 * grp + fr; const size_t row = (size_t)b * SEQ + n * 128 + i;
        bf16x8 qf[2];
#pragma unroll
        for (int ks = 0; ks < 2; ++ks) qf[ks] = *(const bf16x8*)(QS + row * 512 + head * 64 + 32 * ks + 8 * fq);
        const int jlo = max(i + 1, n == 0 ? 128 : 0), jhi = i + 128;
        attn16<64, 12, true, true>(qf, Kl, KP, Vt, VP, 64 * qh, jlo, jhi, 0.125f, sink, MIX + row * 1024 + head * 64, true, fr, fq);
    }
    __syncthreads();
}

DI void swa_decode_unit(const Ctx& C, int l, int unit) {
    unsigned char* ws = C.ws; const CAS Params& P = *C.p;
    const int b = unit >> 1, kvh = unit & 1;
    const bf16_t* QS = (const bf16_t*)(ws + WS_QS); const bf16_t* KS = (const bf16_t*)(ws + WS_KS); const bf16_t* VS = (const bf16_t*)(ws + WS_VS); bf16_t* MIX = (bf16_t*)(ws + WS_MIX);
    constexpr int KP = 144, VP = 144;
    LAS unsigned char* Kl = C.lds; LAS unsigned char* Vt = C.lds + 160 * KP;
    for (int i = C.tid; i < (160 * KP + 160 * VP) / 16; i += 512) *(LAS u32x4*)(C.lds + i * 16) = (u32x4){0u, 0u, 0u, 0u};
    __syncthreads();
    const float* ck = P.in[2] + ((size_t)(l * 128 + b) * 128) * 128 + kvh * 64; const float* cv = P.in[3] + ((size_t)(l * 128 + b) * 128) * 128 + kvh * 64;
    float* ok = C.out + O_KS + ((size_t)(l * 128 + b) * 128) * 128 + kvh * 64; float* ov = C.out + O_VS + ((size_t)(l * 128 + b) * 128) * 128 + kvh * 64;
#pragma unroll
    for (int i = 0; i < 4; ++i) {
        const int key = (C.tid >> 4) + 32 * i, c16 = C.tid & 15;
        const f32x4 kv = *(const f32x4*)(ck + (size_t)key * 128 + 4 * c16), vv = *(const f32x4*)(cv + (size_t)key * 128 + 4 * c16);
        u32x2 w; w.x = pk2(kv[0], kv[1]); w.y = pk2(kv[2], kv[3]); *(LAS u32x2*)(Kl + key * KP + c16 * 8) = w;
        u32x2 wv; wv.x = pk2(vv[0], vv[1]); wv.y = pk2(vv[2], vv[3]); *(LAS u32x2*)(Vt + key * VP + c16 * 8) = wv;
        if (key >= 4) { *(f32x4*)(ok + (size_t)(key - 4) * 128 + 4 * c16) = kv; *(f32x4*)(ov + (size_t)(key - 4) * 128 + 4 * c16) = vv; }
    }
    if (C.tid < 32) {
        const int tt = C.tid >> 3, c8 = C.tid & 7; const size_t row = (size_t)TP + b * 4 + tt;
        const u32x4 kv = *(const u32x4*)(KS + row * 128 + kvh * 64 + 8 * c8), vv = *(const u32x4*)(VS + row * 128 + kvh * 64 + 8 * c8);
        *(LAS u32x4*)(Kl + (128 + tt) * KP + c8 * 16) = kv; *(LAS u32x4*)(Vt + (128 + tt) * VP + c8 * 16) = vv;
    }
    __syncthreads();
    if (C.wave == 0) {
        const int fr = C.lane & 15, fq = C.lane >> 4; const int g = fr >> 2, tt = fr & 3; const int head = kvh * 4 + g; const size_t row = (size_t)TP + b * 4 + tt;
        bf16x8 qf[2];
#pragma unroll
        for (int ks = 0; ks < 2; ++ks) qf[ks] = *(const bf16x8*)(QS + row * 512 + head * 64 + 32 * ks + 8 * fq);
        const float sink = P.in[16][l * 8 + head];
        attn16<64, 10, true, true>(qf, Kl, KP, Vt, VP, 0, tt + 1, tt + 128, 0.125f, sink, MIX + row * 1024 + head * 64, true, fr, fq);
    }
    __syncthreads();
}

DI void xattn_unit(const Ctx& C, int l, int unit) {
    unsigned char* ws = C.ws; const CAS Params& P = *C.p;
    constexpr int KP = 272, VP = 288;
    LAS unsigned char* Kl = C.lds; LAS unsigned char* Vt = C.lds + 256 * KP;
    const bool prompt = unit < 128;
    int b, h, qb = 0;
    if (prompt) { b = unit >> 5; h = (unit >> 3) & 3; qb = (unit & 7) * 2; } else { const int u = unit - 128; b = u >> 2; h = u & 3; }
    const float* ksrc; const float* vsrc; size_t kpitch;
    if (prompt) { ksrc = (const float*)(ws + WS_MKV) + (size_t)(b * 256) * 2048 + l * 1024 + h * 128; vsrc = ksrc + 512; kpitch = 2048; }
    else { ksrc = P.in[5] + ((size_t)(l * 128 + b) * 256) * 512 + h * 128; vsrc = P.in[6] + ((size_t)(l * 128 + b) * 256) * 512 + h * 128; kpitch = 512; }
    const int c4 = C.tid & 31;
    const f32x4 gk = *(const f32x4*)(P.in[27] + l * 128 + 4 * c4);
    const bool wout = prompt && qb == 0;
    float* omk = C.out + O_MKP + ((size_t)(l * 4 + b) * 256) * 512 + h * 128; float* omv = C.out + O_MVP + ((size_t)(l * 4 + b) * 256) * 512 + h * 128;
#pragma unroll 4
    for (int i = 0; i < 16; ++i) {
        const int key = (C.tid >> 5) + 16 * i;
        f32x4 kv = *(const f32x4*)(ksrc + (size_t)key * kpitch + 4 * c4); const f32x4 vv = *(const f32x4*)(vsrc + (size_t)key * kpitch + 4 * c4);
        if (prompt) {
            float ss = kv[0] * kv[0] + kv[1] * kv[1] + kv[2] * kv[2] + kv[3] * kv[3];
#pragma unroll
            for (int o = 1; o < 32; o <<= 1) ss += __shfl_xor(ss, o);
            const float rq = rsqrtf(ss * (1.f / 128.f) + EPS);
            kv = kv * rq * gk;
            if (wout) { *(f32x4*)(omk + (size_t)key * 512 + 4 * c4) = kv; *(f32x4*)(omv + (size_t)key * 512 + 4 * c4) = vv; }
        }
        u32x2 w; w.x = pk2(kv[0], kv[1]); w.y = pk2(kv[2], kv[3]); *(LAS u32x2*)(Kl + key * KP + c4 * 8) = w;
        u32x2 wv; wv.x = pk2(vv[0], vv[1]); wv.y = pk2(vv[2], vv[3]); *(LAS u32x2*)(Vt + key * VP + c4 * 8) = wv;
    }
    __syncthreads();
    const bf16_t* QX = (const bf16_t*)(ws + WS_QX); bf16_t* OX = (bf16_t*)(ws + WS_OX);
    const int fr = C.lane & 15, fq = C.lane >> 4;
    const int ngrp = prompt ? 4 : (C.wave == 0 ? 1 : 0);
    for (int grp = 0; grp < ngrp; ++grp) {
        const size_t row = prompt ? ((size_t)b * SEQ + (qb + (grp >> 1)) * 256 + 32 * C.wave + 16 * (grp & 1) + fr) : ((size_t)TP + b * 4 + (fr & 3));
        float qv[32]; float ss = 0.f;
#pragma unroll
        for (int ks = 0; ks < 4; ++ks) {
            const u32x4 w = *(const u32x4*)(QX + row * 512 + h * 128 + 32 * ks + 8 * fq);
#pragma unroll
            for (int e = 0; e < 4; ++e) { qv[8 * ks + 2 * e] = blo(w[e]); qv[8 * ks + 2 * e + 1] = bhi(w[e]); }
        }
#pragma unroll
        for (int e = 0; e < 32; ++e) ss += qv[e] * qv[e];
        ss += __shfl_xor(ss, 16); ss += __shfl_xor(ss, 32);
        const float rq = rsqrtf(ss * (1.f / 128.f) + EPS) * 0.08838834764831845f;
        bf16x8 qf[4];
#pragma unroll
        for (int ks = 0; ks < 4; ++ks) {
            const f32x4 g0 = *(const f32x4*)(P.in[26] + l * 128 + 32 * ks + 8 * fq), g1 = *(const f32x4*)(P.in[26] + l * 128 + 32 * ks + 8 * fq + 4);
            u32x4 w; w.x = pk2(qv[8 * ks] * rq * g0[0], qv[8 * ks + 1] * rq * g0[1]); w.y = pk2(qv[8 * ks + 2] * rq * g0[2], qv[8 * ks + 3] * rq * g0[3]);
            w.z = pk2(qv[8 * ks + 4] * rq * g1[0], qv[8 * ks + 5] * rq * g1[1]); w.w = pk2(qv[8 * ks + 6] * rq * g1[2], qv[8 * ks + 7] * rq * g1[3]);
            qf[ks] = __builtin_bit_cast(bf16x8, w);
        }
        attn16<128, 16, false, true, true>(qf, Kl, KP, Vt, VP, 0, 0, 255, 1.f, 0.f, OX + row * 512 + h * 128, prompt || fr < 4, fr, fq);
    }
    __syncthreads();
}

DI void gla_a_phase(const Ctx& C, int l) {
    unsigned char* ws = C.ws; const CAS Params& P = *C.p;
    const bf16_t* ZG = (const bf16_t*)(ws + WS_ZG); const float* LR = (const float*)(ws + WS_LR);
    bf16_t* QT = (bf16_t*)(ws + WS_BCUM); bf16_t* KT = QT + (size_t)TP * 256; float* ST = (float*)(ws + WS_ST); bf16_t* VT = (bf16_t*)(ws + WS_VT); float* DEC = (float*)(ws + WS_DEC);
    LAS float* segsum = (LAS float*)C.lds;
    LAS unsigned char* KdT = C.lds + 2048;
    LAS unsigned char* VtL = C.lds + 2048 + 64 * 144;
    const int dk = C.tid & 63, seg = C.wave, tv = C.tid >> 3, dvs = C.tid & 7;
    int unit = C.bx; if (unit >= 1024) return;
    bf16_t kq[16]; u32x4 vw[2];
#define GLA_A_LOAD(u) do { const int bh_ = (u) >> 6, c_ = (u) & 63, b_ = bh_ >> 2, h_ = bh_ & 3; const size_t t0_ = (size_t)b_ * SEQ + c_ * 64; \
        _Pragma("unroll") for (int i = 0; i < 8; ++i) { kq[i] = ZG[(t0_ + 8 * seg + i) * 1536 + 256 + h_ * 64 + dk]; kq[8 + i] = ZG[(t0_ + 8 * seg + i) * 1536 + h_ * 64 + dk]; } \
        _Pragma("unroll") for (int x = 0; x < 2; ++x) vw[x] = *(const u32x4*)(ZG + (t0_ + tv) * 1536 + 512 + h_ * 128 + 16 * dvs + 8 * x); } while (0)
    GLA_A_LOAD(unit);
    int hcur = -1; float wg[16]; float bg = 0.f;
    for (; unit < 1024; unit += C.G) {
        const int bh = unit >> 6, c = unit & 63, b = bh >> 2, h = bh & 3; const size_t t0 = (size_t)b * SEQ + c * 64;
        if (h != hcur) { hcur = h;
#pragma unroll
            for (int r = 0; r < 16; ++r) wg[r] = P.in[17][(size_t)(l * 16 + r) * 256 + h * 64 + dk];
            bg = P.in[18][l * 256 + h * 64 + dk]; }
        float p[8];
        {
            float run = 0.f;
#pragma unroll
            for (int i = 0; i < 8; ++i) {
                const float* lr = LR + (t0 + 8 * seg + i) * 16; float x = bg;
#pragma unroll
                for (int r = 0; r < 16; ++r) x += lr[r] * wg[r];
                run += logsig(x) * (1.f / 16.f); p[i] = run;
            }
            segsum[seg * 64 + dk] = run;
        }
#pragma unroll
        for (int x = 0; x < 2; ++x) *(LAS u32x4*)(VtL + tv * 288 + (16 * dvs + 8 * x) * 2) = vw[x];
        __syncthreads();
        {
            float off = 0.f, tot = 0.f;
#pragma unroll
            for (int s2 = 0; s2 < 8; ++s2) { const float v = segsum[s2 * 64 + dk]; tot += v; if (s2 < seg) off += v; }
#pragma unroll
            for (int i = 0; i < 8; ++i) {
                const int t = 8 * seg + i; const float bv = off + p[i];
                const float kraw = bf2f(kq[i]), qraw = bf2f(kq[8 + i]);
                const float kd = kraw * __expf(tot - bv);
                const unsigned qk = pk2(qraw * 0.125f * __expf(bv), kraw * __expf(-bv));
                QT[(t0 + t) * 256 + h * 64 + dk] = (bf16_t)(qk & 0xffffu); KT[(t0 + t) * 256 + h * 64 + dk] = (bf16_t)(qk >> 16);
                *(LAS unsigned short*)(KdT + t * 144 + dk * 2) = (unsigned short)(pk2(kd, 0.f) & 0xffffu);
            }
            if (seg == 0) DEC[unit * 64 + dk] = __expf(tot);
        }
        if (unit + C.G < 1024) GLA_A_LOAD(unit + C.G);
        __syncthreads();
        {
            const int fr = C.lane & 15, fq = C.lane >> 4, w = C.wave;
            bf16x8 vt[2];
#pragma unroll
            for (int ks = 0; ks < 2; ++ks) {
                const LAS unsigned char* vp = VtL + (32 * ks + 8 * fq + (fr >> 2)) * 288 + 32 * w + 8 * (fr & 3);
                const u32x2 lo = __builtin_bit_cast(u32x2, __builtin_amdgcn_ds_read_tr16_b64_v4i16((LAS v4i16_t*)vp));
                const u32x2 hi = __builtin_bit_cast(u32x2, __builtin_amdgcn_ds_read_tr16_b64_v4i16((LAS v4i16_t*)(vp + 4 * 288)));
                vt[ks] = __builtin_bit_cast(bf16x8, (u32x4){lo.x, lo.y, hi.x, hi.y});
            }
#pragma unroll
            for (int dkt = 0; dkt < 4; ++dkt) {
                f32x4 acc = (f32x4){0.f, 0.f, 0.f, 0.f};
#pragma unroll
                for (int ks = 0; ks < 2; ++ks) {
                    const LAS unsigned char* kp = KdT + (32 * ks + 8 * fq + (fr >> 2)) * 144 + 32 * dkt + 8 * (fr & 3);
                    const u32x2 lo = __builtin_bit_cast(u32x2, __builtin_amdgcn_ds_read_tr16_b64_v4i16((LAS v4i16_t*)kp));
                    const u32x2 hi = __builtin_bit_cast(u32x2, __builtin_amdgcn_ds_read_tr16_b64_v4i16((LAS v4i16_t*)(kp + 4 * 144)));
                    const bf16x8 kd = __builtin_bit_cast(bf16x8, (u32x4){lo.x, lo.y, hi.x, hi.y});
                    acc = MFMA16(kd, vt[ks], acc);
                }
                *(f32x4*)(ST + ((size_t)unit * 128 + 16 * w + fr) * 64 + 16 * dkt + 4 * fq) = acc;
            }
        }
        __syncthreads();
    }
#undef GLA_A_LOAD
}

DI void gla_scan(const Ctx& C, int l) {
    unsigned char* ws = C.ws;
    const float* ST = (const float*)(ws + WS_ST); const float* DEC = (const float*)(ws + WS_DEC); bf16_t* STB = (bf16_t*)(ws + WS_STB);
    for (int e = C.bx * 512 + C.tid; e < 16 * 8192; e += C.G * 512) {
        const int bh = e >> 13, idx = e & 8191, dk = idx & 63, dv = idx >> 6;
        float S = 0.f;
        for (int c0 = 0; c0 < 64; c0 += 8) {
            float d[8], dc[8];
#pragma unroll
            for (int i = 0; i < 8; ++i) { const int unit = bh * 64 + c0 + i; d[i] = ST[(size_t)unit * 8192 + idx]; dc[i] = DEC[unit * 64 + dk]; }
#pragma unroll
            for (int i = 0; i < 8; ++i) { const int unit = bh * 64 + c0 + i; STB[(size_t)unit * 8192 + idx] = (bf16_t)(pk2(S, 0.f) & 0xffffu); S = dc[i] * S + d[i]; }
        }
        C.out[O_GP + ((size_t)(l * 16 + bh)) * 8192 + dk * 128 + dv] = S;
    }
}

DI void gla_c_wave(const Ctx& C, int l, int unit, int qt) {
    unsigned char* ws = C.ws; const CAS Params& P = *C.p;
    const int bh = unit >> 6, c = unit & 63, b = bh >> 2, h = bh & 3; const size_t t0 = (size_t)b * SEQ + c * 64;
    const bf16_t* ZG = (const bf16_t*)(ws + WS_ZG); const bf16_t* QT = (const bf16_t*)(ws + WS_BCUM); const bf16_t* KT = QT + (size_t)TP * 256; const bf16_t* STB = (const bf16_t*)(ws + WS_STB); const bf16_t* VT = (const bf16_t*)(ws + WS_VT);
    bf16_t* MIX = (bf16_t*)(ws + WS_MIX);
    const int fr = C.lane & 15, fq = C.lane >> 4;
    const size_t rq = t0 + 16 * qt + fr;
    bf16x8 qf[2];
#pragma unroll
    for (int ks = 0; ks < 2; ++ks) qf[ks] = *(const bf16x8*)(QT + rq * 256 + h * 64 + 32 * ks + 8 * fq);
    f32x4 a[4];
#pragma unroll
    for (int kt = 0; kt < 4; ++kt) {
        a[kt] = (f32x4){0.f, 0.f, 0.f, 0.f};
        if (kt <= qt) {
            const size_t rk = t0 + 16 * kt + fr;
#pragma unroll
            for (int ks = 0; ks < 2; ++ks) {
                const bf16x8 kf = *(const bf16x8*)(KT + rk * 256 + h * 64 + 32 * ks + 8 * fq);
                a[kt] = MFMA16(kf, qf[ks], a[kt]);
            }
#pragma unroll
            for (int r = 0; r < 4; ++r) if (16 * kt + 4 * fq + r > 16 * qt + fr) a[kt][r] = 0.f;
        }
    }
    bf16x8 pf[2];
#pragma unroll
    for (int kk = 0; kk < 2; ++kk) { u32x4 w; w.x = pk2(a[2 * kk][0], a[2 * kk][1]); w.y = pk2(a[2 * kk][2], a[2 * kk][3]); w.z = pk2(a[2 * kk + 1][0], a[2 * kk + 1][1]); w.w = pk2(a[2 * kk + 1][2], a[2 * kk + 1][3]); pf[kk] = __builtin_bit_cast(bf16x8, w); }
    f32x4 o[8]; float ss = 0.f;
#pragma unroll
    for (int dt = 0; dt < 8; ++dt) {
        f32x4 acc = (f32x4){0.f, 0.f, 0.f, 0.f};
        const size_t vrow = ((size_t)unit * 128 + 16 * dt + fr) * 64;
#pragma unroll
        for (int kk = 0; kk < 2; ++kk) {
            if (2 * kk <= qt) {
                const bf16_t* vp = VT + vrow + 32 * kk + 4 * fq; const u32x2 lo = *(const u32x2*)vp, hi = *(const u32x2*)(vp + 16);
                acc = MFMA16(__builtin_bit_cast(bf16x8, (u32x4){lo.x, lo.y, hi.x, hi.y}), pf[kk], acc);
            }
        }
#pragma unroll
        for (int ks = 0; ks < 2; ++ks) {
            const bf16x8 sf = *(const bf16x8*)(STB + vrow + 32 * ks + 8 * fq);
            acc = MFMA16(sf, qf[ks], acc);
        }
        o[dt] = acc; ss += acc[0] * acc[0] + acc[1] * acc[1] + acc[2] * acc[2] + acc[3] * acc[3];
    }
    ss += __shfl_xor(ss, 16); ss += __shfl_xor(ss, 32);
    const float rn = rsqrtf(ss * (1.f / 128.f) + EPS);
#pragma unroll
    for (int dt = 0; dt < 8; ++dt) {
        const f32x4 gn = *(const f32x4*)(P.in[19] + l * 128 + 16 * dt + 4 * fq);
        const u32x2 gw = *(const u32x2*)(ZG + rq * 1536 + 1024 + h * 128 + 16 * dt + 4 * fq);
        const float g0 = blo(gw.x), g1 = bhi(gw.x), g2 = blo(gw.y), g3 = bhi(gw.y);
        u32x2 w; w.x = pk2(o[dt][0] * rn * gn[0] * silu(g0), o[dt][1] * rn * gn[1] * silu(g1)); w.y = pk2(o[dt][2] * rn * gn[2] * silu(g2), o[dt][3] * rn * gn[3] * silu(g3));
        *(u32x2*)(MIX + rq * 1024 + 512 + h * 128 + 16 * dt + 4 * fq) = w;
    }
}

DI void gla_c_phase(const Ctx& C, int l) {
    unsigned char* ws = C.ws; const CAS Params& P = *C.p;
    const bf16_t* ZG = (const bf16_t*)(ws + WS_ZG); const bf16_t* QT = (const bf16_t*)(ws + WS_BCUM); const bf16_t* KT = QT + (size_t)TP * 256; const bf16_t* STB = (const bf16_t*)(ws + WS_STB); const bf16_t* VT = (const bf16_t*)(ws + WS_VT);
    bf16_t* MIX = (bf16_t*)(ws + WS_MIX);
    constexpr int PB = 144, U_BYTES = (64 + 128 + 128) * PB;
    const int fr = C.lane & 15, fq = C.lane >> 4, us = C.wave >> 2, qt = C.wave & 3;
    for (int pr = C.bx; pr < 512; pr += C.G) {
#pragma unroll
        for (int uu = 0; uu < 2; ++uu) {
            const int unit = 2 * pr + uu; const int bh = unit >> 6, c = unit & 63, b = bh >> 2, h = bh & 3; const size_t t0 = (size_t)b * SEQ + c * 64;
            LAS unsigned char* base = C.lds + uu * U_BYTES;
            { const int row = C.tid >> 3, c8 = C.tid & 7; *(LAS u32x4*)(base + row * PB + c8 * 16) = *(const u32x4*)(KT + (t0 + row) * 256 + h * 64 + 8 * c8); }
#pragma unroll
            for (int i = 0; i < 2; ++i) {
                const int row = (C.tid >> 3) + 64 * i, c8 = C.tid & 7;
                *(LAS u32x4*)(base + (64 + row) * PB + c8 * 16) = *(const u32x4*)(STB + ((size_t)unit * 128 + row) * 64 + 8 * c8);
                const int vr = (C.tid >> 4) + 32 * i, c16 = C.tid & 15;
                *(LAS u32x4*)(base + 192 * PB + vr * 288 + c16 * 16) = *(const u32x4*)(ZG + (t0 + vr) * 1536 + 512 + h * 128 + 8 * c16);
            }
        }
        const int unit = 2 * pr + us; const int bh = unit >> 6, c = unit & 63, b = bh >> 2, h = bh & 3; const size_t t0 = (size_t)b * SEQ + c * 64;
        const size_t rq = t0 + 16 * qt + fr;
        bf16x8 qf[2];
#pragma unroll
        for (int ks = 0; ks < 2; ++ks) qf[ks] = *(const bf16x8*)(QT + rq * 256 + h * 64 + 32 * ks + 8 * fq);
        __syncthreads();
        LAS unsigned char* Kl = C.lds + us * U_BYTES; LAS unsigned char* Sl = Kl + 64 * PB; LAS unsigned char* Vl = Kl + 192 * PB;
        f32x4 a[4];
#pragma unroll
        for (int kt = 0; kt < 4; ++kt) {
            a[kt] = (f32x4){0.f, 0.f, 0.f, 0.f};
            if (kt <= qt) {
#pragma unroll
                for (int ks = 0; ks < 2; ++ks) {
                    const bf16x8 kf = *(const LAS bf16x8*)(Kl + (16 * kt + fr) * PB + (32 * ks + 8 * fq) * 2);
                    a[kt] = MFMA16(kf, qf[ks], a[kt]);
                }
#pragma unroll
                for (int r = 0; r < 4; ++r) if (16 * kt + 4 * fq + r > 16 * qt + fr) a[kt][r] = 0.f;
            }
        }
        bf16x8 pf[2];
#pragma unroll
        for (int kk = 0; kk < 2; ++kk) { u32x4 w; w.x = pk2(a[2 * kk][0], a[2 * kk][1]); w.y = pk2(a[2 * kk][2], a[2 * kk][3]); w.z = pk2(a[2 * kk + 1][0], a[2 * kk + 1][1]); w.w = pk2(a[2 * kk + 1][2], a[2 * kk + 1][3]); pf[kk] = __builtin_bit_cast(bf16x8, w); }
        f32x4 o[8]; float ss = 0.f;
#pragma unroll
        for (int dt = 0; dt < 8; ++dt) {
            f32x4 acc = (f32x4){0.f, 0.f, 0.f, 0.f};
#pragma unroll
            for (int kk = 0; kk < 2; ++kk) {
                if (2 * kk <= qt) {
                    const LAS unsigned char* vp = Vl + (32 * kk + 4 * fq + (fr >> 2)) * 288 + 32 * dt + 8 * (fr & 3);
                    const u32x2 lo = __builtin_bit_cast(u32x2, __builtin_amdgcn_ds_read_tr16_b64_v4i16((LAS v4i16_t*)vp));
                    const u32x2 hi = __builtin_bit_cast(u32x2, __builtin_amdgcn_ds_read_tr16_b64_v4i16((LAS v4i16_t*)(vp + 16 * 288)));
                    acc = MFMA16(__builtin_bit_cast(bf16x8, (u32x4){lo.x, lo.y, hi.x, hi.y}), pf[kk], acc);
                }
            }
#pragma unroll
            for (int ks = 0; ks < 2; ++ks) {
                const bf16x8 sf = *(const LAS bf16x8*)(Sl + (16 * dt + fr) * PB + (32 * ks + 8 * fq) * 2);
                acc = MFMA16(sf, qf[ks], acc);
            }
            o[dt] = acc; ss += acc[0] * acc[0] + acc[1] * acc[1] + acc[2] * acc[2] + acc[3] * acc[3];
        }
        ss += __shfl_xor(ss, 16); ss += __shfl_xor(ss, 32);
        const float rn = rsqrtf(ss * (1.f / 128.f) + EPS);
#pragma unroll
        for (int dt = 0; dt < 8; ++dt) {
            const f32x4 gn = *(const f32x4*)(P.in[19] + l * 128 + 16 * dt + 4 * fq);
            const u32x2 gw = *(const u32x2*)(ZG + rq * 1536 + 1024 + h * 128 + 16 * dt + 4 * fq);
            const float g0 = blo(gw.x), g1 = bhi(gw.x), g2 = blo(gw.y), g3 = bhi(gw.y);
            u32x2 w; w.x = pk2(o[dt][0] * rn * gn[0] * silu(g0), o[dt][1] * rn * gn[1] * silu(g1)); w.y = pk2(o[dt][2] * rn * gn[2] * silu(g2), o[dt][3] * rn * gn[3] * silu(g3));
            *(u32x2*)(MIX + rq * 1024 + 512 + h * 128 + 16 * dt + 4 * fq) = w;
        }
        __syncthreads();
    }
}

DI void gla_decode_unit(const Ctx& C, int l, int unit) {
    unsigned char* ws = C.ws; const CAS Params& P = *C.p;
    const int b = unit >> 2, h = unit & 3; const size_t rb = (size_t)TP + b * 4;
    const bf16_t* ZG = (const bf16_t*)(ws + WS_ZG); const float* LR = (const float*)(ws + WS_LR); bf16_t* MIX = (bf16_t*)(ws + WS_MIX);
    LAS float* la = (LAS float*)C.lds;
    LAS float* qr = la + 256;
    LAS float* kr = qr + 256;
    LAS float* qe = kr + 256;
    LAS float* ke = qe + 256;
    LAS float* Am = ke + 256;
    LAS float* red = Am + 16;
    LAS float* opart = red + 8;
    if (C.tid < 256) {
        const int tt = C.tid >> 6, dk = C.tid & 63; float x = P.in[18][l * 256 + h * 64 + dk];
        const f32x4 l0 = *(const f32x4*)(LR + (rb + tt) * 16), l1 = *(const f32x4*)(LR + (rb + tt) * 16 + 4), l2 = *(const f32x4*)(LR + (rb + tt) * 16 + 8), l3 = *(const f32x4*)(LR + (rb + tt) * 16 + 12);
        const float* wg = P.in[17] + (size_t)(l * 16) * 256 + h * 64 + dk;
#pragma unroll
        for (int r = 0; r < 4; ++r) { x += l0[r] * wg[r * 256] + l1[r] * wg[(4 + r) * 256] + l2[r] * wg[(8 + r) * 256] + l3[r] * wg[(12 + r) * 256]; }
        la[tt * 64 + dk] = logsig(x) * (1.f / 16.f);
        qr[tt * 64 + dk] = bf2f(ZG[(rb + tt) * 1536 + h * 64 + dk]); kr[tt * 64 + dk] = bf2f(ZG[(rb + tt) * 1536 + 256 + h * 64 + dk]);
    }
    __syncthreads();
    if (C.tid < 64) { float run = 0.f;
#pragma unroll
        for (int tt = 0; tt < 4; ++tt) { run += la[tt * 64 + C.tid]; la[tt * 64 + C.tid] = run; } }
    __syncthreads();
    if (C.tid < 256) {
        const int tt = C.tid >> 6, dk = C.tid & 63; const float bt = la[tt * 64 + dk], b3 = la[3 * 64 + dk];
        qe[tt * 64 + dk] = 0.125f * qr[tt * 64 + dk] * __expf(bt); ke[tt * 64 + dk] = kr[tt * 64 + dk] * __expf(b3 - bt);
    } else if (C.tid < 272) {
        const int tt = (C.tid - 256) >> 2, s = (C.tid - 256) & 3; float sum = 0.f;
        if (s <= tt) for (int dk = 0; dk < 64; ++dk) sum += 0.125f * qr[tt * 64 + dk] * kr[s * 64 + dk] * __expf(la[tt * 64 + dk] - la[s * 64 + dk]);
        Am[C.tid - 256] = sum;
    }
    __syncthreads();
    {
        const int dv = C.tid & 127, dq = C.tid >> 7;
        float v[4], o[4] = {0.f, 0.f, 0.f, 0.f};
#pragma unroll
        for (int tt = 0; tt < 4; ++tt) v[tt] = bf2f(ZG[(rb + tt) * 1536 + 512 + h * 128 + dv]);
        const float* S0p = P.in[4] + ((size_t)(l * 128 + b) * 4 + h) * 8192 + (size_t)(16 * dq) * 128 + dv; float* Sn = C.out + O_GS + ((size_t)(l * 128 + b) * 4 + h) * 8192 + (size_t)(16 * dq) * 128 + dv;
        float S0[16];
#pragma unroll
        for (int i = 0; i < 16; ++i) S0[i] = S0p[i * 128];
#pragma unroll
        for (int i = 0; i < 16; ++i) {
            const int dk = 16 * dq + i;
            float sn = __expf(la[3 * 64 + dk]) * S0[i];
#pragma unroll
            for (int tt = 0; tt < 4; ++tt) { o[tt] += qe[tt * 64 + dk] * S0[i]; sn += ke[tt * 64 + dk] * v[tt]; }
            Sn[i * 128] = sn;
        }
#pragma unroll
        for (int tt = 0; tt < 4; ++tt) opart[(dq * 4 + tt) * 128 + dv] = o[tt];
    }
    __syncthreads();
    {
        const int tt = C.tid >> 7, dv = C.tid & 127;
        float o = opart[(0 * 4 + tt) * 128 + dv] + opart[(1 * 4 + tt) * 128 + dv] + opart[(2 * 4 + tt) * 128 + dv] + opart[(3 * 4 + tt) * 128 + dv];
        for (int s = 0; s <= tt; ++s) o += Am[tt * 4 + s] * bf2f(ZG[(rb + s) * 1536 + 512 + h * 128 + dv]);
        float ss = o * o;
#pragma unroll
        for (int of = 1; of < 64; of <<= 1) ss += __shfl_xor(ss, of);
        if (C.lane == 0) red[C.wave] = ss;
        __syncthreads();
        const float tot = red[2 * tt] + red[2 * tt + 1];
        const float rn = rsqrtf(tot * (1.f / 128.f) + EPS);
        const float gg = bf2f(ZG[(rb + tt) * 1536 + 1024 + h * 128 + dv]);
        const float val = o * rn * P.in[19][l * 128 + dv] * silu(gg);
        MIX[(rb + tt) * 1024 + 512 + h * 128 + dv] = (bf16_t)(pk2(val, 0.f) & 0xffffu);
    }
    __syncthreads();
}

__global__ void __launch_bounds__(512, 2) hymba_fwd(Params prm) {
    extern __shared__ __attribute__((aligned(16))) unsigned char smem[];
    cg::grid_group grid = cg::this_grid();
    Ctx C; C.lds = (LAS unsigned char*)smem; C.tid = threadIdx.x; C.lane = C.tid & 63; C.wave = __builtin_amdgcn_readfirstlane(C.tid >> 6);
    C.G = gridDim.x; C.bx = blockIdx.x; C.p = (const CAS Params*)__builtin_amdgcn_kernarg_segment_ptr(); C.ws = C.p->ws; C.out = C.p->out;
    (void)prm;

    unsigned* barw = (unsigned*)(C.ws + WS_BAR);
    if (C.bx == 0) for (int i = C.tid; i < XCD_BAR_WORDS; i += 512) barw[i] = 0u;
    if (C.tid < 4) ((LAS unsigned*)(C.lds + LDS_BYTES - 16))[C.tid] = 0u;
    grid.sync();
    XcdBarrier xbar = xcd_barrier_post(barw, (volatile LAS unsigned*)(C.lds + LDS_BYTES - 16));
    for (int rep = 0; rep < REP_P0; ++rep) p0_prologue(C);
    xcd_barrier(xbar);
    {   unsigned char* ws = C.ws;
        pg8::Gemm g{(const bf16_t*)(ws + WS_MEMB), (const bf16_t*)(ws + WS_WKV), 1024, 2048, 1024};
        const int n1 = (T / 256) * (5632 / 256);
        pg8::StaticOrder S; S.init(1024, 2048, C.G, (C.bx + C.G - (n1 % C.G)) % C.G);
        Epi<EK_MEM> E; E.c = EpiCtx{}; E.c.rss_in = (const float*)(ws + WS_RSSM); E.c.MKV = (float*)(ws + WS_MKV);
        pg8::gemm_phase(C.lds, C.tid, g, S, E);
    }
    int rep = 0;
    for (int ph = 0; ph < 24; ++ph) {
        { int t_ = threadIdx.x; asm volatile("" : "+v"(t_)); C.tid = t_; C.lane = t_ & 63; C.wave = __builtin_amdgcn_readfirstlane(t_ >> 6); }
        asm volatile("" : "+s"(C.ws), "+s"(C.out), "+s"(C.p));
        unsigned char* ws = C.ws; float* RSS = (float*)(ws + WS_RSS);
        const int l = ph / 12, k = ph - 12 * l;
        unsigned char* wl = ws + WS_WL + (size_t)l * WL_SIZE;
        EpiCtx ec{}; ec.l = l;
        if (k == 0 || k == 10) {
            pg8::Gemm g{(const bf16_t*)(ws + WS_XB), (const bf16_t*)(wl + (k == 0 ? WL_W1 : WL_W2)), T, 5632, 1024};
            pg8::StaticOrder S; S.init(T, 5632, C.G, C.bx);
            ec.rss_in = RSS + (size_t)(4 * l + (k == 0 ? 0 : 3)) * T; ec.H = (bf16_t*)(ws + WS_H);
            Epi<EK_SWIGLU> E; E.c = ec; pg8::gemm_phase(C.lds, C.tid, g, S, E);
            if (ph == 0 && rep == 0) convert_in_slack(C, 0, T_WD1, 688, (T / 256) * 22 + 32);
            if (ph == 10 && rep == 0) convert_in_slack(C, 1, 704, T_WKV, (T / 256) * 22);
        } else if (k == 1 || k == 6 || k == 9 || k == 11) {
            const bf16_t* A; const bf16_t* B; int K; float sc; int ro;
            if (k == 1) { A = (const bf16_t*)(ws + WS_H); B = (const bf16_t*)(wl + WL_WD1); K = FF; sc = 0.5f; ro = 4 * l + 1; }
            else if (k == 6) { A = (const bf16_t*)(ws + WS_MIX); B = (const bf16_t*)(wl + WL_WOUT); K = 1024; sc = 1.f; ro = 4 * l + 2; }
            else if (k == 9) { A = (const bf16_t*)(ws + WS_OX); B = (const bf16_t*)(wl + WL_WO); K = 512; sc = 1.f; ro = 4 * l + 3; }
            else { A = (const bf16_t*)(ws + WS_H); B = (const bf16_t*)(wl + WL_WD2); K = FF; sc = 0.5f; ro = 4 * l + 4; }
            pg8::Gemm g{A, B, TP, 1024, K};
            pg8::StaticOrder S; S.init(TP, 1024, C.G, C.bx);
            ec.rss_out = RSS + (size_t)ro * T; ec.X = (ph == 23) ? C.out : nullptr; ec.XB = (bf16_t*)(ws + WS_XB); ec.scale = sc;
            Epi<EK_RES> E; E.c = ec; pg8::gemm_phase(C.lds, C.tid, g, S, E);
            thin_res_gemm(C, A, B, K, sc, RSS + (size_t)ro * T, (ph == 23) ? C.out : nullptr);
        } else if (k == 2) {
            pg8::Gemm g{(const bf16_t*)(ws + WS_XB), (const bf16_t*)(wl + WL_WIN), T, INWP, 1024};
            pg8::StaticOrder S; S.init(T, INWP, C.G, C.bx);
            ec.rss_in = RSS + (size_t)(4 * l + 1) * T; ec.QS = (bf16_t*)(ws + WS_QS); ec.KS = (bf16_t*)(ws + WS_KS); ec.VS = (bf16_t*)(ws + WS_VS); ec.ZG = (bf16_t*)(ws + WS_ZG);
            ec.LR = (float*)(ws + WS_LR); ec.rope = (const float2*)(ws + WS_ROPE); ec.gq = C.p->in[14] + l * 64; ec.gk = C.p->in[15] + l * 64;
            ec.okp = C.out + O_KP; ec.ovp = C.out + O_VP; ec.oks = C.out + O_KS; ec.ovs = C.out + O_VS;
            Epi<EK_WIN> E; E.c = ec; pg8::gemm_phase(C.lds, C.tid, g, S, E);
            if (ph == 2 && rep == 0) convert_in_slack(C, 0, 688, T_WKV, (T / 256) * 10);
        } else if (k == 3) {
            for (int u = C.bx; u < 256; u += C.G) swa_prompt_unit(C, l, u);
            gla_a_phase(C, l);
        } else if (k == 4) {
            gla_scan(C, l);
            for (int u = C.bx; u < 512; u += C.G) gla_decode_unit(C, l, u);
            for (int u = C.bx; u < 256; u += C.G) swa_decode_unit(C, l, u);
        } else if (k == 5) {
            gla_c_phase(C, l);
        } else if (k == 7) {
            pg8::Gemm g{(const bf16_t*)(ws + WS_XB), (const bf16_t*)(wl + WL_WQ), T, 512, 1024};
            pg8::StaticOrder S; S.init(T, 512, C.G, C.bx);
            ec.rss_in = RSS + (size_t)(4 * l + 2) * T; ec.QX = (bf16_t*)(ws + WS_QX);
            Epi<EK_XQ> E; E.c = ec; pg8::gemm_phase(C.lds, C.tid, g, S, E);
            if (ph == 7 && rep == 0) convert_in_slack(C, 1, 0, 704, (T / 256) * 2);
        } else {
            if (C.G == 256) {
                if (C.bx < 128) { xattn_unit(C, l, C.bx); xattn_unit(C, l, 128 + C.bx); }
                else for (int i = 0; i < 3; ++i) xattn_unit(C, l, 128 + 128 + 3 * (C.bx - 128) + i);
            } else for (int u = C.bx; u < 640; u += C.G) xattn_unit(C, l, u);
        }
        if (ph != 23) for (int r2 = 0; r2 < REP_SYNC; ++r2) xcd_barrier(xbar);
        {
            const int want = (k == 0 || k == 2 || k == 7 || k == 10) ? REP_GEMM : (k == 3 ? REP3 : (k == 4 ? REP4 : k == 5 ? REP5 : (k == 8 ? REP8 : 1)));
            if (rep + 1 < want) { ++rep; --ph; } else rep = 0;
        }
    }
}

extern "C" void kernel_launch(void* const* d_in, const int* in_sizes, int n_in, void* d_out, int out_size, void* d_ws, size_t ws_size, hipStream_t stream) {
    static int grid = 0;
    if (grid == 0) {
        if (n_in != 33 || ws_size < WS_TOTAL) { fprintf(stderr, "kernel_launch: need 33 inputs and %zu bytes of workspace; got %d inputs, %zu bytes\n", (size_t)WS_TOTAL, n_in, ws_size); grid = -1; return; }
        int dev = 0, cus = 0, per_cu = 0;
        (void)hipGetDevice(&dev); (void)hipDeviceGetAttribute(&cus, hipDeviceAttributeMultiprocessorCount, dev);
        if (hipFuncSetAttribute((const void*)hymba_fwd, hipFuncAttributeMaxDynamicSharedMemorySize, LDS_BYTES) != hipSuccess) { fprintf(stderr, "kernel_launch: hipFuncSetAttribute failed\n"); grid = -1; return; }
        if (hipOccupancyMaxActiveBlocksPerMultiprocessor(&per_cu, (const void*)hymba_fwd, 512, LDS_BYTES) != hipSuccess || per_cu < 1) { fprintf(stderr, "kernel_launch: occupancy query gave %d\n", per_cu); grid = -1; return; }
        grid = cus * per_cu;
    }
    if (grid < 0) return;
    Params p{};
    for (int i = 0; i < 33; ++i) p.in[i] = (const float*)d_in[i];
    p.out = (float*)d_out; p.ws = (unsigned char*)d_ws;
    void* args[] = {&p};
    hipError_t e = hipLaunchCooperativeKernel((const void*)hymba_fwd, dim3(grid), dim3(512), args, LDS_BYTES, stream);
    if (e != hipSuccess) fprintf(stderr, "kernel_launch: cooperative launch failed: %s (grid %d)\n", hipGetErrorString(e), grid);
}
```

```cpp
#include <hip/hip_runtime.h>
#include <hip/hip_cooperative_groups.h>
#include <cstdio>
#include <cstdint>
namespace cg = cooperative_groups;

#define LAS __attribute__((address_space(3)))
#define DI __device__ __forceinline__
typedef unsigned short bf16_t;
typedef short bf16x8 __attribute__((ext_vector_type(8)));
typedef float f32x4 __attribute__((ext_vector_type(4)));
typedef unsigned u32x4 __attribute__((ext_vector_type(4)));
typedef unsigned u32x2 __attribute__((ext_vector_type(2)));
typedef short v4i16_t __attribute__((ext_vector_type(4)));
#define MFMA16(a, b, c) __builtin_amdgcn_mfma_f32_16x16x32_bf16((a), (b), (c), 0, 0, 0)

constexpr int TP = 16384, TS = 512, T = TP + TS, DM = 1024, FF = 2816, SEQ = 4096;
constexpr int INWP = 2560;
constexpr float EPS = 1e-6f;
constexpr size_t O_Y = 0, O_KP = 17301504, O_VP = 17432576, O_GP = 17563648, O_MKP = 17825792, O_MVP = 18874368, O_KS = 19922944, O_VS = 24117248, O_GS = 28311552;
constexpr size_t al(size_t x) { return (x + 4095) & ~(size_t)4095; }
constexpr size_t WS_RSS = 0;
constexpr size_t WS_RSSM = al(WS_RSS + (size_t)9 * T * 4);
constexpr size_t WS_ROPE = al(WS_RSSM + 1024 * 4);
constexpr size_t WS_XB = al(WS_ROPE + (size_t)4100 * 32 * 8);
constexpr size_t WS_H = al(WS_XB + (size_t)T * 1024 * 2);
constexpr size_t WS_QS = al(WS_H + (size_t)T * FF * 2);
constexpr size_t WS_KS = al(WS_QS + (size_t)T * 512 * 2);
constexpr size_t WS_VS = al(WS_KS + (size_t)T * 128 * 2);
constexpr size_t WS_ZG = al(WS_VS + (size_t)T * 128 * 2);
constexpr size_t WS_LR = al(WS_ZG + (size_t)T * 1536 * 2);
constexpr size_t WS_MIX = al(WS_LR + (size_t)T * 16 * 4);
constexpr size_t WS_QX = al(WS_MIX + (size_t)T * 1024 * 2);
constexpr size_t WS_OX = al(WS_QX + (size_t)T * 512 * 2);
constexpr size_t WS_MEMB = al(WS_OX + (size_t)T * 512 * 2);
constexpr size_t WS_MKV = al(WS_MEMB + (size_t)1024 * 1024 * 2);
constexpr size_t WS_BCUM = al(WS_MKV + (size_t)1024 * 2048 * 4);
constexpr size_t WS_ST = al(WS_BCUM + (size_t)TP * 256 * 4);
constexpr size_t WS_VT = al(WS_ST + (size_t)1024 * 8192 * 4);
constexpr size_t WS_DEC = al(WS_VT + (size_t)1024 * 8192 * 2);
constexpr size_t WS_WKV = al(WS_DEC + (size_t)1024 * 64 * 4);
constexpr size_t WS_WL = al(WS_WKV + (size_t)2048 * 1024 * 2);
constexpr size_t WL_W1 = 0;
constexpr size_t WL_WD1 = WL_W1 + (size_t)5632 * 1024 * 2;
constexpr size_t WL_WIN = WL_WD1 + (size_t)1024 * FF * 2;
constexpr size_t WL_WOUT = WL_WIN + (size_t)INWP * 1024 * 2;
constexpr size_t WL_WQ = WL_WOUT + (size_t)1024 * 1024 * 2;
constexpr size_t WL_WO = WL_WQ + (size_t)512 * 1024 * 2;
constexpr size_t WL_W2 = WL_WO + (size_t)1024 * 512 * 2;
constexpr size_t WL_WD2 = WL_W2 + (size_t)5632 * 1024 * 2;
constexpr size_t WL_SIZE = al(WL_WD2 + (size_t)1024 * FF * 2);
constexpr size_t WS_STB = WS_WL + 2 * WL_SIZE;
constexpr size_t WS_BAR = al(WS_STB + (size_t)1024 * 8192 * 2);
constexpr size_t WS_TOTAL = WS_BAR + 16384;
constexpr int LDS_BYTES = 147456;
constexpr int REP_GEMM = 1, REP_ATT = 1, REP_P0 = 1, REP_SYNC = 1, REP3 = 1, REP4 = 1, REP5 = 1, REP8 = 1;

DI float bf2f(unsigned h) { return __builtin_bit_cast(float, h << 16); }
typedef float f32x2_t __attribute__((ext_vector_type(2)));
typedef __bf16 bf16x2_t __attribute__((ext_vector_type(2)));
DI unsigned pk2(float lo, float hi) { const f32x2_t v = {lo, hi}; const bf16x2_t b = __builtin_convertvector(v, bf16x2_t); return __builtin_bit_cast(unsigned, b); }
DI float blo(unsigned w) { return __builtin_bit_cast(float, w << 16); }
DI float bhi(unsigned w) { return __builtin_bit_cast(float, w & 0xffff0000u); }
DI float silu(float x) { return x * __builtin_amdgcn_rcpf(1.f + __builtin_amdgcn_exp2f(x * -1.4426950408889634f)); }
DI float logsig(float x) { return fminf(x, 0.f) - __logf(1.f + __expf(-fabsf(x))); }

#define XB_TMO      128
#define XB_XCNT(j)  (256  + 64 * (j))
#define XB_XSUB(j)  (1280 + 64 * (j))
#define XB_XGEN(j)  (2304 + 64 * (j))
#define XB_TOP      3328
#define XB_TOPGEN   3392
#define XCD_BAR_WORDS 3456
#define XB_SPIN_CAP (1u << 18)
DI unsigned xb_ld(unsigned* p)              { return __hip_atomic_load(p, __ATOMIC_RELAXED, __HIP_MEMORY_SCOPE_AGENT); }
DI unsigned xb_add(unsigned* p, unsigned v) { return __hip_atomic_fetch_add(p, v, __ATOMIC_RELAXED, __HIP_MEMORY_SCOPE_AGENT); }
DI unsigned xb_xcc_id() { return (unsigned)__builtin_amdgcn_s_getreg((3 << 11) | 20) & 0xFu; }
#define XB_SPIN(cond, bar) do { unsigned _sp = 0; while (cond) { __builtin_amdgcn_s_sleep(1); \
    if ((++_sp & 255u) == 0u) { if (xb_ld(&(bar)[XB_TMO])) break; if (_sp > XB_SPIN_CAP) { atomicAdd(&(bar)[XB_TMO], 1u); break; } } } } while (0)
struct XcdBarrier { unsigned* bar; unsigned x; volatile LAS unsigned* st; };
DI XcdBarrier xcd_barrier_post(unsigned* bar, volatile LAS unsigned* st) {
    XcdBarrier b; b.bar = bar; b.x = xb_xcc_id(); b.st = st;
    if (threadIdx.x == 0) (void)xb_add(&bar[XB_XCNT(b.x)], 1u);
    return b;
}
DI void xcd_barrier_complete(unsigned* bar, unsigned x, unsigned& nloc, unsigned& nx) {
    const unsigned G = gridDim.x * gridDim.y * gridDim.z;
    unsigned sum, cnt, mine, sp = 0u;
    for (;;) {
        sum = 0u; cnt = 0u; mine = 0u;
#pragma unroll
        for (unsigned j = 0; j < 16; ++j) { const unsigned c = xb_ld(&bar[XB_XCNT(j)]); sum += c; cnt += (c > 0u) ? 1u : 0u; mine = (j == x) ? c : mine; }
        if (sum == G) break;
        __builtin_amdgcn_s_sleep(1);
        if ((++sp & 255u) == 0u) { if (xb_ld(&bar[XB_TMO])) break; if (sp > XB_SPIN_CAP) { atomicAdd(&bar[XB_TMO], 1u); break; } }
    }
    nloc = mine > 0u ? mine : 1u; nx = cnt > 0u ? cnt : 1u;
}
DI void xcd_barrier(const XcdBarrier& b) {
    asm volatile("s_waitcnt vmcnt(0)" ::: "memory");
    __syncthreads();
    if (threadIdx.x == 0) {
        unsigned* bar = b.bar;
        __builtin_amdgcn_s_waitcnt(0);
        unsigned nloc = b.st[0], nx = b.st[1];
        if (nloc == 0u) { xcd_barrier_complete(bar, b.x, nloc, nx); b.st[0] = nloc; b.st[1] = nx; }
        const unsigned old = xb_add(&bar[XB_XSUB(b.x)], 1u);
        const unsigned gen = old / nloc;
        if (old + 1u == (gen + 1u) * nloc) {
            __builtin_amdgcn_fence(__ATOMIC_RELEASE, "agent");
            asm volatile("s_waitcnt vmcnt(0)" ::: "memory");
            const unsigned og = xb_add(&bar[XB_TOP], 1u);
            const unsigned tg = og / nx;
            if (og + 1u == (tg + 1u) * nx) xb_add(&bar[XB_TOPGEN], 1u);
            else XB_SPIN(xb_ld(&bar[XB_TOPGEN]) == tg, bar);
            __builtin_amdgcn_fence(__ATOMIC_ACQUIRE, "agent");
            xb_add(&bar[XB_XGEN(b.x)], 1u);
            asm volatile("s_waitcnt vmcnt(0)" ::: "memory");
        } else {
            XB_SPIN(xb_ld(&bar[XB_XGEN(b.x)]) == gen, bar);
            __builtin_amdgcn_fence(__ATOMIC_ACQUIRE, "agent");
            asm volatile("s_waitcnt vmcnt(0)" ::: "memory");
        }
    }
    __syncthreads();
}

namespace pg8 {
constexpr int BM = 256, BK = 64, HALF = 128, HTB = HALF * BK * 2, STAGE_BYTES = 8 * HTB, NXCD = 8, WGM = 8;
DI int lds_byte(int r, int c) { const int st = (r >> 4) * 2 + (c >> 5), rr = r & 15, cc = c & 31, ob = rr * 64 + cc * 2; return st * 1024 + (ob ^ (((ob >> 9) & 1) << 5)); }
DI void stage_rc(int b, int& R, int& C) { const int st = b / 1024, sb = b % 1024, swz = sb ^ (((sb >> 9) & 1) << 5); R = (st >> 1) * 16 + swz / 64; C = (st & 1) * 32 + (swz % 64) / 2; }
DI int perm32(int rho) { const int n = rho >> 4, i = rho & 15; return 8 * (i >> 2) + 4 * n + (i & 3); }
struct Unit { int pm, pn; };
struct Gemm { const bf16_t* A; const bf16_t* Bt; int M, N, K; };
struct StaticOrder {
    int nM, nN, nwg, G, c;
    DI void init(int M, int N, int G_, int c_) { nM = M / BM; nN = N / BM; nwg = nM * nN; G = G_; c = c_; }
    DI bool next(int i, Unit& u) const {
        const long L = (long)i * G + c; if (L >= nwg) return false;
        int wgid = (int)L; { const int q = nwg / NXCD, r = nwg % NXCD, xcd = wgid % NXCD, off = wgid / NXCD; wgid = (xcd < r ? xcd * (q + 1) : r * (q + 1) + (xcd - r) * q) + off; }
        const int nig = WGM * nN, gid = wgid / nig, fm = gid * WGM, gsz = (nM - fm) < WGM ? (nM - fm) : WGM;
        u.pm = fm + ((wgid % nig) % gsz); u.pn = (wgid % nig) / gsz; return true;
    }
};
template <class Epi, class Sched>
DI void gemm_phase(LAS unsigned char* lds, const int tid, const Gemm g, const Sched& S, const Epi& E) {
    const int wid = __builtin_amdgcn_readfirstlane(tid >> 6), lane = tid & 63, wr = wid >> 2, wc = wid & 3, fr = lane & 15, fq = lane >> 4;
    const int K = g.K, nt = K / BK;
    unsigned voffA[2], voffB[2];
#pragma unroll
    for (int i = 0; i < 2; ++i) { int R, C; stage_rc(tid * 16 + i * 8192, R, C); const int Rb = (R & ~31) + perm32(R & 31);
        voffA[i] = (unsigned)(R * K + C) * 2u; voffB[i] = (unsigned)(Rb * K + C) * 2u; }
    const size_t kstep = (size_t)(BK * 2);
    const size_t hstep = (size_t)HALF * K * 2;
    const size_t tstep = 2 * hstep;
    const unsigned ldsw = (unsigned)wid * 1024u;
    const int aoff = lds_byte(wr * 64 + fr, fq * 8), boff = lds_byte(wc * 32 + fr, fq * 8);
#define PG8_SA(b, h) (((b) * 2 + (h)) * HTB)
#define PG8_SB(b, h) ((4 + (b) * 2 + (h)) * HTB)
#define PG8_STAGE(bufoff, gbase, voff) do { _Pragma("unroll") for (int _i = 0; _i < 2; ++_i) \
        __builtin_amdgcn_global_load_lds((const unsigned*)((const char*)(gbase) + (voff)[_i]), (LAS unsigned*)(lds + (bufoff) + ldsw + _i * 8192), 16, 0, 0); } while (0)
#define PG8_LDA(dst, b, h) do { _Pragma("unroll") for (int m = 0; m < 4; ++m) _Pragma("unroll") for (int k = 0; k < 2; ++k) dst[m][k] = *(const LAS bf16x8*)(lds + PG8_SA(b, h) + aoff + m * 2048 + k * 1024); } while (0)
#define PG8_LDB(dst, b, h) do { _Pragma("unroll") for (int n = 0; n < 2; ++n) _Pragma("unroll") for (int k = 0; k < 2; ++k) dst[n][k] = *(const LAS bf16x8*)(lds + PG8_SB(b, h) + boff + n * 2048 + k * 1024); } while (0)
#define PG8_MMA(ai, bj, At, Bt) do { __builtin_amdgcn_s_setprio(1); _Pragma("unroll") for (int m = 0; m < 4; ++m) _Pragma("unroll") for (int n = 0; n < 2; ++n) _Pragma("unroll") for (int k = 0; k < 2; ++k) \
        acc[ai][bj][m][n] = __builtin_amdgcn_mfma_f32_16x16x32_bf16(Bt[n][k], At[m][k], acc[ai][bj][m][n], 0, 0, 0); __builtin_amdgcn_s_setprio(0); } while (0)
#define PG8_WAIT_V(n) asm volatile("s_waitcnt vmcnt(" #n ")" ::: "memory")
#define PG8_WAIT_L(n) asm volatile("s_waitcnt lgkmcnt(" #n ")" ::: "memory")
#define PG8_BAR __builtin_amdgcn_s_barrier()
#define PG8_SCHED __builtin_amdgcn_sched_barrier(0)
    Unit cur, nxt; int ui = 0;
    if (!S.next(0, cur)) return;
    f32x4 acc[2][2][4][2];
#pragma unroll
    for (int a = 0; a < 2; ++a)
#pragma unroll
        for (int b = 0; b < 2; ++b)
#pragma unroll
            for (int m = 0; m < 4; ++m)
#pragma unroll
                for (int n = 0; n < 2; ++n) acc[a][b][m][n] = (f32x4){0.f, 0.f, 0.f, 0.f};
    bf16x8 At[4][2], B0[2][2], B1[2][2];
    const char* cA = (const char*)g.A + (size_t)cur.pm * tstep; const char* cB = (const char*)g.Bt + (size_t)cur.pn * tstep;
    PG8_STAGE(PG8_SB(0, 0), cB, voffB); PG8_STAGE(PG8_SB(0, 1), cB + hstep, voffB); PG8_STAGE(PG8_SA(0, 0), cA, voffA); PG8_STAGE(PG8_SA(0, 1), cA + hstep, voffA);
    if (wr == 1) PG8_BAR;
    PG8_WAIT_V(2); PG8_BAR;
    PG8_STAGE(PG8_SB(1, 0), cB + kstep, voffB); PG8_STAGE(PG8_SA(1, 0), cA + kstep, voffA); PG8_STAGE(PG8_SB(1, 1), cB + hstep + kstep, voffB);
    PG8_WAIT_V(6); PG8_BAR;
    for (;;) {
        const bool has_next = S.next(ui + 1, nxt);
        const char* nA = has_next ? (const char*)g.A + (size_t)nxt.pm * tstep : cA; const char* nB = has_next ? (const char*)g.Bt + (size_t)nxt.pn * tstep : cB;
        for (int t = 0; t < nt; t += 2) {
            const bool last = (t == nt - 2);
            const char* a1 = cA + (size_t)(t + 1) * kstep;
            const char* a2 = last ? nA : cA + (size_t)(t + 2) * kstep; const char* b2 = last ? nB : cB + (size_t)(t + 2) * kstep;
            const char* a3 = a2 + kstep; const char* b3 = b2 + kstep;
            PG8_LDB(B0, 0, 0); PG8_LDB(B1, 0, 1); PG8_SCHED; PG8_LDA(At, 0, 0); PG8_STAGE(PG8_SA(1, 1), a1 + hstep, voffA);
            PG8_WAIT_V(8); PG8_WAIT_L(0); PG8_BAR; PG8_MMA(0, 0, At, B0); PG8_MMA(0, 1, At, B1); PG8_BAR; PG8_SCHED;
            PG8_LDA(At, 0, 1); PG8_STAGE(PG8_SB(0, 0), b2, voffB); PG8_STAGE(PG8_SB(0, 1), b2 + hstep, voffB); PG8_STAGE(PG8_SA(0, 0), a2, voffA);
            PG8_WAIT_V(8); PG8_WAIT_L(0); PG8_BAR; PG8_MMA(1, 0, At, B0); PG8_MMA(1, 1, At, B1); PG8_BAR; PG8_SCHED;
            PG8_LDB(B0, 1, 0); PG8_LDB(B1, 1, 1); PG8_SCHED; PG8_LDA(At, 1, 0); PG8_STAGE(PG8_SA(0, 1), a2 + hstep, voffA);
            PG8_WAIT_V(8); PG8_WAIT_L(0); PG8_BAR; PG8_MMA(0, 0, At, B0); PG8_MMA(0, 1, At, B1); PG8_BAR; PG8_SCHED;
            PG8_LDA(At, 1, 1); PG8_STAGE(PG8_SB(1, 0), b3, voffB); PG8_STAGE(PG8_SB(1, 1), b3 + hstep, voffB); PG8_STAGE(PG8_SA(1, 0), a3, voffA);
            PG8_WAIT_V(8); PG8_WAIT_L(0); PG8_BAR; PG8_MMA(1, 0, At, B0); PG8_MMA(1, 1, At, B1); PG8_BAR; PG8_SCHED;
        }
        if (wr == 0) PG8_BAR;
        E(acc, cur, wr, wc, fr, fq);
        if (!has_next) break;
#pragma unroll
        for (int a = 0; a < 2; ++a)
#pragma unroll
            for (int b = 0; b < 2; ++b)
#pragma unroll
                for (int m = 0; m < 4; ++m)
#pragma unroll
                    for (int n = 0; n < 2; ++n) acc[a][b][m][n] = (f32x4){0.f, 0.f, 0.f, 0.f};
        cur = nxt; cA = nA; cB = nB; ++ui;
        if (wr == 1) PG8_BAR;
    }
    PG8_WAIT_V(0);
    PG8_BAR;
#undef PG8_SA
#undef PG8_SB
#undef PG8_STAGE
#undef PG8_LDA
#undef PG8_LDB
#undef PG8_MMA
#undef PG8_WAIT_V
#undef PG8_WAIT_L
#undef PG8_BAR
#undef PG8_SCHED
}
}

struct EpiCtx {
    const float* rss_in; float* rss_out; float* X; bf16_t* XB; bf16_t* H;
    bf16_t *QS, *KS, *VS, *ZG; float* LR; const float2* rope; const float *gq, *gk;
    float *okp, *ovp, *oks, *ovs; bf16_t* QX; float* MKV; float scale; int l;
};
enum { EK_SWIGLU = 0, EK_RES = 1, EK_WIN = 2, EK_XQ = 3, EK_MEM = 4 };
template <int KIND> struct Epi {
    EpiCtx c;
    DI void operator()(const f32x4 (&acc)[2][2][4][2], const pg8::Unit& u, int wr, int wc, int fr, int fq) const {
        const int row0 = u.pm * 256 + wr * 64 + fr;
        const int cl = wc * 32 + 8 * fq;
        if constexpr (KIND == EK_RES) {
            u32x4 xo[2][4][2];
#pragma unroll
            for (int ai = 0; ai < 2; ++ai)
#pragma unroll
                for (int m = 0; m < 4; ++m)
#pragma unroll
                    for (int bj = 0; bj < 2; ++bj) xo[ai][m][bj] = *(const u32x4*)(c.XB + (size_t)(row0 + ai * 128 + m * 16) * DM + u.pn * 256 + bj * 128 + cl);
#pragma unroll
            for (int ai = 0; ai < 2; ++ai)
#pragma unroll
                for (int m = 0; m < 4; ++m) {
                    const int r = row0 + ai * 128 + m * 16;
                    float ss = 0.f;
#pragma unroll
                    for (int bj = 0; bj < 2; ++bj) {
                        bf16_t* xb = c.XB + (size_t)r * DM + u.pn * 256 + bj * 128 + cl;
                        const u32x4 xv = xo[ai][m][bj];
                        f32x4 x0 = (f32x4){blo(xv[0]), bhi(xv[0]), blo(xv[1]), bhi(xv[1])}, x1 = (f32x4){blo(xv[2]), bhi(xv[2]), blo(xv[3]), bhi(xv[3])};
                        x0 = x0 + acc[ai][bj][m][0] * c.scale; x1 = x1 + acc[ai][bj][m][1] * c.scale;
                        if (c.X) { float* xp = c.X + (size_t)r * DM + u.pn * 256 + bj * 128 + cl; *(f32x4*)xp = x0; *(f32x4*)(xp + 4) = x1; }
                        else {
                            u32x4 w; w.x = pk2(x0[0], x0[1]); w.y = pk2(x0[2], x0[3]); w.z = pk2(x1[0], x1[1]); w.w = pk2(x1[2], x1[3]);
                            *(u32x4*)xb = w;
#pragma unroll
                            for (int e = 0; e < 4; ++e) { const float a0 = blo(w[e]), a1 = bhi(w[e]); ss += a0 * a0 + a1 * a1; }
                        }
                    }
                    if (!c.X) { ss += __shfl_xor(ss, 16); ss += __shfl_xor(ss, 32); if (fq == 0) atomicAdd(c.rss_out + r, ss); }
                }
            return;
        }
#pragma unroll
        for (int ai = 0; ai < 2; ++ai)
#pragma unroll
            for (int m = 0; m < 4; ++m) {
                const int r = row0 + ai * 128 + m * 16;
                if constexpr (KIND == EK_SWIGLU) {
                    const float rs = rsqrtf(c.rss_in[r] * (1.f / 1024.f) + EPS);
                    const float rsn = rs * -1.4426950408889634f, rs2 = rs * rs;
                    float hv[8];
#pragma unroll
                    for (int n = 0; n < 2; ++n)
#pragma unroll
                        for (int j = 0; j < 4; ++j) { const float g0 = acc[ai][0][m][n][j], u0 = acc[ai][1][m][n][j];
                            hv[n * 4 + j] = (g0 * u0) * rs2 * __builtin_amdgcn_rcpf(1.f + __builtin_amdgcn_exp2f(g0 * rsn)); }
                    u32x4 w; w.x = pk2(hv[0], hv[1]); w.y = pk2(hv[2], hv[3]); w.z = pk2(hv[4], hv[5]); w.w = pk2(hv[6], hv[7]);
                    *(u32x4*)(c.H + (size_t)r * FF + u.pn * 128 + cl) = w;
                } else if constexpr (KIND == EK_XQ) {
                    const float rs = rsqrtf(c.rss_in[r] * (1.f / 1024.f) + EPS);
#pragma unroll
                    for (int bj = 0; bj < 2; ++bj) {
                        const f32x4 a0 = acc[ai][bj][m][0] * rs, a1 = acc[ai][bj][m][1] * rs;
                        u32x4 w; w.x = pk2(a0[0], a0[1]); w.y = pk2(a0[2], a0[3]); w.z = pk2(a1[0], a1[1]); w.w = pk2(a1[2], a1[3]);
                        *(u32x4*)(c.QX + (size_t)r * 512 + u.pn * 256 + bj * 128 + cl) = w;
                    }
                } else if constexpr (KIND == EK_MEM) {
                    const float rs = rsqrtf(c.rss_in[r] * (1.f / 1024.f) + EPS);
#pragma unroll
                    for (int bj = 0; bj < 2; ++bj) {
                        float* p = c.MKV + (size_t)r * 2048 + u.pn * 256 + bj * 128 + cl;
                        *(f32x4*)p = acc[ai][bj][m][0] * rs; *(f32x4*)(p + 4) = acc[ai][bj][m][1] * rs;
                    }
                } else {
                    const float rs = rsqrtf(c.rss_in[r] * (1.f / 1024.f) + EPS);
                    const int pn = u.pn;
                    if (pn < 2 || (pn == 2 && wc < 2)) {
                        const bool isq = pn < 2; const int head = isq ? (4 * pn + wc) : wc;
                        const float* gn = isq ? c.gq : c.gk;
                        float ss = 0.f;
#pragma unroll
                        for (int bj = 0; bj < 2; ++bj)
#pragma unroll
                            for (int n = 0; n < 2; ++n)
#pragma unroll
                                for (int j = 0; j < 4; ++j) { const float v = acc[ai][bj][m][n][j] * rs; ss += v * v; }
                        ss += __shfl_xor(ss, 16); ss += __shfl_xor(ss, 32);
                        const float rq = rsqrtf(ss * (1.f / 64.f) + EPS) * rs;
                        const int ridx = r < TP ? (r & (SEQ - 1)) : (4096 + (r & 3));
                        const float2* rp = c.rope + (size_t)ridx * 32 + 8 * fq;
                        float o1[8], o2[8];
#pragma unroll
                        for (int n = 0; n < 2; ++n)
#pragma unroll
                            for (int j = 0; j < 4; ++j) {
                                const int d = 8 * fq + 4 * n + j; const float2 cs = rp[4 * n + j];
                                const float y1 = acc[ai][0][m][n][j] * rq * gn[d], y2 = acc[ai][1][m][n][j] * rq * gn[32 + d];
                                o1[4 * n + j] = y1 * cs.x - y2 * cs.y; o2[4 * n + j] = y2 * cs.x + y1 * cs.y;
                            }
                        if (isq) {
#pragma unroll
                            for (int e = 0; e < 8; ++e) { o1[e] *= 0.18033688011112042f; o2[e] *= 0.18033688011112042f; }
                        }
                        u32x4 w1, w2; w1.x = pk2(o1[0], o1[1]); w1.y = pk2(o1[2], o1[3]); w1.z = pk2(o1[4], o1[5]); w1.w = pk2(o1[6], o1[7]);
                        w2.x = pk2(o2[0], o2[1]); w2.y = pk2(o2[2], o2[3]); w2.z = pk2(o2[4], o2[5]); w2.w = pk2(o2[6], o2[7]);
                        if (isq) { bf16_t* p = c.QS + (size_t)r * 512 + head * 64 + 8 * fq; *(u32x4*)p = w1; *(u32x4*)(p + 32) = w2; }
                        else {
                            bf16_t* p = c.KS + (size_t)r * 128 + head * 64 + 8 * fq; *(u32x4*)p = w1; *(u32x4*)(p + 32) = w2;
                            float* op = nullptr;
                            if (r < TP) { const int t = r & (SEQ - 1); if (t >= SEQ - 128) op = c.okp + ((size_t)((c.l * 4 + (r >> 12)) * 128 + (t - (SEQ - 128)))) * 128; }
                            else { const int rr = r - TP; op = c.oks + ((size_t)((c.l * 128 + (rr >> 2)) * 128 + 124 + (rr & 3))) * 128; }
                            if (op) { op += head * 64 + 8 * fq;
                                *(f32x4*)op = (f32x4){o1[0], o1[1], o1[2], o1[3]}; *(f32x4*)(op + 4) = (f32x4){o1[4], o1[5], o1[6], o1[7]};
                                *(f32x4*)(op + 32) = (f32x4){o2[0], o2[1], o2[2], o2[3]}; *(f32x4*)(op + 36) = (f32x4){o2[4], o2[5], o2[6], o2[7]}; }
                        }
                    } else if (pn == 2) {
                        const int head = wc - 2;
                        float* op = nullptr;
                        if (r < TP) { const int t = r & (SEQ - 1); if (t >= SEQ - 128) op = c.ovp + ((size_t)((c.l * 4 + (r >> 12)) * 128 + (t - (SEQ - 128)))) * 128; }
                        else { const int rr = r - TP; op = c.ovs + ((size_t)((c.l * 128 + (rr >> 2)) * 128 + 124 + (rr & 3))) * 128; }
#pragma unroll
                        for (int bj = 0; bj < 2; ++bj) {
                            const f32x4 a0 = acc[ai][bj][m][0] * rs, a1 = acc[ai][bj][m][1] * rs;
                            u32x4 w; w.x = pk2(a0[0], a0[1]); w.y = pk2(a0[2], a0[3]); w.z = pk2(a1[0], a1[1]); w.w = pk2(a1[2], a1[3]);
                            *(u32x4*)(c.VS + (size_t)r * 128 + head * 64 + 32 * bj + 8 * fq) = w;
                            if (op) { float* q = op + head * 64 + 32 * bj + 8 * fq; *(f32x4*)q = a0; *(f32x4*)(q + 4) = a1; }
                        }
                    } else if (pn < 9) {
#pragma unroll
                        for (int bj = 0; bj < 2; ++bj) {
                            const f32x4 a0 = acc[ai][bj][m][0] * rs, a1 = acc[ai][bj][m][1] * rs;
                            u32x4 w; w.x = pk2(a0[0], a0[1]); w.y = pk2(a0[2], a0[3]); w.z = pk2(a1[0], a1[1]); w.w = pk2(a1[2], a1[3]);
                            *(u32x4*)(c.ZG + (size_t)r * 1536 + (pn - 3) * 256 + bj * 128 + cl) = w;
                        }
                    } else {
                        if (wc == 0 && fq < 2) { float* p = c.LR + (size_t)r * 16 + 8 * fq; *(f32x4*)p = acc[ai][0][m][0] * rs; *(f32x4*)(p + 4) = acc[ai][0][m][1] * rs; }
                    }
                }
            }
    }
};

template <int D, int NKT, bool HAS_SINK, bool NOSCALE = false, bool NOMASK = false>
DI void attn16(const bf16x8 (&qf)[D / 32], LAS unsigned char* Kl, int kpitch, LAS unsigned char* Vt, int vpitch, int key0, int jlo, int jhi,
               float scale, float sink, bf16_t* orow, bool wr_ok, int fr, int fq) {
    f32x4 s[NKT];
#pragma unroll
    for (int t = 0; t < NKT; ++t) {
        s[t] = (f32x4){0.f, 0.f, 0.f, 0.f};
#pragma unroll
        for (int ks = 0; ks < D / 32; ++ks) { const bf16x8 kf = *(const LAS bf16x8*)(Kl + (key0 + 16 * t + fr) * kpitch + (32 * ks + 8 * fq) * 2); s[t] = MFMA16(kf, qf[ks], s[t]); }
    }
    float m = -INFINITY;
    const unsigned jrel = (unsigned)(jlo - key0 - 4 * fq), span = (unsigned)(jhi - jlo);
#pragma unroll
    for (int t = 0; t < NKT; ++t)
#pragma unroll
        for (int r = 0; r < 4; ++r) { const unsigned dj = (unsigned)(16 * t + r) - jrel; const float sv = NOSCALE ? s[t][r] : s[t][r] * scale; const float v = (NOMASK || dj <= span) ? sv : -INFINITY; s[t][r] = v; m = fmaxf(m, v); }
    m = fmaxf(m, __shfl_xor(m, 16)); m = fmaxf(m, __shfl_xor(m, 32));
    const float sk = NOSCALE ? sink * 1.4426950408889634f : sink;
    if (HAS_SINK) m = fmaxf(m, sk);
    if (m == -INFINITY) m = 0.f;
    float sum = 0.f;
#pragma unroll
    for (int t = 0; t < NKT; ++t)
#pragma unroll
        for (int r = 0; r < 4; ++r) { const float e = NOSCALE ? __builtin_amdgcn_exp2f(s[t][r] - m) : __expf(s[t][r] - m); s[t][r] = e; sum += e; }
    sum += __shfl_xor(sum, 16); sum += __shfl_xor(sum, 32);
    if (HAS_SINK) sum += NOSCALE ? __builtin_amdgcn_exp2f(sk - m) : __expf(sk - m);
    const float inv = sum > 0.f ? __builtin_amdgcn_rcpf(sum) : 0.f;
    f32x4 o[D / 16];
#pragma unroll
    for (int dt = 0; dt < D / 16; ++dt) o[dt] = (f32x4){0.f, 0.f, 0.f, 0.f};
#pragma unroll
    for (int kk = 0; kk < NKT / 2; ++kk) {
        u32x4 pw; pw.x = pk2(s[2 * kk][0], s[2 * kk][1]); pw.y = pk2(s[2 * kk][2], s[2 * kk][3]);
        pw.z = pk2(s[2 * kk + 1][0], s[2 * kk + 1][1]); pw.w = pk2(s[2 * kk + 1][2], s[2 * kk + 1][3]);
        const bf16x8 pf = __builtin_bit_cast(bf16x8, pw);
#pragma unroll
        for (int dt = 0; dt < D / 16; ++dt) {
            const LAS unsigned char* vp = Vt + (key0 + 32 * kk + 4 * fq + (fr >> 2)) * vpitch + 32 * dt + 8 * (fr & 3);
            const u32x2 lo = __builtin_bit_cast(u32x2, __builtin_amdgcn_ds_read_tr16_b64_v4i16((LAS v4i16_t*)vp));
            const u32x2 hi = __builtin_bit_cast(u32x2, __builtin_amdgcn_ds_read_tr16_b64_v4i16((LAS v4i16_t*)(vp + 16 * vpitch)));
            const bf16x8 vf = __builtin_bit_cast(bf16x8, (u32x4){lo.x, lo.y, hi.x, hi.y});
            o[dt] = MFMA16(vf, pf, o[dt]);
        }
    }
    if (wr_ok) {
#pragma unroll
        for (int dt = 0; dt < D / 16; ++dt) { u32x2 w; w.x = pk2(o[dt][0] * inv, o[dt][1] * inv); w.y = pk2(o[dt][2] * inv, o[dt][3] * inv); *(u32x2*)(orow + 16 * dt + 4 * fq) = w; }
    }
}

struct Params { const float* in[33]; float* out; unsigned char* ws; };

#define CAS __attribute__((address_space(4)))
struct Ctx {
    LAS unsigned char* lds; int tid, lane, wave, G, bx;
    const CAS Params* p; unsigned char* ws; float* out;
};

DI void thin_res_gemm(const Ctx& C, const bf16_t* A, const bf16_t* Bt, int K, float scale, float* rss_out, float* X) {
    const int fr = C.lane & 15, fq = C.lane >> 4;
    LAS float* part = (LAS float*)C.lds;
    bf16_t* XB = (bf16_t*)(C.ws + WS_XB);
    const int kw = K >> 3;
    for (int tile = C.bx; tile < 256; tile += C.G) {
        const int row0 = TP + (tile >> 4) * 32, n0 = (tile & 15) * 64;
        f32x4 acc[2][4];
#pragma unroll
        for (int mt = 0; mt < 2; ++mt)
#pragma unroll
            for (int nt = 0; nt < 4; ++nt) acc[mt][nt] = (f32x4){0.f, 0.f, 0.f, 0.f};
        const bf16_t* ap = A + (size_t)(row0 + fr) * K + C.wave * kw + 8 * fq;
        const bf16_t* bp = Bt + (size_t)(n0 + fr) * K + C.wave * kw + 8 * fq;
#pragma unroll 4
        for (int k = 0; k < kw; k += 32) {
            bf16x8 af[2], bfr[4];
#pragma unroll
            for (int mt = 0; mt < 2; ++mt) af[mt] = *(const bf16x8*)(ap + (size_t)(16 * mt) * K + k);
#pragma unroll
            for (int nt = 0; nt < 4; ++nt) bfr[nt] = *(const bf16x8*)(bp + (size_t)(16 * nt) * K + k);
#pragma unroll
            for (int mt = 0; mt < 2; ++mt)
#pragma unroll
                for (int nt = 0; nt < 4; ++nt) acc[mt][nt] = MFMA16(bfr[nt], af[mt], acc[mt][nt]);
        }
#pragma unroll
        for (int mt = 0; mt < 2; ++mt)
#pragma unroll
            for (int nt = 0; nt < 4; ++nt) *(LAS f32x4*)(part + ((C.wave * 32 + 16 * mt + fr) * 64 + 16 * nt + 4 * fq)) = acc[mt][nt];
        __syncthreads();
        {
            const int row = C.tid >> 4, c4 = C.tid & 15;
            f32x4 v = (f32x4){0.f, 0.f, 0.f, 0.f};
#pragma unroll
            for (int w = 0; w < 8; ++w) v = v + *(const LAS f32x4*)(part + ((w * 32 + row) * 64 + 4 * c4));
            bf16_t* xb = XB + (size_t)(row0 + row) * DM + n0 + 4 * c4;
            const u32x2 xo = *(const u32x2*)xb;
            f32x4 x = (f32x4){blo(xo.x), bhi(xo.x), blo(xo.y), bhi(xo.y)}; x = x + v * scale;
            if (X) *(f32x4*)(X + (size_t)(row0 + row) * DM + n0 + 4 * c4) = x;
            else {
                u32x2 w2; w2.x = pk2(x[0], x[1]); w2.y = pk2(x[2], x[3]); *(u32x2*)xb = w2;
                const float a0 = blo(w2.x), a1 = bhi(w2.x), a2 = blo(w2.y), a3 = bhi(w2.y);
                float ss = a0 * a0 + a1 * a1 + a2 * a2 + a3 * a3;
                ss += __shfl_xor(ss, 1); ss += __shfl_xor(ss, 2); ss += __shfl_xor(ss, 4); ss += __shfl_xor(ss, 8);
                if (c4 == 0) atomicAdd(rss_out + row0 + row, ss);
            }
        }
        __syncthreads();
    }
}

DI void p0_tile(const float* s0, const float* s1, const float* gain, int mode, int K, int Nsrc, bf16_t* dst, int tile, LAS float* tl, int tid) {
    const int nkt = K >> 6; const int ntile = tile / nkt, kt = tile - ntile * nkt; const int n0 = ntile * 256, k0 = kt * 64;
    const int nn = tid & 255, kk0 = tid >> 8;
    const int n = n0 + nn; const float* src = s0; int col = n;
    if (mode == 1) { const int pn = n >> 8, bj = (n >> 7) & 1, cc = n & 127; src = bj ? s1 : s0; col = pn * 128 + cc; }
    else if (mode == 2) {
        const int pn = n >> 8, rem = n & 255, bj = rem >> 7, wc = (rem >> 5) & 3, j = rem & 31;
        if (pn < 2) col = (4 * pn + wc) * 64 + 32 * bj + j;
        else if (pn == 2) col = (wc < 2) ? (512 + wc * 64 + 32 * bj + j) : (640 + (wc - 2) * 64 + 32 * bj + j);
        else if (pn < 9) col = n;
        else col = (rem < 16) ? (2304 + rem) : -1;
    } else if (mode == 3) { if (n >= 512) { src = s1; col = n - 512; } }
    const float* sp = src + (size_t)(k0 + kk0) * Nsrc + (col >= 0 ? col : 0);
    float v[32];
#pragma unroll
    for (int i = 0; i < 32; ++i) v[i] = (col >= 0) ? sp[(size_t)(2 * i) * Nsrc] : 0.f;
    if (gain) {
#pragma unroll
        for (int i = 0; i < 32; ++i) v[i] *= gain[k0 + kk0 + 2 * i];
    }
#pragma unroll
    for (int i = 0; i < 32; ++i) tl[(kk0 + 2 * i) * 257 + nn] = v[i];
    __syncthreads();
#pragma unroll
    for (int j = 0; j < 4; ++j) { const int ch = tid + 512 * j; const int n2 = ch >> 3, ks = ch & 7; const LAS float* s = tl + (8 * ks) * 257 + n2;
      u32x4 o; o.x = pk2(s[0], s[257]); o.y = pk2(s[2 * 257], s[3 * 257]); o.z = pk2(s[4 * 257], s[5 * 257]); o.w = pk2(s[6 * 257], s[7 * 257]);
      *(u32x4*)(dst + (size_t)(n0 + n2) * K + k0 + 8 * ks) = o; }
    __syncthreads();
}

constexpr int TPL = 1408, T_W1 = 0, T_WD1 = 352, T_WKV = 1344;
DI void p0_dispatch(const Ctx& C, int l, int r) {
    const CAS Params& P = *C.p; unsigned char* ws = C.ws;
    unsigned char* wl = ws + WS_WL + (size_t)l * WL_SIZE;
    const float* s0; const float* s1 = nullptr; const float* gain = nullptr; int mode = 0, K = 1024, Nsrc; bf16_t* dst;
    if (r < 352) { s0 = P.in[9] + (size_t)l * 1024 * FF; s1 = P.in[10] + (size_t)l * 1024 * FF; gain = P.in[8] + l * 1024; mode = 1; Nsrc = FF; dst = (bf16_t*)(wl + WL_W1); }
    else if (r < 528) { r -= 352; s0 = P.in[11] + (size_t)l * FF * 1024; K = FF; Nsrc = 1024; dst = (bf16_t*)(wl + WL_WD1); }
    else if (r < 688) { r -= 528; s0 = P.in[13] + (size_t)l * 1024 * 2320; gain = P.in[12] + l * 1024; mode = 2; Nsrc = 2320; dst = (bf16_t*)(wl + WL_WIN); }
    else if (r < 752) { r -= 688; s0 = P.in[20] + (size_t)l * 1024 * 1024; Nsrc = 1024; dst = (bf16_t*)(wl + WL_WOUT); }
    else if (r < 784) { r -= 752; s0 = P.in[23] + (size_t)l * 1024 * 512; gain = P.in[21] + l * 1024; Nsrc = 512; dst = (bf16_t*)(wl + WL_WQ); }
    else if (r < 816) { r -= 784; s0 = P.in[28] + (size_t)l * 512 * 1024; K = 512; Nsrc = 1024; dst = (bf16_t*)(wl + WL_WO); }
    else if (r < 1168) { r -= 816; s0 = P.in[30] + (size_t)l * 1024 * FF; s1 = P.in[31] + (size_t)l * 1024 * FF; gain = P.in[29] + l * 1024; mode = 1; Nsrc = FF; dst = (bf16_t*)(wl + WL_W2); }
    else if (r < 1344) { r -= 1168; s0 = P.in[32] + (size_t)l * FF * 1024; K = FF; Nsrc = 1024; dst = (bf16_t*)(wl + WL_WD2); }
    else { r -= 1344; s0 = P.in[24] + (size_t)l * 1024 * 512; s1 = P.in[25] + (size_t)l * 1024 * 512; gain = P.in[22] + l * 1024; mode = 3; Nsrc = 512; dst = (bf16_t*)(ws + WS_WKV) + (size_t)l * 1024 * 1024; }
    p0_tile(s0, s1, gain, mode, K, Nsrc, dst, r, (LAS float*)C.lds, C.tid);
}
DI void convert_in_slack(const Ctx& C, int l, int lo, int hi, int nun) {
    const int rem = nun % C.G; const int first = rem ? rem : 0, cnt = C.G - first;
    if (C.bx < first) return;
    for (int t = lo + (C.bx - first); t < hi; t += cnt) p0_dispatch(C, l, t);
}

DI void p0_prologue(const Ctx& C) {
    const CAS Params& P = *C.p; unsigned char* ws = C.ws;
    for (int it = C.bx; it < 352 + 128; it += C.G) {
        if (it < 352) p0_dispatch(C, 0, it); else if (it < 416) p0_dispatch(C, 0, T_WKV + it - 352); else p0_dispatch(C, 1, T_WKV + it - 416);
    }
    const int gw = C.bx * 8 + C.wave, NGW = C.G * 8;
    float* RSS = (float*)(ws + WS_RSS);
    for (int r0 = gw; r0 < T + 1024; r0 += 2 * NGW) {
        const float* src[2]; float* df[2]; bf16_t* db[2]; float* rs[2]; f32x4 v[2][4];
#pragma unroll
        for (int q = 0; q < 2; ++q) {
            int r = r0 + q * NGW; if (r >= T + 1024) r = r0;
            if (r < T) { src[q] = (r < TP ? P.in[0] + (size_t)r * 1024 : P.in[1] + (size_t)(r - TP) * 1024); df[q] = nullptr; db[q] = (bf16_t*)(ws + WS_XB) + (size_t)r * 1024; rs[q] = RSS + r; }
            else { src[q] = P.in[7] + (size_t)(r - T) * 1024; df[q] = nullptr; db[q] = (bf16_t*)(ws + WS_MEMB) + (size_t)(r - T) * 1024; rs[q] = (float*)(ws + WS_RSSM) + (r - T); }
#pragma unroll
            for (int j = 0; j < 4; ++j) v[q][j] = *(const f32x4*)(src[q] + 256 * j + 4 * C.lane);
        }
#pragma unroll
        for (int q = 0; q < 2; ++q) {
            float ss = 0.f;
#pragma unroll
            for (int j = 0; j < 4; ++j) {
                const f32x4 x = v[q][j];
                ss += x[0] * x[0] + x[1] * x[1] + x[2] * x[2] + x[3] * x[3];
                if (df[q]) *(f32x4*)(df[q] + 256 * j + 4 * C.lane) = x;
                u32x2 w; w.x = pk2(x[0], x[1]); w.y = pk2(x[2], x[3]); *(u32x2*)(db[q] + 256 * j + 4 * C.lane) = w;
            }
#pragma unroll
            for (int o = 1; o < 64; o <<= 1) ss += __shfl_xor(ss, o);
            if (C.lane == 0) *rs[q] = ss;
        }
    }
    for (int i = C.bx * 512 + C.tid; i < 8 * T; i += C.G * 512) RSS[T + i] = 0.f;
    float2* rope = (float2*)(ws + WS_ROPE);
    for (int i = C.bx * 512 + C.tid; i < 4100 * 32; i += C.G * 512) {
        const int pidx = i >> 5, f = i & 31; const int pos = pidx < 4096 ? pidx : 16384 + (pidx - 4096);
        const float inv = powf(10000.f, -(float)f * (1.f / 32.f));
        const float ang = (float)pos * inv;
        const double a = (double)ang; const double nrev = rint(a * 0.15915494309189535); const float rr = (float)(a - nrev * 6.283185307179586);
        rope[i] = make_float2(cosf(rr), sinf(rr));
    }
}

DI void swa_prompt_unit(const Ctx& C, int l, int unit) {
    unsigned char* ws = C.ws;
    const int b = unit >> 6, n = (unit >> 1) & 31, kvh = unit & 1;
    const bf16_t* QS = (const bf16_t*)(ws + WS_QS); const bf16_t* KS = (const bf16_t*)(ws + WS_KS); const bf16_t* VS = (const bf16_t*)(ws + WS_VS); bf16_t* MIX = (bf16_t*)(ws + WS_MIX);
    LAS unsigned char* Kl = C.lds; LAS unsigned char* Vt = C.lds + 256 * 144;
    constexpr int KP = 144, VP = 144;
#pragma unroll
    for (int i = 0; i < 4; ++i) {
        const int key = (C.tid >> 3) + 64 * i, c8 = C.tid & 7; const int pos = (n - 1) * 128 + key;
        u32x4 kv = (u32x4){0u, 0u, 0u, 0u}, vv = kv;
        if (pos >= 0) { const size_t row = (size_t)b * SEQ + pos; kv = *(const u32x4*)(KS + row * 128 + kvh * 64 + 8 * c8); vv = *(const u32x4*)(VS + row * 128 + kvh * 64 + 8 * c8); }
        *(LAS u32x4*)(Kl + key * KP + c8 * 16) = kv; *(LAS u32x4*)(Vt + key * VP + c8 * 16) = vv;
    }
    __syncthreads();
    const int fr = C.lane & 15, fq = C.lane >> 4; const int g = C.wave >> 1, qh = C.wave & 1; const int head = kvh * 4 + g;
    const float sink = C.p->in[16][l * 8 + head];
    for (int grp = 0; grp < 4; ++grp) {
        const int i = 64 * qh + 16 * grp + fr; const size_t row = (size_t)b * SEQ + n * 128 + i;
        bf16x8 qf[2];
#pragma unroll
        for (int ks = 0; ks < 2; ++ks) qf[ks] = *(const bf16x8*)(QS + row * 512 + head * 64 + 32 * ks + 8 * fq);
        const int jlo = max(i + 1, n == 0 ? 128 : 0), jhi = i + 128;
        attn16<64, 12, true, true>(qf, Kl, KP, Vt, VP, 64 * qh, jlo, jhi, 0.125f, sink, MIX + row * 1024 + head * 64, true, fr, fq);
    }
    __syncthreads();
}

DI void swa_decode_unit(const Ctx& C, int l, int unit) {
    unsigned char* ws = C.ws; const CAS Params& P = *C.p;
    const int b = unit >> 1, kvh = unit & 1;
    const bf16_t* QS = (const bf16_t*)(ws + WS_QS); const bf16_t* KS = (const bf16_t*)(ws + WS_KS); const bf16_t* VS = (const bf16_t*)(ws + WS_VS); bf16_t* MIX = (bf16_t*)(ws + WS_MIX);
    constexpr int KP = 144, VP = 144;
    LAS unsigned char* Kl = C.lds; LAS unsigned char* Vt = C.lds + 160 * KP;
    for (int i = C.tid; i < (160 * KP + 160 * VP) / 16; i += 512) *(LAS u32x4*)(C.lds + i * 16) = (u32x4){0u, 0u, 0u, 0u};
    __syncthreads();
    const float* ck = P.in[2] + ((size_t)(l * 128 + b) * 128) * 128 + kvh * 64; const float* cv = P.in[3] + ((size_t)(l * 128 + b) * 128) * 128 + kvh * 64;
    float* ok = C.out + O_KS + ((size_t)(l * 128 + b) * 128) * 128 + kvh * 64; float* ov = C.out + O_VS + ((size_t)(l * 128 + b) * 128) * 128 + kvh * 64;
#pragma unroll
    for (int i = 0; i < 4; ++i) {
        const int key = (C.tid >> 4) + 32 * i, c16 = C.tid & 15;
        const f32x4 kv = *(const f32x4*)(ck + (size_t)key * 128 + 4 * c16), vv = *(const f32x4*)(cv + (size_t)key * 128 + 4 * c16);
        u32x2 w; w.x = pk2(kv[0], kv[1]); w.y = pk2(kv[2], kv[3]); *(LAS u32x2*)(Kl + key * KP + c16 * 8) = w;
        u32x2 wv; wv.x = pk2(vv[0], vv[1]); wv.y = pk2(vv[2], vv[3]); *(LAS u32x2*)(Vt + key * VP + c16 * 8) = wv;
        if (key >= 4) { *(f32x4*)(ok + (size_t)(key - 4) * 128 + 4 * c16) = kv; *(f32x4*)(ov + (size_t)(key - 4) * 128 + 4 * c16) = vv; }
    }
    if (C.tid < 32) {
        const int tt = C.tid >> 3, c8 = C.tid & 7; const size_t row = (size_t)TP + b * 4 + tt;
        const u32x4 kv = *(const u32x4*)(KS + row * 128 + kvh * 64 + 8 * c8), vv = *(const u32x4*)(VS + row * 128 + kvh * 64 + 8 * c8);
        *(LAS u32x4*)(Kl + (128 + tt) * KP + c8 * 16) = kv; *(LAS u32x4*)(Vt + (128 + tt) * VP + c8 * 16) = vv;
    }
    __syncthreads();
    if (C.wave == 0) {
        const int fr = C.lane & 15, fq = C.lane >> 4; const int g = fr >> 2, tt = fr & 3; const int head = kvh * 4 + g; const size_t row = (size_t)TP + b * 4 + tt;
        bf16x8 qf[2];
#pragma unroll
        for (int ks = 0; ks < 2; ++ks) qf[ks] = *(const bf16x8*)(QS + row * 512 + head * 64 + 32 * ks + 8 * fq);
        const float sink = P.in[16][l * 8 + head];
        attn16<64, 10, true, true>(qf, Kl, KP, Vt, VP, 0, tt + 1, tt + 128, 0.125f, sink, MIX + row * 1024 + head * 64, true, fr, fq);
    }
    __syncthreads();
}

DI void xattn_unit(const Ctx& C, int l, int unit) {
    unsigned char* ws = C.ws; const CAS Params& P = *C.p;
    constexpr int KP = 272, VP = 288;
    LAS unsigned char* Kl = C.lds; LAS unsigned char* Vt = C.lds + 256 * KP;
    const bool prompt = unit < 128;
    int b, h, qb = 0;
    if (prompt) { b = unit >> 5; h = (unit >> 3) & 3; qb = (unit & 7) * 2; } else { const int u = unit - 128; b = u >> 2; h = u & 3; }
    const float* ksrc; const float* vsrc; size_t kpitch;
    if (prompt) { ksrc = (const float*)(ws + WS_MKV) + (size_t)(b * 256) * 2048 + l * 1024 + h * 128; vsrc = ksrc + 512; kpitch = 2048; }
    else { ksrc = P.in[5] + ((size_t)(l * 128 + b) * 256) * 512 + h * 128; vsrc = P.in[6] + ((size_t)(l * 128 + b) * 256) * 512 + h * 128; kpitch = 512; }
    const int c4 = C.tid & 31;
    const f32x4 gk = *(const f32x4*)(P.in[27] + l * 128 + 4 * c4);
    const bool wout = prompt && qb == 0;
    float* omk = C.out + O_MKP + ((size_t)(l * 4 + b) * 256) * 512 + h * 128; float* omv = C.out + O_MVP + ((size_t)(l * 4 + b) * 256) * 512 + h * 128;
#pragma unroll 4
    for (int i = 0; i < 16; ++i) {
        const int key = (C.tid >> 5) + 16 * i;
        f32x4 kv = *(const f32x4*)(ksrc + (size_t)key * kpitch + 4 * c4); const f32x4 vv = *(const f32x4*)(vsrc + (size_t)key * kpitch + 4 * c4);
        if (prompt) {
            float ss = kv[0] * kv[0] + kv[1] * kv[1] + kv[2] * kv[2] + kv[3] * kv[3];
#pragma unroll
            for (int o = 1; o < 32; o <<= 1) ss += __shfl_xor(ss, o);
            const float rq = rsqrtf(ss * (1.f / 128.f) + EPS);
            kv = kv * rq * gk;
            if (wout) { *(f32x4*)(omk + (size_t)key * 512 + 4 * c4) = kv; *(f32x4*)(omv + (size_t)key * 512 + 4 * c4) = vv; }
        }
        u32x2 w; w.x = pk2(kv[0], kv[1]); w.y = pk2(kv[2], kv[3]); *(LAS u32x2*)(Kl + key * KP + c4 * 8) = w;
        u32x2 wv; wv.x = pk2(vv[0], vv[1]); wv.y = pk2(vv[2], vv[3]); *(LAS u32x2*)(Vt + key * VP + c4 * 8) = wv;
    }
    __syncthreads();
    const bf16_t* QX = (const bf16_t*)(ws + WS_QX); bf16_t* OX = (bf16_t*)(ws + WS_OX);
    const int fr = C.lane & 15, fq = C.lane >> 4;
    const int ngrp = prompt ? 4 : (C.wave == 0 ? 1 : 0);
    for (int grp = 0; grp < ngrp; ++grp) {
        const size_t row = prompt ? ((size_t)b * SEQ + (qb + (grp >> 1)) * 256 + 32 * C.wave + 16 * (grp & 1) + fr) : ((size_t)TP + b * 4 + (fr & 3));
        float qv[32]; float ss = 0.f;
#pragma unroll
        for (int ks = 0; ks < 4; ++ks) {
            const u32x4 w = *(const u32x4*)(QX + row * 512 + h * 128 + 32 * ks + 8 * fq);
#pragma unroll
            for (int e = 0; e < 4; ++e) { qv[8 * ks + 2 * e] = blo(w[e]); qv[8 * ks + 2 * e + 1] = bhi(w[e]); }
        }
#pragma unroll
        for (int e = 0; e < 32; ++e) ss += qv[e] * qv[e];
        ss += __shfl_xor(ss, 16); ss += __shfl_xor(ss, 32);
        const float rq = rsqrtf(ss * (1.f / 128.f) + EPS) * 0.12751743082459868f;
        bf16x8 qf[4];
#pragma unroll
        for (int ks = 0; ks < 4; ++ks) {
            const f32x4 g0 = *(const f32x4*)(P.in[26] + l * 128 + 32 * ks + 8 * fq), g1 = *(const f32x4*)(P.in[26] + l * 128 + 32 * ks + 8 * fq + 4);
            u32x4 w; w.x = pk2(qv[8 * ks] * rq * g0[0], qv[8 * ks + 1] * rq * g0[1]); w.y = pk2(qv[8 * ks + 2] * rq * g0[2], qv[8 * ks + 3] * rq * g0[3]);
            w.z = pk2(qv[8 * ks + 4] * rq * g1[0], qv[8 * ks + 5] * rq * g1[1]); w.w = pk2(qv[8 * ks + 6] * rq * g1[2], qv[8 * ks + 7] * rq * g1[3]);
            qf[ks] = __builtin_bit_cast(bf16x8, w);
        }
        attn16<128, 16, false, true, true>(qf, Kl, KP, Vt, VP, 0, 0, 255, 1.f, 0.f, OX + row * 512 + h * 128, prompt || fr < 4, fr, fq);
    }
    __syncthreads();
}

DI void gla_a_phase(const Ctx& C, int l) {
    unsigned char* ws = C.ws; const CAS Params& P = *C.p;
    const bf16_t* ZG = (const bf16_t*)(ws + WS_ZG); const float* LR = (const float*)(ws + WS_LR);
    bf16_t* QT = (bf16_t*)(ws + WS_BCUM); bf16_t* KT = QT + (size_t)TP * 256; float* ST = (float*)(ws + WS_ST); bf16_t* VT = (bf16_t*)(ws + WS_VT); float* DEC = (float*)(ws + WS_DEC);
    LAS float* segsum = (LAS float*)C.lds;
    LAS unsigned char* KdT = C.lds + 2048;
    LAS unsigned char* VtL = C.lds + 2048 + 64 * 144;
    const int dk = C.tid & 63, seg = C.wave, tv = C.tid >> 3, dvs = C.tid & 7;
    int unit = C.bx; if (unit >= 1024) return;
    bf16_t kq[16]; u32x4 vw[2];
#define GLA_A_LOAD(u) do { const int bh_ = (u) >> 6, c_ = (u) & 63, b_ = bh_ >> 2, h_ = bh_ & 3; const size_t t0_ = (size_t)b_ * SEQ + c_ * 64; \
        _Pragma("unroll") for (int i = 0; i < 8; ++i) { kq[i] = ZG[(t0_ + 8 * seg + i) * 1536 + 256 + h_ * 64 + dk]; kq[8 + i] = ZG[(t0_ + 8 * seg + i) * 1536 + h_ * 64 + dk]; } \
        _Pragma("unroll") for (int x = 0; x < 2; ++x) vw[x] = *(const u32x4*)(ZG + (t0_ + tv) * 1536 + 512 + h_ * 128 + 16 * dvs + 8 * x); } while (0)
    GLA_A_LOAD(unit);
    int hcur = -1; float wg[16]; float bg = 0.f;
    for (; unit < 1024; unit += C.G) {
        const int bh = unit >> 6, c = unit & 63, b = bh >> 2, h = bh & 3; const size_t t0 = (size_t)b * SEQ + c * 64;
        if (h != hcur) { hcur = h;
#pragma unroll
            for (int r = 0; r < 16; ++r) wg[r] = P.in[17][(size_t)(l * 16 + r) * 256 + h * 64 + dk];
            bg = P.in[18][l * 256 + h * 64 + dk]; }
        float p[8];
        {
            float run = 0.f;
#pragma unroll
            for (int i = 0; i < 8; ++i) {
                const float* lr = LR + (t0 + 8 * seg + i) * 16; float x = bg;
#pragma unroll
                for (int r = 0; r < 16; ++r) x += lr[r] * wg[r];
                run += logsig(x) * (1.f / 16.f); p[i] = run;
            }
            segsum[seg * 64 + dk] = run;
        }
#pragma unroll
        for (int x = 0; x < 2; ++x) *(LAS u32x4*)(VtL + tv * 288 + (16 * dvs + 8 * x) * 2) = vw[x];
        __syncthreads();
        {
            float off = 0.f, tot = 0.f;
#pragma unroll
            for (int s2 = 0; s2 < 8; ++s2) { const float v = segsum[s2 * 64 + dk]; tot += v; if (s2 < seg) off += v; }
#pragma unroll
            for (int i = 0; i < 8; ++i) {
                const int t = 8 * seg + i; const float bv = off + p[i];
                const float kraw = bf2f(kq[i]), qraw = bf2f(kq[8 + i]);
                const float kd = kraw * __expf(tot - bv);
                const unsigned qk = pk2(qraw * 0.125f * __expf(bv), kraw * __expf(-bv));
                QT[(t0 + t) * 256 + h * 64 + dk] = (bf16_t)(qk & 0xffffu); KT[(t0 + t) * 256 + h * 64 + dk] = (bf16_t)(qk >> 16);
                *(LAS unsigned short*)(KdT + t * 144 + dk * 2) = (unsigned short)(pk2(kd, 0.f) & 0xffffu);
            }
            if (seg == 0) DEC[unit * 64 + dk] = __expf(tot);
        }
        if (unit + C.G < 1024) GLA_A_LOAD(unit + C.G);
        __syncthreads();
        {
            const int fr = C.lane & 15, fq = C.lane >> 4, w = C.wave;
            bf16x8 vt[2];
#pragma unroll
            for (int ks = 0; ks < 2; ++ks) {
                const LAS unsigned char* vp = VtL + (32 * ks + 8 * fq + (fr >> 2)) * 288 + 32 * w + 8 * (fr & 3);
                const u32x2 lo = __builtin_bit_cast(u32x2, __builtin_amdgcn_ds_read_tr16_b64_v4i16((LAS v4i16_t*)vp));
                const u32x2 hi = __builtin_bit_cast(u32x2, __builtin_amdgcn_ds_read_tr16_b64_v4i16((LAS v4i16_t*)(vp + 4 * 288)));
                vt[ks] = __builtin_bit_cast(bf16x8, (u32x4){lo.x, lo.y, hi.x, hi.y});
            }
#pragma unroll
            for (int dkt = 0; dkt < 4; ++dkt) {
                f32x4 acc = (f32x4){0.f, 0.f, 0.f, 0.f};
#pragma unroll
                for (int ks = 0; ks < 2; ++ks) {
                    const LAS unsigned char* kp = KdT + (32 * ks + 8 * fq + (fr >> 2)) * 144 + 32 * dkt + 8 * (fr & 3);
                    const u32x2 lo = __builtin_bit_cast(u32x2, __builtin_amdgcn_ds_read_tr16_b64_v4i16((LAS v4i16_t*)kp));
                    const u32x2 hi = __builtin_bit_cast(u32x2, __builtin_amdgcn_ds_read_tr16_b64_v4i16((LAS v4i16_t*)(kp + 4 * 144)));
                    const bf16x8 kd = __builtin_bit_cast(bf16x8, (u32x4){lo.x, lo.y, hi.x, hi.y});
                    acc = MFMA16(kd, vt[ks], acc);
                }
                *(f32x4*)(ST + ((size_t)unit * 128 + 16 * w + fr) * 64 + 16 * dkt + 4 * fq) = acc;
            }
        }
        __syncthreads();
    }
#undef GLA_A_LOAD
}

DI void gla_scan(const Ctx& C, int l) {
    unsigned char* ws = C.ws;
    const float* ST = (const float*)(ws + WS_ST); const float* DEC = (const float*)(ws + WS_DEC); bf16_t* STB = (bf16_t*)(ws + WS_STB);
    for (int e = C.bx * 512 + C.tid; e < 16 * 8192; e += C.G * 512) {
        const int bh = e >> 13, idx = e & 8191, dk = idx & 63, dv = idx >> 6;
        float S = 0.f;
        for (int c0 = 0; c0 < 64; c0 += 8) {
            float d[8], dc[8];
#pragma unroll
            for (int i = 0; i < 8; ++i) { const int unit = bh * 64 + c0 + i; d[i] = ST[(size_t)unit * 8192 + idx]; dc[i] = DEC[unit * 64 + dk]; }
#pragma unroll
            for (int i = 0; i < 8; ++i) { const int unit = bh * 64 + c0 + i; STB[(size_t)unit * 8192 + idx] = (bf16_t)(pk2(S, 0.f) & 0xffffu); S = dc[i] * S + d[i]; }
        }
        C.out[O_GP + ((size_t)(l * 16 + bh)) * 8192 + dk * 128 + dv] = S;
    }
}

DI void gla_c_wave(const Ctx& C, int l, int unit, int qt) {
    unsigned char* ws = C.ws; const CAS Params& P = *C.p;
    const int bh = unit >> 6, c = unit & 63, b = bh >> 2, h = bh & 3; const size_t t0 = (size_t)b * SEQ + c * 64;
    const bf16_t* ZG = (const bf16_t*)(ws + WS_ZG); const bf16_t* QT = (const bf16_t*)(ws + WS_BCUM); const bf16_t* KT = QT + (size_t)TP * 256; const bf16_t* STB = (const bf16_t*)(ws + WS_STB); const bf16_t* VT = (const bf16_t*)(ws + WS_VT);
    bf16_t* MIX = (bf16_t*)(ws + WS_MIX);
    const int fr = C.lane & 15, fq = C.lane >> 4;
    const size_t rq = t0 + 16 * qt + fr;
    bf16x8 qf[2];
#pragma unroll
    for (int ks = 0; ks < 2; ++ks) qf[ks] = *(const bf16x8*)(QT + rq * 256 + h * 64 + 32 * ks + 8 * fq);
    f32x4 a[4];
#pragma unroll
    for (int kt = 0; kt < 4; ++kt) {
        a[kt] = (f32x4){0.f, 0.f, 0.f, 0.f};
        if (kt <= qt) {
            const size_t rk = t0 + 16 * kt + fr;
#pragma unroll
            for (int ks = 0; ks < 2; ++ks) {
                const bf16x8 kf = *(const bf16x8*)(KT + rk * 256 + h * 64 + 32 * ks + 8 * fq);
                a[kt] = MFMA16(kf, qf[ks], a[kt]);
            }
#pragma unroll
            for (int r = 0; r < 4; ++r) if (16 * kt + 4 * fq + r > 16 * qt + fr) a[kt][r] = 0.f;
        }
    }
    bf16x8 pf[2];
#pragma unroll
    for (int kk = 0; kk < 2; ++kk) { u32x4 w; w.x = pk2(a[2 * kk][0], a[2 * kk][1]); w.y = pk2(a[2 * kk][2], a[2 * kk][3]); w.z = pk2(a[2 * kk + 1][0], a[2 * kk + 1][1]); w.w = pk2(a[2 * kk + 1][2], a[2 * kk + 1][3]); pf[kk] = __builtin_bit_cast(bf16x8, w); }
    f32x4 o[8]; float ss = 0.f;
#pragma unroll
    for (int dt = 0; dt < 8; ++dt) {
        f32x4 acc = (f32x4){0.f, 0.f, 0.f, 0.f};
        const size_t vrow = ((size_t)unit * 128 + 16 * dt + fr) * 64;
#pragma unroll
        for (int kk = 0; kk < 2; ++kk) {
            if (2 * kk <= qt) {
                const bf16_t* vp = VT + vrow + 32 * kk + 4 * fq; const u32x2 lo = *(const u32x2*)vp, hi = *(const u32x2*)(vp + 16);
                acc = MFMA16(__builtin_bit_cast(bf16x8, (u32x4){lo.x, lo.y, hi.x, hi.y}), pf[kk], acc);
            }
        }
#pragma unroll
        for (int ks = 0; ks < 2; ++ks) {
            const bf16x8 sf = *(const bf16x8*)(STB + vrow + 32 * ks + 8 * fq);
            acc = MFMA16(sf, qf[ks], acc);
        }
        o[dt] = acc; ss += acc[0] * acc[0] + acc[1] * acc[1] + acc[2] * acc[2] + acc[3] * acc[3];
    }
    ss += __shfl_xor(ss, 16); ss += __shfl_xor(ss, 32);
    const float rn = rsqrtf(ss * (1.f / 128.f) + EPS);
#pragma unroll
    for (int dt = 0; dt < 8; ++dt) {
        const f32x4 gn = *(const f32x4*)(P.in[19] + l * 128 + 16 * dt + 4 * fq);
        const u32x2 gw = *(const u32x2*)(ZG + rq * 1536 + 1024 + h * 128 + 16 * dt + 4 * fq);
        const float g0 = blo(gw.x), g1 = bhi(gw.x), g2 = blo(gw.y), g3 = bhi(gw.y);
        u32x2 w; w.x = pk2(o[dt][0] * rn * gn[0] * silu(g0), o[dt][1] * rn * gn[1] * silu(g1)); w.y = pk2(o[dt][2] * rn * gn[2] * silu(g2), o[dt][3] * rn * gn[3] * silu(g3));
        *(u32x2*)(MIX + rq * 1024 + 512 + h * 128 + 16 * dt + 4 * fq) = w;
    }
}

DI void gla_c_phase(const Ctx& C, int l) {
    unsigned char* ws = C.ws; const CAS Params& P = *C.p;
    const bf16_t* ZG = (const bf16_t*)(ws + WS_ZG); const bf16_t* QT = (const bf16_t*)(ws + WS_BCUM); const bf16_t* KT = QT + (size_t)TP * 256; const bf16_t* STB = (const bf16_t*)(ws + WS_STB); const bf16_t* VT = (const bf16_t*)(ws + WS_VT);
    bf16_t* MIX = (bf16_t*)(ws + WS_MIX);
    constexpr int PB = 144, U_BYTES = (64 + 128 + 128) * PB;
    const int fr = C.lane & 15, fq = C.lane >> 4, us = C.wave >> 2, qt = C.wave & 3;
    for (int pr = C.bx; pr < 512; pr += C.G) {
#pragma unroll
        for (int uu = 0; uu < 2; ++uu) {
            const int unit = 2 * pr + uu; const int bh = unit >> 6, c = unit & 63, b = bh >> 2, h = bh & 3; const size_t t0 = (size_t)b * SEQ + c * 64;
            LAS unsigned char* base = C.lds + uu * U_BYTES;
            { const int row = C.tid >> 3, c8 = C.tid & 7; *(LAS u32x4*)(base + row * PB + c8 * 16) = *(const u32x4*)(KT + (t0 + row) * 256 + h * 64 + 8 * c8); }
#pragma unroll
            for (int i = 0; i < 2; ++i) {
                const int row = (C.tid >> 3) + 64 * i, c8 = C.tid & 7;
                *(LAS u32x4*)(base + (64 + row) * PB + c8 * 16) = *(const u32x4*)(STB + ((size_t)unit * 128 + row) * 64 + 8 * c8);
                const int vr = (C.tid >> 4) + 32 * i, c16 = C.tid & 15;
                *(LAS u32x4*)(base + 192 * PB + vr * 288 + c16 * 16) = *(const u32x4*)(ZG + (t0 + vr) * 1536 + 512 + h * 128 + 8 * c16);
            }
        }
        const int unit = 2 * pr + us; const int bh = unit >> 6, c = unit & 63, b = bh >> 2, h = bh & 3; const size_t t0 = (size_t)b * SEQ + c * 64;
        const size_t rq = t0 + 16 * qt + fr;
        bf16x8 qf[2];
#pragma unroll
        for (int ks = 0; ks < 2; ++ks) qf[ks] = *(const bf16x8*)(QT + rq * 256 + h * 64 + 32 * ks + 8 * fq);
        __syncthreads();
        LAS unsigned char* Kl = C.lds + us * U_BYTES; LAS unsigned char* Sl = Kl + 64 * PB; LAS unsigned char* Vl = Kl + 192 * PB;
        f32x4 a[4];
#pragma unroll
        for (int kt = 0; kt < 4; ++kt) {
            a[kt] = (f32x4){0.f, 0.f, 0.f, 0.f};
            if (kt <= qt) {
#pragma unroll
                for (int ks = 0; ks < 2; ++ks) {
                    const bf16x8 kf = *(const LAS bf16x8*)(Kl + (16 * kt + fr) * PB + (32 * ks + 8 * fq) * 2);
                    a[kt] = MFMA16(kf, qf[ks], a[kt]);
                }
#pragma unroll
                for (int r = 0; r < 4; ++r) if (16 * kt + 4 * fq + r > 16 * qt + fr) a[kt][r] = 0.f;
            }
        }
        bf16x8 pf[2];
#pragma unroll
        for (int kk = 0; kk < 2; ++kk) { u32x4 w; w.x = pk2(a[2 * kk][0], a[2 * kk][1]); w.y = pk2(a[2 * kk][2], a[2 * kk][3]); w.z = pk2(a[2 * kk + 1][0], a[2 * kk + 1][1]); w.w = pk2(a[2 * kk + 1][2], a[2 * kk + 1][3]); pf[kk] = __builtin_bit_cast(bf16x8, w); }
        f32x4 o[8]; float ss = 0.f;
#pragma unroll
        for (int dt = 0; dt < 8; ++dt) {
            f32x4 acc = (f32x4){0.f, 0.f, 0.f, 0.f};
#pragma unroll
            for (int kk = 0; kk < 2; ++kk) {
                if (2 * kk <= qt) {
                    const LAS unsigned char* vp = Vl + (32 * kk + 4 * fq + (fr >> 2)) * 288 + 32 * dt + 8 * (fr & 3);
                    const u32x2 lo = __builtin_bit_cast(u32x2, __builtin_amdgcn_ds_read_tr16_b64_v4i16((LAS v4i16_t*)vp));
                    const u32x2 hi = __builtin_bit_cast(u32x2, __builtin_amdgcn_ds_read_tr16_b64_v4i16((LAS v4i16_t*)(vp + 16 * 288)));
                    acc = MFMA16(__builtin_bit_cast(bf16x8, (u32x4){lo.x, lo.y, hi.x, hi.y}), pf[kk], acc);
                }
            }
#pragma unroll
            for (int ks = 0; ks < 2; ++ks) {
                const bf16x8 sf = *(const LAS bf16x8*)(Sl + (16 * dt + fr) * PB + (32 * ks + 8 * fq) * 2);
                acc = MFMA16(sf, qf[ks], acc);
            }
            o[dt] = acc; ss += acc[0] * acc[0] + acc[1] * acc[1] + acc[2] * acc[2] + acc[3] * acc[3];
        }
        ss += __shfl_xor(ss, 16); ss += __shfl_xor(ss, 32);
        const float rn = rsqrtf(ss * (1.f / 128.f) + EPS);
#pragma unroll
        for (int dt = 0; dt < 8; ++dt) {
            const f32x4 gn = *(const f32x4*)(P.in[19] + l * 128 + 16 * dt + 4 * fq);
            const u32x2 gw = *(const u32x2*)(ZG + rq * 1536 + 1024 + h * 128 + 16 * dt + 4 * fq);
            const float g0 = blo(gw.x), g1 = bhi(gw.x), g2 = blo(gw.y), g3 = bhi(gw.y);
            u32x2 w; w.x = pk2(o[dt][0] * rn * gn[0] * silu(g0), o[dt][1] * rn * gn[1] * silu(g1)); w.y = pk2(o[dt][2] * rn * gn[2] * silu(g2), o[dt][3] * rn * gn[3] * silu(g3));
            *(u32x2*)(MIX + rq * 1024 + 512 + h * 128 + 16 * dt + 4 * fq) = w;
        }
        __syncthreads();
    }
}

DI void gla_decode_unit(const Ctx& C, int l, int unit) {
    unsigned char* ws = C.ws; const CAS Params& P = *C.p;
    const int b = unit >> 2, h = unit & 3; const size_t rb = (size_t)TP + b * 4;
    const bf16_t* ZG = (const bf16_t*)(ws + WS_ZG); const float* LR = (const float*)(ws + WS_LR); bf16_t* MIX = (bf16_t*)(ws + WS_MIX);
    LAS float* la = (LAS float*)C.lds;
    LAS float* qr = la + 256;
    LAS float* kr = qr + 256;
    LAS float* qe = kr + 256;
    LAS float* ke = qe + 256;
    LAS float* Am = ke + 256;
    LAS float* red = Am + 16;
    LAS float* opart = red + 8;
    if (C.tid < 256) {
        const int tt = C.tid >> 6, dk = C.tid & 63; float x = P.in[18][l * 256 + h * 64 + dk];
        const f32x4 l0 = *(const f32x4*)(LR + (rb + tt) * 16), l1 = *(const f32x4*)(LR + (rb + tt) * 16 + 4), l2 = *(const f32x4*)(LR + (rb + tt) * 16 + 8), l3 = *(const f32x4*)(LR + (rb + tt) * 16 + 12);
        const float* wg = P.in[17] + (size_t)(l * 16) * 256 + h * 64 + dk;
#pragma unroll
        for (int r = 0; r < 4; ++r) { x += l0[r] * wg[r * 256] + l1[r] * wg[(4 + r) * 256] + l2[r] * wg[(8 + r) * 256] + l3[r] * wg[(12 + r) * 256]; }
        la[tt * 64 + dk] = logsig(x) * (1.f / 16.f);
        qr[tt * 64 + dk] = bf2f(ZG[(rb + tt) * 1536 + h * 64 + dk]); kr[tt * 64 + dk] = bf2f(ZG[(rb + tt) * 1536 + 256 + h * 64 + dk]);
    }
    __syncthreads();
    if (C.tid < 64) { float run = 0.f;
#pragma unroll
        for (int tt = 0; tt < 4; ++tt) { run += la[tt * 64 + C.tid]; la[tt * 64 + C.tid] = run; } }
    __syncthreads();
    if (C.tid < 256) {
        const int tt = C.tid >> 6, dk = C.tid & 63; const float bt = la[tt * 64 + dk], b3 = la[3 * 64 + dk];
        qe[tt * 64 + dk] = 0.125f * qr[tt * 64 + dk] * __expf(bt); ke[tt * 64 + dk] = kr[tt * 64 + dk] * __expf(b3 - bt);
    } else if (C.tid < 272) {
        const int tt = (C.tid - 256) >> 2, s = (C.tid - 256) & 3; float sum = 0.f;
        if (s <= tt) for (int dk = 0; dk < 64; ++dk) sum += 0.125f * qr[tt * 64 + dk] * kr[s * 64 + dk] * __expf(la[tt * 64 + dk] - la[s * 64 + dk]);
        Am[C.tid - 256] = sum;
    }
    __syncthreads();
    {
        const int dv = C.tid & 127, dq = C.tid >> 7;
        float v[4], o[4] = {0.f, 0.f, 0.f, 0.f};
#pragma unroll
        for (int tt = 0; tt < 4; ++tt) v[tt] = bf2f(ZG[(rb + tt) * 1536 + 512 + h * 128 + dv]);
        const float* S0p = P.in[4] + ((size_t)(l * 128 + b) * 4 + h) * 8192 + (size_t)(16 * dq) * 128 + dv; float* Sn = C.out + O_GS + ((size_t)(l * 128 + b) * 4 + h) * 8192 + (size_t)(16 * dq) * 128 + dv;
        float S0[16];
#pragma unroll
        for (int i = 0; i < 16; ++i) S0[i] = S0p[i * 128];
#pragma unroll
        for (int i = 0; i < 16; ++i) {
            const int dk = 16 * dq + i;
            float sn = __expf(la[3 * 64 + dk]) * S0[i];
#pragma unroll
            for (int tt = 0; tt < 4; ++tt) { o[tt] += qe[tt * 64 + dk] * S0[i]; sn += ke[tt * 64 + dk] * v[tt]; }
            Sn[i * 128] = sn;
        }
#pragma unroll
        for (int tt = 0; tt < 4; ++tt) opart[(dq * 4 + tt) * 128 + dv] = o[tt];
    }
    __syncthreads();
    {
        const int tt = C.tid >> 7, dv = C.tid & 127;
        float o = opart[(0 * 4 + tt) * 128 + dv] + opart[(1 * 4 + tt) * 128 + dv] + opart[(2 * 4 + tt) * 128 + dv] + opart[(3 * 4 + tt) * 128 + dv];
        for (int s = 0; s <= tt; ++s) o += Am[tt * 4 + s] * bf2f(ZG[(rb + s) * 1536 + 512 + h * 128 + dv]);
        float ss = o * o;
#pragma unroll
        for (int of = 1; of < 64; of <<= 1) ss += __shfl_xor(ss, of);
        if (C.lane == 0) red[C.wave] = ss;
        __syncthreads();
        const float tot = red[2 * tt] + red[2 * tt + 1];
        const float rn = rsqrtf(tot * (1.f / 128.f) + EPS);
        const float gg = bf2f(ZG[(rb + tt) * 1536 + 1024 + h * 128 + dv]);
        const float val = o * rn * P.in[19][l * 128 + dv] * silu(gg);
        MIX[(rb + tt) * 1024 + 512 + h * 128 + dv] = (bf16_t)(pk2(val, 0.f) & 0xffffu);
    }
    __syncthreads();
}

__global__ void __launch_bounds__(512, 2) hymba_fwd(Params prm) {
    extern __shared__ __attribute__((aligned(16))) unsigned char smem[];
    cg::grid_group grid = cg::this_grid();
    Ctx C; C.lds = (LAS unsigned char*)smem; C.tid = threadIdx.x; C.lane = C.tid & 63; C.wave = __builtin_amdgcn_readfirstlane(C.tid >> 6);
    C.G = gridDim.x; C.bx = blockIdx.x; C.p = (const CAS Params*)__builtin_amdgcn_kernarg_segment_ptr(); C.ws = C.p->ws; C.out = C.p->out;
    (void)prm;

    unsigned* barw = (unsigned*)(C.ws + WS_BAR);
    if (C.bx == 0) for (int i = C.tid; i < XCD_BAR_WORDS; i += 512) barw[i] = 0u;
    if (C.tid < 4) ((LAS unsigned*)(C.lds + LDS_BYTES - 16))[C.tid] = 0u;
    grid.sync();
    XcdBarrier xbar = xcd_barrier_post(barw, (volatile LAS unsigned*)(C.lds + LDS_BYTES - 16));
    for (int rep = 0; rep < REP_P0; ++rep) p0_prologue(C);
    xcd_barrier(xbar);
    {   unsigned char* ws = C.ws;
        pg8::Gemm g{(const bf16_t*)(ws + WS_MEMB), (const bf16_t*)(ws + WS_WKV), 1024, 2048, 1024};
        const int n1 = (T / 256) * (5632 / 256);
        pg8::StaticOrder S; S.init(1024, 2048, C.G, (C.bx + C.G - (n1 % C.G)) % C.G);
        Epi<EK_MEM> E; E.c = EpiCtx{}; E.c.rss_in = (const float*)(ws + WS_RSSM); E.c.MKV = (float*)(ws + WS_MKV);
        pg8::gemm_phase(C.lds, C.tid, g, S, E);
    }
    int rep = 0;
    for (int ph = 0; ph < 24; ++ph) {
        { int t_ = threadIdx.x; asm volatile("" : "+v"(t_)); C.tid = t_; C.lane = t_ & 63; C.wave = __builtin_amdgcn_readfirstlane(t_ >> 6); }
        asm volatile("" : "+s"(C.ws), "+s"(C.out), "+s"(C.p));
        unsigned char* ws = C.ws; float* RSS = (float*)(ws + WS_RSS);
        const int l = ph / 12, k = ph - 12 * l;
        unsigned char* wl = ws + WS_WL + (size_t)l * WL_SIZE;
        EpiCtx ec{}; ec.l = l;
        if (k == 0 || k == 10) {
            pg8::Gemm g{(const bf16_t*)(ws + WS_XB), (const bf16_t*)(wl + (k == 0 ? WL_W1 : WL_W2)), T, 5632, 1024};
            pg8::StaticOrder S; S.init(T, 5632, C.G, C.bx);
            ec.rss_in = RSS + (size_t)(4 * l + (k == 0 ? 0 : 3)) * T; ec.H = (bf16_t*)(ws + WS_H);
            Epi<EK_SWIGLU> E; E.c = ec; pg8::gemm_phase(C.lds, C.tid, g, S, E);
            if (ph == 0 && rep == 0) convert_in_slack(C, 0, T_WD1, 688, (T / 256) * 22 + 32);
            if (ph == 10 && rep == 0) convert_in_slack(C, 1, 704, T_WKV, (T / 256) * 22);
        } else if (k == 1 || k == 6 || k == 9 || k == 11) {
            const bf16_t* A; const bf16_t* B; int K; float sc; int ro;
            if (k == 1) { A = (const bf16_t*)(ws + WS_H); B = (const bf16_t*)(wl + WL_WD1); K = FF; sc = 0.5f; ro = 4 * l + 1; }
            else if (k == 6) { A = (const bf16_t*)(ws + WS_MIX); B = (const bf16_t*)(wl + WL_WOUT); K = 1024; sc = 1.f; ro = 4 * l + 2; }
            else if (k == 9) { A = (const bf16_t*)(ws + WS_OX); B = (const bf16_t*)(wl + WL_WO); K = 512; sc = 1.f; ro = 4 * l + 3; }
            else { A = (const bf16_t*)(ws + WS_H); B = (const bf16_t*)(wl + WL_WD2); K = FF; sc = 0.5f; ro = 4 * l + 4; }
            pg8::Gemm g{A, B, TP, 1024, K};
            pg8::StaticOrder S; S.init(TP, 1024, C.G, C.bx);
            ec.rss_out = RSS + (size_t)ro * T; ec.X = (ph == 23) ? C.out : nullptr; ec.XB = (bf16_t*)(ws + WS_XB); ec.scale = sc;
            Epi<EK_RES> E; E.c = ec; pg8::gemm_phase(C.lds, C.tid, g, S, E);
            thin_res_gemm(C, A, B, K, sc, RSS + (size_t)ro * T, (ph == 23) ? C.out : nullptr);
        } else if (k == 2) {
            pg8::Gemm g{(const bf16_t*)(ws + WS_XB), (const bf16_t*)(wl + WL_WIN), T, INWP, 1024};
            pg8::StaticOrder S; S.init(T, INWP, C.G, C.bx);
            ec.rss_in = RSS + (size_t)(4 * l + 1) * T; ec.QS = (bf16_t*)(ws + WS_QS); ec.KS = (bf16_t*)(ws + WS_KS); ec.VS = (bf16_t*)(ws + WS_VS); ec.ZG = (bf16_t*)(ws + WS_ZG);
            ec.LR = (float*)(ws + WS_LR); ec.rope = (const float2*)(ws + WS_ROPE); ec.gq = C.p->in[14] + l * 64; ec.gk = C.p->in[15] + l * 64;
            ec.okp = C.out + O_KP; ec.ovp = C.out + O_VP; ec.oks = C.out + O_KS; ec.ovs = C.out + O_VS;
            Epi<EK_WIN> E; E.c = ec; pg8::gemm_phase(C.lds, C.tid, g, S, E);
            if (ph == 2 && rep == 0) convert_in_slack(C, 0, 688, T_WKV, (T / 256) * 10);
        } else if (k == 3) {
            for (int u = C.bx; u < 256; u += C.G) swa_prompt_unit(C, l, u);
            gla_a_phase(C, l);
        } else if (k == 4) {
            gla_scan(C, l);
            for (int u = C.bx; u < 512; u += C.G) gla_decode_unit(C, l, u);
            for (int u = C.bx; u < 256; u += C.G) swa_decode_unit(C, l, u);
        } else if (k == 5) {
            gla_c_phase(C, l);
        } else if (k == 7) {
            pg8::Gemm g{(const bf16_t*)(ws + WS_XB), (const bf16_t*)(wl + WL_WQ), T, 512, 1024};
            pg8::StaticOrder S; S.init(T, 512, C.G, C.bx);
            ec.rss_in = RSS + (size_t)(4 * l + 2) * T; ec.QX = (bf16_t*)(ws + WS_QX);
            Epi<EK_XQ> E; E.c = ec; pg8::gemm_phase(C.lds, C.tid, g, S, E);
            if (ph == 7 && rep == 0) convert_in_slack(C, 1, 0, 704, (T / 256) * 2);
        } else {
            if (C.G == 256) {
                if (C.bx < 128) { xattn_unit(C, l, C.bx); xattn_unit(C, l, 128 + C.bx); }
                else for (int i = 0; i < 3; ++i) xattn_unit(C, l, 128 + 128 + 3 * (C.bx - 128) + i);
            } else for (int u = C.bx; u < 640; u += C.G) xattn_unit(C, l, u);
        }
        if (ph != 23) for (int r2 = 0; r2 < REP_SYNC; ++r2) xcd_barrier(xbar);
        {
            const int want = (k == 0 || k == 2 || k == 7 || k == 10) ? REP_GEMM : (k == 3 ? REP3 : (k == 4 ? REP4 : k == 5 ? REP5 : (k == 8 ? REP8 : 1)));
            if (rep + 1 < want) { ++rep; --ph; } else rep = 0;
        }
    }
}

extern "C" void kernel_launch(void* const* d_in, const int* in_sizes, int n_in, void* d_out, int out_size, void* d_ws, size_t ws_size, hipStream_t stream) {
    static int grid = 0;
    if (grid == 0) {
        if (n_in != 33 || ws_size < WS_TOTAL) { fprintf(stderr, "kernel_launch: need 33 inputs and %zu bytes of workspace; got %d inputs, %zu bytes\n", (size_t)WS_TOTAL, n_in, ws_size); grid = -1; return; }
        int dev = 0, cus = 0, per_cu = 0;
        (void)hipGetDevice(&dev); (void)hipDeviceGetAttribute(&cus, hipDeviceAttributeMultiprocessorCount, dev);
        if (hipFuncSetAttribute((const void*)hymba_fwd, hipFuncAttributeMaxDynamicSharedMemorySize, LDS_BYTES) != hipSuccess) { fprintf(stderr, "kernel_launch: hipFuncSetAttribute failed\n"); grid = -1; return; }
        if (hipOccupancyMaxActiveBlocksPerMultiprocessor(&per_cu, (const void*)hymba_fwd, 512, LDS_BYTES) != hipSuccess || per_cu < 1) { fprintf(stderr, "kernel_launch: occupancy query gave %d\n", per_cu); grid = -1; return; }
        grid = cus * per_cu;
    }
    if (grid < 0) return;
    Params p{};
    for (int i = 0; i < 33; ++i) p.in[i] = (const float*)d_in[i];
    p.out = (float*)d_out; p.ws = (unsigned char*)d_ws;
    void* args[] = {&p};
    hipError_t e = hipLaunchCooperativeKernel((const void*)hymba_fwd, dim3(grid), dim3(512), args, LDS_BYTES, stream);
    if (e != hipSuccess) fprintf(stderr, "kernel_launch: cooperative launch failed: %s (grid %d)\n", hipGetErrorString(e), grid);
}
```

```cpp
#include <hip/hip_runtime.h>
#include <hip/hip_cooperative_groups.h>
#include <cstdio>
#include <cstdint>
namespace cg = cooperative_groups;

#define LAS __attribute__((address_space(3)))
#define DI __device__ __forceinline__
typedef unsigned short bf16_t;
typedef short bf16x8 __attribute__((ext_vector_type(8)));
typedef float f32x4 __attribute__((ext_vector_type(4)));
typedef unsigned u32x4 __attribute__((ext_vector_type(4)));
typedef unsigned u32x2 __attribute__((ext_vector_type(2)));
typedef short v4i16_t __attribute__((ext_vector_type(4)));
#define MFMA16(a, b, c) __builtin_amdgcn_mfma_f32_16x16x32_bf16((a), (b), (c), 0, 0, 0)

constexpr int TP = 16384, TS = 512, T = TP + TS, DM = 1024, FF = 2816, SEQ = 4096;
constexpr int INWP = 2560;
constexpr float EPS = 1e-6f;
constexpr size_t O_Y = 0, O_KP = 17301504, O_VP = 17432576, O_GP = 17563648, O_MKP = 17825792, O_MVP = 18874368, O_KS = 19922944, O_VS = 24117248, O_GS = 28311552;
constexpr size_t al(size_t x) { return (x + 4095) & ~(size_t)4095; }
constexpr size_t WS_RSS = 0;
constexpr size_t WS_RSSM = al(WS_RSS + (size_t)9 * T * 4);
constexpr size_t WS_ROPE = al(WS_RSSM + 1024 * 4);
constexpr size_t WS_XB = al(WS_ROPE + (size_t)4100 * 32 * 8);
constexpr size_t WS_H = al(WS_XB + (size_t)T * 1024 * 2);
constexpr size_t WS_QS = al(WS_H + (size_t)T * FF * 2);
constexpr size_t WS_KS = al(WS_QS + (size_t)T * 512 * 2);
constexpr size_t WS_VS = al(WS_KS + (size_t)T * 128 * 2);
constexpr size_t WS_ZG = al(WS_VS + (size_t)T * 128 * 2);
constexpr size_t WS_LR = al(WS_ZG + (size_t)T * 1536 * 2);
constexpr size_t WS_MIX = al(WS_LR + (size_t)T * 16 * 4);
constexpr size_t WS_QX = al(WS_MIX + (size_t)T * 1024 * 2);
constexpr size_t WS_OX = al(WS_QX + (size_t)T * 512 * 2);
constexpr size_t WS_MEMB = al(WS_OX + (size_t)T * 512 * 2);
constexpr size_t WS_MKV = al(WS_MEMB + (size_t)1024 * 1024 * 2);
constexpr size_t WS_BCUM = al(WS_MKV + (size_t)1024 * 2048 * 4);
constexpr size_t WS_ST = al(WS_BCUM + (size_t)TP * 256 * 4);
constexpr size_t WS_VT = al(WS_ST + (size_t)1024 * 8192 * 4);
constexpr size_t WS_DEC = al(WS_VT + (size_t)1024 * 8192 * 2);
constexpr size_t WS_WKV = al(WS_DEC + (size_t)1024 * 64 * 4);
constexpr size_t WS_WL = al(WS_WKV + (size_t)2048 * 1024 * 2);
constexpr size_t WL_W1 = 0;
constexpr size_t WL_WD1 = WL_W1 + (size_t)5632 * 1024 * 2;
constexpr size_t WL_WIN = WL_WD1 + (size_t)1024 * FF * 2;
constexpr size_t WL_WOUT = WL_WIN + (size_t)INWP * 1024 * 2;
constexpr size_t WL_WQ = WL_WOUT + (size_t)1024 * 1024 * 2;
constexpr size_t WL_WO = WL_WQ + (size_t)512 * 1024 * 2;
constexpr size_t WL_W2 = WL_WO + (size_t)1024 * 512 * 2;
constexpr size_t WL_WD2 = WL_W2 + (size_t)5632 * 1024 * 2;
constexpr size_t WL_SIZE = al(WL_WD2 + (size_t)1024 * FF * 2);
constexpr size_t WS_STB = WS_WL + 2 * WL_SIZE;
constexpr size_t WS_BAR = al(WS_STB + (size_t)1024 * 8192 * 2);
constexpr size_t WS_TOTAL = WS_BAR + 16384;
constexpr int LDS_BYTES = 147456;
constexpr int REP_GEMM = 1, REP_ATT = 1, REP_P0 = 1, REP_SYNC = 1, REP3 = 1, REP4 = 1, REP5 = 1, REP8 = 1;

DI float bf2f(unsigned h) { return __builtin_bit_cast(float, h << 16); }
typedef float f32x2_t __attribute__((ext_vector_type(2)));
typedef __bf16 bf16x2_t __attribute__((ext_vector_type(2)));
DI unsigned pk2(float lo, float hi) { const f32x2_t v = {lo, hi}; const bf16x2_t b = __builtin_convertvector(v, bf16x2_t); return __builtin_bit_cast(unsigned, b); }
DI float blo(unsigned w) { return __builtin_bit_cast(float, w << 16); }
DI float bhi(unsigned w) { return __builtin_bit_cast(float, w & 0xffff0000u); }
DI float silu(float x) { return x * __builtin_amdgcn_rcpf(1.f + __builtin_amdgcn_exp2f(x * -1.4426950408889634f)); }
DI float logsig(float x) { return fminf(x, 0.f) - __logf(1.f + __expf(-fabsf(x))); }

#define XB_TMO      128
#define XB_XCNT(j)  (256  + 64 * (j))
#define XB_XSUB(j)  (1280 + 64 * (j))
#define XB_XGEN(j)  (2304 + 64 * (j))
#define XB_TOP      3328
#define XB_TOPGEN   3392
#define XCD_BAR_WORDS 3456
#define XB_SPIN_CAP (1u << 18)
DI unsigned xb_ld(unsigned* p)              { return __hip_atomic_load(p, __ATOMIC_RELAXED, __HIP_MEMORY_SCOPE_AGENT); }
DI unsigned xb_add(unsigned* p, unsigned v) { return __hip_atomic_fetch_add(p, v, __ATOMIC_RELAXED, __HIP_MEMORY_SCOPE_AGENT); }
DI unsigned xb_xcc_id() { return (unsigned)__builtin_amdgcn_s_getreg((3 << 11) | 20) & 0xFu; }
#define XB_SPIN(cond, bar) do { unsigned _sp = 0; while (cond) { __builtin_amdgcn_s_sleep(1); \
    if ((++_sp & 255u) == 0u) { if (xb_ld(&(bar)[XB_TMO])) break; if (_sp > XB_SPIN_CAP) { atomicAdd(&(bar)[XB_TMO], 1u); break; } } } } while (0)
struct XcdBarrier { unsigned* bar; unsigned x; volatile LAS unsigned* st; };
DI XcdBarrier xcd_barrier_post(unsigned* bar, volatile LAS unsigned* st) {
    XcdBarrier b; b.bar = bar; b.x = xb_xcc_id(); b.st = st;
    if (threadIdx.x == 0) (void)xb_add(&bar[XB_XCNT(b.x)], 1u);
    return b;
}
DI void xcd_barrier_complete(unsigned* bar, unsigned x, unsigned& nloc, unsigned& nx) {
    const unsigned G = gridDim.x * gridDim.y * gridDim.z;
    unsigned sum, cnt, mine, sp = 0u;
    for (;;) {
        sum = 0u; cnt = 0u; mine = 0u;
#pragma unroll
        for (unsigned j = 0; j < 16; ++j) { const unsigned c = xb_ld(&bar[XB_XCNT(j)]); sum += c; cnt += (c > 0u) ? 1u : 0u; mine = (j == x) ? c : mine; }
        if (sum == G) break;
        __builtin_amdgcn_s_sleep(1);
        if ((++sp & 255u) == 0u) { if (xb_ld(&bar[XB_TMO])) break; if (sp > XB_SPIN_CAP) { atomicAdd(&bar[XB_TMO], 1u); break; } }
    }
    nloc = mine > 0u ? mine : 1u; nx = cnt > 0u ? cnt : 1u;
}
DI void xcd_barrier(const XcdBarrier& b) {
    asm volatile("s_waitcnt vmcnt(0)" ::: "memory");
    __syncthreads();
    if (threadIdx.x == 0) {
        unsigned* bar = b.bar;
        __builtin_amdgcn_s_waitcnt(0);
        unsigned nloc = b.st[0], nx = b.st[1];
        if (nloc == 0u) { xcd_barrier_complete(bar, b.x, nloc, nx); b.st[0] = nloc; b.st[1] = nx; }
        const unsigned old = xb_add(&bar[XB_XSUB(b.x)], 1u);
        const unsigned gen = old / nloc;
        if (old + 1u == (gen + 1u) * nloc) {
            __builtin_amdgcn_fence(__ATOMIC_RELEASE, "agent");
            asm volatile("s_waitcnt vmcnt(0)" ::: "memory");
            const unsigned og = xb_add(&bar[XB_TOP], 1u);
            const unsigned tg = og / nx;
            if (og + 1u == (tg + 1u) * nx) xb_add(&bar[XB_TOPGEN], 1u);
            else XB_SPIN(xb_ld(&bar[XB_TOPGEN]) == tg, bar);
            __builtin_amdgcn_fence(__ATOMIC_ACQUIRE, "agent");
            xb_add(&bar[XB_XGEN(b.x)], 1u);
            asm volatile("s_waitcnt vmcnt(0)" ::: "memory");
        } else {
            XB_SPIN(xb_ld(&bar[XB_XGEN(b.x)]) == gen, bar);
            __builtin_amdgcn_fence(__ATOMIC_ACQUIRE, "agent");
            asm volatile("s_waitcnt vmcnt(0)" ::: "memory");
        }
    }
    __syncthreads();
}

namespace pg8 {
constexpr int BM = 256, BK = 64, HALF = 128, HTB = HALF * BK * 2, STAGE_BYTES = 8 * HTB, NXCD = 8, WGM = 8;
DI int lds_byte(int r, int c) { const int st = (r >> 4) * 2 + (c >> 5), rr = r & 15, cc = c & 31, ob = rr * 64 + cc * 2; return st * 1024 + (ob ^ (((ob >> 9) & 1) << 5)); }
DI void stage_rc(int b, int& R, int& C) { const int st = b / 1024, sb = b % 1024, swz = sb ^ (((sb >> 9) & 1) << 5); R = (st >> 1) * 16 + swz / 64; C = (st & 1) * 32 + (swz % 64) / 2; }
DI int perm32(int rho) { const int n = rho >> 4, i = rho & 15; return 8 * (i >> 2) + 4 * n + (i & 3); }
struct Unit { int pm, pn; };
struct Gemm { const bf16_t* A; const bf16_t* Bt; int M, N, K; };
struct StaticOrder {
    int nM, nN, nwg, G, c;
    DI void init(int M, int N, int G_, int c_) { nM = M / BM; nN = N / BM; nwg = nM * nN; G = G_; c = c_; }
    DI bool next(int i, Unit& u) const {
        const long L = (long)i * G + c; if (L >= nwg) return false;
        int wgid = (int)L; { const int q = nwg / NXCD, r = nwg % NXCD, xcd = wgid % NXCD, off = wgid / NXCD; wgid = (xcd < r ? xcd * (q + 1) : r * (q + 1) + (xcd - r) * q) + off; }
        const int nig = WGM * nN, gid = wgid / nig, fm = gid * WGM, gsz = (nM - fm) < WGM ? (nM - fm) : WGM;
        u.pm = fm + ((wgid % nig) % gsz); u.pn = (wgid % nig) / gsz; return true;
    }
};
template <class Epi, class Sched>
DI void gemm_phase(LAS unsigned char* lds, const int tid, const Gemm g, const Sched& S, const Epi& E) {
    const int wid = __builtin_amdgcn_readfirstlane(tid >> 6), lane = tid & 63, wr = wid >> 2, wc = wid & 3, fr = lane & 15, fq = lane >> 4;
    const int K = g.K, nt = K / BK;
    unsigned voffA[2], voffB[2];
#pragma unroll
    for (int i = 0; i < 2; ++i) { int R, C; stage_rc(tid * 16 + i * 8192, R, C); const int Rb = (R & ~31) + perm32(R & 31);
        voffA[i] = (unsigned)(R * K + C) * 2u; voffB[i] = (unsigned)(Rb * K + C) * 2u; }
    const size_t kstep = (size_t)(BK * 2);
    const size_t hstep = (size_t)HALF * K * 2;
    const size_t tstep = 2 * hstep;
    const unsigned ldsw = (unsigned)wid * 1024u;
    const int aoff = lds_byte(wr * 64 + fr, fq * 8), boff = lds_byte(wc * 32 + fr, fq * 8);
#define PG8_SA(b, h) (((b) * 2 + (h)) * HTB)
#define PG8_SB(b, h) ((4 + (b) * 2 + (h)) * HTB)
#define PG8_STAGE(bufoff, gbase, voff) do { _Pragma("unroll") for (int _i = 0; _i < 2; ++_i) \
        __builtin_amdgcn_global_load_lds((const unsigned*)((const char*)(gbase) + (voff)[_i]), (LAS unsigned*)(lds + (bufoff) + ldsw + _i * 8192), 16, 0, 0); } while (0)
#define PG8_LDA(dst, b, h) do { _Pragma("unroll") for (int m = 0; m < 4; ++m) _Pragma("unroll") for (int k = 0; k < 2; ++k) dst[m][k] = *(const LAS bf16x8*)(lds + PG8_SA(b, h) + aoff + m * 2048 + k * 1024); } while (0)
#define PG8_LDB(dst, b, h) do { _Pragma("unroll") for (int n = 0; n < 2; ++n) _Pragma("unroll") for (int k = 0; k < 2; ++k) dst[n][k] = *(const LAS bf16x8*)(lds + PG8_SB(b, h) + boff + n * 2048 + k * 1024); } while (0)
#define PG8_MMA(ai, bj, At, Bt) do { __builtin_amdgcn_s_setprio(1); _Pragma("unroll") for (int m = 0; m < 4; ++m) _Pragma("unroll") for (int n = 0; n < 2; ++n) _Pragma("unroll") for (int k = 0; k < 2; ++k) \
        acc[ai][bj][m][n] = __builtin_amdgcn_mfma_f32_16x16x32_bf16(Bt[n][k], At[m][k], acc[ai][bj][m][n], 0, 0, 0); __builtin_amdgcn_s_setprio(0); } while (0)
#define PG8_WAIT_V(n) asm volatile("s_waitcnt vmcnt(" #n ")" ::: "memory")
#define PG8_WAIT_L(n) asm volatile("s_waitcnt lgkmcnt(" #n ")" ::: "memory")
#define PG8_BAR __builtin_amdgcn_s_barrier()
#define PG8_SCHED __builtin_amdgcn_sched_barrier(0)
    Unit cur, nxt; int ui = 0;
    if (!S.next(0, cur)) return;
    f32x4 acc[2][2][4][2];
#pragma unroll
    for (int a = 0; a < 2; ++a)
#pragma unroll
        for (int b = 0; b < 2; ++b)
#pragma unroll
            for (int m = 0; m < 4; ++m)
#pragma unroll
                for (int n = 0; n < 2; ++n) acc[a][b][m][n] = (f32x4){0.f, 0.f, 0.f, 0.f};
    bf16x8 At[4][2], B0[2][2], B1[2][2];
    const char* cA = (const char*)g.A + (size_t)cur.pm * tstep; const char* cB = (const char*)g.Bt + (size_t)cur.pn * tstep;
    PG8_STAGE(PG8_SB(0, 0), cB, voffB); PG8_STAGE(PG8_SB(0, 1), cB + hstep, voffB); PG8_STAGE(PG8_SA(0, 0), cA, voffA); PG8_STAGE(PG8_SA(0, 1), cA + hstep, voffA);
    if (wr == 1) PG8_BAR;
    PG8_WAIT_V(2); PG8_BAR;
    PG8_STAGE(PG8_SB(1, 0), cB + kstep, voffB); PG8_STAGE(PG8_SA(1, 0), cA + kstep, voffA); PG8_STAGE(PG8_SB(1, 1), cB + hstep + kstep, voffB);
    PG8_WAIT_V(6); PG8_BAR;
    for (;;) {
        const bool has_next = S.next(ui + 1, nxt);
        const char* nA = has_next ? (const char*)g.A + (size_t)nxt.pm * tstep : cA; const char* nB = has_next ? (const char*)g.Bt + (size_t)nxt.pn * tstep : cB;
        for (int t = 0; t < nt; t += 2) {
            const bool last = (t == nt - 2);
            const char* a1 = cA + (size_t)(t + 1) * kstep;
            const char* a2 = last ? nA : cA + (size_t)(t + 2) * kstep; const char* b2 = last ? nB : cB + (size_t)(t + 2) * kstep;
            const char* a3 = a2 + kstep; const char* b3 = b2 + kstep;
            PG8_LDB(B0, 0, 0); PG8_LDB(B1, 0, 1); PG8_SCHED; PG8_LDA(At, 0, 0); PG8_STAGE(PG8_SA(1, 1), a1 + hstep, voffA);
            PG8_WAIT_V(8); PG8_WAIT_L(0); PG8_BAR; PG8_MMA(0, 0, At, B0); PG8_MMA(0, 1, At, B1); PG8_BAR; PG8_SCHED;
            PG8_LDA(At, 0, 1); PG8_STAGE(PG8_SB(0, 0), b2, voffB); PG8_STAGE(PG8_SB(0, 1), b2 + hstep, voffB); PG8_STAGE(PG8_SA(0, 0), a2, voffA);
            PG8_WAIT_V(8); PG8_WAIT_L(0); PG8_BAR; PG8_MMA(1, 0, At, B0); PG8_MMA(1, 1, At, B1); PG8_BAR; PG8_SCHED;
            PG8_LDB(B0, 1, 0); PG8_LDB(B1, 1, 1); PG8_SCHED; PG8_LDA(At, 1, 0); PG8_STAGE(PG8_SA(0, 1), a2 + hstep, voffA);
            PG8_WAIT_V(8); PG8_WAIT_L(0); PG8_BAR; PG8_MMA(0, 0, At, B0); PG8_MMA(0, 1, At, B1); PG8_BAR; PG8_SCHED;
            PG8_LDA(At, 1, 1); PG8_STAGE(PG8_SB(1, 0), b3, voffB); PG8_STAGE(PG8_SB(1, 1), b3 + hstep, voffB); PG8_STAGE(PG8_SA(1, 0), a3, voffA);
            PG8_WAIT_V(8); PG8_WAIT_L(0); PG8_BAR; PG8_MMA(1, 0, At, B0); PG8_MMA(1, 1, At, B1); PG8_BAR; PG8_SCHED;
        }
        if (wr == 0) PG8_BAR;
        E(acc, cur, wr, wc, fr, fq);
        if (!has_next) break;
#pragma unroll
        for (int a = 0; a < 2; ++a)
#pragma unroll
            for (int b = 0; b < 2; ++b)
#pragma unroll
                for (int m = 0; m < 4; ++m)
#pragma unroll
                    for (int n = 0; n < 2; ++n) acc[a][b][m][n] = (f32x4){0.f, 0.f, 0.f, 0.f};
        cur = nxt; cA = nA; cB = nB; ++ui;
        if (wr == 1) PG8_BAR;
    }
    PG8_WAIT_V(0);
    PG8_BAR;
#undef PG8_SA
#undef PG8_SB
#undef PG8_STAGE
#undef PG8_LDA
#undef PG8_LDB
#undef PG8_MMA
#undef PG8_WAIT_V
#undef PG8_WAIT_L
#undef PG8_BAR
#undef PG8_SCHED
}
}

struct EpiCtx {
    const float* rss_in; float* rss_out; float* X; bf16_t* XB; bf16_t* H;
    bf16_t *QS, *KS, *VS, *ZG; float* LR; const float2* rope; const float *gq, *gk;
    float *okp, *ovp, *oks, *ovs; bf16_t* QX; float* MKV; float scale; int l;
};
enum { EK_SWIGLU = 0, EK_RES = 1, EK_WIN = 2, EK_XQ = 3, EK_MEM = 4 };
template <int KIND> struct Epi {
    EpiCtx c;
    DI void operator()(const f32x4 (&acc)[2][2][4][2], const pg8::Unit& u, int wr, int wc, int fr, int fq) const {
        const int row0 = u.pm * 256 + wr * 64 + fr;
        const int cl = wc * 32 + 8 * fq;
        if constexpr (KIND == EK_RES) {
            u32x4 xo[2][4][2];
#pragma unroll
            for (int ai = 0; ai < 2; ++ai)
#pragma unroll
                for (int m = 0; m < 4; ++m)
#pragma unroll
                    for (int bj = 0; bj < 2; ++bj) xo[ai][m][bj] = *(const u32x4*)(c.XB + (size_t)(row0 + ai * 128 + m * 16) * DM + u.pn * 256 + bj * 128 + cl);
#pragma unroll
            for (int ai = 0; ai < 2; ++ai)
#pragma unroll
                for (int m = 0; m < 4; ++m) {
                    const int r = row0 + ai * 128 + m * 16;
                    float ss = 0.f;
#pragma unroll
                    for (int bj = 0; bj < 2; ++bj) {
                        bf16_t* xb = c.XB + (size_t)r * DM + u.pn * 256 + bj * 128 + cl;
                        const u32x4 xv = xo[ai][m][bj];
                        f32x4 x0 = (f32x4){blo(xv[0]), bhi(xv[0]), blo(xv[1]), bhi(xv[1])}, x1 = (f32x4){blo(xv[2]), bhi(xv[2]), blo(xv[3]), bhi(xv[3])};
                        x0 = x0 + acc[ai][bj][m][0] * c.scale; x1 = x1 + acc[ai][bj][m][1] * c.scale;
                        if (c.X) { float* xp = c.X + (size_t)r * DM + u.pn * 256 + bj * 128 + cl; *(f32x4*)xp = x0; *(f32x4*)(xp + 4) = x1; }
                        else {
                            u32x4 w; w.x = pk2(x0[0], x0[1]); w.y = pk2(x0[2], x0[3]); w.z = pk2(x1[0], x1[1]); w.w = pk2(x1[2], x1[3]);
                            *(u32x4*)xb = w;
#pragma unroll
                            for (int e = 0; e < 4; ++e) { const float a0 = blo(w[e]), a1 = bhi(w[e]); ss += a0 * a0 + a1 * a1; }
                        }
                    }
                    if (!c.X) { ss += __shfl_xor(ss, 16); ss += __shfl_xor(ss, 32); if (fq == 0) atomicAdd(c.rss_out + r, ss); }
                }
            return;
        }
#pragma unroll
        for (int ai = 0; ai < 2; ++ai)
#pragma unroll
            for (int m = 0; m < 4; ++m) {
                const int r = row0 + ai * 128 + m * 16;
                if constexpr (KIND == EK_SWIGLU) {
                    const float rs = rsqrtf(c.rss_in[r] * (1.f / 1024.f) + EPS);
                    const float rsn = rs * -1.4426950408889634f, irs2 = __builtin_amdgcn_rcpf(rs * rs);
                    float hv[8];
#pragma unroll
                    for (int n = 0; n < 2; ++n)
#pragma unroll
                        for (int j = 0; j < 4; ++j) { const float g0 = acc[ai][0][m][n][j], u0 = acc[ai][1][m][n][j];
                            hv[n * 4 + j] = (g0 * u0) * __builtin_amdgcn_rcpf(__builtin_fmaf(__builtin_amdgcn_exp2f(g0 * rsn), irs2, irs2)); }
                    u32x4 w; w.x = pk2(hv[0], hv[1]); w.y = pk2(hv[2], hv[3]); w.z = pk2(hv[4], hv[5]); w.w = pk2(hv[6], hv[7]);
                    *(u32x4*)(c.H + (size_t)r * FF + u.pn * 128 + cl) = w;
                } else if constexpr (KIND == EK_XQ) {
                    const float rs = rsqrtf(c.rss_in[r] * (1.f / 1024.f) + EPS);
#pragma unroll
                    for (int bj = 0; bj < 2; ++bj) {
                        const f32x4 a0 = acc[ai][bj][m][0] * rs, a1 = acc[ai][bj][m][1] * rs;
                        u32x4 w; w.x = pk2(a0[0], a0[1]); w.y = pk2(a0[2], a0[3]); w.z = pk2(a1[0], a1[1]); w.w = pk2(a1[2], a1[3]);
                        *(u32x4*)(c.QX + (size_t)r * 512 + u.pn * 256 + bj * 128 + cl) = w;
                    }
                } else if constexpr (KIND == EK_MEM) {
                    const float rs = rsqrtf(c.rss_in[r] * (1.f / 1024.f) + EPS);
#pragma unroll
                    for (int bj = 0; bj < 2; ++bj) {
                        float* p = c.MKV + (size_t)r * 2048 + u.pn * 256 + bj * 128 + cl;
                        *(f32x4*)p = acc[ai][bj][m][0] * rs; *(f32x4*)(p + 4) = acc[ai][bj][m][1] * rs;
                    }
                } else {
                    const float rs = rsqrtf(c.rss_in[r] * (1.f / 1024.f) + EPS);
                    const int pn = u.pn;
                    if (pn < 2 || (pn == 2 && wc < 2)) {
                        const bool isq = pn < 2; const int head = isq ? (4 * pn + wc) : wc;
                        const float* gn = isq ? c.gq : c.gk;
                        float ss = 0.f;
#pragma unroll
                        for (int bj = 0; bj < 2; ++bj)
#pragma unroll
                            for (int n = 0; n < 2; ++n)
#pragma unroll
                                for (int j = 0; j < 4; ++j) { const float v = acc[ai][bj][m][n][j] * rs; ss += v * v; }
                        ss += __shfl_xor(ss, 16); ss += __shfl_xor(ss, 32);
                        const float rq = rsqrtf(ss * (1.f / 64.f) + EPS) * rs * (isq ? 0.18033688011112042f : 1.f);
                        const int ridx = r < TP ? (r & (SEQ - 1)) : (4096 + (r & 3));
                        const float2* rp = c.rope + (size_t)ridx * 32 + 8 * fq;
                        float o1[8], o2[8];
#pragma unroll
                        for (int n = 0; n < 2; ++n)
#pragma unroll
                            for (int j = 0; j < 4; ++j) {
                                const int d = 8 * fq + 4 * n + j; const float2 cs = rp[4 * n + j];
                                const float y1 = acc[ai][0][m][n][j] * rq * gn[d], y2 = acc[ai][1][m][n][j] * rq * gn[32 + d];
                                o1[4 * n + j] = y1 * cs.x - y2 * cs.y; o2[4 * n + j] = y2 * cs.x + y1 * cs.y;
                            }
                        u32x4 w1, w2; w1.x = pk2(o1[0], o1[1]); w1.y = pk2(o1[2], o1[3]); w1.z = pk2(o1[4], o1[5]); w1.w = pk2(o1[6], o1[7]);
                        w2.x = pk2(o2[0], o2[1]); w2.y = pk2(o2[2], o2[3]); w2.z = pk2(o2[4], o2[5]); w2.w = pk2(o2[6], o2[7]);
                        if (isq) { bf16_t* p = c.QS + (size_t)r * 512 + head * 64 + 8 * fq; *(u32x4*)p = w1; *(u32x4*)(p + 32) = w2; }
                        else {
                            bf16_t* p = c.KS + (size_t)r * 128 + head * 64 + 8 * fq; *(u32x4*)p = w1; *(u32x4*)(p + 32) = w2;
                            float* op = nullptr;
                            if (r < TP) { const int t = r & (SEQ - 1); if (t >= SEQ - 128) op = c.okp + ((size_t)((c.l * 4 + (r >> 12)) * 128 + (t - (SEQ - 128)))) * 128; }
                            else { const int rr = r - TP; op = c.oks + ((size_t)((c.l * 128 + (rr >> 2)) * 128 + 124 + (rr & 3))) * 128; }
                            if (op) { op += head * 64 + 8 * fq;
                                *(f32x4*)op = (f32x4){o1[0], o1[1], o1[2], o1[3]}; *(f32x4*)(op + 4) = (f32x4){o1[4], o1[5], o1[6], o1[7]};
                                *(f32x4*)(op + 32) = (f32x4){o2[0], o2[1], o2[2], o2[3]}; *(f32x4*)(op + 36) = (f32x4){o2[4], o2[5], o2[6], o2[7]}; }
                        }
                    } else if (pn == 2) {
                        const int head = wc - 2;
                        float* op = nullptr;
                        if (r < TP) { const int t = r & (SEQ - 1); if (t >= SEQ - 128) op = c.ovp + ((size_t)((c.l * 4 + (r >> 12)) * 128 + (t - (SEQ - 128)))) * 128; }
                        else { const int rr = r - TP; op = c.ovs + ((size_t)((c.l * 128 + (rr >> 2)) * 128 + 124 + (rr & 3))) * 128; }
#pragma unroll
                        for (int bj = 0; bj < 2; ++bj) {
                            const f32x4 a0 = acc[ai][bj][m][0] * rs, a1 = acc[ai][bj][m][1] * rs;
                            u32x4 w; w.x = pk2(a0[0], a0[1]); w.y = pk2(a0[2], a0[3]); w.z = pk2(a1[0], a1[1]); w.w = pk2(a1[2], a1[3]);
                            *(u32x4*)(c.VS + (size_t)r * 128 + head * 64 + 32 * bj + 8 * fq) = w;
                            if (op) { float* q = op + head * 64 + 32 * bj + 8 * fq; *(f32x4*)q = a0; *(f32x4*)(q + 4) = a1; }
                        }
                    } else if (pn < 9) {
#pragma unroll
                        for (int bj = 0; bj < 2; ++bj) {
                            const f32x4 a0 = acc[ai][bj][m][0] * rs, a1 = acc[ai][bj][m][1] * rs;
                            u32x4 w; w.x = pk2(a0[0], a0[1]); w.y = pk2(a0[2], a0[3]); w.z = pk2(a1[0], a1[1]); w.w = pk2(a1[2], a1[3]);
                            *(u32x4*)(c.ZG + (size_t)r * 1536 + (pn - 3) * 256 + bj * 128 + cl) = w;
                        }
                    } else {
                        if (wc == 0 && fq < 2) { float* p = c.LR + (size_t)r * 16 + 8 * fq; *(f32x4*)p = acc[ai][0][m][0] * rs; *(f32x4*)(p + 4) = acc[ai][0][m][1] * rs; }
                    }
                }
            }
    }
};

template <int D, int NKT, bool HAS_SINK, bool NOSCALE = false, bool NOMASK = false>
DI void attn16(const bf16x8 (&qf)[D / 32], LAS unsigned char* Kl, int kpitch, LAS unsigned char* Vt, int vpitch, int key0, int jlo, int jhi,
               float scale, float sink, bf16_t* orow, bool wr_ok, int fr, int fq) {
    f32x4 s[NKT];
#pragma unroll
    for (int t = 0; t < NKT; ++t) {
        s[t] = (f32x4){0.f, 0.f, 0.f, 0.f};
#pragma unroll
        for (int ks = 0; ks < D / 32; ++ks) { const bf16x8 kf = *(const LAS bf16x8*)(Kl + (key0 + 16 * t + fr) * kpitch + (32 * ks + 8 * fq) * 2); s[t] = MFMA16(kf, qf[ks], s[t]); }
    }
    float m = -INFINITY;
    const unsigned jrel = (unsigned)(jlo - key0 - 4 * fq), span = (unsigned)(jhi - jlo);
#pragma unroll
    for (int t = 0; t < NKT; ++t)
#pragma unroll
        for (int r = 0; r < 4; ++r) { const unsigned dj = (unsigned)(16 * t + r) - jrel; const float sv = NOSCALE ? s[t][r] : s[t][r] * scale; const float v = (NOMASK || dj <= span) ? sv : -INFINITY; s[t][r] = v; m = fmaxf(m, v); }
    m = fmaxf(m, __shfl_xor(m, 16)); m = fmaxf(m, __shfl_xor(m, 32));
    const float sk = NOSCALE ? sink * 1.4426950408889634f : sink;
    if (HAS_SINK) m = fmaxf(m, sk);
    if (m == -INFINITY) m = 0.f;
    float sum = 0.f;
#pragma unroll
    for (int t = 0; t < NKT; ++t)
#pragma unroll
        for (int r = 0; r < 4; ++r) { const float e = NOSCALE ? __builtin_amdgcn_exp2f(s[t][r] - m) : __expf(s[t][r] - m); s[t][r] = e; sum += e; }
    sum += __shfl_xor(sum, 16); sum += __shfl_xor(sum, 32);
    if (HAS_SINK) sum += NOSCALE ? __builtin_amdgcn_exp2f(sk - m) : __expf(sk - m);
    const float inv = sum > 0.f ? __builtin_amdgcn_rcpf(sum) : 0.f;
    f32x4 o[D / 16];
#pragma unroll
    for (int dt = 0; dt < D / 16; ++dt) o[dt] = (f32x4){0.f, 0.f, 0.f, 0.f};
#pragma unroll
    for (int kk = 0; kk < NKT / 2; ++kk) {
        u32x4 pw; pw.x = pk2(s[2 * kk][0], s[2 * kk][1]); pw.y = pk2(s[2 * kk][2], s[2 * kk][3]);
        pw.z = pk2(s[2 * kk + 1][0], s[2 * kk + 1][1]); pw.w = pk2(s[2 * kk + 1][2], s[2 * kk + 1][3]);
        const bf16x8 pf = __builtin_bit_cast(bf16x8, pw);
#pragma unroll
        for (int dt = 0; dt < D / 16; ++dt) {
            const LAS unsigned char* vp = Vt + (key0 + 32 * kk + 4 * fq + (fr >> 2)) * vpitch + 32 * dt + 8 * (fr & 3);
            const u32x2 lo = __builtin_bit_cast(u32x2, __builtin_amdgcn_ds_read_tr16_b64_v4i16((LAS v4i16_t*)vp));
            const u32x2 hi = __builtin_bit_cast(u32x2, __builtin_amdgcn_ds_read_tr16_b64_v4i16((LAS v4i16_t*)(vp + 16 * vpitch)));
            const bf16x8 vf = __builtin_bit_cast(bf16x8, (u32x4){lo.x, lo.y, hi.x, hi.y});
            o[dt] = MFMA16(vf, pf, o[dt]);
        }
    }
    if (wr_ok) {
#pragma unroll
        for (int dt = 0; dt < D / 16; ++dt) { u32x2 w; w.x = pk2(o[dt][0] * inv, o[dt][1] * inv); w.y = pk2(o[dt][2] * inv, o[dt][3] * inv); *(u32x2*)(orow + 16 * dt + 4 * fq) = w; }
    }
}

struct Params { const float* in[33]; float* out; unsigned char* ws; };

#define CAS __attribute__((address_space(4)))
struct Ctx {
    LAS unsigned char* lds; int tid, lane, wave, G, bx;
    const CAS Params* p; unsigned char* ws; float* out;
};

DI void thin_res_gemm(const Ctx& C, const bf16_t* A, const bf16_t* Bt, int K, float scale, float* rss_out, float* X) {
    const int fr = C.lane & 15, fq = C.lane >> 4;
    LAS float* part = (LAS float*)C.lds;
    bf16_t* XB = (bf16_t*)(C.ws + WS_XB);
    const int kw = K >> 3;
    for (int tile = C.bx; tile < 256; tile += C.G) {
        const int row0 = TP + (tile >> 4) * 32, n0 = (tile & 15) * 64;
        f32x4 acc[2][4];
#pragma unroll
        for (int mt = 0; mt < 2; ++mt)
#pragma unroll
            for (int nt = 0; nt < 4; ++nt) acc[mt][nt] = (f32x4){0.f, 0.f, 0.f, 0.f};
        const bf16_t* ap = A + (size_t)(row0 + fr) * K + C.wave * kw + 8 * fq;
        const bf16_t* bp = Bt + (size_t)(n0 + fr) * K + C.wave * kw + 8 * fq;
#pragma unroll 4
        for (int k = 0; k < kw; k += 32) {
            bf16x8 af[2], bfr[4];
#pragma unroll
            for (int mt = 0; mt < 2; ++mt) af[mt] = *(const bf16x8*)(ap + (size_t)(16 * mt) * K + k);
#pragma unroll
            for (int nt = 0; nt < 4; ++nt) bfr[nt] = *(const bf16x8*)(bp + (size_t)(16 * nt) * K + k);
#pragma unroll
            for (int mt = 0; mt < 2; ++mt)
#pragma unroll
                for (int nt = 0; nt < 4; ++nt) acc[mt][nt] = MFMA16(bfr[nt], af[mt], acc[mt][nt]);
        }
#pragma unroll
        for (int mt = 0; mt < 2; ++mt)
#pragma unroll
            for (int nt = 0; nt < 4; ++nt) *(LAS f32x4*)(part + ((C.wave * 32 + 16 * mt + fr) * 64 + 16 * nt + 4 * fq)) = acc[mt][nt];
        __syncthreads();
        {
            const int row = C.tid >> 4, c4 = C.tid & 15;
            f32x4 v = (f32x4){0.f, 0.f, 0.f, 0.f};
#pragma unroll
            for (int w = 0; w < 8; ++w) v = v + *(const LAS f32x4*)(part + ((w * 32 + row) * 64 + 4 * c4));
            bf16_t* xb = XB + (size_t)(row0 + row) * DM + n0 + 4 * c4;
            const u32x2 xo = *(const u32x2*)xb;
            f32x4 x = (f32x4){blo(xo.x), bhi(xo.x), blo(xo.y), bhi(xo.y)}; x = x + v * scale;
            if (X) *(f32x4*)(X + (size_t)(row0 + row) * DM + n0 + 4 * c4) = x;
            else {
                u32x2 w2; w2.x = pk2(x[0], x[1]); w2.y = pk2(x[2], x[3]); *(u32x2*)xb = w2;
                const float a0 = blo(w2.x), a1 = bhi(w2.x), a2 = blo(w2.y), a3 = bhi(w2.y);
                float ss = a0 * a0 + a1 * a1 + a2 * a2 + a3 * a3;
                ss += __shfl_xor(ss, 1); ss += __shfl_xor(ss, 2); ss += __shfl_xor(ss, 4); ss += __shfl_xor(ss, 8);
                if (c4 == 0) atomicAdd(rss_out + row0 + row, ss);
            }
        }
        __syncthreads();
    }
}

DI void p0_tile(const float* s0, const float* s1, const float* gain, int mode, int K, int Nsrc, bf16_t* dst, int tile, LAS float* tl, int tid) {
    const int nkt = K >> 6; const int ntile = tile / nkt, kt = tile - ntile * nkt; const int n0 = ntile * 256, k0 = kt * 64;
    const int nn = tid & 255, kk0 = tid >> 8;
    const int n = n0 + nn; const float* src = s0; int col = n;
    if (mode == 1) { const int pn = n >> 8, bj = (n >> 7) & 1, cc = n & 127; src = bj ? s1 : s0; col = pn * 128 + cc; }
    else if (mode == 2) {
        const int pn = n >> 8, rem = n & 255, bj = rem >> 7, wc = (rem >> 5) & 3, j = rem & 31;
        if (pn < 2) col = (4 * pn + wc) * 64 + 32 * bj + j;
        else if (pn == 2) col = (wc < 2) ? (512 + wc * 64 + 32 * bj + j) : (640 + (wc - 2) * 64 + 32 * bj + j);
        else if (pn < 9) col = n;
        else col = (rem < 16) ? (2304 + rem) : -1;
    } else if (mode == 3) { if (n >= 512) { src = s1; col = n - 512; } }
    const float* sp = src + (size_t)(k0 + kk0) * Nsrc + (col >= 0 ? col : 0);
    float v[32];
#pragma unroll
    for (int i = 0; i < 32; ++i) v[i] = (col >= 0) ? sp[(size_t)(2 * i) * Nsrc] : 0.f;
    if (gain) {
#pragma unroll
        for (int i = 0; i < 32; ++i) v[i] *= gain[k0 + kk0 + 2 * i];
    }
#pragma unroll
    for (int i = 0; i < 32; ++i) tl[(kk0 + 2 * i) * 257 + nn] = v[i];
    __syncthreads();
#pragma unroll
    for (int j = 0; j < 4; ++j) { const int ch = tid + 512 * j; const int n2 = ch >> 3, ks = ch & 7; const LAS float* s = tl + (8 * ks) * 257 + n2;
      u32x4 o; o.x = pk2(s[0], s[257]); o.y = pk2(s[2 * 257], s[3 * 257]); o.z = pk2(s[4 * 257], s[5 * 257]); o.w = pk2(s[6 * 257], s[7 * 257]);
      *(u32x4*)(dst + (size_t)(n0 + n2) * K + k0 + 8 * ks) = o; }
    __syncthreads();
}

constexpr int TPL = 1408, T_W1 = 0, T_WD1 = 352, T_WKV = 1344;
DI void p0_dispatch(const Ctx& C, int l, int r) {
    const CAS Params& P = *C.p; unsigned char* ws = C.ws;
    unsigned char* wl = ws + WS_WL + (size_t)l * WL_SIZE;
    const float* s0; const float* s1 = nullptr; const float* gain = nullptr; int mode = 0, K = 1024, Nsrc; bf16_t* dst;
    if (r < 352) { s0 = P.in[9] + (size_t)l * 1024 * FF; s1 = P.in[10] + (size_t)l * 1024 * FF; gain = P.in[8] + l * 1024; mode = 1; Nsrc = FF; dst = (bf16_t*)(wl + WL_W1); }
    else if (r < 528) { r -= 352; s0 = P.in[11] + (size_t)l * FF * 1024; K = FF; Nsrc = 1024; dst = (bf16_t*)(wl + WL_WD1); }
    else if (r < 688) { r -= 528; s0 = P.in[13] + (size_t)l * 1024 * 2320; gain = P.in[12] + l * 1024; mode = 2; Nsrc = 2320; dst = (bf16_t*)(wl + WL_WIN); }
    else if (r < 752) { r -= 688; s0 = P.in[20] + (size_t)l * 1024 * 1024; Nsrc = 1024; dst = (bf16_t*)(wl + WL_WOUT); }
    else if (r < 784) { r -= 752; s0 = P.in[23] + (size_t)l * 1024 * 512; gain = P.in[21] + l * 1024; Nsrc = 512; dst = (bf16_t*)(wl + WL_WQ); }
    else if (r < 816) { r -= 784; s0 = P.in[28] + (size_t)l * 512 * 1024; K = 512; Nsrc = 1024; dst = (bf16_t*)(wl + WL_WO); }
    else if (r < 1168) { r -= 816; s0 = P.in[30] + (size_t)l * 1024 * FF; s1 = P.in[31] + (size_t)l * 1024 * FF; gain = P.in[29] + l * 1024; mode = 1; Nsrc = FF; dst = (bf16_t*)(wl + WL_W2); }
    else if (r < 1344) { r -= 1168; s0 = P.in[32] + (size_t)l * FF * 1024; K = FF; Nsrc = 1024; dst = (bf16_t*)(wl + WL_WD2); }
    else { r -= 1344; s0 = P.in[24] + (size_t)l * 1024 * 512; s1 = P.in[25] + (size_t)l * 1024 * 512; gain = P.in[22] + l * 1024; mode = 3; Nsrc = 512; dst = (bf16_t*)(ws + WS_WKV) + (size_t)l * 1024 * 1024; }
    p0_tile(s0, s1, gain, mode, K, Nsrc, dst, r, (LAS float*)C.lds, C.tid);
}
DI void convert_in_slack(const Ctx& C, int l, int lo, int hi, int nun) {
    const int rem = nun % C.G; const int first = rem ? rem : 0, cnt = C.G - first;
    if (C.bx < first) return;
    for (int t = lo + (C.bx - first); t < hi; t += cnt) p0_dispatch(C, l, t);
}

DI void p0_prologue(const Ctx& C) {
    const CAS Params& P = *C.p; unsigned char* ws = C.ws;
    for (int it = C.bx; it < 352 + 128; it += C.G) {
        if (it < 352) p0_dispatch(C, 0, it); else if (it < 416) p0_dispatch(C, 0, T_WKV + it - 352); else p0_dispatch(C, 1, T_WKV + it - 416);
    }
    const int gw = C.bx * 8 + C.wave, NGW = C.G * 8;
    float* RSS = (float*)(ws + WS_RSS);
    for (int r0 = gw; r0 < T + 1024; r0 += 2 * NGW) {
        const float* src[2]; float* df[2]; bf16_t* db[2]; float* rs[2]; f32x4 v[2][4];
#pragma unroll
        for (int q = 0; q < 2; ++q) {
            int r = r0 + q * NGW; if (r >= T + 1024) r = r0;
            if (r < T) { src[q] = (r < TP ? P.in[0] + (size_t)r * 1024 : P.in[1] + (size_t)(r - TP) * 1024); df[q] = nullptr; db[q] = (bf16_t*)(ws + WS_XB) + (size_t)r * 1024; rs[q] = RSS + r; }
            else { src[q] = P.in[7] + (size_t)(r - T) * 1024; df[q] = nullptr; db[q] = (bf16_t*)(ws + WS_MEMB) + (size_t)(r - T) * 1024; rs[q] = (float*)(ws + WS_RSSM) + (r - T); }
#pragma unroll
            for (int j = 0; j < 4; ++j) v[q][j] = *(const f32x4*)(src[q] + 256 * j + 4 * C.lane);
        }
#pragma unroll
        for (int q = 0; q < 2; ++q) {
            float ss = 0.f;
#pragma unroll
            for (int j = 0; j < 4; ++j) {
                const f32x4 x = v[q][j];
                ss += x[0] * x[0] + x[1] * x[1] + x[2] * x[2] + x[3] * x[3];
                if (df[q]) *(f32x4*)(df[q] + 256 * j + 4 * C.lane) = x;
                u32x2 w; w.x = pk2(x[0], x[1]); w.y = pk2(x[2], x[3]); *(u32x2*)(db[q] + 256 * j + 4 * C.lane) = w;
            }
#pragma unroll
            for (int o = 1; o < 64; o <<= 1) ss += __shfl_xor(ss, o);
            if (C.lane == 0) *rs[q] = ss;
        }
    }
    for (int i = C.bx * 512 + C.tid; i < 8 * T; i += C.G * 512) RSS[T + i] = 0.f;
    float2* rope = (float2*)(ws + WS_ROPE);
    for (int i = C.bx * 512 + C.tid; i < 4100 * 32; i += C.G * 512) {
        const int pidx = i >> 5, f = i & 31; const int pos = pidx < 4096 ? pidx : 16384 + (pidx - 4096);
        const float inv = powf(10000.f, -(float)f * (1.f / 32.f));
        const float ang = (float)pos * inv;
        const double a = (double)ang; const double nrev = rint(a * 0.15915494309189535); const float rr = (float)(a - nrev * 6.283185307179586);
        rope[i] = make_float2(cosf(rr), sinf(rr));
    }
}

DI void swa_prompt_unit(const Ctx& C, int l, int unit) {
    unsigned char* ws = C.ws;
    const int b = unit >> 6, n = (unit >> 1) & 31, kvh = unit & 1;
    const bf16_t* QS = (const bf16_t*)(ws + WS_QS); const bf16_t* KS = (const bf16_t*)(ws + WS_KS); const bf16_t* VS = (const bf16_t*)(ws + WS_VS); bf16_t* MIX = (bf16_t*)(ws + WS_MIX);
    LAS unsigned char* Kl = C.lds; LAS unsigned char* Vt = C.lds + 256 * 144;
    constexpr int KP = 144, VP = 144;
#pragma unroll
    for (int i = 0; i < 4; ++i) {
        const int key = (C.tid >> 3) + 64 * i, c8 = C.tid & 7; const int pos = (n - 1) * 128 + key;
        u32x4 kv = (u32x4){0u, 0u, 0u, 0u}, vv = kv;
        if (pos >= 0) { const size_t row = (size_t)b * SEQ + pos; kv = *(const u32x4*)(KS + row * 128 + kvh * 64 + 8 * c8); vv = *(const u32x4*)(VS + row * 128 + kvh * 64 + 8 * c8); }
        *(LAS u32x4*)(Kl + key * KP + c8 * 16) = kv; *(LAS u32x4*)(Vt + key * VP + c8 * 16) = vv;
    }
    __syncthreads();
    const int fr = C.lane & 15, fq = C.lane >> 4; const int g = C.wave >> 1, qh = C.wave & 1; const int head = kvh * 4 + g;
    const float sink = C.p->in[16][l * 8 + head];
    for (int grp = 0; grp < 4; ++grp) {
        const int i = 64 * qh + 16 * grp + fr; const size_t row = (size_t)b * SEQ + n * 128 + i;
        bf16x8 qf[2];
#pragma unroll
        for (int ks = 0; ks < 2; ++ks) qf[ks] = *(const bf16x8*)(QS + row * 512 + head * 64 + 32 * ks + 8 * fq);
        const int jlo = max(i + 1, n == 0 ? 128 : 0), jhi = i + 128;
        attn16<64, 12, true, true>(qf, Kl, KP, Vt, VP, 64 * qh, jlo, jhi, 0.125f, sink, MIX + row * 1024 + head * 64, true, fr, fq);
    }
    __syncthreads();
}

DI void swa_decode_unit(const Ctx& C, int l, int unit) {
    unsigned char* ws = C.ws; const CAS Params& P = *C.p;
    const int b = unit >> 1, kvh = unit & 1;
    const bf16_t* QS = (const bf16_t*)(ws + WS_QS); const bf16_t* KS = (const bf16_t*)(ws + WS_KS); const bf16_t* VS = (const bf16_t*)(ws + WS_VS); bf16_t* MIX = (bf16_t*)(ws + WS_MIX);
    constexpr int KP = 144, VP = 144;
    LAS unsigned char* Kl = C.lds; LAS unsigned char* Vt = C.lds + 160 * KP;
    for (int i = C.tid; i < (160 * KP + 160 * VP) / 16; i += 512) *(LAS u32x4*)(C.lds + i * 16) = (u32x4){0u, 0u, 0u, 0u};
    __syncthreads();
    const float* ck = P.in[2] + ((size_t)(l * 128 + b) * 128) * 128 + kvh * 64; const float* cv = P.in[3] + ((size_t)(l * 128 + b) * 128) * 128 + kvh * 64;
    float* ok = C.out + O_KS + ((size_t)(l * 128 + b) * 128) * 128 + kvh * 64; float* ov = C.out + O_VS + ((size_t)(l * 128 + b) * 128) * 128 + kvh * 64;
#pragma unroll
    for (int i = 0; i < 4; ++i) {
        const int key = (C.tid >> 4) + 32 * i, c16 = C.tid & 15;
        const f32x4 kv = *(const f32x4*)(ck + (size_t)key * 128 + 4 * c16), vv = *(const f32x4*)(cv + (size_t)key * 128 + 4 * c16);
        u32x2 w; w.x = pk2(kv[0], kv[1]); w.y = pk2(kv[2], kv[3]); *(LAS u32x2*)(Kl + key * KP + c16 * 8) = w;
        u32x2 wv; wv.x = pk2(vv[0], vv[1]); wv.y = pk2(vv[2], vv[3]); *(LAS u32x2*)(Vt + key * VP + c16 * 8) = wv;
        if (key >= 4) { *(f32x4*)(ok + (size_t)(key - 4) * 128 + 4 * c16) = kv; *(f32x4*)(ov + (size_t)(key - 4) * 128 + 4 * c16) = vv; }
    }
    if (C.tid < 32) {
        const int tt = C.tid >> 3, c8 = C.tid & 7; const size_t row = (size_t)TP + b * 4 + tt;
        const u32x4 kv = *(const u32x4*)(KS + row * 128 + kvh * 64 + 8 * c8), vv = *(const u32x4*)(VS + row * 128 + kvh * 64 + 8 * c8);
        *(LAS u32x4*)(Kl + (128 + tt) * KP + c8 * 16) = kv; *(LAS u32x4*)(Vt + (128 + tt) * VP + c8 * 16) = vv;
    }
    __syncthreads();
    if (C.wave == 0) {
        const int fr = C.lane & 15, fq = C.lane >> 4; const int g = fr >> 2, tt = fr & 3; const int head = kvh * 4 + g; const size_t row = (size_t)TP + b * 4 + tt;
        bf16x8 qf[2];
#pragma unroll
        for (int ks = 0; ks < 2; ++ks) qf[ks] = *(const bf16x8*)(QS + row * 512 + head * 64 + 32 * ks + 8 * fq);
        const float sink = P.in[16][l * 8 + head];
        attn16<64, 10, true, true>(qf, Kl, KP, Vt, VP, 0, tt + 1, tt + 128, 0.125f, sink, MIX + row * 1024 + head * 64, true, fr, fq);
    }
    __syncthreads();
}

DI void xattn_unit(const Ctx& C, int l, int unit) {
    unsigned char* ws = C.ws; const CAS Params& P = *C.p;
    constexpr int KP = 272, VP = 288;
    LAS unsigned char* Kl = C.lds; LAS unsigned char* Vt = C.lds + 256 * KP;
    const bool prompt = unit < 128;
    int b, h, qb = 0;
    if (prompt) { b = unit >> 5; h = (unit >> 3) & 3; qb = (unit & 7) * 2; } else { const int u = unit - 128; b = u >> 2; h = u & 3; }
    const float* ksrc; const float* vsrc; size_t kpitch;
    if (prompt) { ksrc = (const float*)(ws + WS_MKV) + (size_t)(b * 256) * 2048 + l * 1024 + h * 128; vsrc = ksrc + 512; kpitch = 2048; }
    else { ksrc = P.in[5] + ((size_t)(l * 128 + b) * 256) * 512 + h * 128; vsrc = P.in[6] + ((size_t)(l * 128 + b) * 256) * 512 + h * 128; kpitch = 512; }
    const int c4 = C.tid & 31;
    const f32x4 gk = *(const f32x4*)(P.in[27] + l * 128 + 4 * c4);
    const bool wout = prompt && qb == 0;
    float* omk = C.out + O_MKP + ((size_t)(l * 4 + b) * 256) * 512 + h * 128; float* omv = C.out + O_MVP + ((size_t)(l * 4 + b) * 256) * 512 + h * 128;
#pragma unroll 4
    for (int i = 0; i < 16; ++i) {
        const int key = (C.tid >> 5) + 16 * i;
        f32x4 kv = *(const f32x4*)(ksrc + (size_t)key * kpitch + 4 * c4); const f32x4 vv = *(const f32x4*)(vsrc + (size_t)key * kpitch + 4 * c4);
        if (prompt) {
            float ss = kv[0] * kv[0] + kv[1] * kv[1] + kv[2] * kv[2] + kv[3] * kv[3];
#pragma unroll
            for (int o = 1; o < 32; o <<= 1) ss += __shfl_xor(ss, o);
            const float rq = rsqrtf(ss * (1.f / 128.f) + EPS);
            kv = kv * rq * gk;
            if (wout) { *(f32x4*)(omk + (size_t)key * 512 + 4 * c4) = kv; *(f32x4*)(omv + (size_t)key * 512 + 4 * c4) = vv; }
        }
        u32x2 w; w.x = pk2(kv[0], kv[1]); w.y = pk2(kv[2], kv[3]); *(LAS u32x2*)(Kl + key * KP + c4 * 8) = w;
        u32x2 wv; wv.x = pk2(vv[0], vv[1]); wv.y = pk2(vv[2], vv[3]); *(LAS u32x2*)(Vt + key * VP + c4 * 8) = wv;
    }
    __syncthreads();
    const bf16_t* QX = (const bf16_t*)(ws + WS_QX); bf16_t* OX = (bf16_t*)(ws + WS_OX);
    const int fr = C.lane & 15, fq = C.lane >> 4;
    const int ngrp = prompt ? 4 : (C.wave == 0 ? 1 : 0);
    for (int grp = 0; grp < ngrp; ++grp) {
        const size_t row = prompt ? ((size_t)b * SEQ + (qb + (grp >> 1)) * 256 + 32 * C.wave + 16 * (grp & 1) + fr) : ((size_t)TP + b * 4 + (fr & 3));
        float qv[32]; float ss = 0.f;
#pragma unroll
        for (int ks = 0; ks < 4; ++ks) {
            const u32x4 w = *(const u32x4*)(QX + row * 512 + h * 128 + 32 * ks + 8 * fq);
#pragma unroll
            for (int e = 0; e < 4; ++e) { qv[8 * ks + 2 * e] = blo(w[e]); qv[8 * ks + 2 * e + 1] = bhi(w[e]); }
        }
#pragma unroll
        for (int e = 0; e < 32; ++e) ss += qv[e] * qv[e];
        ss += __shfl_xor(ss, 16); ss += __shfl_xor(ss, 32);
        const float rq = rsqrtf(ss * (1.f / 128.f) + EPS) * 0.12751743082459868f;
        bf16x8 qf[4];
#pragma unroll
        for (int ks = 0; ks < 4; ++ks) {
            const f32x4 g0 = *(const f32x4*)(P.in[26] + l * 128 + 32 * ks + 8 * fq), g1 = *(const f32x4*)(P.in[26] + l * 128 + 32 * ks + 8 * fq + 4);
            u32x4 w; w.x = pk2(qv[8 * ks] * rq * g0[0], qv[8 * ks + 1] * rq * g0[1]); w.y = pk2(qv[8 * ks + 2] * rq * g0[2], qv[8 * ks + 3] * rq * g0[3]);
            w.z = pk2(qv[8 * ks + 4] * rq * g1[0], qv[8 * ks + 5] * rq * g1[1]); w.w = pk2(qv[8 * ks + 6] * rq * g1[2], qv[8 * ks + 7] * rq * g1[3]);
            qf[ks] = __builtin_bit_cast(bf16x8, w);
        }
        attn16<128, 16, false, true, true>(qf, Kl, KP, Vt, VP, 0, 0, 255, 1.f, 0.f, OX + row * 512 + h * 128, prompt || fr < 4, fr, fq);
    }
    __syncthreads();
}

DI void gla_a_phase(const Ctx& C, int l) {
    unsigned char* ws = C.ws; const CAS Params& P = *C.p;
    const bf16_t* ZG = (const bf16_t*)(ws + WS_ZG); const float* LR = (const float*)(ws + WS_LR);
    bf16_t* QT = (bf16_t*)(ws + WS_BCUM); bf16_t* KT = QT + (size_t)TP * 256; float* ST = (float*)(ws + WS_ST); bf16_t* VT = (bf16_t*)(ws + WS_VT); float* DEC = (float*)(ws + WS_DEC);
    LAS float* segsum = (LAS float*)C.lds;
    LAS unsigned char* KdT = C.lds + 2048;
    LAS unsigned char* VtL = C.lds + 2048 + 64 * 144;
    const int dk = C.tid & 63, seg = C.wave, tv = C.tid >> 3, dvs = C.tid & 7;
    int unit = C.bx; if (unit >= 1024) return;
    bf16_t kq[16]; u32x4 vw[2];
#define GLA_A_LOAD(u) do { const int bh_ = (u) >> 6, c_ = (u) & 63, b_ = bh_ >> 2, h_ = bh_ & 3; const size_t t0_ = (size_t)b_ * SEQ + c_ * 64; \
        _Pragma("unroll") for (int i = 0; i < 8; ++i) { kq[i] = ZG[(t0_ + 8 * seg + i) * 1536 + 256 + h_ * 64 + dk]; kq[8 + i] = ZG[(t0_ + 8 * seg + i) * 1536 + h_ * 64 + dk]; } \
        _Pragma("unroll") for (int x = 0; x < 2; ++x) vw[x] = *(const u32x4*)(ZG + (t0_ + tv) * 1536 + 512 + h_ * 128 + 16 * dvs + 8 * x); } while (0)
    GLA_A_LOAD(unit);
    int hcur = -1; float wg[16]; float bg = 0.f;
    for (; unit < 1024; unit += C.G) {
        const int bh = unit >> 6, c = unit & 63, b = bh >> 2, h = bh & 3; const size_t t0 = (size_t)b * SEQ + c * 64;
        if (h != hcur) { hcur = h;
#pragma unroll
            for (int r = 0; r < 16; ++r) wg[r] = P.in[17][(size_t)(l * 16 + r) * 256 + h * 64 + dk];
            bg = P.in[18][l * 256 + h * 64 + dk]; }
        float p[8];
        {
            float run = 0.f;
#pragma unroll
            for (int i = 0; i < 8; ++i) {
                const float* lr = LR + (t0 + 8 * seg + i) * 16; float x = bg;
#pragma unroll
                for (int r = 0; r < 16; ++r) x += lr[r] * wg[r];
                run += logsig(x) * (1.f / 16.f); p[i] = run;
            }
            segsum[seg * 64 + dk] = run;
        }
#pragma unroll
        for (int x = 0; x < 2; ++x) *(LAS u32x4*)(VtL + tv * 288 + (16 * dvs + 8 * x) * 2) = vw[x];
        __syncthreads();
        {
            float off = 0.f, tot = 0.f;
#pragma unroll
            for (int s2 = 0; s2 < 8; ++s2) { const float v = segsum[s2 * 64 + dk]; tot += v; if (s2 < seg) off += v; }
#pragma unroll
            for (int i = 0; i < 8; ++i) {
                const int t = 8 * seg + i; const float bv = off + p[i];
                const float kraw = bf2f(kq[i]), qraw = bf2f(kq[8 + i]);
                const float kd = kraw * __expf(tot - bv);
                const unsigned qk = pk2(qraw * 0.125f * __expf(bv), kraw * __expf(-bv));
                QT[(t0 + t) * 256 + h * 64 + dk] = (bf16_t)(qk & 0xffffu); KT[(t0 + t) * 256 + h * 64 + dk] = (bf16_t)(qk >> 16);
                *(LAS unsigned short*)(KdT + t * 144 + dk * 2) = (unsigned short)(pk2(kd, 0.f) & 0xffffu);
            }
            if (seg == 0) DEC[unit * 64 + dk] = __expf(tot);
        }
        if (unit + C.G < 1024) GLA_A_LOAD(unit + C.G);
        __syncthreads();
        {
            const int fr = C.lane & 15, fq = C.lane >> 4, w = C.wave;
            bf16x8 vt[2];
#pragma unroll
            for (int ks = 0; ks < 2; ++ks) {
                const LAS unsigned char* vp = VtL + (32 * ks + 8 * fq + (fr >> 2)) * 288 + 32 * w + 8 * (fr & 3);
                const u32x2 lo = __builtin_bit_cast(u32x2, __builtin_amdgcn_ds_read_tr16_b64_v4i16((LAS v4i16_t*)vp));
                const u32x2 hi = __builtin_bit_cast(u32x2, __builtin_amdgcn_ds_read_tr16_b64_v4i16((LAS v4i16_t*)(vp + 4 * 288)));
                vt[ks] = __builtin_bit_cast(bf16x8, (u32x4){lo.x, lo.y, hi.x, hi.y});
            }
#pragma unroll
            for (int dkt = 0; dkt < 4; ++dkt) {
                f32x4 acc = (f32x4){0.f, 0.f, 0.f, 0.f};
#pragma unroll
                for (int ks = 0; ks < 2; ++ks) {
                    const LAS unsigned char* kp = KdT + (32 * ks + 8 * fq + (fr >> 2)) * 144 + 32 * dkt + 8 * (fr & 3);
                    const u32x2 lo = __builtin_bit_cast(u32x2, __builtin_amdgcn_ds_read_tr16_b64_v4i16((LAS v4i16_t*)kp));
                    const u32x2 hi = __builtin_bit_cast(u32x2, __builtin_amdgcn_ds_read_tr16_b64_v4i16((LAS v4i16_t*)(kp + 4 * 144)));
                    const bf16x8 kd = __builtin_bit_cast(bf16x8, (u32x4){lo.x, lo.y, hi.x, hi.y});
                    acc = MFMA16(kd, vt[ks], acc);
                }
                *(f32x4*)(ST + ((size_t)unit * 128 + 16 * w + fr) * 64 + 16 * dkt + 4 * fq) = acc;
            }
        }
        __syncthreads();
    }
#undef GLA_A_LOAD
}

DI void gla_scan(const Ctx& C, int l) {
    unsigned char* ws = C.ws;
    const float* ST = (const float*)(ws + WS_ST); const float* DEC = (const float*)(ws + WS_DEC); bf16_t* STB = (bf16_t*)(ws + WS_STB);
    for (int e = C.bx * 512 + C.tid; e < 16 * 8192; e += C.G * 512) {
        const int bh = e >> 13, idx = e & 8191, dk = idx & 63, dv = idx >> 6;
        float S = 0.f;
        for (int c0 = 0; c0 < 64; c0 += 8) {
            float d[8], dc[8];
#pragma unroll
            for (int i = 0; i < 8; ++i) { const int unit = bh * 64 + c0 + i; d[i] = ST[(size_t)unit * 8192 + idx]; dc[i] = DEC[unit * 64 + dk]; }
#pragma unroll
            for (int i = 0; i < 8; ++i) { const int unit = bh * 64 + c0 + i; STB[(size_t)unit * 8192 + idx] = (bf16_t)(pk2(S, 0.f) & 0xffffu); S = dc[i] * S + d[i]; }
        }
        C.out[O_GP + ((size_t)(l * 16 + bh)) * 8192 + dk * 128 + dv] = S;
    }
}

DI void gla_c_wave(const Ctx& C, int l, int unit, int qt) {
    unsigned char* ws = C.ws; const CAS Params& P = *C.p;
    const int bh = unit >> 6, c = unit & 63, b = bh >> 2, h = bh & 3; const size_t t0 = (size_t)b * SEQ + c * 64;
    const bf16_t* ZG = (const bf16_t*)(ws + WS_ZG); const bf16_t* QT = (const bf16_t*)(ws + WS_BCUM); const bf16_t* KT = QT + (size_t)TP * 256; const bf16_t* STB = (const bf16_t*)(ws + WS_STB); const bf16_t* VT = (const bf16_t*)(ws + WS_VT);
    bf16_t* MIX = (bf16_t*)(ws + WS_MIX);
    const int fr = C.lane & 15, fq = C.lane >> 4;
    const size_t rq = t0 + 16 * qt + fr;
    bf16x8 qf[2];
#pragma unroll
    for (int ks = 0; ks < 2; ++ks) qf[ks] = *(const bf16x8*)(QT + rq * 256 + h * 64 + 32 * ks + 8 * fq);
    f32x4 a[4];
#pragma unroll
    for (int kt = 0; kt < 4; ++kt) {
        a[kt] = (f32x4){0.f, 0.f, 0.f, 0.f};
        if (kt <= qt) {
            const size_t rk = t0 + 16 * kt + fr;
#pragma unroll
            for (int ks = 0; ks < 2; ++ks) {
                const bf16x8 kf = *(const bf16x8*)(KT + rk * 256 + h * 64 + 32 * ks + 8 * fq);
                a[kt] = MFMA16(kf, qf[ks], a[kt]);
            }
#pragma unroll
            for (int r = 0; r < 4; ++r) if (16 * kt + 4 * fq + r > 16 * qt + fr) a[kt][r] = 0.f;
        }
    }
    bf16x8 pf[2];
#pragma unroll
    for (int kk = 0; kk < 2; ++kk) { u32x4 w; w.x = pk2(a[2 * kk][0], a[2 * kk][1]); w.y = pk2(a[2 * kk][2], a[2 * kk][3]); w.z = pk2(a[2 * kk + 1][0], a[2 * kk + 1][1]); w.w = pk2(a[2 * kk + 1][2], a[2 * kk + 1][3]); pf[kk] = __builtin_bit_cast(bf16x8, w); }
    f32x4 o[8]; float ss = 0.f;
#pragma unroll
    for (int dt = 0; dt < 8; ++dt) {
        f32x4 acc = (f32x4){0.f, 0.f, 0.f, 0.f};
        const size_t vrow = ((size_t)unit * 128 + 16 * dt + fr) * 64;
#pragma unroll
        for (int kk = 0; kk < 2; ++kk) {
            if (2 * kk <= qt) {
                const bf16_t* vp = VT + vrow + 32 * kk + 4 * fq; const u32x2 lo = *(const u32x2*)vp, hi = *(const u32x2*)(vp + 16);
                acc = MFMA16(__builtin_bit_cast(bf16x8, (u32x4){lo.x, lo.y, hi.x, hi.y}), pf[kk], acc);
            }
        }
#pragma unroll
        for (int ks = 0; ks < 2; ++ks) {
            const bf16x8 sf = *(const bf16x8*)(STB + vrow + 32 * ks + 8 * fq);
            acc = MFMA16(sf, qf[ks], acc);
        }
        o[dt] = acc; ss += acc[0] * acc[0] + acc[1] * acc[1] + acc[2] * acc[2] + acc[3] * acc[3];
    }
    ss += __shfl_xor(ss, 16); ss += __shfl_xor(ss, 32);
    const float rn = rsqrtf(ss * (1.f / 128.f) + EPS);
#pragma unroll
    for (int dt = 0; dt < 8; ++dt) {
        const f32x4 gn = *(const f32x4*)(P.in[19] + l * 128 + 16 * dt + 4 * fq);
        const u32x2 gw = *(const u32x2*)(ZG + rq * 1536 + 1024 + h * 128 + 16 * dt + 4 * fq);
        const float g0 = blo(gw.x), g1 = bhi(gw.x), g2 = blo(gw.y), g3 = bhi(gw.y);
        u32x2 w; w.x = pk2(o[dt][0] * rn * gn[0] * silu(g0), o[dt][1] * rn * gn[1] * silu(g1)); w.y = pk2(o[dt][2] * rn * gn[2] * silu(g2), o[dt][3] * rn * gn[3] * silu(g3));
        *(u32x2*)(MIX + rq * 1024 + 512 + h * 128 + 16 * dt + 4 * fq) = w;
    }
}

DI void gla_c_phase(const Ctx& C, int l) {
    unsigned char* ws = C.ws; const CAS Params& P = *C.p;
    const bf16_t* ZG = (const bf16_t*)(ws + WS_ZG); const bf16_t* QT = (const bf16_t*)(ws + WS_BCUM); const bf16_t* KT = QT + (size_t)TP * 256; const bf16_t* STB = (const bf16_t*)(ws + WS_STB); const bf16_t* VT = (const bf16_t*)(ws + WS_VT);
    bf16_t* MIX = (bf16_t*)(ws + WS_MIX);
    constexpr int PB = 144, U_BYTES = (64 + 128 + 128) * PB;
    const int fr = C.lane & 15, fq = C.lane >> 4, us = C.wave >> 2, qt = C.wave & 3;
    for (int pr = C.bx; pr < 512; pr += C.G) {
#pragma unroll
        for (int uu = 0; uu < 2; ++uu) {
            const int unit = 2 * pr + uu; const int bh = unit >> 6, c = unit & 63, b = bh >> 2, h = bh & 3; const size_t t0 = (size_t)b * SEQ + c * 64;
            LAS unsigned char* base = C.lds + uu * U_BYTES;
            { const int row = C.tid >> 3, c8 = C.tid & 7; *(LAS u32x4*)(base + row * PB + c8 * 16) = *(const u32x4*)(KT + (t0 + row) * 256 + h * 64 + 8 * c8); }
#pragma unroll
            for (int i = 0; i < 2; ++i) {
                const int row = (C.tid >> 3) + 64 * i, c8 = C.tid & 7;
                *(LAS u32x4*)(base + (64 + row) * PB + c8 * 16) = *(const u32x4*)(STB + ((size_t)unit * 128 + row) * 64 + 8 * c8);
                const int vr = (C.tid >> 4) + 32 * i, c16 = C.tid & 15;
                *(LAS u32x4*)(base + 192 * PB + vr * 288 + c16 * 16) = *(const u32x4*)(ZG + (t0 + vr) * 1536 + 512 + h * 128 + 8 * c16);
            }
        }
        const int unit = 2 * pr + us; const int bh = unit >> 6, c = unit & 63, b = bh >> 2, h = bh & 3; const size_t t0 = (size_t)b * SEQ + c * 64;
        const size_t rq = t0 + 16 * qt + fr;
        bf16x8 qf[2];
#pragma unroll
        for (int ks = 0; ks < 2; ++ks) qf[ks] = *(const bf16x8*)(QT + rq * 256 + h * 64 + 32 * ks + 8 * fq);
        __syncthreads();
        LAS unsigned char* Kl = C.lds + us * U_BYTES; LAS unsigned char* Sl = Kl + 64 * PB; LAS unsigned char* Vl = Kl + 192 * PB;
        f32x4 a[4];
#pragma unroll
        for (int kt = 0; kt < 4; ++kt) {
            a[kt] = (f32x4){0.f, 0.f, 0.f, 0.f};
            if (kt <= qt) {
#pragma unroll
                for (int ks = 0; ks < 2; ++ks) {
                    const bf16x8 kf = *(const LAS bf16x8*)(Kl + (16 * kt + fr) * PB + (32 * ks + 8 * fq) * 2);
                    a[kt] = MFMA16(kf, qf[ks], a[kt]);
                }
#pragma unroll
                for (int r = 0; r < 4; ++r) if (16 * kt + 4 * fq + r > 16 * qt + fr) a[kt][r] = 0.f;
            }
        }
        bf16x8 pf[2];
#pragma unroll
        for (int kk = 0; kk < 2; ++kk) { u32x4 w; w.x = pk2(a[2 * kk][0], a[2 * kk][1]); w.y = pk2(a[2 * kk][2], a[2 * kk][3]); w.z = pk2(a[2 * kk + 1][0], a[2 * kk + 1][1]); w.w = pk2(a[2 * kk + 1][2], a[2 * kk + 1][3]); pf[kk] = __builtin_bit_cast(bf16x8, w); }
        f32x4 o[8]; float ss = 0.f;
#pragma unroll
        for (int dt = 0; dt < 8; ++dt) {
            f32x4 acc = (f32x4){0.f, 0.f, 0.f, 0.f};
#pragma unroll
            for (int kk = 0; kk < 2; ++kk) {
                if (2 * kk <= qt) {
                    const LAS unsigned char* vp = Vl + (32 * kk + 4 * fq + (fr >> 2)) * 288 + 32 * dt + 8 * (fr & 3);
                    const u32x2 lo = __builtin_bit_cast(u32x2, __builtin_amdgcn_ds_read_tr16_b64_v4i16((LAS v4i16_t*)vp));
                    const u32x2 hi = __builtin_bit_cast(u32x2, __builtin_amdgcn_ds_read_tr16_b64_v4i16((LAS v4i16_t*)(vp + 16 * 288)));
                    acc = MFMA16(__builtin_bit_cast(bf16x8, (u32x4){lo.x, lo.y, hi.x, hi.y}), pf[kk], acc);
                }
            }
#pragma unroll
            for (int ks = 0; ks < 2; ++ks) {
                const bf16x8 sf = *(const LAS bf16x8*)(Sl + (16 * dt + fr) * PB + (32 * ks + 8 * fq) * 2);
                acc = MFMA16(sf, qf[ks], acc);
            }
            o[dt] = acc; ss += acc[0] * acc[0] + acc[1] * acc[1] + acc[2] * acc[2] + acc[3] * acc[3];
        }
        ss += __shfl_xor(ss, 16); ss += __shfl_xor(ss, 32);
        const float rn = rsqrtf(ss * (1.f / 128.f) + EPS);
#pragma unroll
        for (int dt = 0; dt < 8; ++dt) {
            const f32x4 gn = *(const f32x4*)(P.in[19] + l * 128 + 16 * dt + 4 * fq);
            const u32x2 gw = *(const u32x2*)(ZG + rq * 1536 + 1024 + h * 128 + 16 * dt + 4 * fq);
            const float g0 = blo(gw.x), g1 = bhi(gw.x), g2 = blo(gw.y), g3 = bhi(gw.y);
            u32x2 w; w.x = pk2(o[dt][0] * rn * gn[0] * silu(g0), o[dt][1] * rn * gn[1] * silu(g1)); w.y = pk2(o[dt][2] * rn * gn[2] * silu(g2), o[dt][3] * rn * gn[3] * silu(g3));
            *(u32x2*)(MIX + rq * 1024 + 512 + h * 128 + 16 * dt + 4 * fq) = w;
        }
        __syncthreads();
    }
}

DI void gla_decode_unit(const Ctx& C, int l, int unit) {
    unsigned char* ws = C.ws; const CAS Params& P = *C.p;
    const int b = unit >> 2, h = unit & 3; const size_t rb = (size_t)TP + b * 4;
    const bf16_t* ZG = (const bf16_t*)(ws + WS_ZG); const float* LR = (const float*)(ws + WS_LR); bf16_t* MIX = (bf16_t*)(ws + WS_MIX);
    LAS float* la = (LAS float*)C.lds;
    LAS float* qr = la + 256;
    LAS float* kr = qr + 256;
    LAS float* qe = kr + 256;
    LAS float* ke = qe + 256;
    LAS float* Am = ke + 256;
    LAS float* red = Am + 16;
    LAS float* opart = red + 8;
    if (C.tid < 256) {
        const int tt = C.tid >> 6, dk = C.tid & 63; float x = P.in[18][l * 256 + h * 64 + dk];
        const f32x4 l0 = *(const f32x4*)(LR + (rb + tt) * 16), l1 = *(const f32x4*)(LR + (rb + tt) * 16 + 4), l2 = *(const f32x4*)(LR + (rb + tt) * 16 + 8), l3 = *(const f32x4*)(LR + (rb + tt) * 16 + 12);
        const float* wg = P.in[17] + (size_t)(l * 16) * 256 + h * 64 + dk;
#pragma unroll
        for (int r = 0; r < 4; ++r) { x += l0[r] * wg[r * 256] + l1[r] * wg[(4 + r) * 256] + l2[r] * wg[(8 + r) * 256] + l3[r] * wg[(12 + r) * 256]; }
        la[tt * 64 + dk] = logsig(x) * (1.f / 16.f);
        qr[tt * 64 + dk] = bf2f(ZG[(rb + tt) * 1536 + h * 64 + dk]); kr[tt * 64 + dk] = bf2f(ZG[(rb + tt) * 1536 + 256 + h * 64 + dk]);
    }
    __syncthreads();
    if (C.tid < 64) { float run = 0.f;
#pragma unroll
        for (int tt = 0; tt < 4; ++tt) { run += la[tt * 64 + C.tid]; la[tt * 64 + C.tid] = run; } }
    __syncthreads();
    if (C.tid < 256) {
        const int tt = C.tid >> 6, dk = C.tid & 63; const float bt = la[tt * 64 + dk], b3 = la[3 * 64 + dk];
        qe[tt * 64 + dk] = 0.125f * qr[tt * 64 + dk] * __expf(bt); ke[tt * 64 + dk] = kr[tt * 64 + dk] * __expf(b3 - bt);
    } else if (C.tid < 272) {
        const int tt = (C.tid - 256) >> 2, s = (C.tid - 256) & 3; float sum = 0.f;
        if (s <= tt) for (int dk = 0; dk < 64; ++dk) sum += 0.125f * qr[tt * 64 + dk] * kr[s * 64 + dk] * __expf(la[tt * 64 + dk] - la[s * 64 + dk]);
        Am[C.tid - 256] = sum;
    }
    __syncthreads();
    {
        const int dv = C.tid & 127, dq = C.tid >> 7;
        float v[4], o[4] = {0.f, 0.f, 0.f, 0.f};
#pragma unroll
        for (int tt = 0; tt < 4; ++tt) v[tt] = bf2f(ZG[(rb + tt) * 1536 + 512 + h * 128 + dv]);
        const float* S0p = P.in[4] + ((size_t)(l * 128 + b) * 4 + h) * 8192 + (size_t)(16 * dq) * 128 + dv; float* Sn = C.out + O_GS + ((size_t)(l * 128 + b) * 4 + h) * 8192 + (size_t)(16 * dq) * 128 + dv;
        float S0[16];
#pragma unroll
        for (int i = 0; i < 16; ++i) S0[i] = S0p[i * 128];
#pragma unroll
        for (int i = 0; i < 16; ++i) {
            const int dk = 16 * dq + i;
            float sn = __expf(la[3 * 64 + dk]) * S0[i];
#pragma unroll
            for (int tt = 0; tt < 4; ++tt) { o[tt] += qe[tt * 64 + dk] * S0[i]; sn += ke[tt * 64 + dk] * v[tt]; }
            Sn[i * 128] = sn;
        }
#pragma unroll
        for (int tt = 0; tt < 4; ++tt) opart[(dq * 4 + tt) * 128 + dv] = o[tt];
    }
    __syncthreads();
    {
        const int tt = C.tid >> 7, dv = C.tid & 127;
        float o = opart[(0 * 4 + tt) * 128 + dv] + opart[(1 * 4 + tt) * 128 + dv] + opart[(2 * 4 + tt) * 128 + dv] + opart[(3 * 4 + tt) * 128 + dv];
        for (int s = 0; s <= tt; ++s) o += Am[tt * 4 + s] * bf2f(ZG[(rb + s) * 1536 + 512 + h * 128 + dv]);
        float ss = o * o;
#pragma unroll
        for (int of = 1; of < 64; of <<= 1) ss += __shfl_xor(ss, of);
        if (C.lane == 0) red[C.wave] = ss;
        __syncthreads();
        const float tot = red[2 * tt] + red[2 * tt + 1];
        const float rn = rsqrtf(tot * (1.f / 128.f) + EPS);
        const float gg = bf2f(ZG[(rb + tt) * 1536 + 1024 + h * 128 + dv]);
        const float val = o * rn * P.in[19][l * 128 + dv] * silu(gg);
        MIX[(rb + tt) * 1024 + 512 + h * 128 + dv] = (bf16_t)(pk2(val, 0.f) & 0xffffu);
    }
    __syncthreads();
}

__global__ void __launch_bounds__(512, 2) hymba_fwd(Params prm) {
    extern __shared__ __attribute__((aligned(16))) unsigned char smem[];
    cg::grid_group grid = cg::this_grid();
    Ctx C; C.lds = (LAS unsigned char*)smem; C.tid = threadIdx.x; C.lane = C.tid & 63; C.wave = __builtin_amdgcn_readfirstlane(C.tid >> 6);
    C.G = gridDim.x; C.bx = blockIdx.x; C.p = (const CAS Params*)__builtin_amdgcn_kernarg_segment_ptr(); C.ws = C.p->ws; C.out = C.p->out;
    (void)prm;

    unsigned* barw = (unsigned*)(C.ws + WS_BAR);
    if (C.bx == 0) for (int i = C.tid; i < XCD_BAR_WORDS; i += 512) barw[i] = 0u;
    if (C.tid < 4) ((LAS unsigned*)(C.lds + LDS_BYTES - 16))[C.tid] = 0u;
    grid.sync();
    XcdBarrier xbar = xcd_barrier_post(barw, (volatile LAS unsigned*)(C.lds + LDS_BYTES - 16));
    for (int rep = 0; rep < REP_P0; ++rep) p0_prologue(C);
    xcd_barrier(xbar);
    {   unsigned char* ws = C.ws;
        pg8::Gemm g{(const bf16_t*)(ws + WS_MEMB), (const bf16_t*)(ws + WS_WKV), 1024, 2048, 1024};
        const int n1 = (T / 256) * (5632 / 256);
        pg8::StaticOrder S; S.init(1024, 2048, C.G, (C.bx + C.G - (n1 % C.G)) % C.G);
        Epi<EK_MEM> E; E.c = EpiCtx{}; E.c.rss_in = (const float*)(ws + WS_RSSM); E.c.MKV = (float*)(ws + WS_MKV);
        pg8::gemm_phase(C.lds, C.tid, g, S, E);
    }
    int rep = 0;
    for (int ph = 0; ph < 24; ++ph) {
        { int t_ = threadIdx.x; asm volatile("" : "+v"(t_)); C.tid = t_; C.lane = t_ & 63; C.wave = __builtin_amdgcn_readfirstlane(t_ >> 6); }
        asm volatile("" : "+s"(C.ws), "+s"(C.out), "+s"(C.p));
        unsigned char* ws = C.ws; float* RSS = (float*)(ws + WS_RSS);
        const int l = ph / 12, k = ph - 12 * l;
        unsigned char* wl = ws + WS_WL + (size_t)l * WL_SIZE;
        EpiCtx ec{}; ec.l = l;
        if (k == 0 || k == 10) {
            pg8::Gemm g{(const bf16_t*)(ws + WS_XB), (const bf16_t*)(wl + (k == 0 ? WL_W1 : WL_W2)), T, 5632, 1024};
            pg8::StaticOrder S; S.init(T, 5632, C.G, C.bx);
            ec.rss_in = RSS + (size_t)(4 * l + (k == 0 ? 0 : 3)) * T; ec.H = (bf16_t*)(ws + WS_H);
            Epi<EK_SWIGLU> E; E.c = ec; pg8::gemm_phase(C.lds, C.tid, g, S, E);
            if (ph == 0 && rep == 0) convert_in_slack(C, 0, T_WD1, 688, (T / 256) * 22 + 32);
            if (ph == 10 && rep == 0) convert_in_slack(C, 1, 704, T_WKV, (T / 256) * 22);
        } else if (k == 1 || k == 6 || k == 9 || k == 11) {
            const bf16_t* A; const bf16_t* B; int K; float sc; int ro;
            if (k == 1) { A = (const bf16_t*)(ws + WS_H); B = (const bf16_t*)(wl + WL_WD1); K = FF; sc = 0.5f; ro = 4 * l + 1; }
            else if (k == 6) { A = (const bf16_t*)(ws + WS_MIX); B = (const bf16_t*)(wl + WL_WOUT); K = 1024; sc = 1.f; ro = 4 * l + 2; }
            else if (k == 9) { A = (const bf16_t*)(ws + WS_OX); B = (const bf16_t*)(wl + WL_WO); K = 512; sc = 1.f; ro = 4 * l + 3; }
            else { A = (const bf16_t*)(ws + WS_H); B = (const bf16_t*)(wl + WL_WD2); K = FF; sc = 0.5f; ro = 4 * l + 4; }
            pg8::Gemm g{A, B, TP, 1024, K};
            pg8::StaticOrder S; S.init(TP, 1024, C.G, C.bx);
            ec.rss_out = RSS + (size_t)ro * T; ec.X = (ph == 23) ? C.out : nullptr; ec.XB = (bf16_t*)(ws + WS_XB); ec.scale = sc;
            Epi<EK_RES> E; E.c = ec; pg8::gemm_phase(C.lds, C.tid, g, S, E);
            thin_res_gemm(C, A, B, K, sc, RSS + (size_t)ro * T, (ph == 23) ? C.out : nullptr);
        } else if (k == 2) {
            pg8::Gemm g{(const bf16_t*)(ws + WS_XB), (const bf16_t*)(wl + WL_WIN), T, INWP, 1024};
            pg8::StaticOrder S; S.init(T, INWP, C.G, C.bx);
            ec.rss_in = RSS + (size_t)(4 * l + 1) * T; ec.QS = (bf16_t*)(ws + WS_QS); ec.KS = (bf16_t*)(ws + WS_KS); ec.VS = (bf16_t*)(ws + WS_VS); ec.ZG = (bf16_t*)(ws + WS_ZG);
            ec.LR = (float*)(ws + WS_LR); ec.rope = (const float2*)(ws + WS_ROPE); ec.gq = C.p->in[14] + l * 64; ec.gk = C.p->in[15] + l * 64;
            ec.okp = C.out + O_KP; ec.ovp = C.out + O_VP; ec.oks = C.out + O_KS; ec.ovs = C.out + O_VS;
            Epi<EK_WIN> E; E.c = ec; pg8::gemm_phase(C.lds, C.tid, g, S, E);
            if (ph == 2 && rep == 0) convert_in_slack(C, 0, 688, T_WKV, (T / 256) * 10);
        } else if (k == 3) {
            for (int u = C.bx; u < 256; u += C.G) swa_prompt_unit(C, l, u);
            gla_a_phase(C, l);
        } else if (k == 4) {
            gla_scan(C, l);
            for (int u = C.bx; u < 512; u += C.G) gla_decode_unit(C, l, u);
            for (int u = C.bx; u < 256; u += C.G) swa_decode_unit(C, l, u);
        } else if (k == 5) {
            gla_c_phase(C, l);
        } else if (k == 7) {
            pg8::Gemm g{(const bf16_t*)(ws + WS_XB), (const bf16_t*)(wl + WL_WQ), T, 512, 1024};
            pg8::StaticOrder S; S.init(T, 512, C.G, C.bx);
            ec.rss_in = RSS + (size_t)(4 * l + 2) * T; ec.QX = (bf16_t*)(ws + WS_QX);
            Epi<EK_XQ> E; E.c = ec; pg8::gemm_phase(C.lds, C.tid, g, S, E);
            if (ph == 7 && rep == 0) convert_in_slack(C, 1, 0, 704, (T / 256) * 2);
        } else {
            if (C.G == 256) {
                if (C.bx < 128) { xattn_unit(C, l, C.bx); xattn_unit(C, l, 128 + C.bx); }
                else for (int i = 0; i < 3; ++i) xattn_unit(C, l, 128 + 128 + 3 * (C.bx - 128) + i);
            } else for (int u = C.bx; u < 640; u += C.G) xattn_unit(C, l, u);
        }
        if (ph != 23) for (int r2 = 0; r2 < REP_SYNC; ++r2) xcd_barrier(xbar);
        {
            const int want = (k == 0 || k == 2 || k == 7 || k == 10) ? REP_GEMM : (k == 3 ? REP3 : (k == 4 ? REP4 : k == 5 ? REP5 : (k == 8 ? REP8 : 1)));
            if (rep + 1 < want) { ++rep; --ph; } else rep = 0;
        }
    }
}

extern "C" void kernel_launch(void* const* d_in, const int* in_sizes, int n_in, void* d_out, int out_size, void* d_ws, size_t ws_size, hipStream_t stream) {
    static int grid = 0;
    if (grid == 0) {
        if (n_in != 33 || ws_size < WS_TOTAL) { fprintf(stderr, "kernel_launch: need 33 inputs and %zu bytes of workspace; got %d inputs, %zu bytes\n", (size_t)WS_TOTAL, n_in, ws_size); grid = -1; return; }
        int dev = 0, cus = 0, per_cu = 0;
        (void)hipGetDevice(&dev); (void)hipDeviceGetAttribute(&cus, hipDeviceAttributeMultiprocessorCount, dev);
        if (hipFuncSetAttribute((const void*)hymba_fwd, hipFuncAttributeMaxDynamicSharedMemorySize, LDS_BYTES) != hipSuccess) { fprintf(stderr, "kernel_launch: hipFuncSetAttribute failed\n"); grid = -1; return; }
        if (hipOccupancyMaxActiveBlocksPerMultiprocessor(&per_cu, (const void*)hymba_fwd, 512, LDS_BYTES) != hipSuccess || per_cu < 1) { fprintf(stderr, "kernel_launch: occupancy query gave %d\n", per_cu); grid = -1; return; }
        grid = cus * per_cu;
    }
    if (grid < 0) return;
    Params p{};
    for (int i = 0; i < 33; ++i) p.in[i] = (const float*)d_in[i];
    p.out = (float*)d_out; p.ws = (unsigned char*)d_ws;
    void* args[] = {&p};
    hipError_t e = hipLaunchCooperativeKernel((const void*)hymba_fwd, dim3(grid), dim3(512), args, LDS_BYTES, stream);
    if (e != hipSuccess) fprintf(stderr, "kernel_launch: cooperative launch failed: %s (grid %d)\n", hipGetErrorString(e), grid);
}
```

```cpp
#include <hip/hip_runtime.h>
#include <hip/hip_cooperative_groups.h>
#include <cstdio>
#include <cstdint>
namespace cg = cooperative_groups;

#define LAS __attribute__((address_space(3)))
#define DI __device__ __forceinline__
typedef unsigned short bf16_t;
typedef short bf16x8 __attribute__((ext_vector_type(8)));
typedef float f32x4 __attribute__((ext_vector_type(4)));
typedef unsigned u32x4 __attribute__((ext_vector_type(4)));
typedef unsigned u32x2 __attribute__((ext_vector_type(2)));
typedef short v4i16_t __attribute__((ext_vector_type(4)));
#define MFMA16(a, b, c) __builtin_amdgcn_mfma_f32_16x16x32_bf16((a), (b), (c), 0, 0, 0)

constexpr int TP = 16384, TS = 512, T = TP + TS, DM = 1024, FF = 2816, SEQ = 4096;
constexpr int INWP = 2560;
constexpr float EPS = 1e-6f;
constexpr size_t O_Y = 0, O_KP = 17301504, O_VP = 17432576, O_GP = 17563648, O_MKP = 17825792, O_MVP = 18874368, O_KS = 19922944, O_VS = 24117248, O_GS = 28311552;
constexpr size_t al(size_t x) { return (x + 4095) & ~(size_t)4095; }
constexpr size_t WS_RSS = 0;
constexpr size_t WS_RSSM = al(WS_RSS + (size_t)9 * T * 4);
constexpr size_t WS_ROPE = al(WS_RSSM + 1024 * 4);
constexpr size_t WS_XB = al(WS_ROPE + (size_t)4100 * 32 * 8);
constexpr size_t WS_H = al(WS_XB + (size_t)T * 1024 * 2);
constexpr size_t WS_QS = al(WS_H + (size_t)T * FF * 2);
constexpr size_t WS_KS = al(WS_QS + (size_t)T * 512 * 2);
constexpr size_t WS_VS = al(WS_KS + (size_t)T * 128 * 2);
constexpr size_t WS_ZG = al(WS_VS + (size_t)T * 128 * 2);
constexpr size_t WS_LR = al(WS_ZG + (size_t)T * 1536 * 2);
constexpr size_t WS_MIX = al(WS_LR + (size_t)T * 16 * 4);
constexpr size_t WS_QX = al(WS_MIX + (size_t)T * 1024 * 2);
constexpr size_t WS_OX = al(WS_QX + (size_t)T * 512 * 2);
constexpr size_t WS_MEMB = al(WS_OX + (size_t)T * 512 * 2);
constexpr size_t WS_MKV = al(WS_MEMB + (size_t)1024 * 1024 * 2);
constexpr size_t WS_BCUM = al(WS_MKV + (size_t)1024 * 2048 * 4);
constexpr size_t WS_ST = al(WS_BCUM + (size_t)TP * 256 * 4);
constexpr size_t WS_VT = al(WS_ST + (size_t)1024 * 8192 * 4);
constexpr size_t WS_DEC = al(WS_VT + (size_t)1024 * 8192 * 2);
constexpr size_t WS_WKV = al(WS_DEC + (size_t)1024 * 64 * 4);
constexpr size_t WS_WL = al(WS_WKV + (size_t)2048 * 1024 * 2);
constexpr size_t WL_W1 = 0;
constexpr size_t WL_WD1 = WL_W1 + (size_t)5632 * 1024 * 2;
constexpr size_t WL_WIN = WL_WD1 + (size_t)1024 * FF * 2;
constexpr size_t WL_WOUT = WL_WIN + (size_t)INWP * 1024 * 2;
constexpr size_t WL_WQ = WL_WOUT + (size_t)1024 * 1024 * 2;
constexpr size_t WL_WO = WL_WQ + (size_t)512 * 1024 * 2;
constexpr size_t WL_W2 = WL_WO + (size_t)1024 * 512 * 2;
constexpr size_t WL_WD2 = WL_W2 + (size_t)5632 * 1024 * 2;
constexpr size_t WL_SIZE = al(WL_WD2 + (size_t)1024 * FF * 2);
constexpr size_t WS_STB = WS_WL + 2 * WL_SIZE;
constexpr size_t WS_BAR = al(WS_STB + (size_t)1024 * 8192 * 2);
constexpr size_t WS_TOTAL = WS_BAR + 16384;
constexpr int LDS_BYTES = 147456;
constexpr int REP_GEMM = 1, REP_ATT = 1, REP_P0 = 1, REP_SYNC = 1, REP3 = 1, REP4 = 1, REP5 = 1, REP8 = 1;

DI float bf2f(unsigned h) { return __builtin_bit_cast(float, h << 16); }
typedef float f32x2_t __attribute__((ext_vector_type(2)));
typedef __bf16 bf16x2_t __attribute__((ext_vector_type(2)));
DI unsigned pk2(float lo, float hi) { const f32x2_t v = {lo, hi}; const bf16x2_t b = __builtin_convertvector(v, bf16x2_t); return __builtin_bit_cast(unsigned, b); }
DI float blo(unsigned w) { return __builtin_bit_cast(float, w << 16); }
DI float bhi(unsigned w) { return __builtin_bit_cast(float, w & 0xffff0000u); }
DI float silu(float x) { return x * __builtin_amdgcn_rcpf(1.f + __builtin_amdgcn_exp2f(x * -1.4426950408889634f)); }
DI float logsig(float x) { return fminf(x, 0.f) - __logf(1.f + __expf(-fabsf(x))); }

#define XB_TMO      128
#define XB_XCNT(j)  (256  + 64 * (j))
#define XB_XSUB(j)  (1280 + 64 * (j))
#define XB_XGEN(j)  (2304 + 64 * (j))
#define XB_TOP      3328
#define XB_TOPGEN   3392
#define XCD_BAR_WORDS 3456
#define XB_SPIN_CAP (1u << 18)
DI unsigned xb_ld(unsigned* p)              { return __hip_atomic_load(p, __ATOMIC_RELAXED, __HIP_MEMORY_SCOPE_AGENT); }
DI unsigned xb_add(unsigned* p, unsigned v) { return __hip_atomic_fetch_add(p, v, __ATOMIC_RELAXED, __HIP_MEMORY_SCOPE_AGENT); }
DI unsigned xb_xcc_id() { return (unsigned)__builtin_amdgcn_s_getreg((3 << 11) | 20) & 0xFu; }
#define XB_SPIN(cond, bar) do { unsigned _sp = 0; while (cond) { __builtin_amdgcn_s_sleep(1); \
    if ((++_sp & 255u) == 0u) { if (xb_ld(&(bar)[XB_TMO])) break; if (_sp > XB_SPIN_CAP) { atomicAdd(&(bar)[XB_TMO], 1u); break; } } } } while (0)
struct XcdBarrier { unsigned* bar; unsigned x; volatile LAS unsigned* st; };
DI XcdBarrier xcd_barrier_post(unsigned* bar, volatile LAS unsigned* st) {
    XcdBarrier b; b.bar = bar; b.x = xb_xcc_id(); b.st = st;
    if (threadIdx.x == 0) (void)xb_add(&bar[XB_XCNT(b.x)], 1u);
    return b;
}
DI void xcd_barrier_complete(unsigned* bar, unsigned x, unsigned& nloc, unsigned& nx) {
    const unsigned G = gridDim.x * gridDim.y * gridDim.z;
    unsigned sum, cnt, mine, sp = 0u;
    for (;;) {
        sum = 0u; cnt = 0u; mine = 0u;
#pragma unroll
        for (unsigned j = 0; j < 16; ++j) { const unsigned c = xb_ld(&bar[XB_XCNT(j)]); sum += c; cnt += (c > 0u) ? 1u : 0u; mine = (j == x) ? c : mine; }
        if (sum == G) break;
        __builtin_amdgcn_s_sleep(1);
        if ((++sp & 255u) == 0u) { if (xb_ld(&bar[XB_TMO])) break; if (sp > XB_SPIN_CAP) { atomicAdd(&bar[XB_TMO], 1u); break; } }
    }
    nloc = mine > 0u ? mine : 1u; nx = cnt > 0u ? cnt : 1u;
}
DI void xcd_barrier(const XcdBarrier& b) {
    asm volatile("s_waitcnt vmcnt(0)" ::: "memory");
    __syncthreads();
    if (threadIdx.x == 0) {
        unsigned* bar = b.bar;
        __builtin_amdgcn_s_waitcnt(0);
        unsigned nloc = b.st[0], nx = b.st[1];
        if (nloc == 0u) { xcd_barrier_complete(bar, b.x, nloc, nx); b.st[0] = nloc; b.st[1] = nx; }
        const unsigned old = xb_add(&bar[XB_XSUB(b.x)], 1u);
        const unsigned gen = old / nloc;
        if (old + 1u == (gen + 1u) * nloc) {
            __builtin_amdgcn_fence(__ATOMIC_RELEASE, "agent");
            asm volatile("s_waitcnt vmcnt(0)" ::: "memory");
            const unsigned og = xb_add(&bar[XB_TOP], 1u);
            const unsigned tg = og / nx;
            if (og + 1u == (tg + 1u) * nx) xb_add(&bar[XB_TOPGEN], 1u);
            else XB_SPIN(xb_ld(&bar[XB_TOPGEN]) == tg, bar);
            __builtin_amdgcn_fence(__ATOMIC_ACQUIRE, "agent");
            xb_add(&bar[XB_XGEN(b.x)], 1u);
            asm volatile("s_waitcnt vmcnt(0)" ::: "memory");
        } else {
            XB_SPIN(xb_ld(&bar[XB_XGEN(b.x)]) == gen, bar);
            __builtin_amdgcn_fence(__ATOMIC_ACQUIRE, "agent");
            asm volatile("s_waitcnt vmcnt(0)" ::: "memory");
        }
    }
    __syncthreads();
}

namespace pg8 {
constexpr int BM = 256, BK = 64, HALF = 128, HTB = HALF * BK * 2, STAGE_BYTES = 8 * HTB, NXCD = 8, WGM = 8;
DI int lds_byte(int r, int c) { const int st = (r >> 4) * 2 + (c >> 5), rr = r & 15, cc = c & 31, ob = rr * 64 + cc * 2; return st * 1024 + (ob ^ (((ob >> 9) & 1) << 5)); }
DI void stage_rc(int b, int& R, int& C) { const int st = b / 1024, sb = b % 1024, swz = sb ^ (((sb >> 9) & 1) << 5); R = (st >> 1) * 16 + swz / 64; C = (st & 1) * 32 + (swz % 64) / 2; }
DI int perm32(int rho) { const int n = rho >> 4, i = rho & 15; return 8 * (i >> 2) + 4 * n + (i & 3); }
struct Unit { int pm, pn; };
struct Gemm { const bf16_t* A; const bf16_t* Bt; int M, N, K; };
struct StaticOrder {
    int nM, nN, nwg, G, c;
    DI void init(int M, int N, int G_, int c_) { nM = M / BM; nN = N / BM; nwg = nM * nN; G = G_; c = c_; }
    DI bool next(int i, Unit& u) const {
        const long L = (long)i * G + c; if (L >= nwg) return false;
        int wgid = (int)L; { const int q = nwg / NXCD, r = nwg % NXCD, xcd = wgid % NXCD, off = wgid / NXCD; wgid = (xcd < r ? xcd * (q + 1) : r * (q + 1) + (xcd - r) * q) + off; }
        const int nig = WGM * nN, gid = wgid / nig, fm = gid * WGM, gsz = (nM - fm) < WGM ? (nM - fm) : WGM;
        u.pm = fm + ((wgid % nig) % gsz); u.pn = (wgid % nig) / gsz; return true;
    }
};
template <class Epi, class Sched>
DI void gemm_phase(LAS unsigned char* lds, const int tid, const Gemm g, const Sched& S, const Epi& E) {
    const int wid = __builtin_amdgcn_readfirstlane(tid >> 6), lane = tid & 63, wr = wid >> 2, wc = wid & 3, fr = lane & 15, fq = lane >> 4;
    const int K = g.K, nt = K / BK;
    unsigned voffA[2], voffB[2];
#pragma unroll
    for (int i = 0; i < 2; ++i) { int R, C; stage_rc(tid * 16 + i * 8192, R, C); const int Rb = (R & ~31) + perm32(R & 31);
        voffA[i] = (unsigned)(R * K + C) * 2u; voffB[i] = (unsigned)(Rb * K + C) * 2u; }
    const size_t kstep = (size_t)(BK * 2);
    const size_t hstep = (size_t)HALF * K * 2;
    const size_t tstep = 2 * hstep;
    const unsigned ldsw = (unsigned)wid * 1024u;
    const int aoff = lds_byte(wr * 64 + fr, fq * 8), boff = lds_byte(wc * 32 + fr, fq * 8);
#define PG8_SA(b, h) (((b) * 2 + (h)) * HTB)
#define PG8_SB(b, h) ((4 + (b) * 2 + (h)) * HTB)
#define PG8_STAGE(bufoff, gbase, voff) do { _Pragma("unroll") for (int _i = 0; _i < 2; ++_i) \
        __builtin_amdgcn_global_load_lds((const unsigned*)((const char*)(gbase) + (voff)[_i]), (LAS unsigned*)(lds + (bufoff) + ldsw + _i * 8192), 16, 0, 0); } while (0)
#define PG8_LDA(dst, b, h) do { _Pragma("unroll") for (int m = 0; m < 4; ++m) _Pragma("unroll") for (int k = 0; k < 2; ++k) dst[m][k] = *(const LAS bf16x8*)(lds + PG8_SA(b, h) + aoff + m * 2048 + k * 1024); } while (0)
#define PG8_LDB(dst, b, h) do { _Pragma("unroll") for (int n = 0; n < 2; ++n) _Pragma("unroll") for (int k = 0; k < 2; ++k) dst[n][k] = *(const LAS bf16x8*)(lds + PG8_SB(b, h) + boff + n * 2048 + k * 1024); } while (0)
#define PG8_MMA(ai, bj, At, Bt) do { __builtin_amdgcn_s_setprio(1); _Pragma("unroll") for (int m = 0; m < 4; ++m) _Pragma("unroll") for (int n = 0; n < 2; ++n) _Pragma("unroll") for (int k = 0; k < 2; ++k) \
        acc[ai][bj][m][n] = __builtin_amdgcn_mfma_f32_16x16x32_bf16(Bt[n][k], At[m][k], acc[ai][bj][m][n], 0, 0, 0); __builtin_amdgcn_s_setprio(0); } while (0)
#define PG8_WAIT_V(n) asm volatile("s_waitcnt vmcnt(" #n ")" ::: "memory")
#define PG8_WAIT_L(n) asm volatile("s_waitcnt lgkmcnt(" #n ")" ::: "memory")
#define PG8_BAR __builtin_amdgcn_s_barrier()
#define PG8_SCHED __builtin_amdgcn_sched_barrier(0)
    Unit cur, nxt; int ui = 0;
    if (!S.next(0, cur)) return;
    f32x4 acc[2][2][4][2];
#pragma unroll
    for (int a = 0; a < 2; ++a)
#pragma unroll
        for (int b = 0; b < 2; ++b)
#pragma unroll
            for (int m = 0; m < 4; ++m)
#pragma unroll
                for (int n = 0; n < 2; ++n) acc[a][b][m][n] = (f32x4){0.f, 0.f, 0.f, 0.f};
    bf16x8 At[4][2], B0[2][2], B1[2][2];
    const char* cA = (const char*)g.A + (size_t)cur.pm * tstep; const char* cB = (const char*)g.Bt + (size_t)cur.pn * tstep;
    PG8_STAGE(PG8_SB(0, 0), cB, voffB); PG8_STAGE(PG8_SB(0, 1), cB + hstep, voffB); PG8_STAGE(PG8_SA(0, 0), cA, voffA); PG8_STAGE(PG8_SA(0, 1), cA + hstep, voffA);
    if (wr == 1) PG8_BAR;
    PG8_WAIT_V(2); PG8_BAR;
    PG8_STAGE(PG8_SB(1, 0), cB + kstep, voffB); PG8_STAGE(PG8_SA(1, 0), cA + kstep, voffA); PG8_STAGE(PG8_SB(1, 1), cB + hstep + kstep, voffB);
    PG8_WAIT_V(6); PG8_BAR;
    for (;;) {
        const bool has_next = S.next(ui + 1, nxt);
        const char* nA = has_next ? (const char*)g.A + (size_t)nxt.pm * tstep : cA; const char* nB = has_next ? (const char*)g.Bt + (size_t)nxt.pn * tstep : cB;
        for (int t = 0; t < nt; t += 2) {
            const bool last = (t == nt - 2);
            const char* a1 = cA + (size_t)(t + 1) * kstep;
            const char* a2 = last ? nA : cA + (size_t)(t + 2) * kstep; const char* b2 = last ? nB : cB + (size_t)(t + 2) * kstep;
            const char* a3 = a2 + kstep; const char* b3 = b2 + kstep;
            PG8_LDB(B0, 0, 0); PG8_LDB(B1, 0, 1); PG8_SCHED; PG8_LDA(At, 0, 0); PG8_STAGE(PG8_SA(1, 1), a1 + hstep, voffA);
            PG8_WAIT_V(8); PG8_WAIT_L(0); PG8_BAR; PG8_MMA(0, 0, At, B0); PG8_MMA(0, 1, At, B1); PG8_BAR; PG8_SCHED;
            PG8_LDA(At, 0, 1); PG8_STAGE(PG8_SB(0, 0), b2, voffB); PG8_STAGE(PG8_SB(0, 1), b2 + hstep, voffB); PG8_STAGE(PG8_SA(0, 0), a2, voffA);
            PG8_WAIT_V(8); PG8_WAIT_L(0); PG8_BAR; PG8_MMA(1, 0, At, B0); PG8_MMA(1, 1, At, B1); PG8_BAR; PG8_SCHED;
            PG8_LDB(B0, 1, 0); PG8_LDB(B1, 1, 1); PG8_SCHED; PG8_LDA(At, 1, 0); PG8_STAGE(PG8_SA(0, 1), a2 + hstep, voffA);
            PG8_WAIT_V(8); PG8_WAIT_L(0); PG8_BAR; PG8_MMA(0, 0, At, B0); PG8_MMA(0, 1, At, B1); PG8_BAR; PG8_SCHED;
            PG8_LDA(At, 1, 1); PG8_STAGE(PG8_SB(1, 0), b3, voffB); PG8_STAGE(PG8_SB(1, 1), b3 + hstep, voffB); PG8_STAGE(PG8_SA(1, 0), a3, voffA);
            PG8_WAIT_V(8); PG8_WAIT_L(0); PG8_BAR; PG8_MMA(1, 0, At, B0); PG8_MMA(1, 1, At, B1); PG8_BAR; PG8_SCHED;
        }
        if (wr == 0) PG8_BAR;
        E(acc, cur, wr, wc, fr, fq);
        if (!has_next) break;
#pragma unroll
        for (int a = 0; a < 2; ++a)
#pragma unroll
            for (int b = 0; b < 2; ++b)
#pragma unroll
                for (int m = 0; m < 4; ++m)
#pragma unroll
                    for (int n = 0; n < 2; ++n) acc[a][b][m][n] = (f32x4){0.f, 0.f, 0.f, 0.f};
        cur = nxt; cA = nA; cB = nB; ++ui;
        if (wr == 1) PG8_BAR;
    }
    PG8_WAIT_V(0);
    PG8_BAR;
#undef PG8_SA
#undef PG8_SB
#undef PG8_STAGE
#undef PG8_LDA
#undef PG8_LDB
#undef PG8_MMA
#undef PG8_WAIT_V
#undef PG8_WAIT_L
#undef PG8_BAR
#undef PG8_SCHED
}
}

struct EpiCtx {
    const float* rss_in; float* rss_out; float* X; bf16_t* XB; bf16_t* H;
    bf16_t *QS, *KS, *VS, *ZG; float* LR; const float2* rope; const float *gq, *gk;
    float *okp, *ovp, *oks, *ovs; bf16_t* QX; float* MKV; float scale; int l;
};
enum { EK_SWIGLU = 0, EK_RES = 1, EK_WIN = 2, EK_XQ = 3, EK_MEM = 4 };
template <int KIND> struct Epi {
    EpiCtx c;
    DI void operator()(const f32x4 (&acc)[2][2][4][2], const pg8::Unit& u, int wr, int wc, int fr, int fq) const {
        const int row0 = u.pm * 256 + wr * 64 + fr;
        const int cl = wc * 32 + 8 * fq;
        if constexpr (KIND == EK_RES) {
            u32x4 xo[2][4][2];
#pragma unroll
            for (int ai = 0; ai < 2; ++ai)
#pragma unroll
                for (int m = 0; m < 4; ++m)
#pragma unroll
                    for (int bj = 0; bj < 2; ++bj) xo[ai][m][bj] = *(const u32x4*)(c.XB + (size_t)(row0 + ai * 128 + m * 16) * DM + u.pn * 256 + bj * 128 + cl);
#pragma unroll
            for (int ai = 0; ai < 2; ++ai)
#pragma unroll
                for (int m = 0; m < 4; ++m) {
                    const int r = row0 + ai * 128 + m * 16;
                    float ss = 0.f;
#pragma unroll
                    for (int bj = 0; bj < 2; ++bj) {
                        bf16_t* xb = c.XB + (size_t)r * DM + u.pn * 256 + bj * 128 + cl;
                        const u32x4 xv = xo[ai][m][bj];
                        f32x4 x0 = (f32x4){blo(xv[0]), bhi(xv[0]), blo(xv[1]), bhi(xv[1])}, x1 = (f32x4){blo(xv[2]), bhi(xv[2]), blo(xv[3]), bhi(xv[3])};
                        x0 = x0 + acc[ai][bj][m][0] * c.scale; x1 = x1 + acc[ai][bj][m][1] * c.scale;
                        if (c.X) { float* xp = c.X + (size_t)r * DM + u.pn * 256 + bj * 128 + cl; *(f32x4*)xp = x0; *(f32x4*)(xp + 4) = x1; }
                        else {
                            u32x4 w; w.x = pk2(x0[0], x0[1]); w.y = pk2(x0[2], x0[3]); w.z = pk2(x1[0], x1[1]); w.w = pk2(x1[2], x1[3]);
                            *(u32x4*)xb = w;
#pragma unroll
                            for (int e = 0; e < 4; ++e) { const float a0 = blo(w[e]), a1 = bhi(w[e]); ss += a0 * a0 + a1 * a1; }
                        }
                    }
                    if (!c.X) { ss += __shfl_xor(ss, 16); ss += __shfl_xor(ss, 32); if (fq == 0) atomicAdd(c.rss_out + r, ss); }
                }
            return;
        }
#pragma unroll
        for (int ai = 0; ai < 2; ++ai)
#pragma unroll
            for (int m = 0; m < 4; ++m) {
                const int r = row0 + ai * 128 + m * 16;
                if constexpr (KIND == EK_SWIGLU) {
                    const float rs = rsqrtf(c.rss_in[r] * (1.f / 1024.f) + EPS);
                    const float rsn = rs * -1.4426950408889634f, irs2 = __builtin_amdgcn_rcpf(rs * rs);
                    float hv[8];
#pragma unroll
                    for (int n = 0; n < 2; ++n)
#pragma unroll
                        for (int j = 0; j < 4; ++j) { const float g0 = acc[ai][0][m][n][j], u0 = acc[ai][1][m][n][j];
                            hv[n * 4 + j] = (g0 * u0) * __builtin_amdgcn_rcpf(__builtin_fmaf(__builtin_amdgcn_exp2f(g0 * rsn), irs2, irs2)); }
                    u32x4 w; w.x = pk2(hv[0], hv[1]); w.y = pk2(hv[2], hv[3]); w.z = pk2(hv[4], hv[5]); w.w = pk2(hv[6], hv[7]);
                    *(u32x4*)(c.H + (size_t)r * FF + u.pn * 128 + cl) = w;
                } else if constexpr (KIND == EK_XQ) {
                    const float rs = rsqrtf(c.rss_in[r] * (1.f / 1024.f) + EPS);
#pragma unroll
                    for (int bj = 0; bj < 2; ++bj) {
                        const f32x4 a0 = acc[ai][bj][m][0] * rs, a1 = acc[ai][bj][m][1] * rs;
                        u32x4 w; w.x = pk2(a0[0], a0[1]); w.y = pk2(a0[2], a0[3]); w.z = pk2(a1[0], a1[1]); w.w = pk2(a1[2], a1[3]);
                        *(u32x4*)(c.QX + (size_t)r * 512 + u.pn * 256 + bj * 128 + cl) = w;
                    }
                } else if constexpr (KIND == EK_MEM) {
                    const float rs = rsqrtf(c.rss_in[r] * (1.f / 1024.f) + EPS);
#pragma unroll
                    for (int bj = 0; bj < 2; ++bj) {
                        float* p = c.MKV + (size_t)r * 2048 + u.pn * 256 + bj * 128 + cl;
                        *(f32x4*)p = acc[ai][bj][m][0] * rs; *(f32x4*)(p + 4) = acc[ai][bj][m][1] * rs;
                    }
                } else {
                    const float rs = rsqrtf(c.rss_in[r] * (1.f / 1024.f) + EPS);
                    const int pn = u.pn;
                    if (pn < 2 || (pn == 2 && wc < 2)) {
                        const bool isq = pn < 2; const int head = isq ? (4 * pn + wc) : wc;
                        const float* gn = isq ? c.gq : c.gk;
                        float ss = 0.f;
#pragma unroll
                        for (int bj = 0; bj < 2; ++bj)
#pragma unroll
                            for (int n = 0; n < 2; ++n)
#pragma unroll
                                for (int j = 0; j < 4; ++j) { const float v = acc[ai][bj][m][n][j] * rs; ss += v * v; }
                        ss += __shfl_xor(ss, 16); ss += __shfl_xor(ss, 32);
                        const float rq = rsqrtf(ss * (1.f / 64.f) + EPS) * rs * (isq ? 0.18033688011112042f : 1.f);
                        const int ridx = r < TP ? (r & (SEQ - 1)) : (4096 + (r & 3));
                        const float2* rp = c.rope + (size_t)ridx * 32 + 8 * fq;
                        float o1[8], o2[8];
#pragma unroll
                        for (int n = 0; n < 2; ++n)
#pragma unroll
                            for (int j = 0; j < 4; ++j) {
                                const int d = 8 * fq + 4 * n + j; const float2 cs = rp[4 * n + j];
                                const float y1 = acc[ai][0][m][n][j] * rq * gn[d], y2 = acc[ai][1][m][n][j] * rq * gn[32 + d];
                                o1[4 * n + j] = y1 * cs.x - y2 * cs.y; o2[4 * n + j] = y2 * cs.x + y1 * cs.y;
                            }
                        u32x4 w1, w2; w1.x = pk2(o1[0], o1[1]); w1.y = pk2(o1[2], o1[3]); w1.z = pk2(o1[4], o1[5]); w1.w = pk2(o1[6], o1[7]);
                        w2.x = pk2(o2[0], o2[1]); w2.y = pk2(o2[2], o2[3]); w2.z = pk2(o2[4], o2[5]); w2.w = pk2(o2[6], o2[7]);
                        if (isq) { bf16_t* p = c.QS + (size_t)r * 512 + head * 64 + 8 * fq; *(u32x4*)p = w1; *(u32x4*)(p + 32) = w2; }
                        else {
                            bf16_t* p = c.KS + (size_t)r * 128 + head * 64 + 8 * fq; *(u32x4*)p = w1; *(u32x4*)(p + 32) = w2;
                            float* op = nullptr;
                            if (r < TP) { const int t = r & (SEQ - 1); if (t >= SEQ - 128) op = c.okp + ((size_t)((c.l * 4 + (r >> 12)) * 128 + (t - (SEQ - 128)))) * 128; }
                            else { const int rr = r - TP; op = c.oks + ((size_t)((c.l * 128 + (rr >> 2)) * 128 + 124 + (rr & 3))) * 128; }
                            if (op) { op += head * 64 + 8 * fq;
                                *(f32x4*)op = (f32x4){o1[0], o1[1], o1[2], o1[3]}; *(f32x4*)(op + 4) = (f32x4){o1[4], o1[5], o1[6], o1[7]};
                                *(f32x4*)(op + 32) = (f32x4){o2[0], o2[1], o2[2], o2[3]}; *(f32x4*)(op + 36) = (f32x4){o2[4], o2[5], o2[6], o2[7]}; }
                        }
                    } else if (pn == 2) {
                        const int head = wc - 2;
                        float* op = nullptr;
                        if (r < TP) { const int t = r & (SEQ - 1); if (t >= SEQ - 128) op = c.ovp + ((size_t)((c.l * 4 + (r >> 12)) * 128 + (t - (SEQ - 128)))) * 128; }
                        else { const int rr = r - TP; op = c.ovs + ((size_t)((c.l * 128 + (rr >> 2)) * 128 + 124 + (rr & 3))) * 128; }
#pragma unroll
                        for (int bj = 0; bj < 2; ++bj) {
                            const f32x4 a0 = acc[ai][bj][m][0] * rs, a1 = acc[ai][bj][m][1] * rs;
                            u32x4 w; w.x = pk2(a0[0], a0[1]); w.y = pk2(a0[2], a0[3]); w.z = pk2(a1[0], a1[1]); w.w = pk2(a1[2], a1[3]);
                            *(u32x4*)(c.VS + (size_t)r * 128 + head * 64 + 32 * bj + 8 * fq) = w;
                            if (op) { float* q = op + head * 64 + 32 * bj + 8 * fq; *(f32x4*)q = a0; *(f32x4*)(q + 4) = a1; }
                        }
                    } else if (pn < 9) {
#pragma unroll
                        for (int bj = 0; bj < 2; ++bj) {
                            const f32x4 a0 = acc[ai][bj][m][0] * rs, a1 = acc[ai][bj][m][1] * rs;
                            u32x4 w; w.x = pk2(a0[0], a0[1]); w.y = pk2(a0[2], a0[3]); w.z = pk2(a1[0], a1[1]); w.w = pk2(a1[2], a1[3]);
                            *(u32x4*)(c.ZG + (size_t)r * 1536 + (pn - 3) * 256 + bj * 128 + cl) = w;
                        }
                    } else {
                        if (wc == 0 && fq < 2) { float* p = c.LR + (size_t)r * 16 + 8 * fq; *(f32x4*)p = acc[ai][0][m][0] * rs; *(f32x4*)(p + 4) = acc[ai][0][m][1] * rs; }
                    }
                }
            }
    }
};

template <int D, int NKT, bool HAS_SINK, bool NOSCALE = false, bool NOMASK = false>
DI void attn16(const bf16x8 (&qf)[D / 32], LAS unsigned char* Kl, int kpitch, LAS unsigned char* Vt, int vpitch, int key0, int jlo, int jhi,
               float scale, float sink, bf16_t* orow, bool wr_ok, int fr, int fq) {
    f32x4 s[NKT];
#pragma unroll
    for (int t = 0; t < NKT; ++t) {
        s[t] = (f32x4){0.f, 0.f, 0.f, 0.f};
#pragma unroll
        for (int ks = 0; ks < D / 32; ++ks) { const bf16x8 kf = *(const LAS bf16x8*)(Kl + (key0 + 16 * t + fr) * kpitch + (32 * ks + 8 * fq) * 2); s[t] = MFMA16(kf, qf[ks], s[t]); }
    }
    float m = -INFINITY;
    const unsigned jrel = (unsigned)(jlo - key0 - 4 * fq), span = (unsigned)(jhi - jlo);
#pragma unroll
    for (int t = 0; t < NKT; ++t)
#pragma unroll
        for (int r = 0; r < 4; ++r) { const unsigned dj = (unsigned)(16 * t + r) - jrel; const float sv = NOSCALE ? s[t][r] : s[t][r] * scale; const float v = (NOMASK || dj <= span) ? sv : -INFINITY; s[t][r] = v; m = fmaxf(m, v); }
    m = fmaxf(m, __shfl_xor(m, 16)); m = fmaxf(m, __shfl_xor(m, 32));
    const float sk = NOSCALE ? sink * 1.4426950408889634f : sink;
    if (HAS_SINK) m = fmaxf(m, sk);
    if (m == -INFINITY) m = 0.f;
    float sum = 0.f;
#pragma unroll
    for (int t = 0; t < NKT; ++t)
#pragma unroll
        for (int r = 0; r < 4; ++r) { const float e = NOSCALE ? __builtin_amdgcn_exp2f(s[t][r] - m) : __expf(s[t][r] - m); s[t][r] = e; sum += e; }
    sum += __shfl_xor(sum, 16); sum += __shfl_xor(sum, 32);
    if (HAS_SINK) sum += NOSCALE ? __builtin_amdgcn_exp2f(sk - m) : __expf(sk - m);
    const float inv = sum > 0.f ? __builtin_amdgcn_rcpf(sum) : 0.f;
    f32x4 o[D / 16];
#pragma unroll
    for (int dt = 0; dt < D / 16; ++dt) o[dt] = (f32x4){0.f, 0.f, 0.f, 0.f};
#pragma unroll
    for (int kk = 0; kk < NKT / 2; ++kk) {
        u32x4 pw; pw.x = pk2(s[2 * kk][0], s[2 * kk][1]); pw.y = pk2(s[2 * kk][2], s[2 * kk][3]);
        pw.z = pk2(s[2 * kk + 1][0], s[2 * kk + 1][1]); pw.w = pk2(s[2 * kk + 1][2], s[2 * kk + 1][3]);
        const bf16x8 pf = __builtin_bit_cast(bf16x8, pw);
#pragma unroll
        for (int dt = 0; dt < D / 16; ++dt) {
            const LAS unsigned char* vp = Vt + (key0 + 32 * kk + 4 * fq + (fr >> 2)) * vpitch + 32 * dt + 8 * (fr & 3);
            const u32x2 lo = __builtin_bit_cast(u32x2, __builtin_amdgcn_ds_read_tr16_b64_v4i16((LAS v4i16_t*)vp));
            const u32x2 hi = __builtin_bit_cast(u32x2, __builtin_amdgcn_ds_read_tr16_b64_v4i16((LAS v4i16_t*)(vp + 16 * vpitch)));
            const bf16x8 vf = __builtin_bit_cast(bf16x8, (u32x4){lo.x, lo.y, hi.x, hi.y});
            o[dt] = MFMA16(vf, pf, o[dt]);
        }
    }
    if (wr_ok) {
#pragma unroll
        for (int dt = 0; dt < D / 16; ++dt) { u32x2 w; w.x = pk2(o[dt][0] * inv, o[dt][1] * inv); w.y = pk2(o[dt][2] * inv, o[dt][3] * inv); *(u32x2*)(orow + 16 * dt + 4 * fq) = w; }
    }
}

struct Params { const float* in[33]; float* out; unsigned char* ws; };

#define CAS __attribute__((address_space(4)))
struct Ctx {
    LAS unsigned char* lds; int tid, lane, wave, G, bx;
    const CAS Params* p; unsigned char* ws; float* out;
};

DI void thin_res_gemm(const Ctx& C, const bf16_t* A, const bf16_t* Bt, int K, float scale, float* rss_out, float* X) {
    const int fr = C.lane & 15, fq = C.lane >> 4;
    LAS float* part = (LAS float*)C.lds;
    bf16_t* XB = (bf16_t*)(C.ws + WS_XB);
    const int kw = K >> 3;
    for (int tile = C.bx; tile < 256; tile += C.G) {
        const int row0 = TP + (tile >> 4) * 32, n0 = (tile & 15) * 64;
        f32x4 acc[2][4];
#pragma unroll
        for (int mt = 0; mt < 2; ++mt)
#pragma unroll
            for (int nt = 0; nt < 4; ++nt) acc[mt][nt] = (f32x4){0.f, 0.f, 0.f, 0.f};
        const bf16_t* ap = A + (size_t)(row0 + fr) * K + C.wave * kw + 8 * fq;
        const bf16_t* bp = Bt + (size_t)(n0 + fr) * K + C.wave * kw + 8 * fq;
#pragma unroll 4
        for (int k = 0; k < kw; k += 32) {
            bf16x8 af[2], bfr[4];
#pragma unroll
            for (int mt = 0; mt < 2; ++mt) af[mt] = *(const bf16x8*)(ap + (size_t)(16 * mt) * K + k);
#pragma unroll
            for (int nt = 0; nt < 4; ++nt) bfr[nt] = *(const bf16x8*)(bp + (size_t)(16 * nt) * K + k);
#pragma unroll
            for (int mt = 0; mt < 2; ++mt)
#pragma unroll
                for (int nt = 0; nt < 4; ++nt) acc[mt][nt] = MFMA16(bfr[nt], af[mt], acc[mt][nt]);
        }
#pragma unroll
        for (int mt = 0; mt < 2; ++mt)
#pragma unroll
            for (int nt = 0; nt < 4; ++nt) *(LAS f32x4*)(part + ((C.wave * 32 + 16 * mt + fr) * 64 + 16 * nt + 4 * fq)) = acc[mt][nt];
        __syncthreads();
        {
            const int row = C.tid >> 4, c4 = C.tid & 15;
            f32x4 v = (f32x4){0.f, 0.f, 0.f, 0.f};
#pragma unroll
            for (int w = 0; w < 8; ++w) v = v + *(const LAS f32x4*)(part + ((w * 32 + row) * 64 + 4 * c4));
            bf16_t* xb = XB + (size_t)(row0 + row) * DM + n0 + 4 * c4;
            const u32x2 xo = *(const u32x2*)xb;
            f32x4 x = (f32x4){blo(xo.x), bhi(xo.x), blo(xo.y), bhi(xo.y)}; x = x + v * scale;
            if (X) *(f32x4*)(X + (size_t)(row0 + row) * DM + n0 + 4 * c4) = x;
            else {
                u32x2 w2; w2.x = pk2(x[0], x[1]); w2.y = pk2(x[2], x[3]); *(u32x2*)xb = w2;
                const float a0 = blo(w2.x), a1 = bhi(w2.x), a2 = blo(w2.y), a3 = bhi(w2.y);
                float ss = a0 * a0 + a1 * a1 + a2 * a2 + a3 * a3;
                ss += __shfl_xor(ss, 1); ss += __shfl_xor(ss, 2); ss += __shfl_xor(ss, 4); ss += __shfl_xor(ss, 8);
                if (c4 == 0) atomicAdd(rss_out + row0 + row, ss);
            }
        }
        __syncthreads();
    }
}

DI void p0_tile(const float* s0, const float* s1, const float* gain, int mode, int K, int Nsrc, bf16_t* dst, int tile, LAS float* tl, int tid) {
    const int nkt = K >> 6; const int ntile = tile / nkt, kt = tile - ntile * nkt; const int n0 = ntile * 256, k0 = kt * 64;
    const int nn = tid & 255, kk0 = tid >> 8;
    const int n = n0 + nn; const float* src = s0; int col = n;
    if (mode == 1) { const int pn = n >> 8, bj = (n >> 7) & 1, cc = n & 127; src = bj ? s1 : s0; col = pn * 128 + cc; }
    else if (mode == 2) {
        const int pn = n >> 8, rem = n & 255, bj = rem >> 7, wc = (rem >> 5) & 3, j = rem & 31;
        if (pn < 2) col = (4 * pn + wc) * 64 + 32 * bj + j;
        else if (pn == 2) col = (wc < 2) ? (512 + wc * 64 + 32 * bj + j) : (640 + (wc - 2) * 64 + 32 * bj + j);
        else if (pn < 9) col = n;
        else col = (rem < 16) ? (2304 + rem) : -1;
    } else if (mode == 3) { if (n >= 512) { src = s1; col = n - 512; } }
    const float* sp = src + (size_t)(k0 + kk0) * Nsrc + (col >= 0 ? col : 0);
    float v[32];
#pragma unroll
    for (int i = 0; i < 32; ++i) v[i] = (col >= 0) ? sp[(size_t)(2 * i) * Nsrc] : 0.f;
    if (gain) {
#pragma unroll
        for (int i = 0; i < 32; ++i) v[i] *= gain[k0 + kk0 + 2 * i];
    }
#pragma unroll
    for (int i = 0; i < 32; ++i) tl[(kk0 + 2 * i) * 257 + nn] = v[i];
    __syncthreads();
#pragma unroll
    for (int j = 0; j < 4; ++j) { const int ch = tid + 512 * j; const int n2 = ch >> 3, ks = ch & 7; const LAS float* s = tl + (8 * ks) * 257 + n2;
      u32x4 o; o.x = pk2(s[0], s[257]); o.y = pk2(s[2 * 257], s[3 * 257]); o.z = pk2(s[4 * 257], s[5 * 257]); o.w = pk2(s[6 * 257], s[7 * 257]);
      *(u32x4*)(dst + (size_t)(n0 + n2) * K + k0 + 8 * ks) = o; }
    __syncthreads();
}

constexpr int TPL = 1408, T_W1 = 0, T_WD1 = 352, T_WKV = 1344;
DI void p0_dispatch(const Ctx& C, int l, int r) {
    const CAS Params& P = *C.p; unsigned char* ws = C.ws;
    unsigned char* wl = ws + WS_WL + (size_t)l * WL_SIZE;
    const float* s0; const float* s1 = nullptr; const float* gain = nullptr; int mode = 0, K = 1024, Nsrc; bf16_t* dst;
    if (r < 352) { s0 = P.in[9] + (size_t)l * 1024 * FF; s1 = P.in[10] + (size_t)l * 1024 * FF; gain = P.in[8] + l * 1024; mode = 1; Nsrc = FF; dst = (bf16_t*)(wl + WL_W1); }
    else if (r < 528) { r -= 352; s0 = P.in[11] + (size_t)l * FF * 1024; K = FF; Nsrc = 1024; dst = (bf16_t*)(wl + WL_WD1); }
    else if (r < 688) { r -= 528; s0 = P.in[13] + (size_t)l * 1024 * 2320; gain = P.in[12] + l * 1024; mode = 2; Nsrc = 2320; dst = (bf16_t*)(wl + WL_WIN); }
    else if (r < 752) { r -= 688; s0 = P.in[20] + (size_t)l * 1024 * 1024; Nsrc = 1024; dst = (bf16_t*)(wl + WL_WOUT); }
    else if (r < 784) { r -= 752; s0 = P.in[23] + (size_t)l * 1024 * 512; gain = P.in[21] + l * 1024; Nsrc = 512; dst = (bf16_t*)(wl + WL_WQ); }
    else if (r < 816) { r -= 784; s0 = P.in[28] + (size_t)l * 512 * 1024; K = 512; Nsrc = 1024; dst = (bf16_t*)(wl + WL_WO); }
    else if (r < 1168) { r -= 816; s0 = P.in[30] + (size_t)l * 1024 * FF; s1 = P.in[31] + (size_t)l * 1024 * FF; gain = P.in[29] + l * 1024; mode = 1; Nsrc = FF; dst = (bf16_t*)(wl + WL_W2); }
    else if (r < 1344) { r -= 1168; s0 = P.in[32] + (size_t)l * FF * 1024; K = FF; Nsrc = 1024; dst = (bf16_t*)(wl + WL_WD2); }
    else { r -= 1344; s0 = P.in[24] + (size_t)l * 1024 * 512; s1 = P.in[25] + (size_t)l * 1024 * 512; gain = P.in[22] + l * 1024; mode = 3; Nsrc = 512; dst = (bf16_t*)(ws + WS_WKV) + (size_t)l * 1024 * 1024; }
    p0_tile(s0, s1, gain, mode, K, Nsrc, dst, r, (LAS float*)C.lds, C.tid);
}
DI void convert_in_slack(const Ctx& C, int l, int lo, int hi, int nun) {
    const int rem = nun % C.G; const int first = rem ? rem : 0, cnt = C.G - first;
    if (C.bx < first) return;
    for (int t = lo + (C.bx - first); t < hi; t += cnt) p0_dispatch(C, l, t);
}

DI void p0_prologue(const Ctx& C) {
    const CAS Params& P = *C.p; unsigned char* ws = C.ws;
    for (int it = C.bx; it < 352 + 128; it += C.G) {
        if (it < 352) p0_dispatch(C, 0, it); else if (it < 416) p0_dispatch(C, 0, T_WKV + it - 352); else p0_dispatch(C, 1, T_WKV + it - 416);
    }
    const int gw = C.bx * 8 + C.wave, NGW = C.G * 8;
    float* RSS = (float*)(ws + WS_RSS);
    for (int r0 = gw; r0 < T + 1024; r0 += 2 * NGW) {
        const float* src[2]; float* df[2]; bf16_t* db[2]; float* rs[2]; f32x4 v[2][4];
#pragma unroll
        for (int q = 0; q < 2; ++q) {
            int r = r0 + q * NGW; if (r >= T + 1024) r = r0;
            if (r < T) { src[q] = (r < TP ? P.in[0] + (size_t)r * 1024 : P.in[1] + (size_t)(r - TP) * 1024); df[q] = nullptr; db[q] = (bf16_t*)(ws + WS_XB) + (size_t)r * 1024; rs[q] = RSS + r; }
            else { src[q] = P.in[7] + (size_t)(r - T) * 1024; df[q] = nullptr; db[q] = (bf16_t*)(ws + WS_MEMB) + (size_t)(r - T) * 1024; rs[q] = (float*)(ws + WS_RSSM) + (r - T); }
#pragma unroll
            for (int j = 0; j < 4; ++j) v[q][j] = *(const f32x4*)(src[q] + 256 * j + 4 * C.lane);
        }
#pragma unroll
        for (int q = 0; q < 2; ++q) {
            float ss = 0.f;
#pragma unroll
            for (int j = 0; j < 4; ++j) {
                const f32x4 x = v[q][j];
                ss += x[0] * x[0] + x[1] * x[1] + x[2] * x[2] + x[3] * x[3];
                if (df[q]) *(f32x4*)(df[q] + 256 * j + 4 * C.lane) = x;
                u32x2 w; w.x = pk2(x[0], x[1]); w.y = pk2(x[2], x[3]); *(u32x2*)(db[q] + 256 * j + 4 * C.lane) = w;
            }
#pragma unroll
            for (int o = 1; o < 64; o <<= 1) ss += __shfl_xor(ss, o);
            if (C.lane == 0) *rs[q] = ss;
        }
    }
    for (int i = C.bx * 512 + C.tid; i < 8 * T; i += C.G * 512) RSS[T + i] = 0.f;
    float2* rope = (float2*)(ws + WS_ROPE);
    for (int i = C.bx * 512 + C.tid; i < 4100 * 32; i += C.G * 512) {
        const int pidx = i >> 5, f = i & 31; const int pos = pidx < 4096 ? pidx : 16384 + (pidx - 4096);
        const float inv = powf(10000.f, -(float)f * (1.f / 32.f));
        const float ang = (float)pos * inv;
        const double a = (double)ang; const double nrev = rint(a * 0.15915494309189535); const float rr = (float)(a - nrev * 6.283185307179586);
        rope[i] = make_float2(cosf(rr), sinf(rr));
    }
}

DI void swa_prompt_unit(const Ctx& C, int l, int unit) {
    unsigned char* ws = C.ws;
    const int b = unit >> 6, n = (unit >> 1) & 31, kvh = unit & 1;
    const bf16_t* QS = (const bf16_t*)(ws + WS_QS); const bf16_t* KS = (const bf16_t*)(ws + WS_KS); const bf16_t* VS = (const bf16_t*)(ws + WS_VS); bf16_t* MIX = (bf16_t*)(ws + WS_MIX);
    LAS unsigned char* Kl = C.lds; LAS unsigned char* Vt = C.lds + 256 * 144;
    constexpr int KP = 144, VP = 144;
#pragma unroll
    for (int i = 0; i < 4; ++i) {
        const int key = (C.tid >> 3) + 64 * i, c8 = C.tid & 7; const int pos = (n - 1) * 128 + key;
        u32x4 kv = (u32x4){0u, 0u, 0u, 0u}, vv = kv;
        if (pos >= 0) { const size_t row = (size_t)b * SEQ + pos; kv = *(const u32x4*)(KS + row * 128 + kvh * 64 + 8 * c8); vv = *(const u32x4*)(VS + row * 128 + kvh * 64 + 8 * c8); }
        *(LAS u32x4*)(Kl + key * KP + c8 * 16) = kv; *(LAS u32x4*)(Vt + key * VP + c8 * 16) = vv;
    }
    __syncthreads();
    const int fr = C.lane & 15, fq = C.lane >> 4; const int g = C.wave >> 1, qh = C.wave & 1; const int head = kvh * 4 + g;
    const float sink = C.p->in[16][l * 8 + head];
    for (int grp = 0; grp < 4; ++grp) {
        const int i = 64 * qh + 16 * grp + fr; const size_t row = (size_t)b * SEQ + n * 128 + i;
        bf16x8 qf[2];
#pragma unroll
        for (int ks = 0; ks < 2; ++ks) qf[ks] = *(const bf16x8*)(QS + row * 512 + head * 64 + 32 * ks + 8 * fq);
        const int jlo = max(i + 1, n == 0 ? 128 : 0), jhi = i + 128;
        attn16<64, 12, true, true>(qf, Kl, KP, Vt, VP, 64 * qh, jlo, jhi, 0.125f, sink, MIX + row * 1024 + head * 64, true, fr, fq);
    }
    __syncthreads();
}

DI void swa_decode_unit(const Ctx& C, int l, int unit) {
    unsigned char* ws = C.ws; const CAS Params& P = *C.p;
    const int b = unit >> 1, kvh = unit & 1;
    const bf16_t* QS = (const bf16_t*)(ws + WS_QS); const bf16_t* KS = (const bf16_t*)(ws + WS_KS); const bf16_t* VS = (const bf16_t*)(ws + WS_VS); bf16_t* MIX = (bf16_t*)(ws + WS_MIX);
    constexpr int KP = 144, VP = 144;
    LAS unsigned char* Kl = C.lds; LAS unsigned char* Vt = C.lds + 160 * KP;
    for (int i = C.tid; i < (160 * KP + 160 * VP) / 16; i += 512) *(LAS u32x4*)(C.lds + i * 16) = (u32x4){0u, 0u, 0u, 0u};
    __syncthreads();
    const float* ck = P.in[2] + ((size_t)(l * 128 + b) * 128) * 128 + kvh * 64; const float* cv = P.in[3] + ((size_t)(l * 128 + b) * 128) * 128 + kvh * 64;
    float* ok = C.out + O_KS + ((size_t)(l * 128 + b) * 128) * 128 + kvh * 64; float* ov = C.out + O_VS + ((size_t)(l * 128 + b) * 128) * 128 + kvh * 64;
#pragma unroll
    for (int i = 0; i < 4; ++i) {
        const int key = (C.tid >> 4) + 32 * i, c16 = C.tid & 15;
        const f32x4 kv = *(const f32x4*)(ck + (size_t)key * 128 + 4 * c16), vv = *(const f32x4*)(cv + (size_t)key * 128 + 4 * c16);
        u32x2 w; w.x = pk2(kv[0], kv[1]); w.y = pk2(kv[2], kv[3]); *(LAS u32x2*)(Kl + key * KP + c16 * 8) = w;
        u32x2 wv; wv.x = pk2(vv[0], vv[1]); wv.y = pk2(vv[2], vv[3]); *(LAS u32x2*)(Vt + key * VP + c16 * 8) = wv;
        if (key >= 4) { *(f32x4*)(ok + (size_t)(key - 4) * 128 + 4 * c16) = kv; *(f32x4*)(ov + (size_t)(key - 4) * 128 + 4 * c16) = vv; }
    }
    if (C.tid < 32) {
        const int tt = C.tid >> 3, c8 = C.tid & 7; const size_t row = (size_t)TP + b * 4 + tt;
        const u32x4 kv = *(const u32x4*)(KS + row * 128 + kvh * 64 + 8 * c8), vv = *(const u32x4*)(VS + row * 128 + kvh * 64 + 8 * c8);
        *(LAS u32x4*)(Kl + (128 + tt) * KP + c8 * 16) = kv; *(LAS u32x4*)(Vt + (128 + tt) * VP + c8 * 16) = vv;
    }
    __syncthreads();
    if (C.wave == 0) {
        const int fr = C.lane & 15, fq = C.lane >> 4; const int g = fr >> 2, tt = fr & 3; const int head = kvh * 4 + g; const size_t row = (size_t)TP + b * 4 + tt;
        bf16x8 qf[2];
#pragma unroll
        for (int ks = 0; ks < 2; ++ks) qf[ks] = *(const bf16x8*)(QS + row * 512 + head * 64 + 32 * ks + 8 * fq);
        const float sink = P.in[16][l * 8 + head];
        attn16<64, 10, true, true>(qf, Kl, KP, Vt, VP, 0, tt + 1, tt + 128, 0.125f, sink, MIX + row * 1024 + head * 64, true, fr, fq);
    }
    __syncthreads();
}

DI void xattn_unit(const Ctx& C, int l, int unit) {
    unsigned char* ws = C.ws; const CAS Params& P = *C.p;
    constexpr int KP = 272, VP = 288;
    LAS unsigned char* Kl = C.lds; LAS unsigned char* Vt = C.lds + 256 * KP;
    const bool prompt = unit < 128;
    int b, h, qb = 0;
    if (prompt) { b = unit >> 5; h = (unit >> 3) & 3; qb = (unit & 7) * 2; } else { const int u = unit - 128; b = u >> 2; h = u & 3; }
    const float* ksrc; const float* vsrc; size_t kpitch;
    if (prompt) { ksrc = (const float*)(ws + WS_MKV) + (size_t)(b * 256) * 2048 + l * 1024 + h * 128; vsrc = ksrc + 512; kpitch = 2048; }
    else { ksrc = P.in[5] + ((size_t)(l * 128 + b) * 256) * 512 + h * 128; vsrc = P.in[6] + ((size_t)(l * 128 + b) * 256) * 512 + h * 128; kpitch = 512; }
    const int c4 = C.tid & 31;
    const f32x4 gk = *(const f32x4*)(P.in[27] + l * 128 + 4 * c4);
    const bool wout = prompt && qb == 0;
    float* omk = C.out + O_MKP + ((size_t)(l * 4 + b) * 256) * 512 + h * 128; float* omv = C.out + O_MVP + ((size_t)(l * 4 + b) * 256) * 512 + h * 128;
#pragma unroll 4
    for (int i = 0; i < 16; ++i) {
        const int key = (C.tid >> 5) + 16 * i;
        f32x4 kv = *(const f32x4*)(ksrc + (size_t)key * kpitch + 4 * c4); const f32x4 vv = *(const f32x4*)(vsrc + (size_t)key * kpitch + 4 * c4);
        if (prompt) {
            float ss = kv[0] * kv[0] + kv[1] * kv[1] + kv[2] * kv[2] + kv[3] * kv[3];
#pragma unroll
            for (int o = 1; o < 32; o <<= 1) ss += __shfl_xor(ss, o);
            const float rq = rsqrtf(ss * (1.f / 128.f) + EPS);
            kv = kv * rq * gk;
            if (wout) { *(f32x4*)(omk + (size_t)key * 512 + 4 * c4) = kv; *(f32x4*)(omv + (size_t)key * 512 + 4 * c4) = vv; }
        }
        u32x2 w; w.x = pk2(kv[0], kv[1]); w.y = pk2(kv[2], kv[3]); *(LAS u32x2*)(Kl + key * KP + c4 * 8) = w;
        u32x2 wv; wv.x = pk2(vv[0], vv[1]); wv.y = pk2(vv[2], vv[3]); *(LAS u32x2*)(Vt + key * VP + c4 * 8) = wv;
    }
    __syncthreads();
    const bf16_t* QX = (const bf16_t*)(ws + WS_QX); bf16_t* OX = (bf16_t*)(ws + WS_OX);
    const int fr = C.lane & 15, fq = C.lane >> 4;
    const int ngrp = prompt ? 4 : (C.wave == 0 ? 1 : 0);
    for (int grp = 0; grp < ngrp; ++grp) {
        const size_t row = prompt ? ((size_t)b * SEQ + (qb + (grp >> 1)) * 256 + 32 * C.wave + 16 * (grp & 1) + fr) : ((size_t)TP + b * 4 + (fr & 3));
        float qv[32]; float ss = 0.f;
#pragma unroll
        for (int ks = 0; ks < 4; ++ks) {
            const u32x4 w = *(const u32x4*)(QX + row * 512 + h * 128 + 32 * ks + 8 * fq);
#pragma unroll
            for (int e = 0; e < 4; ++e) { qv[8 * ks + 2 * e] = blo(w[e]); qv[8 * ks + 2 * e + 1] = bhi(w[e]); }
        }
#pragma unroll
        for (int e = 0; e < 32; ++e) ss += qv[e] * qv[e];
        ss += __shfl_xor(ss, 16); ss += __shfl_xor(ss, 32);
        const float rq = rsqrtf(ss * (1.f / 128.f) + EPS) * 0.12751743082459868f;
        bf16x8 qf[4];
#pragma unroll
        for (int ks = 0; ks < 4; ++ks) {
            const f32x4 g0 = *(const f32x4*)(P.in[26] + l * 128 + 32 * ks + 8 * fq), g1 = *(const f32x4*)(P.in[26] + l * 128 + 32 * ks + 8 * fq + 4);
            u32x4 w; w.x = pk2(qv[8 * ks] * rq * g0[0], qv[8 * ks + 1] * rq * g0[1]); w.y = pk2(qv[8 * ks + 2] * rq * g0[2], qv[8 * ks + 3] * rq * g0[3]);
            w.z = pk2(qv[8 * ks + 4] * rq * g1[0], qv[8 * ks + 5] * rq * g1[1]); w.w = pk2(qv[8 * ks + 6] * rq * g1[2], qv[8 * ks + 7] * rq * g1[3]);
            qf[ks] = __builtin_bit_cast(bf16x8, w);
        }
        attn16<128, 16, false, true, true>(qf, Kl, KP, Vt, VP, 0, 0, 255, 1.f, 0.f, OX + row * 512 + h * 128, prompt || fr < 4, fr, fq);
    }
    __syncthreads();
}

DI void gla_a_phase(const Ctx& C, int l) {
    unsigned char* ws = C.ws; const CAS Params& P = *C.p;
    const bf16_t* ZG = (const bf16_t*)(ws + WS_ZG); const float* LR = (const float*)(ws + WS_LR);
    bf16_t* QT = (bf16_t*)(ws + WS_BCUM); bf16_t* KT = QT + (size_t)TP * 256; float* ST = (float*)(ws + WS_ST); bf16_t* VT = (bf16_t*)(ws + WS_VT); float* DEC = (float*)(ws + WS_DEC);
    const int dk = C.tid & 63, seg = C.wave, tv = C.tid >> 3, dvs = C.tid & 7;
    int unit = C.bx; if (unit >= 1024) return;
    bf16_t kq[16]; u32x4 vw[2];
#define GLA_A_LOAD(u) do { const int bh_ = (u) >> 6, c_ = (u) & 63, b_ = bh_ >> 2, h_ = bh_ & 3; const size_t t0_ = (size_t)b_ * SEQ + c_ * 64; \
        _Pragma("unroll") for (int i = 0; i < 8; ++i) { kq[i] = ZG[(t0_ + 8 * seg + i) * 1536 + 256 + h_ * 64 + dk]; kq[8 + i] = ZG[(t0_ + 8 * seg + i) * 1536 + h_ * 64 + dk]; } \
        _Pragma("unroll") for (int x = 0; x < 2; ++x) vw[x] = *(const u32x4*)(ZG + (t0_ + tv) * 1536 + 512 + h_ * 128 + 16 * dvs + 8 * x); } while (0)
    GLA_A_LOAD(unit);
    int hcur = -1; float wg[16]; float bg = 0.f;
    for (int it = 0; unit < 1024; unit += C.G, ++it) {
        LAS unsigned char* lb = C.lds + (it & 1) * 32768;
        LAS float* segsum = (LAS float*)lb;
        LAS unsigned char* KdT = lb + 2048;
        LAS unsigned char* VtL = lb + 2048 + 64 * 144;
        const int bh = unit >> 6, c = unit & 63, b = bh >> 2, h = bh & 3; const size_t t0 = (size_t)b * SEQ + c * 64;
        if (h != hcur) { hcur = h;
#pragma unroll
            for (int r = 0; r < 16; ++r) wg[r] = P.in[17][(size_t)(l * 16 + r) * 256 + h * 64 + dk];
            bg = P.in[18][l * 256 + h * 64 + dk]; }
        float p[8];
        {
            float run = 0.f;
#pragma unroll
            for (int i = 0; i < 8; ++i) {
                const float* lr = LR + (t0 + 8 * seg + i) * 16; float x = bg;
#pragma unroll
                for (int r = 0; r < 16; ++r) x += lr[r] * wg[r];
                run += logsig(x) * (1.f / 16.f); p[i] = run;
            }
            segsum[seg * 64 + dk] = run;
        }
#pragma unroll
        for (int x = 0; x < 2; ++x) *(LAS u32x4*)(VtL + tv * 288 + (16 * dvs + 8 * x) * 2) = vw[x];
        __syncthreads();
        {
            float off = 0.f, tot = 0.f;
#pragma unroll
            for (int s2 = 0; s2 < 8; ++s2) { const float v = segsum[s2 * 64 + dk]; tot += v; if (s2 < seg) off += v; }
#pragma unroll
            for (int i = 0; i < 8; ++i) {
                const int t = 8 * seg + i; const float bv = off + p[i];
                const float kraw = bf2f(kq[i]), qraw = bf2f(kq[8 + i]);
                const float kd = kraw * __expf(tot - bv);
                const unsigned qk = pk2(qraw * 0.125f * __expf(bv), kraw * __expf(-bv));
                QT[(t0 + t) * 256 + h * 64 + dk] = (bf16_t)(qk & 0xffffu); KT[(t0 + t) * 256 + h * 64 + dk] = (bf16_t)(qk >> 16);
                *(LAS unsigned short*)(KdT + t * 144 + dk * 2) = (unsigned short)(pk2(kd, 0.f) & 0xffffu);
            }
            if (seg == 0) DEC[unit * 64 + dk] = __expf(tot);
        }
        if (unit + C.G < 1024) GLA_A_LOAD(unit + C.G);
        __syncthreads();
        {
            const int fr = C.lane & 15, fq = C.lane >> 4, w = C.wave;
            bf16x8 vt[2];
#pragma unroll
            for (int ks = 0; ks < 2; ++ks) {
                const LAS unsigned char* vp = VtL + (32 * ks + 8 * fq + (fr >> 2)) * 288 + 32 * w + 8 * (fr & 3);
                const u32x2 lo = __builtin_bit_cast(u32x2, __builtin_amdgcn_ds_read_tr16_b64_v4i16((LAS v4i16_t*)vp));
                const u32x2 hi = __builtin_bit_cast(u32x2, __builtin_amdgcn_ds_read_tr16_b64_v4i16((LAS v4i16_t*)(vp + 4 * 288)));
                vt[ks] = __builtin_bit_cast(bf16x8, (u32x4){lo.x, lo.y, hi.x, hi.y});
            }
#pragma unroll
            for (int dkt = 0; dkt < 4; ++dkt) {
                f32x4 acc = (f32x4){0.f, 0.f, 0.f, 0.f};
#pragma unroll
                for (int ks = 0; ks < 2; ++ks) {
                    const LAS unsigned char* kp = KdT + (32 * ks + 8 * fq + (fr >> 2)) * 144 + 32 * dkt + 8 * (fr & 3);
                    const u32x2 lo = __builtin_bit_cast(u32x2, __builtin_amdgcn_ds_read_tr16_b64_v4i16((LAS v4i16_t*)kp));
                    const u32x2 hi = __builtin_bit_cast(u32x2, __builtin_amdgcn_ds_read_tr16_b64_v4i16((LAS v4i16_t*)(kp + 4 * 144)));
                    const bf16x8 kd = __builtin_bit_cast(bf16x8, (u32x4){lo.x, lo.y, hi.x, hi.y});
                    acc = MFMA16(kd, vt[ks], acc);
                }
                *(f32x4*)(ST + ((size_t)unit * 128 + 16 * w + fr) * 64 + 16 * dkt + 4 * fq) = acc;
            }
        }
    }
    __syncthreads();
#undef GLA_A_LOAD
}

DI void gla_scan(const Ctx& C, int l) {
    unsigned char* ws = C.ws;
    const float* ST = (const float*)(ws + WS_ST); const float* DEC = (const float*)(ws + WS_DEC); bf16_t* STB = (bf16_t*)(ws + WS_STB);
    for (int e = C.bx * 512 + C.tid; e < 16 * 8192; e += C.G * 512) {
        const int bh = e >> 13, idx = e & 8191, dk = idx & 63, dv = idx >> 6;
        float S = 0.f;
        for (int c0 = 0; c0 < 64; c0 += 8) {
            float d[8], dc[8];
#pragma unroll
            for (int i = 0; i < 8; ++i) { const int unit = bh * 64 + c0 + i; d[i] = ST[(size_t)unit * 8192 + idx]; dc[i] = DEC[unit * 64 + dk]; }
#pragma unroll
            for (int i = 0; i < 8; ++i) { const int unit = bh * 64 + c0 + i; STB[(size_t)unit * 8192 + idx] = (bf16_t)(pk2(S, 0.f) & 0xffffu); S = dc[i] * S + d[i]; }
        }
        C.out[O_GP + ((size_t)(l * 16 + bh)) * 8192 + dk * 128 + dv] = S;
    }
}

DI void gla_c_wave(const Ctx& C, int l, int unit, int qt) {
    unsigned char* ws = C.ws; const CAS Params& P = *C.p;
    const int bh = unit >> 6, c = unit & 63, b = bh >> 2, h = bh & 3; const size_t t0 = (size_t)b * SEQ + c * 64;
    const bf16_t* ZG = (const bf16_t*)(ws + WS_ZG); const bf16_t* QT = (const bf16_t*)(ws + WS_BCUM); const bf16_t* KT = QT + (size_t)TP * 256; const bf16_t* STB = (const bf16_t*)(ws + WS_STB); const bf16_t* VT = (const bf16_t*)(ws + WS_VT);
    bf16_t* MIX = (bf16_t*)(ws + WS_MIX);
    const int fr = C.lane & 15, fq = C.lane >> 4;
    const size_t rq = t0 + 16 * qt + fr;
    bf16x8 qf[2];
#pragma unroll
    for (int ks = 0; ks < 2; ++ks) qf[ks] = *(const bf16x8*)(QT + rq * 256 + h * 64 + 32 * ks + 8 * fq);
    f32x4 a[4];
#pragma unroll
    for (int kt = 0; kt < 4; ++kt) {
        a[kt] = (f32x4){0.f, 0.f, 0.f, 0.f};
        if (kt <= qt) {
            const size_t rk = t0 + 16 * kt + fr;
#pragma unroll
            for (int ks = 0; ks < 2; ++ks) {
                const bf16x8 kf = *(const bf16x8*)(KT + rk * 256 + h * 64 + 32 * ks + 8 * fq);
                a[kt] = MFMA16(kf, qf[ks], a[kt]);
            }
#pragma unroll
            for (int r = 0; r < 4; ++r) if (16 * kt + 4 * fq + r > 16 * qt + fr) a[kt][r] = 0.f;
        }
    }
    bf16x8 pf[2];
#pragma unroll
    for (int kk = 0; kk < 2; ++kk) { u32x4 w; w.x = pk2(a[2 * kk][0], a[2 * kk][1]); w.y = pk2(a[2 * kk][2], a[2 * kk][3]); w.z = pk2(a[2 * kk + 1][0], a[2 * kk + 1][1]); w.w = pk2(a[2 * kk + 1][2], a[2 * kk + 1][3]); pf[kk] = __builtin_bit_cast(bf16x8, w); }
    f32x4 o[8]; float ss = 0.f;
#pragma unroll
    for (int dt = 0; dt < 8; ++dt) {
        f32x4 acc = (f32x4){0.f, 0.f, 0.f, 0.f};
        const size_t vrow = ((size_t)unit * 128 + 16 * dt + fr) * 64;
#pragma unroll
        for (int kk = 0; kk < 2; ++kk) {
            if (2 * kk <= qt) {
                const bf16_t* vp = VT + vrow + 32 * kk + 4 * fq; const u32x2 lo = *(const u32x2*)vp, hi = *(const u32x2*)(vp + 16);
                acc = MFMA16(__builtin_bit_cast(bf16x8, (u32x4){lo.x, lo.y, hi.x, hi.y}), pf[kk], acc);
            }
        }
#pragma unroll
        for (int ks = 0; ks < 2; ++ks) {
            const bf16x8 sf = *(const bf16x8*)(STB + vrow + 32 * ks + 8 * fq);
            acc = MFMA16(sf, qf[ks], acc);
        }
        o[dt] = acc; ss += acc[0] * acc[0] + acc[1] * acc[1] + acc[2] * acc[2] + acc[3] * acc[3];
    }
    ss += __shfl_xor(ss, 16); ss += __shfl_xor(ss, 32);
    const float rn = rsqrtf(ss * (1.f / 128.f) + EPS);
#pragma unroll
    for (int dt = 0; dt < 8; ++dt) {
        const f32x4 gn = *(const f32x4*)(P.in[19] + l * 128 + 16 * dt + 4 * fq);
        const u32x2 gw = *(const u32x2*)(ZG + rq * 1536 + 1024 + h * 128 + 16 * dt + 4 * fq);
        const float g0 = blo(gw.x), g1 = bhi(gw.x), g2 = blo(gw.y), g3 = bhi(gw.y);
        u32x2 w; w.x = pk2(o[dt][0] * rn * gn[0] * silu(g0), o[dt][1] * rn * gn[1] * silu(g1)); w.y = pk2(o[dt][2] * rn * gn[2] * silu(g2), o[dt][3] * rn * gn[3] * silu(g3));
        *(u32x2*)(MIX + rq * 1024 + 512 + h * 128 + 16 * dt + 4 * fq) = w;
    }
}

DI void gla_c_phase(const Ctx& C, int l) {
    unsigned char* ws = C.ws; const CAS Params& P = *C.p;
    const bf16_t* ZG = (const bf16_t*)(ws + WS_ZG); const bf16_t* QT = (const bf16_t*)(ws + WS_BCUM); const bf16_t* KT = QT + (size_t)TP * 256; const bf16_t* STB = (const bf16_t*)(ws + WS_STB); const bf16_t* VT = (const bf16_t*)(ws + WS_VT);
    bf16_t* MIX = (bf16_t*)(ws + WS_MIX);
    constexpr int PB = 144, U_BYTES = (64 + 128 + 128) * PB;
    const int fr = C.lane & 15, fq = C.lane >> 4, us = C.wave >> 2, qt = C.wave & 3;
    for (int pr = C.bx; pr < 512; pr += C.G) {
#pragma unroll
        for (int uu = 0; uu < 2; ++uu) {
            const int unit = 2 * pr + uu; const int bh = unit >> 6, c = unit & 63, b = bh >> 2, h = bh & 3; const size_t t0 = (size_t)b * SEQ + c * 64;
            LAS unsigned char* base = C.lds + uu * U_BYTES;
            { const int row = C.tid >> 3, c8 = C.tid & 7; *(LAS u32x4*)(base + row * PB + c8 * 16) = *(const u32x4*)(KT + (t0 + row) * 256 + h * 64 + 8 * c8); }
#pragma unroll
            for (int i = 0; i < 2; ++i) {
                const int row = (C.tid >> 3) + 64 * i, c8 = C.tid & 7;
                *(LAS u32x4*)(base + (64 + row) * PB + c8 * 16) = *(const u32x4*)(STB + ((size_t)unit * 128 + row) * 64 + 8 * c8);
                const int vr = (C.tid >> 4) + 32 * i, c16 = C.tid & 15;
                *(LAS u32x4*)(base + 192 * PB + vr * 288 + c16 * 16) = *(const u32x4*)(ZG + (t0 + vr) * 1536 + 512 + h * 128 + 8 * c16);
            }
        }
        const int unit = 2 * pr + us; const int bh = unit >> 6, c = unit & 63, b = bh >> 2, h = bh & 3; const size_t t0 = (size_t)b * SEQ + c * 64;
        const size_t rq = t0 + 16 * qt + fr;
        bf16x8 qf[2];
#pragma unroll
        for (int ks = 0; ks < 2; ++ks) qf[ks] = *(const bf16x8*)(QT + rq * 256 + h * 64 + 32 * ks + 8 * fq);
        __syncthreads();
        LAS unsigned char* Kl = C.lds + us * U_BYTES; LAS unsigned char* Sl = Kl + 64 * PB; LAS unsigned char* Vl = Kl + 192 * PB;
        f32x4 a[4];
#pragma unroll
        for (int kt = 0; kt < 4; ++kt) {
            a[kt] = (f32x4){0.f, 0.f, 0.f, 0.f};
            if (kt <= qt) {
#pragma unroll
                for (int ks = 0; ks < 2; ++ks) {
                    const bf16x8 kf = *(const LAS bf16x8*)(Kl + (16 * kt + fr) * PB + (32 * ks + 8 * fq) * 2);
                    a[kt] = MFMA16(kf, qf[ks], a[kt]);
                }
#pragma unroll
                for (int r = 0; r < 4; ++r) if (16 * kt + 4 * fq + r > 16 * qt + fr) a[kt][r] = 0.f;
            }
        }
        bf16x8 pf[2];
#pragma unroll
        for (int kk = 0; kk < 2; ++kk) { u32x4 w; w.x = pk2(a[2 * kk][0], a[2 * kk][1]); w.y = pk2(a[2 * kk][2], a[2 * kk][3]); w.z = pk2(a[2 * kk + 1][0], a[2 * kk + 1][1]); w.w = pk2(a[2 * kk + 1][2], a[2 * kk + 1][3]); pf[kk] = __builtin_bit_cast(bf16x8, w); }
        f32x4 o[8]; float ss = 0.f;
#pragma unroll
        for (int dt = 0; dt < 8; ++dt) {
            f32x4 acc = (f32x4){0.f, 0.f, 0.f, 0.f};
#pragma unroll
            for (int kk = 0; kk < 2; ++kk) {
                if (2 * kk <= qt) {
                    const LAS unsigned char* vp = Vl + (32 * kk + 4 * fq + (fr >> 2)) * 288 + 32 * dt + 8 * (fr & 3);
                    const u32x2 lo = __builtin_bit_cast(u32x2, __builtin_amdgcn_ds_read_tr16_b64_v4i16((LAS v4i16_t*)vp));
                    const u32x2 hi = __builtin_bit_cast(u32x2, __builtin_amdgcn_ds_read_tr16_b64_v4i16((LAS v4i16_t*)(vp + 16 * 288)));
                    acc = MFMA16(__builtin_bit_cast(bf16x8, (u32x4){lo.x, lo.y, hi.x, hi.y}), pf[kk], acc);
                }
            }
#pragma unroll
            for (int ks = 0; ks < 2; ++ks) {
                const bf16x8 sf = *(const LAS bf16x8*)(Sl + (16 * dt + fr) * PB + (32 * ks + 8 * fq) * 2);
                acc = MFMA16(sf, qf[ks], acc);
            }
            o[dt] = acc; ss += acc[0] * acc[0] + acc[1] * acc[1] + acc[2] * acc[2] + acc[3] * acc[3];
        }
        ss += __shfl_xor(ss, 16); ss += __shfl_xor(ss, 32);
        const float rn = rsqrtf(ss * (1.f / 128.f) + EPS);
#pragma unroll
        for (int dt = 0; dt < 8; ++dt) {
            const f32x4 gn = *(const f32x4*)(P.in[19] + l * 128 + 16 * dt + 4 * fq);
            const u32x2 gw = *(const u32x2*)(ZG + rq * 1536 + 1024 + h * 128 + 16 * dt + 4 * fq);
            const float g0 = blo(gw.x), g1 = bhi(gw.x), g2 = blo(gw.y), g3 = bhi(gw.y);
            u32x2 w; w.x = pk2(o[dt][0] * rn * gn[0] * silu(g0), o[dt][1] * rn * gn[1] * silu(g1)); w.y = pk2(o[dt][2] * rn * gn[2] * silu(g2), o[dt][3] * rn * gn[3] * silu(g3));
            *(u32x2*)(MIX + rq * 1024 + 512 + h * 128 + 16 * dt + 4 * fq) = w;
        }
        __syncthreads();
    }
}

DI void gla_decode_unit(const Ctx& C, int l, int unit) {
    unsigned char* ws = C.ws; const CAS Params& P = *C.p;
    const int b = unit >> 2, h = unit & 3; const size_t rb = (size_t)TP + b * 4;
    const bf16_t* ZG = (const bf16_t*)(ws + WS_ZG); const float* LR = (const float*)(ws + WS_LR); bf16_t* MIX = (bf16_t*)(ws + WS_MIX);
    LAS float* la = (LAS float*)C.lds;
    LAS float* qr = la + 256;
    LAS float* kr = qr + 256;
    LAS float* qe = kr + 256;
    LAS float* ke = qe + 256;
    LAS float* Am = ke + 256;
    LAS float* red = Am + 16;
    LAS float* opart = red + 8;
    if (C.tid < 256) {
        const int tt = C.tid >> 6, dk = C.tid & 63; float x = P.in[18][l * 256 + h * 64 + dk];
        const f32x4 l0 = *(const f32x4*)(LR + (rb + tt) * 16), l1 = *(const f32x4*)(LR + (rb + tt) * 16 + 4), l2 = *(const f32x4*)(LR + (rb + tt) * 16 + 8), l3 = *(const f32x4*)(LR + (rb + tt) * 16 + 12);
        const float* wg = P.in[17] + (size_t)(l * 16) * 256 + h * 64 + dk;
#pragma unroll
        for (int r = 0; r < 4; ++r) { x += l0[r] * wg[r * 256] + l1[r] * wg[(4 + r) * 256] + l2[r] * wg[(8 + r) * 256] + l3[r] * wg[(12 + r) * 256]; }
        la[tt * 64 + dk] = logsig(x) * (1.f / 16.f);
        qr[tt * 64 + dk] = bf2f(ZG[(rb + tt) * 1536 + h * 64 + dk]); kr[tt * 64 + dk] = bf2f(ZG[(rb + tt) * 1536 + 256 + h * 64 + dk]);
    }
    __syncthreads();
    if (C.tid < 64) { float run = 0.f;
#pragma unroll
        for (int tt = 0; tt < 4; ++tt) { run += la[tt * 64 + C.tid]; la[tt * 64 + C.tid] = run; } }
    __syncthreads();
    if (C.tid < 256) {
        const int tt = C.tid >> 6, dk = C.tid & 63; const float bt = la[tt * 64 + dk], b3 = la[3 * 64 + dk];
        qe[tt * 64 + dk] = 0.125f * qr[tt * 64 + dk] * __expf(bt); ke[tt * 64 + dk] = kr[tt * 64 + dk] * __expf(b3 - bt);
    } else if (C.tid < 272) {
        const int tt = (C.tid - 256) >> 2, s = (C.tid - 256) & 3; float sum = 0.f;
        if (s <= tt) for (int dk = 0; dk < 64; ++dk) sum += 0.125f * qr[tt * 64 + dk] * kr[s * 64 + dk] * __expf(la[tt * 64 + dk] - la[s * 64 + dk]);
        Am[C.tid - 256] = sum;
    }
    __syncthreads();
    {
        const int dv = C.tid & 127, dq = C.tid >> 7;
        float v[4], o[4] = {0.f, 0.f, 0.f, 0.f};
#pragma unroll
        for (int tt = 0; tt < 4; ++tt) v[tt] = bf2f(ZG[(rb + tt) * 1536 + 512 + h * 128 + dv]);
        const float* S0p = P.in[4] + ((size_t)(l * 128 + b) * 4 + h) * 8192 + (size_t)(16 * dq) * 128 + dv; float* Sn = C.out + O_GS + ((size_t)(l * 128 + b) * 4 + h) * 8192 + (size_t)(16 * dq) * 128 + dv;
        float S0[16];
#pragma unroll
        for (int i = 0; i < 16; ++i) S0[i] = S0p[i * 128];
#pragma unroll
        for (int i = 0; i < 16; ++i) {
            const int dk = 16 * dq + i;
            float sn = __expf(la[3 * 64 + dk]) * S0[i];
#pragma unroll
            for (int tt = 0; tt < 4; ++tt) { o[tt] += qe[tt * 64 + dk] * S0[i]; sn += ke[tt * 64 + dk] * v[tt]; }
            Sn[i * 128] = sn;
        }
#pragma unroll
        for (int tt = 0; tt < 4; ++tt) opart[(dq * 4 + tt) * 128 + dv] = o[tt];
    }
    __syncthreads();
    {
        const int tt = C.tid >> 7, dv = C.tid & 127;
        float o = opart[(0 * 4 + tt) * 128 + dv] + opart[(1 * 4 + tt) * 128 + dv] + opart[(2 * 4 + tt) * 128 + dv] + opart[(3 * 4 + tt) * 128 + dv];
        for (int s = 0; s <= tt; ++s) o += Am[tt * 4 + s] * bf2f(ZG[(rb + s) * 1536 + 512 + h * 128 + dv]);
        float ss = o * o;
#pragma unroll
        for (int of = 1; of < 64; of <<= 1) ss += __shfl_xor(ss, of);
        if (C.lane == 0) red[C.wave] = ss;
        __syncthreads();
        const float tot = red[2 * tt] + red[2 * tt + 1];
        const float rn = rsqrtf(tot * (1.f / 128.f) + EPS);
        const float gg = bf2f(ZG[(rb + tt) * 1536 + 1024 + h * 128 + dv]);
        const float val = o * rn * P.in[19][l * 128 + dv] * silu(gg);
        MIX[(rb + tt) * 1024 + 512 + h * 128 + dv] = (bf16_t)(pk2(val, 0.f) & 0xffffu);
    }
    __syncthreads();
}

__global__ void __launch_bounds__(512, 2) hymba_fwd(Params prm) {
    extern __shared__ __attribute__((aligned(16))) unsigned char smem[];
    cg::grid_group grid = cg::this_grid();
    Ctx C; C.lds = (LAS unsigned char*)smem; C.tid = threadIdx.x; C.lane = C.tid & 63; C.wave = __builtin_amdgcn_readfirstlane(C.tid >> 6);
    C.G = gridDim.x; C.bx = blockIdx.x; C.p = (const CAS Params*)__builtin_amdgcn_kernarg_segment_ptr(); C.ws = C.p->ws; C.out = C.p->out;
    (void)prm;

    unsigned* barw = (unsigned*)(C.ws + WS_BAR);
    if (C.bx == 0) for (int i = C.tid; i < XCD_BAR_WORDS; i += 512) barw[i] = 0u;
    if (C.tid < 4) ((LAS unsigned*)(C.lds + LDS_BYTES - 16))[C.tid] = 0u;
    grid.sync();
    XcdBarrier xbar = xcd_barrier_post(barw, (volatile LAS unsigned*)(C.lds + LDS_BYTES - 16));
    for (int rep = 0; rep < REP_P0; ++rep) p0_prologue(C);
    xcd_barrier(xbar);
    {   unsigned char* ws = C.ws;
        pg8::Gemm g{(const bf16_t*)(ws + WS_MEMB), (const bf16_t*)(ws + WS_WKV), 1024, 2048, 1024};
        const int n1 = (T / 256) * (5632 / 256);
        pg8::StaticOrder S; S.init(1024, 2048, C.G, (C.bx + C.G - (n1 % C.G)) % C.G);
        Epi<EK_MEM> E; E.c = EpiCtx{}; E.c.rss_in = (const float*)(ws + WS_RSSM); E.c.MKV = (float*)(ws + WS_MKV);
        pg8::gemm_phase(C.lds, C.tid, g, S, E);
    }
    int rep = 0;
    for (int ph = 0; ph < 24; ++ph) {
        { int t_ = threadIdx.x; asm volatile("" : "+v"(t_)); C.tid = t_; C.lane = t_ & 63; C.wave = __builtin_amdgcn_readfirstlane(t_ >> 6); }
        asm volatile("" : "+s"(C.ws), "+s"(C.out), "+s"(C.p));
        unsigned char* ws = C.ws; float* RSS = (float*)(ws + WS_RSS);
        const int l = ph / 12, k = ph - 12 * l;
        unsigned char* wl = ws + WS_WL + (size_t)l * WL_SIZE;
        EpiCtx ec{}; ec.l = l;
        if (k == 0 || k == 10) {
            pg8::Gemm g{(const bf16_t*)(ws + WS_XB), (const bf16_t*)(wl + (k == 0 ? WL_W1 : WL_W2)), T, 5632, 1024};
            pg8::StaticOrder S; S.init(T, 5632, C.G, C.bx);
            ec.rss_in = RSS + (size_t)(4 * l + (k == 0 ? 0 : 3)) * T; ec.H = (bf16_t*)(ws + WS_H);
            Epi<EK_SWIGLU> E; E.c = ec; pg8::gemm_phase(C.lds, C.tid, g, S, E);
            if (ph == 0 && rep == 0) convert_in_slack(C, 0, T_WD1, 688, (T / 256) * 22 + 32);
            if (ph == 10 && rep == 0) convert_in_slack(C, 1, 704, T_WKV, (T / 256) * 22);
        } else if (k == 1 || k == 6 || k == 9 || k == 11) {
            const bf16_t* A; const bf16_t* B; int K; float sc; int ro;
            if (k == 1) { A = (const bf16_t*)(ws + WS_H); B = (const bf16_t*)(wl + WL_WD1); K = FF; sc = 0.5f; ro = 4 * l + 1; }
            else if (k == 6) { A = (const bf16_t*)(ws + WS_MIX); B = (const bf16_t*)(wl + WL_WOUT); K = 1024; sc = 1.f; ro = 4 * l + 2; }
            else if (k == 9) { A = (const bf16_t*)(ws + WS_OX); B = (const bf16_t*)(wl + WL_WO); K = 512; sc = 1.f; ro = 4 * l + 3; }
            else { A = (const bf16_t*)(ws + WS_H); B = (const bf16_t*)(wl + WL_WD2); K = FF; sc = 0.5f; ro = 4 * l + 4; }
            pg8::Gemm g{A, B, TP, 1024, K};
            pg8::StaticOrder S; S.init(TP, 1024, C.G, C.bx);
            ec.rss_out = RSS + (size_t)ro * T; ec.X = (ph == 23) ? C.out : nullptr; ec.XB = (bf16_t*)(ws + WS_XB); ec.scale = sc;
            Epi<EK_RES> E; E.c = ec; pg8::gemm_phase(C.lds, C.tid, g, S, E);
            thin_res_gemm(C, A, B, K, sc, RSS + (size_t)ro * T, (ph == 23) ? C.out : nullptr);
        } else if (k == 2) {
            pg8::Gemm g{(const bf16_t*)(ws + WS_XB), (const bf16_t*)(wl + WL_WIN), T, INWP, 1024};
            pg8::StaticOrder S; S.init(T, INWP, C.G, C.bx);
            ec.rss_in = RSS + (size_t)(4 * l + 1) * T; ec.QS = (bf16_t*)(ws + WS_QS); ec.KS = (bf16_t*)(ws + WS_KS); ec.VS = (bf16_t*)(ws + WS_VS); ec.ZG = (bf16_t*)(ws + WS_ZG);
            ec.LR = (float*)(ws + WS_LR); ec.rope = (const float2*)(ws + WS_ROPE); ec.gq = C.p->in[14] + l * 64; ec.gk = C.p->in[15] + l * 64;
            ec.okp = C.out + O_KP; ec.ovp = C.out + O_VP; ec.oks = C.out + O_KS; ec.ovs = C.out + O_VS;
            Epi<EK_WIN> E; E.c = ec; pg8::gemm_phase(C.lds, C.tid, g, S, E);
            if (ph == 2 && rep == 0) convert_in_slack(C, 0, 688, T_WKV, (T / 256) * 10);
        } else if (k == 3) {
            for (int u = C.bx; u < 256; u += C.G) swa_prompt_unit(C, l, u);
            gla_a_phase(C, l);
        } else if (k == 4) {
            gla_scan(C, l);
            for (int u = C.bx; u < 512; u += C.G) gla_decode_unit(C, l, u);
            for (int u = C.bx; u < 256; u += C.G) swa_decode_unit(C, l, u);
        } else if (k == 5) {
            gla_c_phase(C, l);
        } else if (k == 7) {
            pg8::Gemm g{(const bf16_t*)(ws + WS_XB), (const bf16_t*)(wl + WL_WQ), T, 512, 1024};
            pg8::StaticOrder S; S.init(T, 512, C.G, C.bx);
            ec.rss_in = RSS + (size_t)(4 * l + 2) * T; ec.QX = (bf16_t*)(ws + WS_QX);
            Epi<EK_XQ> E; E.c = ec; pg8::gemm_phase(C.lds, C.tid, g, S, E);
            if (ph == 7 && rep == 0) convert_in_slack(C, 1, 0, 704, (T / 256) * 2);
        } else {
            if (C.G == 256) {
                if (C.bx < 128) { xattn_unit(C, l, C.bx); xattn_unit(C, l, 128 + C.bx); }
                else for (int i = 0; i < 3; ++i) xattn_unit(C, l, 128 + 128 + 3 * (C.bx - 128) + i);
            } else for (int u = C.bx; u < 640; u += C.G) xattn_unit(C, l, u);
        }
        if (ph != 23) for (int r2 = 0; r2 < REP_SYNC; ++r2) xcd_barrier(xbar);
        {
            const int want = (k == 0 || k == 2 || k == 7 || k == 10) ? REP_GEMM : (k == 3 ? REP3 : (k == 4 ? REP4 : k == 5 ? REP5 : (k == 8 ? REP8 : 1)));
            if (rep + 1 < want) { ++rep; --ph; } else rep = 0;
        }
    }
}

extern "C" void kernel_launch(void* const* d_in, const int* in_sizes, int n_in, void* d_out, int out_size, void* d_ws, size_t ws_size, hipStream_t stream) {
    static int grid = 0;
    if (grid == 0) {
        if (n_in != 33 || ws_size < WS_TOTAL) { fprintf(stderr, "kernel_launch: need 33 inputs and %zu bytes of workspace; got %d inputs, %zu bytes\n", (size_t)WS_TOTAL, n_in, ws_size); grid = -1; return; }
        int dev = 0, cus = 0, per_cu = 0;
        (void)hipGetDevice(&dev); (void)hipDeviceGetAttribute(&cus, hipDeviceAttributeMultiprocessorCount, dev);
        if (hipFuncSetAttribute((const void*)hymba_fwd, hipFuncAttributeMaxDynamicSharedMemorySize, LDS_BYTES) != hipSuccess) { fprintf(stderr, "kernel_launch: hipFuncSetAttribute failed\n"); grid = -1; return; }
        if (hipOccupancyMaxActiveBlocksPerMultiprocessor(&per_cu, (const void*)hymba_fwd, 512, LDS_BYTES) != hipSuccess || per_cu < 1) { fprintf(stderr, "kernel_launch: occupancy query gave %d\n", per_cu); grid = -1; return; }
        grid = cus * per_cu;
    }
    if (grid < 0) return;
    Params p{};
    for (int i = 0; i < 33; ++i) p.in[i] = (const float*)d_in[i];
    p.out = (float*)d_out; p.ws = (unsigned char*)d_ws;
    void* args[] = {&p};
    hipError_t e = hipLaunchCooperativeKernel((const void*)hymba_fwd, dim3(grid), dim3(512), args, LDS_BYTES, stream);
    if (e != hipSuccess) fprintf(stderr, "kernel_launch: cooperative launch failed: %s (grid %d)\n", hipGetErrorString(e), grid);
}
```
